# Optimizing an MI355X kernel written in HIP

```python
import jax
import jax.numpy as jnp
from jax import lax
import numpy as np

D_MODEL = 4096
BATCH = 2
SEQ = 4096
DEPTH = 2

MEM_LEN = 256
CONV_W = 4
RMS_EPS = 1e-6
W_A = D_MODEL // 2
NB_A = 8
BS_A = W_A // NB_A
LRU_C = 8.0
W_B = D_MODEL // 2
N_B = 64
H_B = W_B // N_B
R_W = 96
R_A = 96
RWKV_GN_EPS = 64e-5
B_SHIFT_W = 3 * W_B + R_W + R_A
W_C = D_MODEL // 2
H_C = 4
DV_C = W_C // H_C
DQK_C = DV_C // 2
QK_W = H_C * DQK_C
CHUNK = 64
MLSTM_GN_EPS = 1e-6
H_X = 4
DH_X = 128
W_X = H_X * DH_X
N_BRANCH = 4
IN_SIZES = (W_A, W_A, B_SHIFT_W, W_B, 2 * QK_W, W_C, W_C, W_C, 2 * H_C, W_X, W_X, N_BRANCH * D_MODEL)
C_IN = sum(IN_SIZES)

kernel_name = 'hybrid_rglru_rwkv7_mlstm_memxattn'

F32 = jnp.float32


def rmsnorm(x, g, eps=RMS_EPS):
    xf = x.astype(F32)
    y = xf * lax.rsqrt(jnp.mean(xf * xf, axis=-1, keepdims=True) + eps)
    return (y * g.astype(F32)).astype(x.dtype)


def head_layernorm(y, w, b, eps):
    mu = jnp.mean(y, axis=-1, keepdims=True)
    yc = y - mu
    var = jnp.mean(yc * yc, axis=-1, keepdims=True)
    out = (yc * lax.rsqrt(var + eps)).reshape(y.shape[0], y.shape[1], -1) * w.astype(F32)
    if b is not None:
        out = out + b.astype(F32)
    return out


def causal_dwconv(u, w, b):
    k_w = w.shape[0]
    s = u.shape[1]
    up = jnp.pad(u, ((0, 0), (k_w - 1, 0), (0, 0)))
    return sum(up[:, j:j + s] * w[j] for j in range(k_w)) + b


def token_shift(p, mu):
    prev = jnp.pad(p, ((0, 0), (1, 0), (0, 0)))[:, :-1]
    return p + (prev - p) * mu


def _lin_combine(left, right):
    a1, b1 = left
    a2, b2 = right
    return a1 * a2, a2 * b1 + b2


def rg_lru_branch(u_in, gate, conv_w, conv_b, w_a, b_a, w_x, b_x, lam):
    bsz, s, _ = u_in.shape
    u = causal_dwconv(u_in, conv_w, conv_b)
    ub = u.reshape(bsz, s, NB_A, BS_A)
    r = jax.nn.sigmoid(jnp.einsum('bsnc,ncd->bsnd', ub, w_a).reshape(bsz, s, W_A) + b_a)
    i = jax.nn.sigmoid(jnp.einsum('bsnc,ncd->bsnd', ub, w_x).reshape(bsz, s, W_A) + b_x)
    log_a = (-LRU_C * r.astype(F32) * jax.nn.softplus(-lam.astype(F32)))
    a = jnp.exp(log_a)
    mult = jnp.sqrt(-jnp.expm1(2.0 * log_a))
    bterm = mult * (i * u).astype(F32)
    _, h = lax.associative_scan(_lin_combine, (a, bterm), axis=1)
    return (h * jax.nn.silu(gate.astype(F32))).astype(u_in.dtype)


def rwkv7_branch(p, gate, mu, w0, w_up, a0, a_up, k_k, k_a, r_k, gn_w, gn_b):
    bsz, s, _ = p.shape
    q = token_shift(p, mu)
    r, k, v, wd, ad = jnp.split(q, [W_B, 2 * W_B, 3 * W_B, 3 * W_B + R_W], axis=-1)
    w_log = -jax.nn.softplus(-(w0 + jnp.tanh(wd) @ w_up)) - 0.5
    decay = jnp.exp(-jnp.exp(w_log.astype(F32)))
    a = jax.nn.sigmoid(a0 + ad @ a_up)

    def heads(t):
        return t.astype(F32).reshape(bsz, s, H_B, N_B)

    r, k, v, decay, a = heads(r), heads(k), heads(v), heads(decay), heads(a)
    kk = k * k_k.astype(F32).reshape(H_B, N_B)
    kk = kk / jnp.maximum(jnp.sqrt(jnp.sum(kk * kk, axis=-1, keepdims=True)), 1e-12)
    k = k * (1.0 + (a - 1.0) * k_a.astype(F32).reshape(H_B, N_B))
    kka = kk * a

    def step(state, inp):
        r_t, w_t, k_t, v_t, kk_t, kka_t = inp
        sa = jnp.einsum('bhij,bhj->bhi', state, kk_t)
        state = (state * w_t[:, :, None, :] - sa[..., None] * kka_t[:, :, None, :]
                 + v_t[..., None] * k_t[:, :, None, :])
        return state, jnp.einsum('bhij,bhj->bhi', state, r_t)

    xs = tuple(jnp.moveaxis(t, 1, 0) for t in (r, decay, k, v, kk, kka))
    state0 = jnp.zeros((bsz, H_B, N_B, N_B), F32)
    _, y = lax.scan(step, state0, xs)
    y = head_layernorm(jnp.moveaxis(y, 0, 1), gn_w, gn_b, RWKV_GN_EPS)
    bonus = (jnp.sum(r * k * r_k.astype(F32), axis=-1, keepdims=True) * v).reshape(bsz, s, W_B)
    return ((y + bonus) * jax.nn.silu(gate.astype(F32))).astype(p.dtype)


def mlstm_branch(qk_in, v_in, o_in, gate, if_in, conv_w, conv_b, b_i, b_f, gn_w):
    bsz, s, _ = v_in.shape
    n_chunks = s // CHUNK
    qk = jax.nn.silu(causal_dwconv(qk_in, conv_w, conv_b))
    q, k = jnp.split(qk, 2, axis=-1)
    q = q.reshape(bsz, s, H_C, DQK_C)
    k = k.reshape(bsz, s, H_C, DQK_C) * (DQK_C ** -0.5)
    v = v_in.reshape(bsz, s, H_C, DV_C)
    i_pre, f_pre = jnp.split(if_in, 2, axis=-1)
    log_i = (i_pre + b_i).astype(F32)
    log_f = jax.nn.log_sigmoid((f_pre + b_f).astype(F32))

    def to_chunks(t):
        t = t.astype(F32).reshape(bsz, n_chunks, CHUNK, H_C, *t.shape[3:])
        return jnp.moveaxis(t, (1, 3), (0, 2))

    causal = jnp.tril(jnp.ones((CHUNK, CHUNK), dtype=bool))

    def chunk_step(carry, inp):
        c_st, n_st, m_st = carry
        qc, kc, vc, li, lf = inp
        bcum = jnp.cumsum(lf, axis=-1)
        g_tot = bcum[..., -1]
        dmat = bcum[..., :, None] - bcum[..., None, :] + li[..., None, :]
        dmat = jnp.where(causal, dmat, -jnp.inf)
        inter = bcum + m_st[..., None]
        m_t = jnp.maximum(inter, jnp.max(dmat, axis=-1))
        w_intra = jnp.exp(dmat - m_t[..., None])
        w_inter = jnp.exp(inter - m_t)
        sc = jnp.einsum('bhld,bhsd->bhls', qc, kc) * w_intra
        num = (w_inter[..., None] * jnp.einsum('bhld,bhde->bhle', qc, c_st)
               + jnp.einsum('bhls,bhse->bhle', sc, vc))
        den = w_inter * jnp.einsum('bhld,bhd->bhl', qc, n_st) + jnp.sum(sc, axis=-1)
        h = num / jnp.maximum(jnp.abs(den), jnp.exp(-m_t))[..., None]
        le = g_tot[..., None] - bcum + li
        m_new = jnp.maximum(g_tot + m_st, jnp.max(le, axis=-1))
        keep = jnp.exp(g_tot + m_st - m_new)
        wk = jnp.exp(le - m_new[..., None])
        c_st = keep[..., None, None] * c_st + jnp.einsum('bhs,bhsd,bhse->bhde', wk, kc, vc)
        n_st = keep[..., None] * n_st + jnp.einsum('bhs,bhsd->bhd', wk, kc)
        return (c_st, n_st, m_new), h

    c0 = jnp.zeros((bsz, H_C, DQK_C, DV_C), F32)
    n0 = jnp.zeros((bsz, H_C, DQK_C), F32)
    m0 = jnp.full((bsz, H_C), -jnp.inf, F32)
    _, h = lax.scan(chunk_step, (c0, n0, m0), tuple(to_chunks(t) for t in (q, k, v, log_i, log_f)))
    h = jnp.moveaxis(h, (0, 2), (1, 3)).reshape(bsz, s, H_C, DV_C)
    o = jax.nn.sigmoid(o_in.astype(F32)).reshape(bsz, s, H_C, DV_C)
    hn = head_layernorm(h * o, gn_w, None, MLSTM_GN_EPS)
    return (hn * jax.nn.silu(gate.astype(F32))).astype(v_in.dtype)


def memory_xattn_branch(q_in, gate, mem_n, w_kv):
    bsz, s, _ = q_in.shape
    m_len = mem_n.shape[1]
    k, v = jnp.split(mem_n @ w_kv, 2, axis=-1)
    k = k.reshape(bsz, m_len, H_X, DH_X)
    v = v.reshape(bsz, m_len, H_X, DH_X)
    q = q_in.reshape(bsz, s, H_X, DH_X)
    logits = jnp.einsum('bshd,bmhd->bhsm', q, k).astype(F32) * (DH_X ** -0.5)
    probs = jax.nn.softmax(logits, axis=-1).astype(v.dtype)
    o = jnp.einsum('bhsm,bmhd->bshd', probs, v).reshape(bsz, s, W_X)
    return (o * jax.nn.silu(gate)).astype(q_in.dtype)


def hybrid_layer(x, mem, norm_g, mem_norm_g, w_in,
                 lru_conv_w, lru_conv_b, lru_wa, lru_ba, lru_wx, lru_bx, lru_lambda,
                 rwkv_mu, rwkv_w0, rwkv_w_up, rwkv_a0, rwkv_a_up, rwkv_k_k, rwkv_k_a, rwkv_r_k,
                 rwkv_gn_w, rwkv_gn_b,
                 mlstm_conv_w, mlstm_conv_b, mlstm_b_i, mlstm_b_f, mlstm_gn_w,
                 xattn_w_kv, w_branch_a, w_branch_b, w_branch_c, w_branch_x, w_out):
    bsz, s, d = x.shape
    h = rmsnorm(x, norm_g)
    proj = h @ w_in
    cuts = [int(c) for c in np.cumsum(IN_SIZES)[:-1]]
    (a_x, a_g, b_s, b_g, c_qk, c_v, c_o, c_g, c_if, x_q, x_g,
     gate_logits) = jnp.split(proj, cuts, axis=-1)
    y_a = rg_lru_branch(a_x, a_g, lru_conv_w, lru_conv_b, lru_wa, lru_ba, lru_wx, lru_bx, lru_lambda)
    y_b = rwkv7_branch(b_s, b_g, rwkv_mu, rwkv_w0, rwkv_w_up, rwkv_a0, rwkv_a_up,
                       rwkv_k_k, rwkv_k_a, rwkv_r_k, rwkv_gn_w, rwkv_gn_b)
    y_c = mlstm_branch(c_qk, c_v, c_o, c_g, c_if, mlstm_conv_w, mlstm_conv_b,
                       mlstm_b_i, mlstm_b_f, mlstm_gn_w)
    y_x = memory_xattn_branch(x_q, x_g, rmsnorm(mem, mem_norm_g), xattn_w_kv)
    gates = jax.nn.sigmoid(gate_logits.reshape(bsz, s, N_BRANCH, d))
    merged = (gates[:, :, 0] * (y_a @ w_branch_a) + gates[:, :, 1] * (y_b @ w_branch_b)
              + gates[:, :, 2] * (y_c @ w_branch_c) + gates[:, :, 3] * (y_x @ w_branch_x))
    return x + merged @ w_out


def setup_inputs(seed: int = 0) -> dict:
    key = jax.random.key(seed)
    ks = iter(jax.random.split(key, 40))
    L, D = DEPTH, D_MODEL

    def nrm(shape, scale):
        return scale * jax.random.normal(next(ks), shape, F32)

    def uni(shape, lo, hi):
        return jax.random.uniform(next(ks), shape, F32, lo, hi)

    u_lru = uni((L, W_A), 0.9, 0.999) ** (1.0 / LRU_C)
    lru_lambda = jnp.log(u_lru) - jnp.log1p(-u_lru)
    return {
        'x': nrm((BATCH, SEQ, D), 1.0),
        'mem': nrm((BATCH, MEM_LEN, D), 1.0),
        'norm_g': 1.0 + nrm((L, D), 0.01),
        'mem_norm_g': 1.0 + nrm((L, D), 0.01),
        'w_in': nrm((L, D, C_IN), D ** -0.5),
        'lru_conv_w': nrm((L, CONV_W, W_A), CONV_W ** -0.5),
        'lru_conv_b': nrm((L, W_A), 0.01),
        'lru_wa': nrm((L, NB_A, BS_A, BS_A), BS_A ** -0.5),
        'lru_ba': nrm((L, W_A), 0.01),
        'lru_wx': nrm((L, NB_A, BS_A, BS_A), BS_A ** -0.5),
        'lru_bx': nrm((L, W_A), 0.01),
        'lru_lambda': lru_lambda,
        'rwkv_mu': uni((L, B_SHIFT_W), 0.0, 1.0),
        'rwkv_w0': uni((L, W_B), -6.0, -1.0),
        'rwkv_w_up': nrm((L, R_W, W_B), 0.5 * R_W ** -0.5),
        'rwkv_a0': nrm((L, W_B), 0.1),
        'rwkv_a_up': nrm((L, R_A, W_B), R_A ** -0.5),
        'rwkv_k_k': 0.85 + nrm((L, W_B), 0.05),
        'rwkv_k_a': 1.0 + nrm((L, W_B), 0.05),
        'rwkv_r_k': nrm((L, H_B, N_B), 0.1),
        'rwkv_gn_w': 1.0 + nrm((L, W_B), 0.01),
        'rwkv_gn_b': nrm((L, W_B), 0.01),
        'mlstm_conv_w': nrm((L, CONV_W, 2 * QK_W), CONV_W ** -0.5),
        'mlstm_conv_b': nrm((L, 2 * QK_W), 0.01),
        'mlstm_b_i': nrm((L, H_C), 0.1),
        'mlstm_b_f': uni((L, H_C), 3.0, 6.0),
        'mlstm_gn_w': 1.0 + nrm((L, W_C), 0.01),
        'xattn_w_kv': nrm((L, D, 2 * W_X), D ** -0.5),
        'w_branch_a': nrm((L, W_A, D), W_A ** -0.5),
        'w_branch_b': nrm((L, W_B, D), W_B ** -0.5),
        'w_branch_c': nrm((L, W_C, D), W_C ** -0.5),
        'w_branch_x': nrm((L, W_X, D), W_X ** -0.5),
        'w_out': nrm((L, D, D), D ** -0.5),
        'final_norm_g': 1.0 + nrm((D,), 0.01),
    }


def reference(x, mem, norm_g, mem_norm_g, w_in,
              lru_conv_w, lru_conv_b, lru_wa, lru_ba, lru_wx, lru_bx, lru_lambda,
              rwkv_mu, rwkv_w0, rwkv_w_up, rwkv_a0, rwkv_a_up, rwkv_k_k, rwkv_k_a, rwkv_r_k,
              rwkv_gn_w, rwkv_gn_b,
              mlstm_conv_w, mlstm_conv_b, mlstm_b_i, mlstm_b_f, mlstm_gn_w,
              xattn_w_kv, w_branch_a, w_branch_b, w_branch_c, w_branch_x, w_out, final_norm_g):
    for l in range(DEPTH):
        x = hybrid_layer(x, mem, norm_g[l], mem_norm_g[l], w_in[l],
                         lru_conv_w[l], lru_conv_b[l], lru_wa[l], lru_ba[l], lru_wx[l], lru_bx[l],
                         lru_lambda[l],
                         rwkv_mu[l], rwkv_w0[l], rwkv_w_up[l], rwkv_a0[l], rwkv_a_up[l],
                         rwkv_k_k[l], rwkv_k_a[l], rwkv_r_k[l], rwkv_gn_w[l], rwkv_gn_b[l],
                         mlstm_conv_w[l], mlstm_conv_b[l], mlstm_b_i[l], mlstm_b_f[l], mlstm_gn_w[l],
                         xattn_w_kv[l], w_branch_a[l], w_branch_b[l], w_branch_c[l], w_branch_x[l],
                         w_out[l])
    return rmsnorm(x, final_norm_g)
```

```cpp
#include <hip/hip_runtime.h>
#include <cstdio>
#include <cstdint>

#ifndef MK_PER_PHASE
#define MK_PER_PHASE 0
#endif

#define LAS __attribute__((address_space(3)))
#define GAS __attribute__((address_space(1)))
typedef unsigned short bf16;
typedef short bf16x8 __attribute__((ext_vector_type(8)));
typedef short s16x4 __attribute__((ext_vector_type(4)));
typedef float f32x4 __attribute__((ext_vector_type(4)));
typedef float f32x2 __attribute__((ext_vector_type(2)));
typedef unsigned u32x4 __attribute__((ext_vector_type(4)));
typedef unsigned u32x2 __attribute__((ext_vector_type(2)));
typedef int i32x4 __attribute__((ext_vector_type(4)));

constexpr int D = 4096, NBATCH = 2, SEQ = 4096, M = NBATCH * SEQ, DEPTH = 2, MEML = 256, MM = NBATCH * MEML;
constexpr int CIN = 38088;
constexpr int NPJ = 38400;
constexpr int PC_AX = 0, PC_AG = 2048, PC_BR = 4096, PC_BK = 6144, PC_BV = 8192, PC_BWD = 10240, PC_BAD = 10368, PC_BG = 10496,
              PC_CQK = 12544, PC_CV = 14592, PC_CG = 16640, PC_XQ = 18688, PC_XG = 19200, PC_IF = 19712, PC_CO = 19968, PC_GATE = 22016;
constexpr int PN_IF = PC_IF / 256;
constexpr int KCAT = 6656;
constexpr int YC_A = 0, YC_B = 2048, YC_C = 4096, YC_X = 6144;

constexpr size_t MiB = 1u << 20;
constexpr size_t WS_CTL = 0, CTL_ZERO_BYTES = 1 * MiB;
constexpr size_t SZ_WIN = 300 * MiB, SZ_WCAT = 52 * MiB, SZ_WOUT = 32 * MiB, SZ_WKV = 8 * MiB, SZ_WG = 2 * MiB, SZ_WL = 2 * MiB;
constexpr size_t SZ_WLAYER = SZ_WIN + SZ_WCAT + SZ_WOUT + SZ_WKV + SZ_WG + SZ_WL;
constexpr size_t WS_W = 1 * MiB;
constexpr size_t WO_WIN = 0, WO_WCAT = SZ_WIN, WO_WOUT = WO_WCAT + SZ_WCAT, WO_WKV = WO_WOUT + SZ_WOUT, WO_WG = WO_WKV + SZ_WKV, WO_WL = WO_WG + SZ_WG;
constexpr size_t WS_MEMN = WS_W + 2 * SZ_WLAYER;
constexpr size_t WS_KV = WS_MEMN + 8 * MiB;
constexpr size_t WS_H = WS_KV + 2 * MiB;
constexpr size_t WS_PROJ = WS_H + 64 * MiB;
constexpr size_t WS_IFB = WS_PROJ + 600 * MiB;
constexpr size_t WS_U = WS_IFB + 1 * MiB;
constexpr size_t WS_LA = WS_U + 32 * MiB;
constexpr size_t WS_LB = WS_LA + 64 * MiB;
constexpr size_t WS_CARRY = WS_LB + 64 * MiB;
constexpr size_t WS_LORA = WS_CARRY + 1 * MiB;
constexpr size_t WS_WDEC = WS_LORA + 4 * MiB;
constexpr size_t WS_AA = WS_WDEC + 64 * MiB;
constexpr size_t WS_RV = WS_AA + 64 * MiB;
constexpr size_t WS_VV = WS_RV + 320 * MiB;
constexpr size_t WS_BON = WS_VV + 64 * MiB;
constexpr size_t WS_YR = WS_BON + 1 * MiB;
constexpr size_t WS_QC = WS_YR + 64 * MiB;
constexpr size_t WS_KC = WS_QC + 16 * MiB;
constexpr size_t WS_SCAL = WS_KC + 16 * MiB;
constexpr size_t WS_HC = WS_SCAL + 1 * MiB;
constexpr size_t WS_Y = WS_HC + 64 * MiB;
constexpr size_t WS_MERGED = WS_Y + 104 * MiB;
constexpr size_t WS_X1 = WS_MERGED + 64 * MiB;
constexpr size_t WS_H8 = WS_X1 + 128 * MiB;
constexpr size_t WS_HS = WS_H8 + 32 * MiB;
constexpr size_t WS_END = WS_HS + 1 * MiB;
constexpr int CW_BAR = 4096, CW_QUEUE = 8192;
constexpr int CW_CMAX = 131072;
constexpr int NGATE = 16384, PC_I8 = PC_CO, N8 = 2048 + NGATE, PN_I8 = PC_I8 / 256;
#ifndef CONV1_IN_QUEUE
#define CONV1_IN_QUEUE 1
#endif
constexpr int CONV_NVB = 512;

constexpr int RING_BYTES = 155648;
constexpr int MISC_OFF = RING_BYTES;
constexpr int LDS_BYTES = 159744;
constexpr int NWAVES = 8, NTHREADS = 512;

__device__ __forceinline__ float bf2f(unsigned short b) { return __uint_as_float(((unsigned)b) << 16); }
__device__ __forceinline__ unsigned f2bf(float f) { unsigned u = __float_as_uint(f); return (u + 0x7fffu + ((u >> 16) & 1u)) >> 16; }
__device__ __forceinline__ unsigned pk2(float lo, float hi) { return f2bf(lo) | (f2bf(hi) << 16); }
__device__ __forceinline__ unsigned cvt_pk_bf16(float lo, float hi) { unsigned r; asm volatile("v_cvt_pk_bf16_f32 %0, %1, %2" : "=v"(r) : "v"(lo), "v"(hi)); return r; }
__device__ __forceinline__ float sigm(float x) { return __builtin_amdgcn_rcpf(1.0f + __expf(-x)); }
__device__ __forceinline__ float siluf_(float x) { return x * __builtin_amdgcn_rcpf(1.0f + __expf(-x)); }
__device__ __forceinline__ float softplusf_(float x) { return fmaxf(x, 0.f) + __logf(1.0f + __expf(-fabsf(x))); }
__device__ __forceinline__ float expm1s_(float x) { const float p = x * (1.0f + x * (0.5f + x * (0.16666667f + x * (0.041666668f + x * 0.0083333338f)))); return fabsf(x) < 0.25f ? p : __expf(x) - 1.0f; }

template <int CTRL> __device__ __forceinline__ float dpp_mov(float v) { return __int_as_float(__builtin_amdgcn_update_dpp(0, __float_as_int(v), CTRL, 0xf, 0xf, true)); }
__device__ __forceinline__ float row16_sum(float v) {
    v += dpp_mov<0xB1>(v); v += dpp_mov<0x4E>(v); v += dpp_mov<0x141>(v); v += dpp_mov<0x140>(v); return v;
}
__device__ __forceinline__ float wave_sum(float v) { v = row16_sum(v); v += __shfl_xor(v, 16); v += __shfl_xor(v, 32); return v; }
__device__ __forceinline__ float row16_max(float v) {
    v = fmaxf(v, dpp_mov<0xB1>(v)); v = fmaxf(v, dpp_mov<0x4E>(v)); v = fmaxf(v, dpp_mov<0x141>(v)); v = fmaxf(v, dpp_mov<0x140>(v)); return v;
}
__device__ __forceinline__ void unpack8(const u32x4 w, float* f) {
    f[0] = __uint_as_float(w.x << 16); f[1] = __uint_as_float(w.x & 0xffff0000u); f[2] = __uint_as_float(w.y << 16); f[3] = __uint_as_float(w.y & 0xffff0000u);
    f[4] = __uint_as_float(w.z << 16); f[5] = __uint_as_float(w.z & 0xffff0000u); f[6] = __uint_as_float(w.w << 16); f[7] = __uint_as_float(w.w & 0xffff0000u);
}
__device__ __forceinline__ int opaque_v(int v) { asm volatile("" : "+v"(v)); return v; }
template <class T> __device__ __forceinline__ const T* opaque_p(const T* p) { asm volatile("" : "+s"(p)); return p; }
__device__ __forceinline__ int opaque_s(int v) { asm volatile("" : "+s"(v)); return v; }
__device__ __forceinline__ int lane_id() { unsigned z; asm volatile("v_mov_b32 %0, 0" : "=v"(z)); return (int)__builtin_amdgcn_mbcnt_hi(~0u, __builtin_amdgcn_mbcnt_lo(~0u, z)); }
#define LDS_WAIT() asm volatile("s_waitcnt lgkmcnt(0)" ::: "memory")
#define VM_WAIT() asm volatile("s_waitcnt vmcnt(0)" ::: "memory")

#define XB_TMO      128
#define XB_XCNT(j)  (256  + 64 * (j))
#define XB_XSUB(j)  (1280 + 64 * (j))
#define XB_XGEN(j)  (2304 + 64 * (j))
#define XB_TOP      3328
#define XB_TOPGEN   3392
#define XCD_BAR_WORDS 3456
#define XB_SPIN_CAP (1u << 18)
__device__ __forceinline__ unsigned xb_ld(unsigned* p)              { return __hip_atomic_load(p, __ATOMIC_RELAXED, __HIP_MEMORY_SCOPE_AGENT); }
__device__ __forceinline__ unsigned xb_add(unsigned* p, unsigned v) { return __hip_atomic_fetch_add(p, v, __ATOMIC_RELAXED, __HIP_MEMORY_SCOPE_AGENT); }
__device__ __forceinline__ unsigned xb_xcc_id() { return (unsigned)__builtin_amdgcn_s_getreg((3 << 11) | 20) & 0xFu; }
#define XB_SPIN(cond, bar) do { unsigned _sp = 0; while (cond) { __builtin_amdgcn_s_sleep(1); \
    if ((++_sp & 255u) == 0u) { if (xb_ld(&(bar)[XB_TMO])) break; if (_sp > XB_SPIN_CAP) { atomicAdd(&(bar)[XB_TMO], 1u); break; } } } } while (0)
struct XcdBarrier { unsigned* bar; volatile LAS unsigned* st; };
__device__ __forceinline__ void xcd_barrier_setup(const XcdBarrier& b, const int wave_) {
    if (opaque_s(wave_) == 0 && lane_id() == 0) {
        unsigned* bar = b.bar; const unsigned x = xb_xcc_id();
        (void)xb_add(&bar[XB_XCNT(x)], 1u);
        const unsigned G = gridDim.x * gridDim.y * gridDim.z;
        unsigned sum, cnt, mine, sp = 0u;
        for (;;) {
            sum = 0u; cnt = 0u; mine = 0u;
            for (unsigned j = 0; j < 16; ++j) { const unsigned c = xb_ld(&bar[XB_XCNT(j)]); sum += c; cnt += (c > 0u) ? 1u : 0u; mine = (j == x) ? c : mine; }
            if (sum == G) break;
            __builtin_amdgcn_s_sleep(1);
            if ((++sp & 255u) == 0u) { if (xb_ld(&bar[XB_TMO])) break; if (sp > XB_SPIN_CAP) { atomicAdd(&bar[XB_TMO], 1u); break; } }
        }
        b.st[0] = mine > 0u ? mine : 1u; b.st[1] = cnt > 0u ? cnt : 1u; b.st[2] = x;
    }
    __syncthreads();
}
__device__ __forceinline__ void xcd_barrier(const XcdBarrier& b, const int wave_) {
    asm volatile("s_waitcnt vmcnt(0)" ::: "memory");
    __syncthreads();
    if (opaque_s(wave_) == 0 && lane_id() == 0) {
        unsigned* bar = b.bar;
        __builtin_amdgcn_s_waitcnt(0);
        const unsigned nloc = b.st[0], nx = b.st[1], x = b.st[2];
        const unsigned old = xb_add(&bar[XB_XSUB(x)], 1u);
        const unsigned gen = old / nloc;
        if (old + 1u == (gen + 1u) * nloc) {
            __builtin_amdgcn_fence(__ATOMIC_RELEASE, "agent");
            asm volatile("s_waitcnt vmcnt(0)" ::: "memory");
            const unsigned og = xb_add(&bar[XB_TOP], 1u);
            const unsigned tg = og / nx;
            if (og + 1u == (tg + 1u) * nx) xb_add(&bar[XB_TOPGEN], 1u);
            else XB_SPIN(xb_ld(&bar[XB_TOPGEN]) == tg, bar);
            __builtin_amdgcn_fence(__ATOMIC_ACQUIRE, "agent");
            xb_add(&bar[XB_XGEN(x)], 1u);
            asm volatile("s_waitcnt vmcnt(0)" ::: "memory");
        } else {
            XB_SPIN(xb_ld(&bar[XB_XGEN(x)]) == gen, bar);
            __builtin_amdgcn_fence(__ATOMIC_ACQUIRE, "agent");
            asm volatile("s_waitcnt vmcnt(0)" ::: "memory");
        }
    }
    __syncthreads();
}

namespace pg8 {
constexpr int BM = 256, BK = 64, HALF = 128, HTB = HALF * BK * 2, STAGE_BYTES = 8 * HTB, NXCD = 8, WGM = 8;
__host__ __device__ __forceinline__ int lds_byte(int r, int c) { const int st = (r >> 4) * 2 + (c >> 5), rr = r & 15, cc = c & 31, ob = rr * 64 + cc * 2; return st * 1024 + (ob ^ (((ob >> 9) & 1) << 5)); }
__host__ __device__ __forceinline__ void stage_rc(int b, int& R, int& C) { const int st = b / 1024, sb = b % 1024, swz = sb ^ (((sb >> 9) & 1) << 5); R = (st >> 1) * 16 + swz / 64; C = (st & 1) * 32 + (swz % 64) / 2; }
__host__ __device__ __forceinline__ int perm32(int rho) { const int n = rho >> 4, i = rho & 15; return 8 * (i >> 2) + 4 * n + (i & 3); }
struct Unit { int pm, pn; };
struct Gemm { const char* A; const char* Bt; };
template <int LDA_, int LDB_, int K_, int NM_, int NN_, int ASHIFT_ = 0, int ASTEP_ = 0, bool I8_ = false> struct Geo { static constexpr int LDA = LDA_, LDB = LDB_, K = K_, NM = NM_, NN = NN_, ASHIFT = ASHIFT_, ASTEP = ASTEP_; static constexpr bool I8 = I8_; };
template <bool I8> __device__ __forceinline__ f32x4 mma16(const bf16x8 a, const bf16x8 b, const f32x4 c) {
    if constexpr (I8) return __builtin_bit_cast(f32x4, __builtin_amdgcn_mfma_i32_16x16x64_i8(__builtin_bit_cast(i32x4, a), __builtin_bit_cast(i32x4, b), __builtin_bit_cast(i32x4, c), 0, 0, 0));
    else return __builtin_amdgcn_mfma_f32_16x16x32_bf16(a, b, c, 0, 0, 0); }
struct StaticOrder {
    int nM, nN, nwg, G, c;
    __device__ void init(int nM_, int nN_, int G_, int c_) { nM = nM_; nN = nN_; nwg = nM * nN; G = G_; c = c_; }
    __device__ bool next(int i, Unit& u) const {
        const long L = (long)i * G + c; if (L >= nwg) return false;
        int wgid = (int)L; { const int q = nwg / NXCD, r = nwg % NXCD, xcd = wgid % NXCD, off = wgid / NXCD; wgid = (xcd < r ? xcd * (q + 1) : r * (q + 1) + (xcd - r) * q) + off; }
        const int nig = WGM * nN, gid = wgid / nig, fm = gid * WGM, gsz = (nM - fm) < WGM ? (nM - fm) : WGM;
        u.pm = fm + ((wgid % nig) % gsz); u.pn = (wgid % nig) / gsz; return true;
    }
};
template <class GEO, class Epi>
__device__ __forceinline__ void gemm_phase(LAS unsigned char* lds, const Gemm g, const int G_, const int c_, const int wave_, const Epi& E) {
    StaticOrder S; S.init(GEO::NM, GEO::NN, opaque_s(G_), opaque_s(c_));
    const int wid = opaque_s(wave_), lane = lane_id(), tid = wid * 64 + lane, wr = wid >> 2, wc = wid & 3, fr = lane & 15, fq = lane >> 4;
    constexpr int nt = GEO::K / BK;
    unsigned voffA[2], voffB[2];
#pragma unroll
    for (int i = 0; i < 2; ++i) { int R, C; stage_rc(tid * 16 + i * 8192, R, C); const int Rb = Epi::PERM ? ((R & ~31) + perm32(R & 31)) : R;
        voffA[i] = (unsigned)(R * GEO::LDA + C * 2); voffB[i] = (unsigned)(Rb * GEO::LDB + C * 2); }
    constexpr size_t kstep = (size_t)(BK * 2);
    constexpr size_t hstepA = (size_t)HALF * GEO::LDA, hstepB = (size_t)HALF * GEO::LDB;
    const unsigned ldsw = (unsigned)wid * 1024u;
    const int aoff = lds_byte(wr * 64 + fr, fq * 8), boff = lds_byte(wc * 32 + fr, fq * 8);
#define PG8_SA(b, h) (((b) * 2 + (h)) * HTB)
#define PG8_SB(b, h) ((4 + (b) * 2 + (h)) * HTB)
#define PG8_STAGE(bufoff, gbase, voff) do { _Pragma("unroll") for (int _i = 0; _i < 2; ++_i) \
        __builtin_amdgcn_global_load_lds((const unsigned*)((const char*)(gbase) + (voff)[_i]), (LAS unsigned*)(lds + (bufoff) + ldsw + _i * 8192), 16, 0, 0); } while (0)
#define PG8_LDA(dst, b, h) do { _Pragma("unroll") for (int m = 0; m < 4; ++m) _Pragma("unroll") for (int k = 0; k < 2; ++k) dst[m][k] = *(const LAS bf16x8*)(lds + PG8_SA(b, h) + aoff + m * 2048 + k * 1024); } while (0)
#define PG8_LDB(dst, b, h) do { _Pragma("unroll") for (int n = 0; n < 2; ++n) _Pragma("unroll") for (int k = 0; k < 2; ++k) dst[n][k] = *(const LAS bf16x8*)(lds + PG8_SB(b, h) + boff + n * 2048 + k * 1024); } while (0)
#define PG8_MMA(ai, bj, At, Bt) do { __builtin_amdgcn_s_setprio(1); _Pragma("unroll") for (int m = 0; m < 4; ++m) _Pragma("unroll") for (int n = 0; n < 2; ++n) _Pragma("unroll") for (int k = 0; k < 2; ++k) \
        acc[ai][bj][m][n] = mma16<GEO::I8>(Bt[n][k], At[m][k], acc[ai][bj][m][n]); __builtin_amdgcn_s_setprio(0); } while (0)
#define PG8_WAIT_V(n) asm volatile("s_waitcnt vmcnt(" #n ")" ::: "memory")
#define PG8_WAIT_L(n) asm volatile("s_waitcnt lgkmcnt(" #n ")" ::: "memory")
#define PG8_BAR __builtin_amdgcn_s_barrier()
#define PG8_SCHED __builtin_amdgcn_sched_barrier(0)
    Unit cur, nxt; int ui = 0;
    if (!S.next(0, cur)) return;
    f32x4 acc[2][2][4][2];
#pragma unroll
    for (int a = 0; a < 2; ++a)
#pragma unroll
        for (int b = 0; b < 2; ++b)
#pragma unroll
            for (int m = 0; m < 4; ++m)
#pragma unroll
                for (int n = 0; n < 2; ++n) acc[a][b][m][n] = (f32x4){0.f, 0.f, 0.f, 0.f};
    bf16x8 At[4][2], B0[2][2], B1[2][2];
    const char* cA = g.A + (size_t)cur.pm * (BM * GEO::LDA) + (size_t)((cur.pn >> GEO::ASHIFT) * GEO::ASTEP);
    const char* cB = g.Bt + (size_t)cur.pn * (BM * GEO::LDB);
    PG8_STAGE(PG8_SB(0, 0), cB, voffB); PG8_STAGE(PG8_SB(0, 1), cB + hstepB, voffB); PG8_STAGE(PG8_SA(0, 0), cA, voffA); PG8_STAGE(PG8_SA(0, 1), cA + hstepA, voffA);
    if (wr == 1) PG8_BAR;
    PG8_WAIT_V(2); PG8_BAR;
    PG8_STAGE(PG8_SB(1, 0), cB + kstep, voffB); PG8_STAGE(PG8_SA(1, 0), cA + kstep, voffA); PG8_STAGE(PG8_SB(1, 1), cB + hstepB + kstep, voffB);
    PG8_WAIT_V(6); PG8_BAR;
    for (;;) {
        const bool has_next = S.next(ui + 1, nxt);
        const char* nA = has_next ? g.A + (size_t)nxt.pm * (BM * GEO::LDA) + (size_t)((nxt.pn >> GEO::ASHIFT) * GEO::ASTEP) : cA;
        const char* nB = has_next ? g.Bt + (size_t)nxt.pn * (BM * GEO::LDB) : cB;
#pragma unroll 1
        for (int t = 0; t < nt; t += 2) {
            const bool last = (t == nt - 2);
            const char* a1 = cA + (size_t)(t + 1) * kstep;
            const char* a2 = last ? nA : cA + (size_t)(t + 2) * kstep; const char* b2 = last ? nB : cB + (size_t)(t + 2) * kstep;
            const char* a3 = a2 + kstep; const char* b3 = b2 + kstep;
            if constexpr (Epi::HOOK) { if (t != 0 && (t & 31) == 0) E.hook(acc, cur, (t >> 5) - 1, wr, wc, fr, fq); }
            PG8_LDB(B0, 0, 0); PG8_LDB(B1, 0, 1); PG8_SCHED; PG8_LDA(At, 0, 0); PG8_STAGE(PG8_SA(1, 1), a1 + hstepA, voffA);
            PG8_WAIT_V(8); PG8_WAIT_L(0); PG8_BAR; PG8_MMA(0, 0, At, B0); PG8_MMA(0, 1, At, B1); PG8_BAR; PG8_SCHED;
            PG8_LDA(At, 0, 1); PG8_STAGE(PG8_SB(0, 0), b2, voffB); PG8_STAGE(PG8_SB(0, 1), b2 + hstepB, voffB); PG8_STAGE(PG8_SA(0, 0), a2, voffA);
            PG8_WAIT_V(8); PG8_WAIT_L(0); PG8_BAR; PG8_MMA(1, 0, At, B0); PG8_MMA(1, 1, At, B1); PG8_BAR; PG8_SCHED;
            PG8_LDB(B0, 1, 0); PG8_LDB(B1, 1, 1); PG8_SCHED; PG8_LDA(At, 1, 0); PG8_STAGE(PG8_SA(0, 1), a2 + hstepA, voffA);
            PG8_WAIT_V(8); PG8_WAIT_L(0); PG8_BAR; PG8_MMA(0, 0, At, B0); PG8_MMA(0, 1, At, B1); PG8_BAR; PG8_SCHED;
            PG8_LDA(At, 1, 1); PG8_STAGE(PG8_SB(1, 0), b3, voffB); PG8_STAGE(PG8_SB(1, 1), b3 + hstepB, voffB); PG8_STAGE(PG8_SA(1, 0), a3, voffA);
            PG8_WAIT_V(8); PG8_WAIT_L(0); PG8_BAR; PG8_MMA(1, 0, At, B0); PG8_MMA(1, 1, At, B1); PG8_BAR; PG8_SCHED;
        }
        if (wr == 0) PG8_BAR;
        E(acc, cur, wr, wc, fr, fq);
        if (!has_next) break;
#pragma unroll
        for (int a = 0; a < 2; ++a)
#pragma unroll
            for (int b = 0; b < 2; ++b)
#pragma unroll
                for (int m = 0; m < 4; ++m)
#pragma unroll
                    for (int n = 0; n < 2; ++n) acc[a][b][m][n] = (f32x4){0.f, 0.f, 0.f, 0.f};
        cur = nxt; cA = nA; cB = nB; ++ui;
        if (wr == 1) PG8_BAR;
    }
    PG8_WAIT_V(0);
    PG8_BAR;
#undef PG8_SA
#undef PG8_SB
#undef PG8_STAGE
#undef PG8_LDA
#undef PG8_LDB
#undef PG8_MMA
#undef PG8_WAIT_V
#undef PG8_WAIT_L
#undef PG8_BAR
#undef PG8_SCHED
}
}

struct Ctx { const float* in[34]; float* out; unsigned char* ws; };
enum { I_X = 0, I_MEM, I_NORM_G, I_MEMNORM_G, I_WIN, I_LRU_CW, I_LRU_CB, I_LRU_WA, I_LRU_BA, I_LRU_WX, I_LRU_BX, I_LRU_LAM, I_MU, I_W0, I_WUP, I_A0, I_AUP,
       I_KK, I_KA, I_RK, I_GNW, I_GNB, I_MCW, I_MCB, I_MBI, I_MBF, I_MGNW, I_WKV, I_WBA, I_WBB, I_WBC, I_WBX, I_WOUT, I_FNG };


typedef const __attribute__((address_space(4))) char* kargp_t;
template <int OFF> __device__ __forceinline__ unsigned long long karg_u64() {
    kargp_t kp = (kargp_t)__builtin_amdgcn_kernarg_segment_ptr(); unsigned long long v;
    asm volatile("s_load_dwordx2 %0, %1, %2\n\ts_waitcnt lgkmcnt(0)" : "=s"(v) : "s"(kp), "i"(OFF)); return v; }
#define KIN(i) ((const float*)(const GAS float*)karg_u64<(i) * 8>())
#define KOUT() ((float*)(GAS float*)karg_u64<34 * 8>())
#define KWS() ((unsigned char*)(GAS unsigned char*)karg_u64<35 * 8>())

template <int ldc, bool HAS_IF> struct EpiProj {
    static constexpr bool PERM = true, HOOK = false;
    bf16* O; float* ifb;
    __device__ __forceinline__ void operator()(const f32x4 (&acc)[2][2][4][2], const pg8::Unit& u, int wr, int wc, int fr, int fq) const {
        const int row0 = u.pm * 256 + wr * 64 + fr, col0 = u.pn * 256 + wc * 32 + 8 * fq;
#pragma unroll
        for (int ai = 0; ai < 2; ++ai)
#pragma unroll
            for (int m = 0; m < 4; ++m) { const int row = row0 + ai * 128 + m * 16; bf16* rowp = O + (size_t)row * ldc + col0;
#pragma unroll
                for (int bj = 0; bj < 2; ++bj) { const f32x4 v0 = acc[ai][bj][m][0], v1 = acc[ai][bj][m][1];
                    u32x4 w; w.x = cvt_pk_bf16(v0[0], v0[1]); w.y = cvt_pk_bf16(v0[2], v0[3]); w.z = cvt_pk_bf16(v1[0], v1[1]); w.w = cvt_pk_bf16(v1[2], v1[3]);
                    *(u32x4*)(rowp + bj * 128) = w; }
                if (HAS_IF && u.pn == PN_IF && wc == 0 && fq == 0) { *(f32x4*)(ifb + (size_t)row * 8) = acc[ai][0][m][0]; *(f32x4*)(ifb + (size_t)row * 8 + 4) = acc[ai][0][m][1]; }
            }
    }
};
__device__ __forceinline__ void gl2n_issue(u32x4& a0, u32x4& a1, const void* pa, unsigned voff) {
    asm volatile("s_nop 4\n\tglobal_load_dwordx4 %0, %2, %3\n\tglobal_load_dwordx4 %1, %2, %3 offset:16" : "=&v"(a0), "=&v"(a1) : "v"(voff), "s"(pa) : "memory"); }
#define GL_WAIT4(g) asm volatile("s_waitcnt vmcnt(0)" : "+v"(g[0]), "+v"(g[1]), "+v"(g[2]), "+v"(g[3]) :: "memory")
struct EpiGate8 {
    static constexpr bool PERM = true, HOOK = false;
    bf16* O; const float* hs; const unsigned* cmax;
    __device__ __forceinline__ void operator()(const f32x4 (&acc)[2][2][4][2], const pg8::Unit& u, int wr, int wc, int fr, int fq) const {
        const int row0 = u.pm * 256 + wr * 64 + fr, col0 = u.pn * 256 + wc * 32 + 8 * fq;
        u32x4 cs[4]; const unsigned coff = (unsigned)((wc * 32 + 8 * fq) * 4);
        gl2n_issue(cs[0], cs[1], cmax + u.pn * 256, coff); gl2n_issue(cs[2], cs[3], cmax + u.pn * 256 + 128, coff);
        float rsv[8]; { const float* hb = hs + u.pm * 256 + wr * 64; const unsigned roff = (unsigned)(fr * 4);
            asm volatile("s_nop 4\n\tglobal_load_dword %0, %8, %9\n\tglobal_load_dword %1, %8, %9 offset:64\n\tglobal_load_dword %2, %8, %9 offset:128\n\tglobal_load_dword %3, %8, %9 offset:192\n\t"
                         "global_load_dword %4, %8, %9 offset:512\n\tglobal_load_dword %5, %8, %9 offset:576\n\tglobal_load_dword %6, %8, %9 offset:640\n\tglobal_load_dword %7, %8, %9 offset:704\n\ts_waitcnt vmcnt(0)"
                         : "=&v"(rsv[0]), "=&v"(rsv[1]), "=&v"(rsv[2]), "=&v"(rsv[3]), "=&v"(rsv[4]), "=&v"(rsv[5]), "=&v"(rsv[6]), "=&v"(rsv[7]) : "v"(roff), "s"(hb) : "memory"); }
        GL_WAIT4(cs);
        float wsc[2][8];
#pragma unroll
        for (int bj = 0; bj < 2; ++bj)
#pragma unroll
            for (int j = 0; j < 8; ++j) wsc[bj][j] = __uint_as_float(cs[2 * bj + (j >> 2)][j & 3]) * (1.0f / 127.0f);
#pragma unroll
        for (int ai = 0; ai < 2; ++ai)
#pragma unroll
            for (int m = 0; m < 4; ++m) { const int row = row0 + ai * 128 + m * 16; const float rs = rsv[ai * 4 + m]; bf16* rowp = O + (size_t)row * NPJ + col0;
#pragma unroll
                for (int bj = 0; bj < 2; ++bj) { const i32x4 v0 = __builtin_bit_cast(i32x4, acc[ai][bj][m][0]), v1 = __builtin_bit_cast(i32x4, acc[ai][bj][m][1]);
                    u32x4 w; w.x = cvt_pk_bf16((float)v0[0] * (rs * wsc[bj][0]), (float)v0[1] * (rs * wsc[bj][1])); w.y = cvt_pk_bf16((float)v0[2] * (rs * wsc[bj][2]), (float)v0[3] * (rs * wsc[bj][3]));
                    w.z = cvt_pk_bf16((float)v1[0] * (rs * wsc[bj][4]), (float)v1[1] * (rs * wsc[bj][5])); w.w = cvt_pk_bf16((float)v1[2] * (rs * wsc[bj][6]), (float)v1[3] * (rs * wsc[bj][7]));
                    *(u32x4*)(rowp + bj * 128) = w; } }
    }
};
struct EpiLru {
    static constexpr bool PERM = true, HOOK = false;
    const bf16* U; float* LA; float* LB; const float* ba; const float* bx; const float* lam;
    __device__ __forceinline__ void operator()(const f32x4 (&acc)[2][2][4][2], const pg8::Unit& u, int wr, int wc, int fr, int fq) const {
        const int row0 = u.pm * 256 + wr * 64 + fr, ch0 = u.pn * 128 + wc * 32 + 8 * fq;
        float cba[8], cbx[8], csp[8];
#pragma unroll
        for (int j = 0; j < 8; ++j) { cba[j] = ba[ch0 + j]; cbx[j] = bx[ch0 + j]; csp[j] = -8.0f * softplusf_(-lam[ch0 + j]); }
        u32x4 uws[8];
#pragma unroll
        for (int i = 0; i < 8; ++i) uws[i] = *(const u32x4*)(U + (size_t)(row0 + (i >> 2) * 128 + (i & 3) * 16) * 2048 + ch0);
        asm volatile("" ::: "memory");
#pragma unroll
        for (int ai = 0; ai < 2; ++ai)
#pragma unroll
            for (int m = 0; m < 4; ++m) { const int row = row0 + ai * 128 + m * 16;
                float uf[8]; unpack8(uws[ai * 4 + m], uf);
                float a8[8], b8[8];
#pragma unroll
                for (int n = 0; n < 2; ++n)
#pragma unroll
                    for (int j = 0; j < 4; ++j) { const int q = 4 * n + j;
                        const float r = sigm(acc[ai][0][m][n][j] + cba[q]), ig = sigm(acc[ai][1][m][n][j] + cbx[q]);
                        const float la = csp[q] * r; a8[q] = __expf(la); b8[q] = sqrtf(-expm1s_(2.0f * la)) * (ig * uf[q]); }
                float* pa = LA + (size_t)row * 2048 + ch0; float* pb = LB + (size_t)row * 2048 + ch0;
                *(f32x4*)pa = (f32x4){a8[0], a8[1], a8[2], a8[3]}; *(f32x4*)(pa + 4) = (f32x4){a8[4], a8[5], a8[6], a8[7]};
                *(f32x4*)pb = (f32x4){b8[0], b8[1], b8[2], b8[3]}; *(f32x4*)(pb + 4) = (f32x4){b8[4], b8[5], b8[6], b8[7]};
            }
    }
};
struct EpiLora {
    static constexpr bool PERM = true, HOOK = false;
    float* WDEC; float* AA; const float* w0; const float* a0;
    __device__ __forceinline__ void operator()(const f32x4 (&acc)[2][2][4][2], const pg8::Unit& u, int wr, int wc, int fr, int fq) const {
        const int row0 = u.pm * 256 + wr * 64 + fr, ch0 = u.pn * 128 + wc * 32 + 8 * fq;
        float cw0[8], ca0[8];
#pragma unroll
        for (int j = 0; j < 8; ++j) { cw0[j] = w0[ch0 + j]; ca0[j] = a0[ch0 + j]; }
#pragma unroll
        for (int ai = 0; ai < 2; ++ai)
#pragma unroll
            for (int m = 0; m < 4; ++m) { const int row = row0 + ai * 128 + m * 16; float d8[8], a8[8];
#pragma unroll
                for (int n = 0; n < 2; ++n)
#pragma unroll
                    for (int j = 0; j < 4; ++j) { const int q = 4 * n + j;
                        const float wl = -softplusf_(-(cw0[q] + acc[ai][0][m][n][j])) - 0.5f; d8[q] = __expf(-__expf(wl)); a8[q] = sigm(ca0[q] + acc[ai][1][m][n][j]); }
                float* pd = WDEC + ((((size_t)((row >> 12) * 32 + (ch0 >> 6)) * SEQ + (row & (SEQ - 1))) * 5 + 1) * 64 + (ch0 & 63)); float* pa = AA + (size_t)row * 2048 + ch0;
                *(f32x4*)pd = (f32x4){d8[0], d8[1], d8[2], d8[3]}; *(f32x4*)(pd + 4) = (f32x4){d8[4], d8[5], d8[6], d8[7]};
                *(f32x4*)pa = (f32x4){a8[0], a8[1], a8[2], a8[3]}; *(f32x4*)(pa + 4) = (f32x4){a8[4], a8[5], a8[6], a8[7]};
            }
    }
};
__device__ __forceinline__ void gl2_issue(u32x4& a0, u32x4& a1, const void* pa, unsigned voff) {
    asm volatile("s_nop 4\n\tglobal_load_dwordx4 %0, %2, %3\n\tglobal_load_dwordx4 %1, %2, %3 offset:256" : "=&v"(a0), "=&v"(a1) : "v"(voff), "s"(pa) : "memory"); }
__device__ __forceinline__ void gl4f_issue(u32x4& a0, u32x4& a1, u32x4& a2, u32x4& a3, const void* pa, unsigned voff) {
    asm volatile("s_nop 4\n\tglobal_load_dwordx4 %0, %4, %5\n\tglobal_load_dwordx4 %1, %4, %5 offset:64\n\tglobal_load_dwordx4 %2, %4, %5 offset:512\n\tglobal_load_dwordx4 %3, %4, %5 offset:576"
                 : "=&v"(a0), "=&v"(a1), "=&v"(a2), "=&v"(a3) : "v"(voff), "s"(pa) : "memory"); }
#define GL_WAIT8(g) asm volatile("s_waitcnt vmcnt(0)" : "+v"(g[0]), "+v"(g[1]), "+v"(g[2]), "+v"(g[3]), "+v"(g[4]), "+v"(g[5]), "+v"(g[6]), "+v"(g[7]) :: "memory")
#define GL_WAIT16(g) asm volatile("s_waitcnt vmcnt(0)" : "+v"(g[0]), "+v"(g[1]), "+v"(g[2]), "+v"(g[3]), "+v"(g[4]), "+v"(g[5]), "+v"(g[6]), "+v"(g[7]), \
                                  "+v"(g[8]), "+v"(g[9]), "+v"(g[10]), "+v"(g[11]), "+v"(g[12]), "+v"(g[13]), "+v"(g[14]), "+v"(g[15]) :: "memory")
struct EpiMerge {
    static constexpr bool PERM = true, HOOK = true;
    const bf16* GL; bf16* O; static constexpr int ldg = NPJ;
    __device__ __forceinline__ void hook(f32x4 (&acc)[2][2][4][2], const pg8::Unit& u, int br, int wr, int wc, int fr, int fq) const {
        const unsigned voff = (unsigned)(fr * (ldg * 2) + (wc * 32 + 8 * fq) * 2);
        const char* base = (const char*)GL + ((size_t)(u.pm * 256 + wr * 64) * ldg + br * 4096 + u.pn * 256) * 2;
#pragma unroll
        for (int ai = 0; ai < 2; ++ai) { u32x4 g[16];
#pragma unroll
            for (int m = 0; m < 4; ++m) { const char* pm_ = base + (size_t)(ai * 128 + m * 16) * (ldg * 2); gl2_issue(g[4 * m], g[4 * m + 1], pm_, voff); gl2_issue(g[4 * m + 2], g[4 * m + 3], pm_ + 8192, voff); }
            GL_WAIT16(g);
#pragma unroll
            for (int m = 0; m < 4; ++m)
#pragma unroll
                for (int bj = 0; bj < 2; ++bj) { float f0[8], f1[8]; unpack8(g[4 * m + bj], f0); unpack8(g[4 * m + 2 + bj], f1);
#pragma unroll
                    for (int n = 0; n < 2; ++n)
#pragma unroll
                        for (int j = 0; j < 4; ++j) { const int q = 4 * n + j; acc[ai][bj][m][n][j] *= (1.0f + __expf(-f1[q])) * __builtin_amdgcn_rcpf(1.0f + __expf(-f0[q])); } } }
    }
    __device__ __forceinline__ void operator()(const f32x4 (&acc)[2][2][4][2], const pg8::Unit& u, int wr, int wc, int fr, int fq) const {
        const int row0 = u.pm * 256 + wr * 64 + fr, col0 = u.pn * 256 + wc * 32 + 8 * fq;
        const unsigned voff = (unsigned)(fr * (ldg * 2) + (wc * 32 + 8 * fq) * 2);
        const char* base = (const char*)GL + ((size_t)(u.pm * 256 + wr * 64) * ldg + 3 * 4096 + u.pn * 256) * 2;
#pragma unroll
        for (int ai = 0; ai < 2; ++ai) { u32x4 g[8];
#pragma unroll
            for (int m = 0; m < 4; ++m) gl2_issue(g[2 * m], g[2 * m + 1], base + (size_t)(ai * 128 + m * 16) * (ldg * 2), voff);
            GL_WAIT8(g);
#pragma unroll
            for (int m = 0; m < 4; ++m) { const int row = row0 + ai * 128 + m * 16;
#pragma unroll
                for (int bj = 0; bj < 2; ++bj) { float f[8]; unpack8(g[2 * m + bj], f);
                    const f32x4 v0 = acc[ai][bj][m][0], v1 = acc[ai][bj][m][1];
                    u32x4 w; w.x = cvt_pk_bf16(v0[0] * sigm(f[0]), v0[1] * sigm(f[1])); w.y = cvt_pk_bf16(v0[2] * sigm(f[2]), v0[3] * sigm(f[3]));
                    w.z = cvt_pk_bf16(v1[0] * sigm(f[4]), v1[1] * sigm(f[5])); w.w = cvt_pk_bf16(v1[2] * sigm(f[6]), v1[3] * sigm(f[7]));
                    *(u32x4*)(O + (size_t)row * 4096 + col0 + bj * 128) = w; } } }
    }
};
struct EpiOut {
    static constexpr bool PERM = false, HOOK = false;
    const float* XI; float* XO;
    __device__ __forceinline__ void operator()(const f32x4 (&acc)[2][2][4][2], const pg8::Unit& u, int wr, int wc, int fr, int fq) const {
        const int row0 = u.pm * 256 + wr * 64 + fr, col0 = u.pn * 256 + wc * 32 + 4 * fq;
        const unsigned voff = (unsigned)(fr * 16384 + (wc * 32 + 4 * fq) * 4);
        const char* base = (const char*)XI + ((size_t)(u.pm * 256 + wr * 64) * 4096 + u.pn * 256) * 4;
#pragma unroll
        for (int ai = 0; ai < 2; ++ai) { u32x4 g[16];
#pragma unroll
            for (int m = 0; m < 4; ++m) gl4f_issue(g[4 * m], g[4 * m + 1], g[4 * m + 2], g[4 * m + 3], base + (size_t)(ai * 128 + m * 16) * 16384, voff);
            GL_WAIT16(g);
#pragma unroll
            for (int m = 0; m < 4; ++m) { const size_t off = (size_t)(row0 + ai * 128 + m * 16) * 4096 + col0;
#pragma unroll
                for (int bj = 0; bj < 2; ++bj)
#pragma unroll
                    for (int n = 0; n < 2; ++n) { const f32x4 xi = __builtin_bit_cast(f32x4, g[4 * m + 2 * bj + n]); *(f32x4*)(XO + off + bj * 128 + n * 16) = xi + acc[ai][bj][m][n]; } } }
    }
};

struct Frame { LAS unsigned char* lds; int tid, lane, wave, bid, nblk; };
__device__ __forceinline__ Frame reframe(const Frame& G) { Frame F; F.lds = G.lds; F.wave = opaque_s(G.wave); F.lane = lane_id(); F.tid = F.wave * 64 + F.lane; F.bid = opaque_s(G.bid); F.nblk = opaque_s(G.nblk); return F; }

__device__ __forceinline__ void tr_item(const float* W, size_t ldw, bf16* WT, size_t ldt, LAS float* scr, int k0, int n0, int lane) {
    float tv[32];
#pragma unroll
    for (int i = 0; i < 32; ++i) tv[i] = W[(size_t)(k0 + 2 * i + (lane >> 5)) * ldw + n0 + (lane & 31)];
#pragma unroll
    for (int i = 0; i < 32; ++i) scr[(2 * i + (lane >> 5)) * 33 + (lane & 31)] = tv[i];
    LDS_WAIT(); asm volatile("" ::: "memory");
    const int c = lane & 7;
#pragma unroll
    for (int j = 0; j < 4; ++j) { const int n = (lane >> 3) + 8 * j; const LAS float* s = scr + (8 * c) * 33 + n;
        u32x4 o; o.x = pk2(s[0 * 33], s[1 * 33]); o.y = pk2(s[2 * 33], s[3 * 33]); o.z = pk2(s[4 * 33], s[5 * 33]); o.w = pk2(s[6 * 33], s[7 * 33]);
        *(u32x4*)(WT + (size_t)(n0 + n) * ldt + k0 + 8 * c) = o; }
    LDS_WAIT(); asm volatile("" ::: "memory");
}
__device__ __forceinline__ void tr_job(const Frame& F, const float* W, size_t ldw, int K, int ncols, bf16* WT, size_t ldt) {
    LAS float* scr = (LAS float*)(F.lds + F.wave * 16384);
    const int gw = F.bid * NWAVES + F.wave, NGW = F.nblk * NWAVES, nb = ncols / 32, items = (K / 64) * nb;
    for (int it = gw; it < items; it += NGW) tr_item(W, ldw, WT, ldt, scr, 64 * (it / nb), 32 * (it % nb), F.lane);
}
__device__ __forceinline__ void tr8_item(const float* W, size_t ldw, signed char* WT, const unsigned* cmax, LAS float* scr, int k0, int n0, int lane) {
    float tv[32];
#pragma unroll
    for (int i = 0; i < 32; ++i) tv[i] = W[(size_t)(k0 + 2 * i + (lane >> 5)) * ldw + n0 + (lane & 31)];
#pragma unroll
    for (int i = 0; i < 32; ++i) scr[(2 * i + (lane >> 5)) * 33 + (lane & 31)] = tv[i];
    LDS_WAIT(); asm volatile("" ::: "memory");
    const int n = lane >> 1, hh = lane & 1; const float am = __uint_as_float(cmax[n0 + n]); const float inv = am > 0.f ? 127.0f / am : 0.f;
#pragma unroll
    for (int c = 0; c < 2; ++c) { const LAS float* sp = scr + (32 * hh + 16 * c) * 33 + n; unsigned wq[4];
#pragma unroll
        for (int q = 0; q < 4; ++q) { const int a0 = (int)rintf(sp[(4 * q) * 33] * inv), a1 = (int)rintf(sp[(4 * q + 1) * 33] * inv), a2 = (int)rintf(sp[(4 * q + 2) * 33] * inv), a3 = (int)rintf(sp[(4 * q + 3) * 33] * inv);
            wq[q] = (unsigned)(a0 & 255) | ((unsigned)(a1 & 255) << 8) | ((unsigned)(a2 & 255) << 16) | ((unsigned)(a3 & 255) << 24); }
        *(u32x4*)(WT + (size_t)(n0 + n) * 4096 + k0 + 32 * hh + 16 * c) = (u32x4){wq[0], wq[1], wq[2], wq[3]}; }
    LDS_WAIT(); asm volatile("" ::: "memory");
}
__device__ __forceinline__ void tr8_job(const Frame& F, const float* W, size_t ldw, int K, int ncols, signed char* WT, const unsigned* cmax) {
    LAS float* scr = (LAS float*)(F.lds + F.wave * 16384);
    const int gw = F.bid * NWAVES + F.wave, NGW = F.nblk * NWAVES, nb = ncols / 32, items = (K / 64) * nb;
    for (int it = gw; it < items; it += NGW) tr8_item(W, ldw, WT, cmax, scr, 64 * (it / nb), 32 * (it % nb), F.lane);
}
__device__ __forceinline__ void phase_gate_absmax(const Frame& F0) {
    const Frame F = reframe(F0);
    unsigned* cmax = (unsigned*)(KWS() + WS_CTL) + CW_CMAX;
    const int gw = F.bid * NWAVES + F.wave, NGW = F.nblk * NWAVES, lane = F.lane, c4 = lane & 15, rsub = lane >> 4;
    for (int it = gw; it < DEPTH * (N8 / 64) * 32; it += NGW) { const int l = it / ((N8 / 64) * 32), g64 = (it >> 5) % (N8 / 64), kc = it & 31;
        const float* w = KIN(I_WIN) + (size_t)l * 4096 * CIN + (size_t)(kc * 128 + rsub) * CIN + (g64 < 32 ? 16576 + g64 * 64 : 21704 + (g64 - 32) * 64) + 4 * c4;
        f32x4 m = (f32x4){0.f, 0.f, 0.f, 0.f};
        for (int i0 = 0; i0 < 32; i0 += 16) { f32x4 tv[16];
#pragma unroll
            for (int i = 0; i < 16; ++i) tv[i] = *(const f32x4*)(w + (size_t)(4 * (i0 + i)) * CIN);
            asm volatile("" : "+v"(tv[0]), "+v"(tv[1]), "+v"(tv[2]), "+v"(tv[3]), "+v"(tv[4]), "+v"(tv[5]), "+v"(tv[6]), "+v"(tv[7]), "+v"(tv[8]), "+v"(tv[9]), "+v"(tv[10]), "+v"(tv[11]), "+v"(tv[12]), "+v"(tv[13]), "+v"(tv[14]), "+v"(tv[15]) :: "memory");
#pragma unroll
            for (int i = 0; i < 16; ++i) { m.x = fmaxf(m.x, fabsf(tv[i].x)); m.y = fmaxf(m.y, fabsf(tv[i].y)); m.z = fmaxf(m.z, fabsf(tv[i].z)); m.w = fmaxf(m.w, fabsf(tv[i].w)); } }
#pragma unroll
        for (int q = 0; q < 4; ++q) { float v = m[q]; v = fmaxf(v, __shfl_xor(v, 16)); v = fmaxf(v, __shfl_xor(v, 32)); m[q] = v; }
        if (lane < 16) { unsigned* cp = cmax + l * N8 + g64 * 64 + 4 * c4; atomicMax(cp, __float_as_uint(m.x)); atomicMax(cp + 1, __float_as_uint(m.y)); atomicMax(cp + 2, __float_as_uint(m.z)); atomicMax(cp + 3, __float_as_uint(m.w)); } }
}
__device__ __forceinline__ void rms_row_bf16(const float* x, const float* g, bf16* o, int lane, signed char* q8 = nullptr, float* qs = nullptr) {
    const f32x4* xr = (const f32x4*)x + lane; const f32x4* gr = (const f32x4*)g + lane; f32x4 v[16], gv[16]; float ss = 0.f;
#pragma unroll
    for (int j = 0; j < 16; ++j) v[j] = xr[64 * j];
#pragma unroll
    for (int j = 0; j < 16; ++j) gv[j] = gr[64 * j];
    asm volatile("" ::: "memory");
#pragma unroll
    for (int j = 0; j < 16; ++j) ss += (v[j].x * v[j].x + v[j].y * v[j].y) + (v[j].z * v[j].z + v[j].w * v[j].w);
    const float r = rsqrtf(wave_sum(ss) * (1.0f / 4096.0f) + 1e-6f);
    u32x2* o8 = (u32x2*)o + lane; float am = 0.f;
#pragma unroll
    for (int j = 0; j < 16; ++j) { const f32x4 gg = gv[j]; v[j] = (f32x4){v[j].x * r * gg.x, v[j].y * r * gg.y, v[j].z * r * gg.z, v[j].w * r * gg.w};
        u32x2 w; w.x = pk2(v[j].x, v[j].y); w.y = pk2(v[j].z, v[j].w); o8[64 * j] = w;
        am = fmaxf(fmaxf(am, fmaxf(fabsf(v[j].x), fabsf(v[j].y))), fmaxf(fabsf(v[j].z), fabsf(v[j].w))); }
    if (q8 != nullptr) {
        am = row16_max(am); am = fmaxf(am, __shfl_xor(am, 16)); am = fmaxf(am, __shfl_xor(am, 32));
        const float inv = am > 0.f ? 127.0f / am : 0.f; unsigned* q4 = (unsigned*)q8 + lane;
#pragma unroll
        for (int j = 0; j < 16; ++j) { const int a0 = (int)rintf(v[j].x * inv), a1 = (int)rintf(v[j].y * inv), a2 = (int)rintf(v[j].z * inv), a3 = (int)rintf(v[j].w * inv);
            q4[64 * j] = (unsigned)(a0 & 255) | ((unsigned)(a1 & 255) << 8) | ((unsigned)(a2 & 255) << 16) | ((unsigned)(a3 & 255) << 24); }
        if (lane == 0) *qs = am * (1.0f / 127.0f); }
}
__device__ __forceinline__ void rms_row_f32(const float* x, const float* g, float* o, int lane) {
    const f32x4* xr = (const f32x4*)x + lane; const f32x4* gr = (const f32x4*)g + lane; f32x4 v[16], gv[16]; float ss = 0.f;
#pragma unroll
    for (int j = 0; j < 16; ++j) v[j] = xr[64 * j];
#pragma unroll
    for (int j = 0; j < 16; ++j) gv[j] = gr[64 * j];
    asm volatile("" ::: "memory");
#pragma unroll
    for (int j = 0; j < 16; ++j) ss += (v[j].x * v[j].x + v[j].y * v[j].y) + (v[j].z * v[j].z + v[j].w * v[j].w);
    const float r = rsqrtf(wave_sum(ss) * (1.0f / 4096.0f) + 1e-6f);
    f32x4* o4 = (f32x4*)o + lane;
#pragma unroll
    for (int j = 0; j < 16; ++j) { const f32x4 gg = gv[j]; o4[64 * j] = (f32x4){v[j].x * r * gg.x, v[j].y * r * gg.y, v[j].z * r * gg.z, v[j].w * r * gg.w}; }
}

__device__ __forceinline__ void phase_convert_layer(const Frame& F0, int l, const int parts, const int vb, const int nvb) {
    Frame F = reframe(F0); F.bid = vb; F.nblk = nvb;
    unsigned char* wl = KWS() + WS_W + (size_t)l * SZ_WLAYER;
    bf16* WIN = (bf16*)(wl + WO_WIN); bf16* WCAT = (bf16*)(wl + WO_WCAT); bf16* WOUT = (bf16*)(wl + WO_WOUT); bf16* WKV = (bf16*)(wl + WO_WKV); bf16* WG = (bf16*)(wl + WO_WG); bf16* WL = (bf16*)(wl + WO_WL);
    const float* win = KIN(I_WIN) + (size_t)l * 4096 * CIN;
    if (parts & 2) {
    tr_job(F, win + 0, CIN, 4096, 4096, WIN + (size_t)0 * 4096, 4096);
    tr_job(F, win + 4096, CIN, 4096, 6144, WIN + (size_t)PC_BR * 4096, 4096);
    tr_job(F, win + 10240, CIN, 4096, 96, WIN + (size_t)PC_BWD * 4096, 4096);
    tr_job(F, win + 10336, CIN, 4096, 96, WIN + (size_t)PC_BAD * 4096, 4096);
    tr_job(F, win + 10432, CIN, 4096, 2048, WIN + (size_t)PC_BG * 4096, 4096);
    tr_job(F, win + 12480, CIN, 4096, 4096, WIN + (size_t)PC_CQK * 4096, 4096);
    tr_job(F, win + 18624, CIN, 4096, 2048, WIN + (size_t)PC_CG * 4096, 4096);
    tr_job(F, win + 20680, CIN, 4096, 1024, WIN + (size_t)PC_XQ * 4096, 4096);
    tr8_job(F, win + 16576, CIN, 4096, 2048, (signed char*)(WIN + (size_t)PC_I8 * 4096), (const unsigned*)(KWS() + WS_CTL) + CW_CMAX + l * N8);
    tr8_job(F, win + 21704, CIN, 4096, NGATE, (signed char*)(WIN + (size_t)PC_I8 * 4096) + (size_t)2048 * 4096, (const unsigned*)(KWS() + WS_CTL) + CW_CMAX + l * N8 + 2048);
    tr_job(F, KIN(I_WBA) + (size_t)l * 2048 * 4096, 4096, 2048, 4096, WCAT + YC_A, KCAT);
    tr_job(F, KIN(I_WBB) + (size_t)l * 2048 * 4096, 4096, 2048, 4096, WCAT + YC_B, KCAT);
    tr_job(F, KIN(I_WBC) + (size_t)l * 2048 * 4096, 4096, 2048, 4096, WCAT + YC_C, KCAT);
    tr_job(F, KIN(I_WBX) + (size_t)l * 512 * 4096, 4096, 512, 4096, WCAT + YC_X, KCAT);
    tr_job(F, KIN(I_WOUT) + (size_t)l * 4096 * 4096, 4096, 4096, 4096, WOUT, 4096);
    }
    if (parts & 1) tr_job(F, KIN(I_WKV) + (size_t)l * 4096 * 1024, 1024, 4096, 1024, WKV, 4096);
    if (parts & 2) {
    const size_t gt = (size_t)F.bid * NTHREADS + F.tid, NGT = (size_t)F.nblk * NTHREADS;
    for (size_t i = gt; i < (size_t)8 * 4096; i += NGT) { const int j = (int)(i >> 12), k = (int)(i & 4095); WIN[(size_t)(PC_IF + j) * 4096 + k] = (bf16)f2bf(win[(size_t)k * CIN + 20672 + j]); }
    for (size_t i = gt; i < (size_t)(32 + 32 + 248) * 4096; i += NGT) { const int r = (int)(i >> 12), k = (int)(i & 4095);
        const int row = r < 32 ? PC_BWD + 96 + r : (r < 64 ? PC_BAD + 96 + (r - 32) : PC_IF + 8 + (r - 64)); WIN[(size_t)row * 4096 + k] = 0; }
    const float* wa = KIN(I_LRU_WA) + (size_t)l * 8 * 256 * 256; const float* wx = KIN(I_LRU_WX) + (size_t)l * 8 * 256 * 256;
    for (size_t c = gt; c < (size_t)4096 * 32; c += NGT) { const int n = (int)(c >> 5), k0 = (int)(c & 31) * 8, pn = n >> 8, dd = n & 255, nb = pn >> 1, d = (pn & 1) * 128 + (dd & 127);
        const float* sp = (dd < 128 ? wa : wx) + ((size_t)nb * 256 + k0) * 256 + d; float v[8];
#pragma unroll
        for (int q = 0; q < 8; ++q) v[q] = sp[(size_t)q * 256];
        asm volatile("" : "+v"(v[0]), "+v"(v[1]), "+v"(v[2]), "+v"(v[3]), "+v"(v[4]), "+v"(v[5]), "+v"(v[6]), "+v"(v[7]) :: "memory");
        u32x4 o; o.x = pk2(v[0], v[1]); o.y = pk2(v[2], v[3]); o.z = pk2(v[4], v[5]); o.w = pk2(v[6], v[7]); *(u32x4*)(WG + (size_t)n * 256 + k0) = o; }
    const float* wup = KIN(I_WUP) + (size_t)l * 96 * 2048; const float* aup = KIN(I_AUP) + (size_t)l * 96 * 2048;
    for (size_t c = gt; c < (size_t)4096 * 32; c += NGT) { const int n = (int)(c >> 5), k0 = (int)(c & 31) * 8, pn = n >> 8, dd = n & 255, ch = pn * 128 + (dd & 127);
        const float* sp = nullptr; if (dd < 128) { if (k0 < 96) sp = wup + (size_t)k0 * 2048 + ch; } else { if (k0 >= 128 && k0 < 224) sp = aup + (size_t)(k0 - 128) * 2048 + ch; }
        u32x4 o = (u32x4){0u, 0u, 0u, 0u};
        if (sp != nullptr) { float v[8];
#pragma unroll
            for (int q = 0; q < 8; ++q) v[q] = sp[(size_t)q * 2048];
            asm volatile("" : "+v"(v[0]), "+v"(v[1]), "+v"(v[2]), "+v"(v[3]), "+v"(v[4]), "+v"(v[5]), "+v"(v[6]), "+v"(v[7]) :: "memory");
            o.x = pk2(v[0], v[1]); o.y = pk2(v[2], v[3]); o.z = pk2(v[4], v[5]); o.w = pk2(v[6], v[7]); }
        *(u32x4*)(WL + (size_t)n * 256 + k0) = o; }
    }
    if (parts & 1) {
    const int gw = F.bid * NWAVES + F.wave, NGW = F.nblk * NWAVES;
    bf16* MEMN = (bf16*)(KWS() + WS_MEMN) + (size_t)l * MM * 4096;
    for (int r = gw; r < MM; r += NGW) rms_row_bf16(KIN(I_MEM) + (size_t)r * 4096, KIN(I_MEMNORM_G) + (size_t)l * 4096, MEMN + (size_t)r * 4096, F.lane);
    }
}
__device__ __forceinline__ void phase_norm(const Frame& F0, const float* X, const float* g, bool final_out) {
    const Frame F = reframe(F0);
    const int gw = F.bid * NWAVES + F.wave, NGW = F.nblk * NWAVES;
    bf16* H = (bf16*)(KWS() + WS_H);
    for (int r = gw; r < M; r += NGW) { if (final_out) rms_row_f32(X + (size_t)r * 4096, g, KOUT() + (size_t)r * 4096, F.lane); else rms_row_bf16(X + (size_t)r * 4096, g, H + (size_t)r * 4096, F.lane, (signed char*)(KWS() + WS_H8) + (size_t)r * 4096, (float*)(KWS() + WS_HS) + r); }
}

__device__ __forceinline__ float logsigf_(float x) { return fminf(x, 0.f) - log1pf(__expf(-fabsf(x))); }
__device__ __forceinline__ void phase_prep(const Frame& F0, int l) {
    const Frame F = reframe(F0);
    const bf16* __restrict__ PROJ = (const bf16*)(KWS() + WS_PROJ);
    const size_t gt = (size_t)F.bid * NTHREADS + F.tid, NGT = (size_t)F.nblk * NTHREADS;
    bf16* __restrict__ U = (bf16*)(KWS() + WS_U); bf16* __restrict__ QC = (bf16*)(KWS() + WS_QC); bf16* __restrict__ KC = (bf16*)(KWS() + WS_KC);
    for (size_t id = gt; id < (size_t)2 * 256 * (M / 32); id += NGT) {
        const int which = (int)(id / ((size_t)256 * (M / 32))), rem = (int)(id % ((size_t)256 * (M / 32))), c8 = (rem & 255) * 8, t0 = (rem >> 8) * 32, ts0 = t0 & (SEQ - 1);
        const float* cw = (which == 0 ? KIN(I_LRU_CW) : KIN(I_MCW)) + (size_t)l * 4 * 2048 + c8; const float* cb = (which == 0 ? KIN(I_LRU_CB) : KIN(I_MCB)) + (size_t)l * 2048 + c8;
        const bf16* src = PROJ + (size_t)t0 * NPJ + (which == 0 ? PC_AX : PC_CQK) + c8;
        f32x4 wv[4][2];
#pragma unroll
        for (int j = 0; j < 4; ++j) { wv[j][0] = *(const f32x4*)(cw + j * 2048); wv[j][1] = *(const f32x4*)(cw + j * 2048 + 4); }
        const f32x4 b0 = *(const f32x4*)cb, b1 = *(const f32x4*)(cb + 4);
        u32x4 hw[3];
#pragma unroll
        for (int j = 0; j < 3; ++j) hw[j] = ts0 > 0 ? *(const u32x4*)(src - (size_t)(3 - j) * NPJ) : (u32x4){0u, 0u, 0u, 0u};
        float w0[8], w1[8], w2[8]; unpack8(hw[0], w0); unpack8(hw[1], w1); unpack8(hw[2], w2);
        const float sc = c8 < 1024 ? 1.0f : 0.0625f;
        for (int g = 0; g < 32; g += 8) { u32x4 x[8];
#pragma unroll
            for (int u = 0; u < 8; ++u) x[u] = *(const u32x4*)(src + (size_t)(g + u) * NPJ);
#pragma unroll
            for (int u = 0; u < 8; ++u) { float w3[8], a[8]; unpack8(x[u], w3);
#pragma unroll
                for (int q = 0; q < 8; ++q) a[q] = (q < 4 ? b0[q] : b1[q - 4]) + wv[0][q >> 2][q & 3] * w0[q] + wv[1][q >> 2][q & 3] * w1[q] + wv[2][q >> 2][q & 3] * w2[q] + wv[3][q >> 2][q & 3] * w3[q];
#pragma unroll
                for (int q = 0; q < 8; ++q) { w0[q] = w1[q]; w1[q] = w2[q]; w2[q] = w3[q]; }
                const size_t t = (size_t)t0 + g + u;
                if (which == 0) { u32x4 o; o.x = pk2(a[0], a[1]); o.y = pk2(a[2], a[3]); o.z = pk2(a[4], a[5]); o.w = pk2(a[6], a[7]); *(u32x4*)(U + t * 2048 + c8) = o; }
                else {
#pragma unroll
                    for (int q = 0; q < 8; ++q) a[q] = siluf_(a[q]) * sc;
                    u32x4 o; o.x = pk2(a[0], a[1]); o.y = pk2(a[2], a[3]); o.z = pk2(a[4], a[5]); o.w = pk2(a[6], a[7]);
                    if (c8 < 1024) *(u32x4*)(QC + t * 1024 + c8) = o; else *(u32x4*)(KC + t * 1024 + (c8 - 1024)) = o; } } }
    }
    bf16* LORA = (bf16*)(KWS() + WS_LORA); const float* mu = KIN(I_MU) + (size_t)l * 6336;
    for (size_t i = gt; i < (size_t)M * 32; i += NGT) { const int t = (int)(i >> 5), c8 = (int)(i & 31) * 8, ts = t & (SEQ - 1), seg = c8 >> 7, i0 = c8 & 127;
        u32x4 o = (u32x4){0u, 0u, 0u, 0u};
        if (i0 < 96) { const int pc = (seg == 0 ? PC_BWD : PC_BAD) + i0; const float* m8 = mu + 6144 + seg * 96 + i0;
            const u32x4 w = *(const u32x4*)(PROJ + (size_t)t * NPJ + pc); const u32x4 w2 = *(const u32x4*)(PROJ + (size_t)(ts > 0 ? t - 1 : t) * NPJ + pc);
            const f32x4 ma = *(const f32x4*)m8, mb = *(const f32x4*)(m8 + 4);
            float p[8], pv[8]; unpack8(w, p); unpack8(w2, pv);
            if (ts == 0) {
#pragma unroll
                for (int q = 0; q < 8; ++q) pv[q] = 0.f; }
            float r[8];
#pragma unroll
            for (int q = 0; q < 8; ++q) { const float s = p[q] + (pv[q] - p[q]) * (q < 4 ? ma[q] : mb[q - 4]); r[q] = seg == 0 ? tanhf(s) : s; }
            o.x = pk2(r[0], r[1]); o.y = pk2(r[2], r[3]); o.z = pk2(r[4], r[5]); o.w = pk2(r[6], r[7]); }
        *(u32x4*)(LORA + (size_t)t * 256 + c8) = o; }
    if (F.bid < 8) {
        const float* IFB = (const float*)(KWS() + WS_IFB); float* G = (float*)(KWS() + WS_SCAL); float* MX = G + (size_t)M * 4; float* MT = MX + (size_t)M * 4;
        const int b = F.bid >> 2, hd = F.bid & 3, lane = F.lane; const float bi = KIN(I_MBI)[l * 4 + hd], bfv = KIN(I_MBF)[l * 4 + hd];
        const size_t tok0 = (size_t)b * SEQ + (size_t)F.tid * 8; LAS float* sc = (LAS float*)F.lds;
        float lf[8], li[8];
#pragma unroll
        for (int j = 0; j < 8; ++j) { lf[j] = IFB[(tok0 + j) * 8 + 4 + hd]; li[j] = IFB[(tok0 + j) * 8 + hd]; }
        asm volatile("" ::: "memory");
#pragma unroll
        for (int j = 0; j < 8; ++j) { lf[j] = logsigf_(lf[j] + bfv); li[j] += bi; }
#pragma unroll
        for (int j = 1; j < 8; ++j) lf[j] += lf[j - 1];
        float incl = lf[7];
#pragma unroll
        for (int o = 1; o < 64; o <<= 1) { const float t = __shfl_up(incl, o); if (lane >= o) incl += t; }
        if (lane == 63) sc[F.wave] = incl;
        __syncthreads();
        float woff = 0.f;
        for (int w2 = 0; w2 < F.wave; ++w2) woff += sc[w2];
        const float excl = woff + incl - lf[7];
        float mx[8]; float run = -INFINITY;
#pragma unroll
        for (int j = 0; j < 8; ++j) { lf[j] += excl; li[j] -= lf[j]; run = fmaxf(run, li[j]); mx[j] = run; }
        float im = run;
#pragma unroll
        for (int o = 1; o < 64; o <<= 1) { const float t = __shfl_up(im, o); if (lane >= o) im = fmaxf(im, t); }
        if (lane == 63) sc[16 + F.wave] = im;
        float pm = __shfl_up(im, 1); if (lane == 0) pm = -INFINITY;
        __syncthreads();
        for (int w2 = 0; w2 < F.wave; ++w2) pm = fmaxf(pm, sc[16 + w2]);
#pragma unroll
        for (int j = 0; j < 8; ++j) { const float m = fmaxf(pm, mx[j]); G[(tok0 + j) * 4 + hd] = li[j]; MX[(tok0 + j) * 4 + hd] = m; MT[(tok0 + j) * 4 + hd] = lf[j] + m; }
        __syncthreads();
    }
}

__device__ __forceinline__ f32x4 ld_bf4(const bf16* p) { const u32x2 w = *(const u32x2*)p; return (f32x4){__uint_as_float(w.x << 16), __uint_as_float(w.x & 0xffff0000u), __uint_as_float(w.y << 16), __uint_as_float(w.y & 0xffff0000u)}; }
__device__ __forceinline__ f32x4 bf4_unpack(const u32x2 w) { return (f32x4){__uint_as_float(w.x << 16), __uint_as_float(w.x & 0xffff0000u), __uint_as_float(w.y << 16), __uint_as_float(w.y & 0xffff0000u)}; }
struct VecIn { u32x2 r, k, v, r1, k1, v1; f32x4 a; };
__device__ __forceinline__ void phase_rwkv_vec(const Frame& F0, int l) {
    const Frame F = reframe(F0);
    const bf16* __restrict__ PROJ = (const bf16*)(KWS() + WS_PROJ); const float* __restrict__ AA = (const float*)(KWS() + WS_AA);
    float* __restrict__ RV = (float*)(KWS() + WS_RV); float* __restrict__ VV = (float*)(KWS() + WS_VV); float* __restrict__ BON = (float*)(KWS() + WS_BON);
    const float* mu = KIN(I_MU) + (size_t)l * 6336; const float* kkw = KIN(I_KK) + (size_t)l * 2048; const float* kaw = KIN(I_KA) + (size_t)l * 2048; const float* rkw = KIN(I_RK) + (size_t)l * 2048;
    const int gw = F.bid * NWAVES + F.wave, NGW = F.nblk * NWAVES, lane = F.lane;
    const int hq = gw & 7, ch = hq * 256 + lane * 4, h = hq * 4 + (lane >> 4);
    const f32x4 mr = *(const f32x4*)(mu + ch), mk = *(const f32x4*)(mu + 2048 + ch), mv = *(const f32x4*)(mu + 4096 + ch), ckk = *(const f32x4*)(kkw + ch), cka = *(const f32x4*)(kaw + ch), crk = *(const f32x4*)(rkw + ch);
    auto vload = [&](const int it, VecIn& x) { const int t = it >> 3, ts = t & (SEQ - 1);
        const bf16* pr = PROJ + (size_t)t * NPJ + ch; const bf16* pp = ts > 0 ? pr - NPJ : pr;
        x.r = *(const u32x2*)(pr + PC_BR); x.k = *(const u32x2*)(pr + PC_BK); x.v = *(const u32x2*)(pr + PC_BV);
        x.r1 = *(const u32x2*)(pp + PC_BR); x.k1 = *(const u32x2*)(pp + PC_BK); x.v1 = *(const u32x2*)(pp + PC_BV);
        x.a = *(const f32x4*)(AA + (size_t)t * 2048 + ch); };
    auto vcomp = [&](const int it, const VecIn& x) { const int t = it >> 3, ts = t & (SEQ - 1), b = t >> 12;
        f32x4 r = bf4_unpack(x.r), k = bf4_unpack(x.k), v = bf4_unpack(x.v);
        const f32x4 z = (f32x4){0.f, 0.f, 0.f, 0.f}; const f32x4 r1 = ts > 0 ? bf4_unpack(x.r1) : z, k1 = ts > 0 ? bf4_unpack(x.k1) : z, v1 = ts > 0 ? bf4_unpack(x.v1) : z;
        r += (r1 - r) * mr; k += (k1 - k) * mk; v += (v1 - v) * mv;
        const f32x4 a = x.a;
        const f32x4 kku = k * ckk;
        const float n2 = row16_sum((kku.x * kku.x + kku.y * kku.y) + (kku.z * kku.z + kku.w * kku.w));
        const float inv = __builtin_amdgcn_rcpf(fmaxf(sqrtf(n2), 1e-12f)); const f32x4 kk = kku * inv;
        const f32x4 kmod = k * ((a - 1.0f) * cka + 1.0f);
        const f32x4 rkk = r * kmod * crk;
        const float bon = row16_sum((rkk.x + rkk.y) + (rkk.z + rkk.w));
        float* rv = RV + (((size_t)(b * 32 + h) * SEQ + ts) * 5) * 64 + (lane & 15) * 4;
        *(f32x4*)rv = kk; *(f32x4*)(rv + 128) = -(kk * a); *(f32x4*)(rv + 192) = kmod; *(f32x4*)(rv + 256) = r;
        *(f32x4*)(VV + (size_t)t * 2048 + ch) = v; if ((lane & 15) == 0) BON[(size_t)t * 32 + h] = bon; };
    int it = gw;
    for (; it + 3 * NGW < M * 8; it += 4 * NGW) { VecIn x0, x1, x2, x3; vload(it, x0); vload(it + NGW, x1); vload(it + 2 * NGW, x2); vload(it + 3 * NGW, x3);
        vcomp(it, x0); vcomp(it + NGW, x1); vcomp(it + 2 * NGW, x2); vcomp(it + 3 * NGW, x3); }
    for (; it < M * 8; it += NGW) { VecIn x0; vload(it, x0); vcomp(it, x0); }
}

#define SC_PIN(a) asm volatile("" : "+v"(a[0]), "+v"(a[1]), "+v"(a[2]), "+v"(a[3]), "+v"(a[4]), "+v"(a[5]), "+v"(a[6]), "+v"(a[7]), "+v"(a[8]), "+v"(a[9]), "+v"(a[10]), "+v"(a[11]), "+v"(a[12]), "+v"(a[13]), "+v"(a[14]), "+v"(a[15]) :: "memory")
__device__ __forceinline__ void phase_lru_scan1(const Frame& F0) {
    const Frame F = reframe(F0);
    const float* LA = (const float*)(KWS() + WS_LA); const float* LB = (const float*)(KWS() + WS_LB); float* CA = (float*)(KWS() + WS_CARRY); float* CH = CA + 2 * 32 * 2048;
    const size_t gt = (size_t)F.bid * NTHREADS + F.tid, NGT = (size_t)F.nblk * NTHREADS;
    for (size_t i = gt; i < (size_t)2 * 32 * 2048; i += NGT) { const int ch = (int)(i & 2047), chunk = (int)(i >> 11) & 31, b = (int)(i >> 16);
        const size_t base = ((size_t)b * SEQ + chunk * 128) * 2048 + ch; float A = 1.f, H = 0.f;
        for (int s0 = 0; s0 < 128; s0 += 16) { float la[16], lb[16];
#pragma unroll
            for (int u = 0; u < 16; ++u) { la[u] = LA[base + (size_t)(s0 + u) * 2048]; lb[u] = LB[base + (size_t)(s0 + u) * 2048]; }
            SC_PIN(la); SC_PIN(lb);
#pragma unroll
            for (int u = 0; u < 16; ++u) { H = la[u] * H + lb[u]; A *= la[u]; } }
        CA[i] = A; CH[i] = H; }
}
__device__ __forceinline__ void scan2_item(const Frame& F, const int vb) {
    const float* __restrict__ LA = (const float*)(KWS() + WS_LA); const float* __restrict__ LB = (const float*)(KWS() + WS_LB); const float* __restrict__ CA = (const float*)(KWS() + WS_CARRY); const float* __restrict__ CH = CA + 2 * 32 * 2048;
    const bf16* __restrict__ PROJ = (const bf16*)(KWS() + WS_PROJ); bf16* __restrict__ Y = (bf16*)(KWS() + WS_Y);
    { const size_t i = (size_t)vb * NTHREADS + F.tid; const int ch = (int)(i & 2047), chunk = (int)(i >> 11) & 31, b = (int)(i >> 16);
        float H = 0.f;
        for (int j0 = 0; j0 < chunk; j0 += 16) { float ca[16], chh[16];
#pragma unroll
            for (int u = 0; u < 16; ++u) { const int j = j0 + u < chunk ? j0 + u : chunk - 1; const size_t ci = ((size_t)b * 32 + j) * 2048 + ch; ca[u] = CA[ci]; chh[u] = CH[ci]; }
            SC_PIN(ca); SC_PIN(chh);
#pragma unroll
            for (int u = 0; u < 16; ++u) if (j0 + u < chunk) H = ca[u] * H + chh[u]; }
        const size_t row0 = (size_t)b * SEQ + chunk * 128;
        for (int s0 = 0; s0 < 128; s0 += 16) { float la[16], lb[16]; unsigned gg[16];
#pragma unroll
            for (int u = 0; u < 16; ++u) { const size_t row = row0 + s0 + u; la[u] = LA[row * 2048 + ch]; lb[u] = LB[row * 2048 + ch]; gg[u] = PROJ[row * NPJ + PC_AG + ch]; }
            SC_PIN(la); SC_PIN(lb); SC_PIN(gg);
#pragma unroll
            for (int u = 0; u < 16; ++u) { const size_t row = row0 + s0 + u; H = la[u] * H + lb[u]; Y[row * KCAT + YC_A + ch] = (bf16)f2bf(H * siluf_(bf2f((bf16)gg[u]))); } } }
}

constexpr int RW_CH = 32;
constexpr int RW_RVB = RW_CH * 1280, RW_VVB = RW_CH * 256;
struct RwVec { f32x4 kk, wv, nk, kv, rv; f32x2 vi; };
template <int S> __device__ __forceinline__ void rw_issue(RwVec& d, unsigned a, unsigned av) {
    asm volatile("ds_read_b128 %0, %6 offset:%8\n\tds_read_b128 %1, %6 offset:%9\n\tds_read_b128 %2, %6 offset:%10\n\tds_read_b128 %3, %6 offset:%11\n\tds_read_b128 %4, %6 offset:%12\n\tds_read_b64 %5, %7 offset:%13"
                 : "=&v"(d.kk), "=&v"(d.wv), "=&v"(d.nk), "=&v"(d.kv), "=&v"(d.rv), "=&v"(d.vi) : "v"(a), "v"(av), "n"(S * 1280), "n"(S * 1280 + 256), "n"(S * 1280 + 512), "n"(S * 1280 + 768), "n"(S * 1280 + 1024), "n"(S * 256) : "memory"); }
#define RW_OPS(d) "+v"(d.kk), "+v"(d.wv), "+v"(d.nk), "+v"(d.kv), "+v"(d.rv), "+v"(d.vi)
__device__ __forceinline__ void rw_wait6(RwVec& d) { asm volatile("s_waitcnt lgkmcnt(6)" : RW_OPS(d) :: "memory"); }
__device__ __forceinline__ void rw_wait0(RwVec& d) { asm volatile("s_waitcnt lgkmcnt(0)" : RW_OPS(d) :: "memory"); }
__device__ __forceinline__ void phase_rwkv_rec(const Frame& F0, const int first, const int stride) {
    const Frame F = reframe(F0);
    const char* RV = (const char*)(KWS() + WS_RV); const char* VV = (const char*)(KWS() + WS_VV); float* YR = (float*)(KWS() + WS_YR);
    LAS unsigned char* lds = F.lds;
    for (int item = first; item < 128; item += stride) {
        const int bh = item >> 1, hf = item & 1, b = bh >> 5, h = bh & 31, w = F.wave, lane = F.lane, cg = lane & 15, rl = lane >> 4;
        const int row = hf * 32 + (w & 3) * 8 + rl * 2;
        const char* rvg = RV + (size_t)bh * SEQ * 1280; const char* vvg = VV + ((size_t)b * SEQ * 2048 + h * 64) * 4;
        f32x2 Sa0 = (f32x2){0.f, 0.f}, Sa1 = Sa0, Sb0 = Sa0, Sb1 = Sa0;
#define RW_DMA(ck) do { const int _buf = (ck) & 1; _Pragma("unroll") for (int _p = 0; _p < 6; ++_p) { const int pc = w * 6 + _p; \
            if (pc < 40) __builtin_amdgcn_global_load_lds((const unsigned*)(rvg + (size_t)(ck) * RW_RVB + pc * 1024 + lane * 16), (LAS unsigned*)(lds + _buf * RW_RVB + pc * 1024), 16, 0, 0); \
            else { const int pv = pc - 40; __builtin_amdgcn_global_load_lds((const unsigned*)(vvg + ((size_t)((ck) * RW_CH + pv * 4 + (lane >> 4)) * 2048) * 4 + (lane & 15) * 16), (LAS unsigned*)(lds + 2 * RW_RVB + _buf * RW_VVB + pv * 1024), 16, 0, 0); } } } while (0)
        RW_DMA(0);
        VM_WAIT(); __syncthreads();
        for (int ck = 0; ck < SEQ / RW_CH; ++ck) {
            if (ck + 1 < SEQ / RW_CH) RW_DMA(ck + 1);
            if (w < 4) {
                const unsigned ra = (unsigned)(size_t)(lds + (ck & 1) * RW_RVB + cg * 16), va = (unsigned)(size_t)(lds + 2 * RW_RVB + (ck & 1) * RW_VVB + row * 4);
                float* yo = YR + ((size_t)b * SEQ + (size_t)ck * RW_CH + (cg & 3)) * 2048 + h * 64 + row;
                RwVec A_, B_;
                rw_issue<0>(A_, ra, va);
#define P2(v, hi) ((f32x2){(hi) ? v.z : v.x, (hi) ? v.w : v.y})
#define RW_STEP(CUR, NXT, s_) do { if ((s_) + 1 < RW_CH) { rw_issue<((s_) + 1) % RW_CH>(NXT, ra, va); rw_wait6(CUR); } else rw_wait0(CUR); \
                    const f32x2 via = (f32x2){CUR.vi.x, CUR.vi.x}, vib = (f32x2){CUR.vi.y, CUR.vi.y}; \
                    const f32x2 pa = Sa0 * P2(CUR.kk, 0) + Sa1 * P2(CUR.kk, 1), pb = Sb0 * P2(CUR.kk, 0) + Sb1 * P2(CUR.kk, 1); \
                    float sa = pa.x + pa.y, sb = pb.x + pb.y; \
                    sa += dpp_mov<0xB1>(sa); sb += dpp_mov<0xB1>(sb); sa += dpp_mov<0x4E>(sa); sb += dpp_mov<0x4E>(sb); sa += dpp_mov<0x141>(sa); sb += dpp_mov<0x141>(sb); sa += dpp_mov<0x140>(sa); sb += dpp_mov<0x140>(sb); \
                    const f32x2 sa2 = (f32x2){sa, sa}, sb2 = (f32x2){sb, sb}; \
                    Sa0 = sa2 * P2(CUR.nk, 0) + (via * P2(CUR.kv, 0) + Sa0 * P2(CUR.wv, 0)); Sa1 = sa2 * P2(CUR.nk, 1) + (via * P2(CUR.kv, 1) + Sa1 * P2(CUR.wv, 1)); \
                    Sb0 = sb2 * P2(CUR.nk, 0) + (vib * P2(CUR.kv, 0) + Sb0 * P2(CUR.wv, 0)); Sb1 = sb2 * P2(CUR.nk, 1) + (vib * P2(CUR.kv, 1) + Sb1 * P2(CUR.wv, 1)); \
                    const f32x2 qa = Sa0 * P2(CUR.rv, 0) + Sa1 * P2(CUR.rv, 1), qb = Sb0 * P2(CUR.rv, 0) + Sb1 * P2(CUR.rv, 1); \
                    ya[(s_) & 3] = qa.x + qa.y; yb[(s_) & 3] = qb.x + qb.y; } while (0)
#define RW_G4(g4) do { \
                    float ya[4], yb[4]; \
                    RW_STEP(A_, B_, g4 * 4 + 0); RW_STEP(B_, A_, g4 * 4 + 1); RW_STEP(A_, B_, g4 * 4 + 2); RW_STEP(B_, A_, g4 * 4 + 3); \
                      \
                    const bool o1 = cg & 1, o2 = cg & 2; \
                    const float uA = (o1 ? ya[1] : ya[0]) + dpp_mov<0xB1>(o1 ? ya[0] : ya[1]), uB = (o1 ? ya[3] : ya[2]) + dpp_mov<0xB1>(o1 ? ya[2] : ya[3]); \
                    const float wA = (o1 ? yb[1] : yb[0]) + dpp_mov<0xB1>(o1 ? yb[0] : yb[1]), wB = (o1 ? yb[3] : yb[2]) + dpp_mov<0xB1>(o1 ? yb[2] : yb[3]); \
                    float ysa = (o2 ? uB : uA) + dpp_mov<0x4E>(o2 ? uA : uB), ysb = (o2 ? wB : wA) + dpp_mov<0x4E>(o2 ? wA : wB); \
                    ysa += dpp_mov<0x114>(ysa); ysb += dpp_mov<0x114>(ysb); \
                    ysa += dpp_mov<0x118>(ysa); ysb += dpp_mov<0x118>(ysb); \
                    if (cg >= 12) *(f32x2*)(yo + (size_t)(g4) * 4 * 2048) = (f32x2){ysa, ysb}; } while (0)
                RW_G4(0); RW_G4(1); RW_G4(2); RW_G4(3); RW_G4(4); RW_G4(5); RW_G4(6); RW_G4(7);
                static_assert(RW_CH == 32, "eight groups of four steps");
#undef RW_G4
#undef RW_STEP
#undef P2
            }
            VM_WAIT(); __syncthreads();
        }
#undef RW_DMA
    }
}

__device__ __forceinline__ void phase_rwkv_post(const Frame& F0, int l) {
    const Frame F = reframe(F0);
    const float* __restrict__ YR = (const float*)(KWS() + WS_YR); const float* __restrict__ VV = (const float*)(KWS() + WS_VV); const float* __restrict__ BON = (const float*)(KWS() + WS_BON);
    const bf16* __restrict__ PROJ = (const bf16*)(KWS() + WS_PROJ); bf16* __restrict__ Y = (bf16*)(KWS() + WS_Y);
    const float* gw_ = KIN(I_GNW) + (size_t)l * 2048; const float* gb_ = KIN(I_GNB) + (size_t)l * 2048;
    const int gw = F.bid * NWAVES + F.wave, NGW = F.nblk * NWAVES, lane = F.lane;
    const int hq = gw & 7, ch = hq * 256 + lane * 4, h = hq * 4 + (lane >> 4);
    const f32x4 w4 = *(const f32x4*)(gw_ + ch), b4 = *(const f32x4*)(gb_ + ch);
    struct PostIn { f32x4 y, v; float bon; u32x2 g; };
    auto pload = [&](const int it, PostIn& x) { const int t = it >> 3; x.y = *(const f32x4*)(YR + (size_t)t * 2048 + ch); x.v = *(const f32x4*)(VV + (size_t)t * 2048 + ch); x.bon = BON[(size_t)t * 32 + h]; x.g = *(const u32x2*)(PROJ + (size_t)t * NPJ + PC_BG + ch); };
    auto pcomp = [&](const int it, const PostIn& x) { const int t = it >> 3; const f32x4 y = x.y, v = x.v, g = bf4_unpack(x.g); const float bon = x.bon;
        const float mean = row16_sum((y.x + y.y) + (y.z + y.w)) * (1.0f / 64.0f); const f32x4 d = y - mean;
        const float var = row16_sum((d.x * d.x + d.y * d.y) + (d.z * d.z + d.w * d.w)) * (1.0f / 64.0f); const float rs = rsqrtf(var + 64e-5f);
        const f32x4 o = (d * rs * w4 + b4 + v * bon);
        u32x2 pk; pk.x = pk2(o.x * siluf_(g.x), o.y * siluf_(g.y)); pk.y = pk2(o.z * siluf_(g.z), o.w * siluf_(g.w));
        *(u32x2*)(Y + (size_t)t * KCAT + YC_B + ch) = pk; };
    int it = gw;
    for (; it + 3 * NGW < M * 8; it += 4 * NGW) { PostIn x0, x1, x2, x3; pload(it, x0); pload(it + NGW, x1); pload(it + 2 * NGW, x2); pload(it + 3 * NGW, x3);
        pcomp(it, x0); pcomp(it + NGW, x1); pcomp(it + 2 * NGW, x2); pcomp(it + 3 * NGW, x3); }
    for (; it < M * 8; it += NGW) { PostIn x0; pload(it, x0); pcomp(it, x0); }
}
__device__ __forceinline__ void phase_mlstm_post(const Frame& F0, int l) {
    const Frame F = reframe(F0);
    const float* __restrict__ HC = (const float*)(KWS() + WS_HC); const bf16* __restrict__ PROJ = (const bf16*)(KWS() + WS_PROJ); bf16* __restrict__ Y = (bf16*)(KWS() + WS_Y);
    const float* gw_ = KIN(I_MGNW) + (size_t)l * 2048;
    const int gw = F.bid * NWAVES + F.wave, NGW = F.nblk * NWAVES, lane = F.lane;
#pragma unroll 2
    for (int it = gw; it < M * 4; it += NGW) { const int t = it >> 2, hd = it & 3, ch = hd * 512 + lane * 8;
        const f32x4 v0 = *(const f32x4*)(HC + (size_t)t * 2048 + ch), v1 = *(const f32x4*)(HC + (size_t)t * 2048 + ch + 4);
        float x[8] = {v0.x, v0.y, v0.z, v0.w, v1.x, v1.y, v1.z, v1.w}; float s = 0.f;
#pragma unroll
        for (int q = 0; q < 8; ++q) s += x[q];
        const float mean = wave_sum(s) * (1.0f / 512.0f); float s2 = 0.f;
#pragma unroll
        for (int q = 0; q < 8; ++q) { x[q] -= mean; s2 += x[q] * x[q]; }
        const float rstd = rsqrtf(wave_sum(s2) * (1.0f / 512.0f) + 1e-6f);
        const u32x4 gg = *(const u32x4*)(PROJ + (size_t)t * NPJ + PC_CG + ch); float gf[8]; unpack8(gg, gf); float o[8];
#pragma unroll
        for (int q = 0; q < 8; ++q) o[q] = x[q] * rstd * gw_[ch + q] * siluf_(gf[q]);
        u32x4 w; w.x = pk2(o[0], o[1]); w.y = pk2(o[2], o[3]); w.z = pk2(o[4], o[5]); w.w = pk2(o[6], o[7]);
        *(u32x4*)(Y + (size_t)t * KCAT + YC_C + ch) = w; }
}

__device__ __forceinline__ s16x4 tr16(const LAS unsigned char* p) { return __builtin_bit_cast(s16x4, __builtin_amdgcn_ds_read_tr16_b64_v4i16((LAS s16x4*)p)); }
constexpr int ML_SROW = 80;
constexpr int ML_K = 0, ML_V = 3 * 16384, ML_S = ML_V + 3 * 32768, ML_G = ML_S + 64 * ML_SROW, ML_DEN = ML_G + 1024, ML_END = ML_DEN + 512;
static_assert(ML_END <= RING_BYTES, "mLSTM LDS");
__device__ __forceinline__ void xattn_item(const Frame& F, int l, const int item);
__device__ __forceinline__ int ml_vswz(int row) { return ((row & 3) << 1) | (((row >> 3) & 1) << 3); }
__device__ __forceinline__ void phase_mlstm(const Frame& F0, int l, unsigned* queue, const int lim_lo = 0, const int lim_hi = 1 << 30) {
    const Frame F = reframe(F0);
    const bf16* PROJ = (const bf16*)(KWS() + WS_PROJ); const bf16* QC = (const bf16*)(KWS() + WS_QC); const bf16* KC = (const bf16*)(KWS() + WS_KC);
    const float* G = (const float*)(KWS() + WS_SCAL); const float* MX = G + (size_t)M * 4; const float* MT = MX + (size_t)M * 4; float* HC = (float*)(KWS() + WS_HC);
    LAS unsigned char* lds = F.lds; LAS float* denl = (LAS float*)(lds + ML_DEN);
    const int tid = F.tid, lane = F.lane, w = F.wave, l15 = lane & 15, lg = lane >> 4, rt = w >> 1, ctp = w & 1;
    volatile LAS unsigned* qslot = (volatile LAS unsigned*)(F.lds + MISC_OFF);
    const bool affine = (lim_lo == 0) && (lim_hi == (1 << 30)); bool ml_left = affine;
    for (;;) {
        __syncthreads();
        if (tid == 0) { unsigned it = 0xffffffffu;
            if (ml_left) { const unsigned x = xb_xcc_id() & 7u;
                for (unsigned j = 0; j < 8u; ++j) { const unsigned sidx = (x + j) & 7u; const unsigned t = __hip_atomic_fetch_add(queue + 8 + sidx, 1u, __ATOMIC_RELAXED, __HIP_MEMORY_SCOPE_AGENT); if (t < 64u) { it = (t << 3) | sidx; break; } }
                if (it == 0xffffffffu) ml_left = false; }
            if (it == 0xffffffffu) it = (affine ? 512u : 0u) + __hip_atomic_fetch_add(queue, 1u, __ATOMIC_RELAXED, __HIP_MEMORY_SCOPE_AGENT);
            qslot[0] = it; }
        __syncthreads();
        const int item = (int)qslot[0] + lim_lo; if (item >= lim_hi || item >= 1024 + ((CONV1_IN_QUEUE && l == 0) ? CONV_NVB : 0)) break;
        if (item >= 1024) { phase_convert_layer(F, 1, 2, item - 1024, CONV_NVB); continue; }
        if (item >= 768) { scan2_item(F, item - 768); continue; }
        if (item >= 512) { xattn_item(F, l, item - 512); continue; }
        const int qt = 63 - (item >> 3), b = (item >> 2) & 1, hd = item & 3, t0 = qt * 64; const size_t rowb = (size_t)b * SEQ;
        const int tq = opaque_v(lane);
        const int q15 = tq & 15, qg = tq >> 4;
        bf16x8 qf[8];
#pragma unroll
        for (int ks = 0; ks < 8; ++ks) qf[ks] = *(const bf16x8*)(QC + (rowb + t0 + 16 * rt + q15) * 1024 + hd * 256 + 32 * ks + 8 * qg);
        float mxr[4];
#pragma unroll
        for (int j = 0; j < 4; ++j) mxr[j] = MX[(rowb + t0 + 16 * rt + qg * 4 + j) * 4 + hd];
        f32x4 num[4][4];
#pragma unroll
        for (int r4 = 0; r4 < 4; ++r4)
#pragma unroll
            for (int c4 = 0; c4 < 4; ++c4) num[r4][c4] = (f32x4){0.f, 0.f, 0.f, 0.f};
        float dacc[4] = {0.f, 0.f, 0.f, 0.f};
        asm volatile("s_waitcnt vmcnt(0)" ::: "memory");
        asm volatile("" : "+v"(qf[0]), "+v"(qf[1]), "+v"(qf[2]), "+v"(qf[3]), "+v"(qf[4]), "+v"(qf[5]), "+v"(qf[6]), "+v"(qf[7]));
        asm volatile("" : "+v"(mxr[0]), "+v"(mxr[1]), "+v"(mxr[2]), "+v"(mxr[3]));
#define ML_DMA_KV(kt_, bf_) do { const int s0_ = (kt_) * 32; const char* kb_ = (const char*)KC + ((rowb + s0_) * 1024 + hd * 256) * 2; const char* vb_ = (const char*)PROJ + ((rowb + s0_) * NPJ + PC_CV + hd * 512) * 2; \
            _Pragma("unroll") for (int i = 0; i < 2; ++i) { const int pc = w * 2 + i, row = 2 * pc + (lane >> 5), p = lane & 31; \
                __builtin_amdgcn_global_load_lds((const unsigned*)(kb_ + (size_t)row * 2048 + ((p ^ (row & 15)) * 16)), (LAS unsigned*)(lds + ML_K + (bf_) * 16384 + pc * 1024), 16, 0, 0); } \
            _Pragma("unroll") for (int i = 0; i < 4; ++i) { const int row = w * 4 + i; \
                __builtin_amdgcn_global_load_lds((const unsigned*)(vb_ + (size_t)row * (NPJ * 2) + ((lane ^ ml_vswz(row)) * 16)), (LAS unsigned*)(lds + ML_V + (bf_) * 32768 + row * 1024), 16, 0, 0); } \
            if (w == 0) __builtin_amdgcn_global_load_lds((const unsigned*)(G + (rowb + s0_ + (lane & 31)) * 4 + hd), (LAS unsigned*)(lds + ML_G + (bf_) * 256), 4, 0, 0); } while (0)
        const int nkt = 2 * qt + 2;
        ML_DMA_KV(0, 0); ML_DMA_KV(1, 1);
        int buf = 0;
        for (int kt = 0; kt < nkt; ++kt) {
            const int s0 = kt * 32;
            if (kt + 1 < nkt) { if (w == 0) asm volatile("s_waitcnt vmcnt(7) lgkmcnt(0)" ::: "memory"); else asm volatile("s_waitcnt vmcnt(6) lgkmcnt(0)" ::: "memory"); }
            else asm volatile("s_waitcnt vmcnt(0) lgkmcnt(0)" ::: "memory");
            __builtin_amdgcn_s_barrier(); asm volatile("" ::: "memory");
            { const int bf2 = buf >= 1 ? buf - 1 : 2; if (kt + 2 < nkt) ML_DMA_KV(kt + 2, bf2); }
            const LAS unsigned char* kb = lds + ML_K + buf * 16384; const LAS unsigned char* vbuf = lds + ML_V + buf * 32768; const LAS float* gl = (const LAS float*)(lds + ML_G + buf * 256);
            f32x4 sacc = (f32x4){0.f, 0.f, 0.f, 0.f};
            { bf16x8 kf[8];
#pragma unroll
              for (int ks = 0; ks < 8; ++ks) { const int r = 16 * ctp + l15; kf[ks] = *(const LAS bf16x8*)(kb + r * 512 + (((4 * ks + lg) ^ (r & 15)) * 16)); }
              asm volatile("" : "+v"(kf[0]), "+v"(kf[1]), "+v"(kf[2]), "+v"(kf[3]), "+v"(kf[4]), "+v"(kf[5]), "+v"(kf[6]), "+v"(kf[7]));
              f32x4 sacc1 = (f32x4){0.f, 0.f, 0.f, 0.f};
#pragma unroll
              for (int ks = 0; ks < 8; ks += 2) { sacc = __builtin_amdgcn_mfma_f32_16x16x32_bf16(qf[ks], kf[ks], sacc, 0, 0, 0); sacc1 = __builtin_amdgcn_mfma_f32_16x16x32_bf16(qf[ks + 1], kf[ks + 1], sacc1, 0, 0, 0); }
              sacc += sacc1; }
            { const int sl = 16 * ctp + l15; const float gs = gl[sl];
#pragma unroll
                for (int j = 0; j < 4; ++j) { const int tl = 16 * rt + lg * 4 + j;
                    const float wgt = (s0 + sl <= t0 + tl) ? __expf(gs - mxr[j]) : 0.f; const float val = sacc[j] * wgt;
                    *(LAS unsigned short*)(lds + ML_S + tl * ML_SROW + sl * 2) = (unsigned short)f2bf(val);
                    dacc[j] += row16_sum(val); } }
            asm volatile("s_waitcnt lgkmcnt(0)" ::: "memory"); __builtin_amdgcn_s_barrier(); asm volatile("" ::: "memory");
            { bf16x8 afr[4];
#pragma unroll
                for (int r4 = 0; r4 < 4; ++r4) afr[r4] = *(const LAS bf16x8*)(lds + ML_S + (16 * r4 + l15) * ML_SROW + (8 * lg) * 2);
                unsigned va[4];
#pragma unroll
                for (int c4 = 0; c4 < 4; ++c4) { const int r = 8 * lg + (l15 >> 2), ch = 8 * w + 2 * c4 + ((l15 & 3) >> 1); va[c4] = (unsigned)(size_t)(vbuf + r * 1024 + ((ch ^ ml_vswz(r)) * 16) + (l15 & 1) * 8); }
                s16x4 lo[4], hi[4];
                asm volatile("ds_read_b64_tr_b16 %0, %8\n\tds_read_b64_tr_b16 %1, %8 offset:4096\n\tds_read_b64_tr_b16 %2, %9\n\tds_read_b64_tr_b16 %3, %9 offset:4096\n\t"
                             "ds_read_b64_tr_b16 %4, %10\n\tds_read_b64_tr_b16 %5, %10 offset:4096\n\tds_read_b64_tr_b16 %6, %11\n\tds_read_b64_tr_b16 %7, %11 offset:4096\n\ts_waitcnt lgkmcnt(0)"
                             : "=&v"(lo[0]), "=&v"(hi[0]), "=&v"(lo[1]), "=&v"(hi[1]), "=&v"(lo[2]), "=&v"(hi[2]), "=&v"(lo[3]), "=&v"(hi[3]) : "v"(va[0]), "v"(va[1]), "v"(va[2]), "v"(va[3]) : "memory");
#pragma unroll
                for (int c4 = 0; c4 < 4; ++c4) { const bf16x8 bfr = __builtin_shufflevector(lo[c4], hi[c4], 0, 1, 2, 3, 4, 5, 6, 7);
#pragma unroll
                    for (int r4 = 0; r4 < 4; ++r4) num[r4][c4] = __builtin_amdgcn_mfma_f32_16x16x32_bf16(afr[r4], bfr, num[r4][c4], 0, 0, 0); } }
            buf = buf == 2 ? 0 : buf + 1;
        }
#undef ML_DMA_KV
        if (l15 == 0) {
#pragma unroll
            for (int j = 0; j < 4; ++j) denl[(16 * rt + lg * 4 + j) * 2 + ctp] = dacc[j]; }
        __syncthreads();
        { unsigned short co[4][4][4]; float mtv[4][4];
#pragma unroll
          for (int r4 = 0; r4 < 4; ++r4)
#pragma unroll
            for (int j = 0; j < 4; ++j) { const size_t row = rowb + t0 + 16 * r4 + lg * 4 + j; mtv[r4][j] = MT[row * 4 + hd];
#pragma unroll
                for (int c4 = 0; c4 < 4; ++c4) co[r4][j][c4] = PROJ[row * NPJ + PC_CO + hd * 512 + 64 * w + 16 * c4 + l15]; }
#pragma unroll
          for (int r4 = 0; r4 < 4; ++r4)
#pragma unroll
            for (int j = 0; j < 4; ++j) { const int tl = 16 * r4 + lg * 4 + j; const size_t row = rowb + t0 + tl;
                const float den = denl[2 * tl] + denl[2 * tl + 1], mt = mtv[r4][j]; const float inv = __builtin_amdgcn_rcpf(fmaxf(fabsf(den), __expf(-mt)));
#pragma unroll
                for (int c4 = 0; c4 < 4; ++c4) { const int dv = 64 * w + 16 * c4 + l15; const float o = sigm(bf2f(co[r4][j][c4]));
                    HC[row * 2048 + hd * 512 + dv] = num[r4][c4][j] * inv * o; } } }
        asm volatile("s_waitcnt vmcnt(0)" ::: "memory"); __syncthreads();
        { const float* gw_ = KIN(I_MGNW) + (size_t)l * 2048; bf16* Y = (bf16*)(KWS() + WS_Y); const int ch = hd * 512 + lane * 8;
          f32x4 hv0[8], hv1[8]; u32x4 hg[8]; const f32x4 gwa = *(const f32x4*)(gw_ + ch), gwb = *(const f32x4*)(gw_ + ch + 4);
#pragma unroll
          for (int rr = 0; rr < 8; ++rr) { const size_t t = rowb + t0 + w * 8 + rr; hv0[rr] = *(const f32x4*)(HC + t * 2048 + ch); hv1[rr] = *(const f32x4*)(HC + t * 2048 + ch + 4); hg[rr] = *(const u32x4*)(PROJ + t * NPJ + PC_CG + ch); }
          asm volatile("" ::: "memory");
#pragma unroll
          for (int rr = 0; rr < 8; ++rr) { const size_t t = rowb + t0 + w * 8 + rr;
            const f32x4 v0 = hv0[rr], v1 = hv1[rr];
            float x[8] = {v0.x, v0.y, v0.z, v0.w, v1.x, v1.y, v1.z, v1.w}; float sm_ = 0.f;
#pragma unroll
            for (int q = 0; q < 8; ++q) sm_ += x[q];
            const float mean = wave_sum(sm_) * (1.0f / 512.0f); float s2 = 0.f;
#pragma unroll
            for (int q = 0; q < 8; ++q) { x[q] -= mean; s2 += x[q] * x[q]; }
            const float rstd = rsqrtf(wave_sum(s2) * (1.0f / 512.0f) + 1e-6f);
            float gf[8]; unpack8(hg[rr], gf); float o[8];
#pragma unroll
            for (int q = 0; q < 8; ++q) o[q] = x[q] * rstd * (q < 4 ? gwa[q] : gwb[q - 4]) * siluf_(gf[q]);
            u32x4 wv; wv.x = pk2(o[0], o[1]); wv.y = pk2(o[2], o[3]); wv.z = pk2(o[4], o[5]); wv.w = pk2(o[6], o[7]);
            *(u32x4*)(Y + t * KCAT + YC_C + ch) = wv; } }
    }
    __syncthreads();
}

constexpr int XA_ROW = 272, XA_K = 0, XA_V = 256 * XA_ROW, XA_END = 2 * 256 * XA_ROW, XA_PROW = 528;
static_assert(XA_END <= RING_BYTES && 8 * 16 * XA_PROW <= XA_V, "x-attn LDS");
__device__ __forceinline__ void xattn_item(const Frame& F, int l, const int item) {
    const bf16* PROJ = (const bf16*)(KWS() + WS_PROJ); const bf16* KV = (const bf16*)(KWS() + WS_KV) + (size_t)l * MM * 1024; bf16* Y = (bf16*)(KWS() + WS_Y);
    LAS unsigned char* lds = F.lds; const int lane = opaque_v(F.lane), w = F.wave, tid = w * 64 + lane, l15 = lane & 15, lg = lane >> 4;
    {
        const int b = item >> 7, hd = (item >> 5) & 3, qb = item & 31; const size_t row0 = (size_t)b * SEQ + qb * 128 + 16 * w;
        __syncthreads();
        { u32x4 kq[8], vq[8];
#pragma unroll
          for (int i = 0; i < 8; ++i) { const int p = tid + 512 * i, r = p >> 4, c16 = p & 15; const bf16* src = KV + (size_t)(b * MEML + r) * 1024 + hd * 128 + c16 * 8; kq[i] = *(const u32x4*)src; vq[i] = *(const u32x4*)(src + 512); }
          asm volatile("" : "+v"(kq[0]), "+v"(kq[1]), "+v"(kq[2]), "+v"(kq[3]), "+v"(kq[4]), "+v"(kq[5]), "+v"(kq[6]), "+v"(kq[7]), "+v"(vq[0]), "+v"(vq[1]), "+v"(vq[2]), "+v"(vq[3]), "+v"(vq[4]), "+v"(vq[5]), "+v"(vq[6]), "+v"(vq[7]) :: "memory");
#pragma unroll
          for (int i = 0; i < 8; ++i) { const int p = tid + 512 * i, r = p >> 4, c16 = p & 15; *(LAS u32x4*)(lds + XA_K + r * XA_ROW + c16 * 16) = kq[i]; *(LAS u32x4*)(lds + XA_V + r * XA_ROW + c16 * 16) = vq[i]; } }
        bf16x8 qf[4];
#pragma unroll
        for (int ks = 0; ks < 4; ++ks) qf[ks] = *(const bf16x8*)(PROJ + (row0 + l15) * NPJ + PC_XQ + hd * 128 + 32 * ks + 8 * lg);
        unsigned short xg[4][8];
#pragma unroll
        for (int j = 0; j < 4; ++j)
#pragma unroll
            for (int cc = 0; cc < 8; ++cc) xg[j][cc] = PROJ[(row0 + lg * 4 + j) * NPJ + PC_XG + hd * 128 + 16 * cc + l15];
        __syncthreads();
        f32x4 sacc[16];
#pragma unroll
        for (int ct = 0; ct < 16; ++ct) { sacc[ct] = (f32x4){0.f, 0.f, 0.f, 0.f};
#pragma unroll
            for (int ks = 0; ks < 4; ++ks) { const bf16x8 bfr = *(const LAS bf16x8*)(lds + XA_K + (16 * ct + l15) * XA_ROW + (32 * ks + 8 * lg) * 2);
                sacc[ct] = __builtin_amdgcn_mfma_f32_16x16x32_bf16(qf[ks], bfr, sacc[ct], 0, 0, 0); } }
        float mx[4], sm[4];
#pragma unroll
        for (int j = 0; j < 4; ++j) { float m = sacc[0][j];
#pragma unroll
            for (int ct = 1; ct < 16; ++ct) m = fmaxf(m, sacc[ct][j]);
            mx[j] = row16_max(m); sm[j] = 0.f; }
        __syncthreads();
        LAS unsigned char* pw = lds + XA_K + w * 16 * XA_PROW;
#pragma unroll
        for (int ct = 0; ct < 16; ++ct)
#pragma unroll
            for (int j = 0; j < 4; ++j) { const float p = __expf((sacc[ct][j] - mx[j]) * 0.08838834764831845f); sm[j] += p;
                *(LAS unsigned short*)(pw + (lg * 4 + j) * XA_PROW + (16 * ct + l15) * 2) = (unsigned short)f2bf(p); }
#pragma unroll
        for (int j = 0; j < 4; ++j) sm[j] = row16_sum(sm[j]);
        LDS_WAIT(); asm volatile("" ::: "memory");
        f32x4 oacc[8];
#pragma unroll
        for (int cc = 0; cc < 8; ++cc) oacc[cc] = (f32x4){0.f, 0.f, 0.f, 0.f};
#pragma unroll
        for (int ks = 0; ks < 8; ++ks) { const bf16x8 afr = *(const LAS bf16x8*)(pw + l15 * XA_PROW + (32 * ks + 8 * lg) * 2);
#pragma unroll
            for (int cc = 0; cc < 8; ++cc) { const LAS unsigned char* vp = lds + XA_V + (32 * ks + 8 * lg + (l15 >> 2)) * XA_ROW + (16 * cc + 4 * (l15 & 3)) * 2;
                const s16x4 lo = tr16(vp), hi = tr16(vp + 4 * XA_ROW); const bf16x8 bfr = __builtin_shufflevector(lo, hi, 0, 1, 2, 3, 4, 5, 6, 7);
                oacc[cc] = __builtin_amdgcn_mfma_f32_16x16x32_bf16(afr, bfr, oacc[cc], 0, 0, 0); } }
#pragma unroll
        for (int j = 0; j < 4; ++j) { const size_t row = row0 + lg * 4 + j; const float inv = __builtin_amdgcn_rcpf(sm[j]);
#pragma unroll
            for (int cc = 0; cc < 8; ++cc) { const int d = 16 * cc + l15; const float gate = siluf_(bf2f(xg[j][cc]));
                Y[row * KCAT + YC_X + hd * 128 + d] = (bf16)f2bf(oacc[cc][j] * inv * gate); } }
    }
    __syncthreads();
}

constexpr int NPL = 9, NPHASE = 2 + DEPTH * NPL;
struct Args { Ctx c; int ph_lo, ph_hi; };
template <unsigned PH_MASK> __global__ void __launch_bounds__(NTHREADS, 2) mega(Args args) {
    extern __shared__ __attribute__((aligned(16))) unsigned char lds_raw[];
    Frame F; F.lds = (LAS unsigned char*)lds_raw; F.wave = __builtin_amdgcn_readfirstlane((int)threadIdx.x >> 6); F.lane = lane_id(); F.tid = F.wave * 64 + F.lane; F.bid = blockIdx.x; F.nblk = gridDim.x;
    volatile LAS unsigned* MISC = (volatile LAS unsigned*)(F.lds + MISC_OFF);
    if (F.tid < 16) MISC[F.tid] = 0u;
    __syncthreads();
    const int lo = args.ph_lo, hi = args.ph_hi;
    XcdBarrier bar; bar.bar = (unsigned*)(KWS() + WS_CTL) + CW_BAR; bar.st = MISC + 8;
    if (PH_MASK == 0x7FFu) { if (hi - lo > 1) xcd_barrier_setup(bar, F.wave); }
#ifndef PROBE_DUP
#define PROBE_DUP 0u
#endif
#define DUP(j) (((PROBE_DUP >> (j)) & 1u) ? 2 : 1)
#define IN(k) (lo <= (k) && (k) < hi)
#define EN(j) ((PH_MASK >> (j)) & 1u)
#define SEAM(k) do { if (PH_MASK == 0x7FFu) { if (IN(k) && IN((k) + 1)) xcd_barrier(bar, F.wave); } } while (0)
    if (IN(0) && EN(0)) for (int rep = 0; rep < DUP(0); ++rep) { phase_gate_absmax(F); phase_convert_layer(F, 0, 1, F.bid, F.nblk); phase_convert_layer(F, 1, 1, F.bid, F.nblk); phase_norm(F, KIN(I_X), KIN(I_NORM_G), false); }
    SEAM(0);
    if (IN(1) && EN(1)) for (int rep = 0; rep < DUP(1); ++rep) { phase_convert_layer(F, 0, 2, F.bid, F.nblk); if (!CONV1_IN_QUEUE) phase_convert_layer(F, 1, 2, F.bid, F.nblk); }
    SEAM(1);
    for (int l0 = 0; l0 < DEPTH; ++l0) {
        const int l = opaque_s(l0);
        const int pb = 2 + l * NPL;
        if (IN(pb + 0) && EN(2)) for (int rep = 0; rep < DUP(2); ++rep) {
            if (l == 0) {
                for (int l2 = 0; l2 < DEPTH; ++l2) { unsigned char* ws = KWS(); unsigned char* wl2 = ws + WS_W + (size_t)l2 * SZ_WLAYER;
                    pg8::Gemm g{(const char*)(ws + WS_MEMN) + (size_t)l2 * MM * 4096 * 2, (const char*)(wl2 + WO_WKV)};
                    EpiProj<1024, false> E{(bf16*)(ws + WS_KV) + (size_t)l2 * MM * 1024, nullptr};
                    const int cc = F.bid - (F.nblk - 16) - 8 * l2;
                    pg8::gemm_phase<pg8::Geo<8192, 8192, 4096, MM / 256, 4>, EpiProj<1024, false>>(F.lds, g, 8, (cc >= 0 && cc < 8) ? cc : 1000, F.wave, E); }
            }
            unsigned char* ws = KWS(); unsigned char* wl = ws + WS_W + (size_t)l * SZ_WLAYER;
            { pg8::Gemm g{(const char*)(ws + WS_H), (const char*)(wl + WO_WIN)};
              EpiProj<NPJ, true> E{(bf16*)(ws + WS_PROJ), (float*)(ws + WS_IFB)};
              pg8::gemm_phase<pg8::Geo<8192, 8192, 4096, M / 256, PN_I8>, EpiProj<NPJ, true>>(F.lds, g, F.nblk, F.bid, F.wave, E); }
            { pg8::Gemm g{(const char*)(ws + WS_H8), (const char*)(wl + WO_WIN) + (size_t)PC_I8 * 8192};
              EpiGate8 E{(bf16*)(ws + WS_PROJ) + PC_I8, (const float*)(ws + WS_HS), (const unsigned*)(ws + WS_CTL) + CW_CMAX + l * N8};
              pg8::gemm_phase<pg8::Geo<4096, 4096, 2048, M / 256, N8 / 256, 0, 0, true>, EpiGate8>(F.lds, g, F.nblk, F.bid, F.wave, E); }
        }
        SEAM(pb + 0);
        if (IN(pb + 1) && EN(3)) for (int rep = 0; rep < DUP(3); ++rep) { phase_prep(F, l); }
        SEAM(pb + 1);
        if (IN(pb + 2) && EN(4)) for (int rep = 0; rep < DUP(4); ++rep) {
            { unsigned char* ws = KWS(); unsigned char* wl = ws + WS_W + (size_t)l * SZ_WLAYER;
              pg8::Gemm g{(const char*)(ws + WS_U), (const char*)(wl + WO_WG)};
              EpiLru E{(const bf16*)(ws + WS_U), (float*)(ws + WS_LA), (float*)(ws + WS_LB), KIN(I_LRU_BA) + (size_t)l * 2048, KIN(I_LRU_BX) + (size_t)l * 2048, KIN(I_LRU_LAM) + (size_t)l * 2048};
              pg8::gemm_phase<pg8::Geo<4096, 512, 256, M / 256, 16, 1, 512>, EpiLru>(F.lds, g, F.nblk, F.bid, F.wave, E); }
            { unsigned char* ws = KWS(); unsigned char* wl = ws + WS_W + (size_t)l * SZ_WLAYER;
              pg8::Gemm g{(const char*)(ws + WS_LORA), (const char*)(wl + WO_WL)};
              EpiLora E{(float*)(ws + WS_RV), (float*)(ws + WS_AA), KIN(I_W0) + (size_t)l * 2048, KIN(I_A0) + (size_t)l * 2048};
              pg8::gemm_phase<pg8::Geo<512, 512, 256, M / 256, 16>, EpiLora>(F.lds, g, F.nblk, F.bid, F.wave, E); }
        }
        SEAM(pb + 2);
        if (IN(pb + 3) && EN(5)) for (int rep = 0; rep < DUP(5); ++rep) { phase_rwkv_vec(F, l); phase_lru_scan1(F); }
        SEAM(pb + 3);
        if (IN(pb + 4) && EN(6)) {
            for (int rep = 0; rep < DUP(6); ++rep) phase_rwkv_rec(F, F.bid, F.nblk);
#ifdef PROBE_Q
            phase_mlstm(F, l, (unsigned*)(KWS() + WS_CTL) + CW_QUEUE + 64 * l + 32, PROBE_Q_LO, PROBE_Q_HI);
#endif
            phase_mlstm(F, l, (unsigned*)(KWS() + WS_CTL) + CW_QUEUE + 64 * l);
        }
        SEAM(pb + 4);
        if (IN(pb + 5) && EN(7)) for (int rep = 0; rep < DUP(7); ++rep) { phase_rwkv_post(F, l); }
        SEAM(pb + 5);
        if (IN(pb + 6) && EN(8)) for (int rep = 0; rep < DUP(8); ++rep) {
            unsigned char* ws = KWS(); unsigned char* wl = ws + WS_W + (size_t)l * SZ_WLAYER;
            pg8::Gemm g{(const char*)(ws + WS_Y), (const char*)(wl + WO_WCAT)};
            EpiMerge E{(const bf16*)(ws + WS_PROJ) + PC_GATE, (bf16*)(ws + WS_MERGED)};
            pg8::gemm_phase<pg8::Geo<KCAT * 2, KCAT * 2, KCAT, M / 256, 16>, EpiMerge>(F.lds, g, F.nblk, F.bid, F.wave, E);
        }
        SEAM(pb + 6);
        if (IN(pb + 7) && EN(9)) for (int rep = 0; rep < ((l == 0) ? DUP(9) : 1); ++rep) {
            unsigned char* ws = KWS(); unsigned char* wl = ws + WS_W + (size_t)l * SZ_WLAYER;
            pg8::Gemm g{(const char*)(ws + WS_MERGED), (const char*)(wl + WO_WOUT)};
            EpiOut E{(l == 0) ? KIN(I_X) : (const float*)(ws + WS_X1), (float*)(ws + WS_X1)};
            pg8::gemm_phase<pg8::Geo<8192, 8192, 4096, M / 256, 16>, EpiOut>(F.lds, g, F.nblk, F.bid, F.wave, E);
        }
        SEAM(pb + 7);
        if (IN(pb + 8) && EN(10)) { const float* X1 = (const float*)(KWS() + WS_X1); if (l + 1 < DEPTH) phase_norm(F, X1, KIN(I_NORM_G) + (size_t)(l + 1) * 4096, false); else phase_norm(F, X1, KIN(I_FNG), true); }
        SEAM(pb + 8);
    }
#undef IN
#undef SEAM
}

typedef void (*kern_t)(Args);
static kern_t phase_kernel(int p) {
    const int j = p < 2 ? p : 2 + (p - 2) % NPL;
    switch (j) { case 0: return mega<1u << 0>; case 1: return mega<1u << 1>; case 2: return mega<1u << 2>; case 3: return mega<1u << 3>; case 4: return mega<1u << 4>; case 5: return mega<1u << 5>;
                 case 6: return mega<1u << 6>; case 7: return mega<1u << 7>; case 8: return mega<1u << 8>; case 9: return mega<1u << 9>; default: return mega<1u << 10>; }
}
extern "C" void kernel_launch(void* const* d_in, const int* in_sizes, int n_in, void* d_out, int out_size, void* d_ws, size_t ws_size, hipStream_t stream) {
    static int grid = 0;
    if (grid == 0) {
        if (n_in != 34 || ws_size < WS_END) { fprintf(stderr, "kernel_launch: unexpected problem (n_in %d, ws %zu, need %zu)\n", n_in, ws_size, (size_t)WS_END); grid = -1; return; }
        int dev = 0, cus = 0;
        if (hipGetDevice(&dev) != hipSuccess || hipDeviceGetAttribute(&cus, hipDeviceAttributeMultiprocessorCount, dev) != hipSuccess) { grid = -1; return; }
#if MK_PER_PHASE
        for (int p = 0; p < 2 + NPL; ++p) if (hipFuncSetAttribute((const void*)phase_kernel(p), hipFuncAttributeMaxDynamicSharedMemorySize, LDS_BYTES) != hipSuccess) { fprintf(stderr, "kernel_launch: hipFuncSetAttribute failed\n"); grid = -1; return; }
#else
        if (hipFuncSetAttribute((const void*)mega<0x7FFu>, hipFuncAttributeMaxDynamicSharedMemorySize, LDS_BYTES) != hipSuccess) { fprintf(stderr, "kernel_launch: hipFuncSetAttribute failed\n"); grid = -1; return; }
#endif
        int occ = 0;
#if MK_PER_PHASE
        occ = 1;
#else
        if (hipOccupancyMaxActiveBlocksPerMultiprocessor(&occ, mega<0x7FFu>, NTHREADS, LDS_BYTES) != hipSuccess || occ < 1) { fprintf(stderr, "kernel_launch: occupancy query reports %d workgroups per CU\n", occ); grid = -1; return; }
#endif
        (void)hipGetLastError();
        grid = cus;
    }
    if (grid < 0) return;
    (void)hipMemsetAsync((char*)d_ws + WS_CTL, 0, CTL_ZERO_BYTES, stream);
    Args a{};
    for (int i = 0; i < 34; ++i) a.c.in[i] = (const float*)d_in[i];
    a.c.out = (float*)d_out; a.c.ws = (unsigned char*)d_ws;
#if MK_PER_PHASE
    for (int p = 0; p < NPHASE; ++p) { a.ph_lo = p; a.ph_hi = p + 1; hipLaunchKernelGGL(phase_kernel(p), dim3(grid), dim3(NTHREADS), LDS_BYTES, stream, a); }
#else
    a.ph_lo = 0; a.ph_hi = NPHASE; hipLaunchKernelGGL(mega<0x7FFu>, dim3(grid), dim3(NTHREADS), LDS_BYTES, stream, a);
#endif
    (void)in_sizes; (void)out_size;
}
```

```cpp
#include <hip/hip_runtime.h>
#include <cstdio>
#include <cstdint>

#ifndef MK_PER_PHASE
#define MK_PER_PHASE 0
#endif

#define LAS __attribute__((address_space(3)))
#define GAS __attribute__((address_space(1)))
typedef unsigned short bf16;
typedef short bf16x8 __attribute__((ext_vector_type(8)));
typedef short s16x4 __attribute__((ext_vector_type(4)));
typedef float f32x4 __attribute__((ext_vector_type(4)));
typedef float f32x2 __attribute__((ext_vector_type(2)));
typedef unsigned u32x4 __attribute__((ext_vector_type(4)));
typedef unsigned u32x2 __attribute__((ext_vector_type(2)));
typedef int i32x4 __attribute__((ext_vector_type(4)));

constexpr int D = 4096, NBATCH = 2, SEQ = 4096, M = NBATCH * SEQ, DEPTH = 2, MEML = 256, MM = NBATCH * MEML;
constexpr int CIN = 38088;
constexpr int NPJ = 38400;
constexpr int PC_AX = 0, PC_AG = 2048, PC_BR = 4096, PC_BK = 6144, PC_BV = 8192, PC_BWD = 10240, PC_BAD = 10368, PC_BG = 10496,
              PC_CQK = 12544, PC_CV = 14592, PC_CG = 16640, PC_XQ = 18688, PC_XG = 19200, PC_IF = 19712, PC_CO = 19968, PC_GATE = 22016;
constexpr int PN_IF = PC_IF / 256;
constexpr int KCAT = 6656;
constexpr int YC_A = 0, YC_B = 2048, YC_C = 4096, YC_X = 6144;

constexpr size_t MiB = 1u << 20;
constexpr size_t WS_CTL = 0, CTL_ZERO_BYTES = 1 * MiB;
constexpr size_t SZ_WIN = 300 * MiB, SZ_WCAT = 52 * MiB, SZ_WOUT = 32 * MiB, SZ_WKV = 8 * MiB, SZ_WG = 2 * MiB, SZ_WL = 2 * MiB;
constexpr size_t SZ_WLAYER = SZ_WIN + SZ_WCAT + SZ_WOUT + SZ_WKV + SZ_WG + SZ_WL;
constexpr size_t WS_W = 1 * MiB;
constexpr size_t WO_WIN = 0, WO_WCAT = SZ_WIN, WO_WOUT = WO_WCAT + SZ_WCAT, WO_WKV = WO_WOUT + SZ_WOUT, WO_WG = WO_WKV + SZ_WKV, WO_WL = WO_WG + SZ_WG;
constexpr size_t WS_MEMN = WS_W + 2 * SZ_WLAYER;
constexpr size_t WS_KV = WS_MEMN + 8 * MiB;
constexpr size_t WS_H = WS_KV + 2 * MiB;
constexpr size_t WS_PROJ = WS_H + 64 * MiB;
constexpr size_t WS_IFB = WS_PROJ + 600 * MiB;
constexpr size_t WS_U = WS_IFB + 1 * MiB;
constexpr size_t WS_LA = WS_U + 32 * MiB;
constexpr size_t WS_LB = WS_LA + 64 * MiB;
constexpr size_t WS_CARRY = WS_LB + 64 * MiB;
constexpr size_t WS_LORA = WS_CARRY + 1 * MiB;
constexpr size_t WS_WDEC = WS_LORA + 4 * MiB;
constexpr size_t WS_AA = WS_WDEC + 64 * MiB;
constexpr size_t WS_RV = WS_AA + 64 * MiB;
constexpr size_t WS_VV = WS_RV + 320 * MiB;
constexpr size_t WS_BON = WS_VV + 64 * MiB;
constexpr size_t WS_YR = WS_BON + 1 * MiB;
constexpr size_t WS_QC = WS_YR + 64 * MiB;
constexpr size_t WS_KC = WS_QC + 16 * MiB;
constexpr size_t WS_SCAL = WS_KC + 16 * MiB;
constexpr size_t WS_HC = WS_SCAL + 1 * MiB;
constexpr size_t WS_Y = WS_HC + 64 * MiB;
constexpr size_t WS_MERGED = WS_Y + 104 * MiB;
constexpr size_t WS_X1 = WS_MERGED + 64 * MiB;
constexpr size_t WS_H8 = WS_X1 + 128 * MiB;
constexpr size_t WS_HS = WS_H8 + 32 * MiB;
constexpr size_t WS_END = WS_HS + 1 * MiB;
constexpr int CW_BAR = 4096, CW_QUEUE = 8192;
constexpr int CW_CMAX = 131072;
constexpr int NGATE = 16384, PC_I8 = PC_CO, N8 = 2048 + NGATE, PN_I8 = PC_I8 / 256;
#ifndef CONV1_IN_QUEUE
#define CONV1_IN_QUEUE 1
#endif
constexpr int CONV_NVB = 512;

constexpr int RING_BYTES = 155648;
constexpr int MISC_OFF = RING_BYTES;
constexpr int LDS_BYTES = 159744;
constexpr int NWAVES = 8, NTHREADS = 512;

__device__ __forceinline__ float bf2f(unsigned short b) { return __uint_as_float(((unsigned)b) << 16); }
__device__ __forceinline__ unsigned f2bf(float f) { unsigned u = __float_as_uint(f); return (u + 0x7fffu + ((u >> 16) & 1u)) >> 16; }
__device__ __forceinline__ unsigned pk2(float lo, float hi) { return f2bf(lo) | (f2bf(hi) << 16); }
__device__ __forceinline__ unsigned cvt_pk_bf16(float lo, float hi) { unsigned r; asm volatile("v_cvt_pk_bf16_f32 %0, %1, %2" : "=v"(r) : "v"(lo), "v"(hi)); return r; }
__device__ __forceinline__ float sigm(float x) { return __builtin_amdgcn_rcpf(1.0f + __expf(-x)); }
__device__ __forceinline__ float siluf_(float x) { return x * __builtin_amdgcn_rcpf(1.0f + __expf(-x)); }
__device__ __forceinline__ float softplusf_(float x) { return fmaxf(x, 0.f) + __logf(1.0f + __expf(-fabsf(x))); }
__device__ __forceinline__ float expm1s_(float x) { const float p = x * (1.0f + x * (0.5f + x * (0.16666667f + x * (0.041666668f + x * 0.0083333338f)))); return fabsf(x) < 0.25f ? p : __expf(x) - 1.0f; }

template <int CTRL> __device__ __forceinline__ float dpp_mov(float v) { return __int_as_float(__builtin_amdgcn_update_dpp(0, __float_as_int(v), CTRL, 0xf, 0xf, true)); }
__device__ __forceinline__ float row16_sum(float v) {
    v += dpp_mov<0xB1>(v); v += dpp_mov<0x4E>(v); v += dpp_mov<0x141>(v); v += dpp_mov<0x140>(v); return v;
}
__device__ __forceinline__ float wave_sum(float v) { v = row16_sum(v); v += __shfl_xor(v, 16); v += __shfl_xor(v, 32); return v; }
__device__ __forceinline__ float row16_max(float v) {
    v = fmaxf(v, dpp_mov<0xB1>(v)); v = fmaxf(v, dpp_mov<0x4E>(v)); v = fmaxf(v, dpp_mov<0x141>(v)); v = fmaxf(v, dpp_mov<0x140>(v)); return v;
}
__device__ __forceinline__ void unpack8(const u32x4 w, float* f) {
    f[0] = __uint_as_float(w.x << 16); f[1] = __uint_as_float(w.x & 0xffff0000u); f[2] = __uint_as_float(w.y << 16); f[3] = __uint_as_float(w.y & 0xffff0000u);
    f[4] = __uint_as_float(w.z << 16); f[5] = __uint_as_float(w.z & 0xffff0000u); f[6] = __uint_as_float(w.w << 16); f[7] = __uint_as_float(w.w & 0xffff0000u);
}
__device__ __forceinline__ int opaque_v(int v) { asm volatile("" : "+v"(v)); return v; }
template <class T> __device__ __forceinline__ const T* opaque_p(const T* p) { asm volatile("" : "+s"(p)); return p; }
__device__ __forceinline__ int opaque_s(int v) { asm volatile("" : "+s"(v)); return v; }
__device__ __forceinline__ int lane_id() { unsigned z; asm volatile("v_mov_b32 %0, 0" : "=v"(z)); return (int)__builtin_amdgcn_mbcnt_hi(~0u, __builtin_amdgcn_mbcnt_lo(~0u, z)); }
#define LDS_WAIT() asm volatile("s_waitcnt lgkmcnt(0)" ::: "memory")
#define VM_WAIT() asm volatile("s_waitcnt vmcnt(0)" ::: "memory")

#define XB_TMO      128
#define XB_XCNT(j)  (256  + 64 * (j))
#define XB_XSUB(j)  (1280 + 64 * (j))
#define XB_XGEN(j)  (2304 + 64 * (j))
#define XB_TOP      3328
#define XB_TOPGEN   3392
#define XCD_BAR_WORDS 3456
#define XB_SPIN_CAP (1u << 18)
__device__ __forceinline__ unsigned xb_ld(unsigned* p)              { return __hip_atomic_load(p, __ATOMIC_RELAXED, __HIP_MEMORY_SCOPE_AGENT); }
__device__ __forceinline__ unsigned xb_add(unsigned* p, unsigned v) { return __hip_atomic_fetch_add(p, v, __ATOMIC_RELAXED, __HIP_MEMORY_SCOPE_AGENT); }
__device__ __forceinline__ unsigned xb_xcc_id() { return (unsigned)__builtin_amdgcn_s_getreg((3 << 11) | 20) & 0xFu; }
#define XB_SPIN(cond, bar) do { unsigned _sp = 0; while (cond) { __builtin_amdgcn_s_sleep(1); \
    if ((++_sp & 255u) == 0u) { if (xb_ld(&(bar)[XB_TMO])) break; if (_sp > XB_SPIN_CAP) { atomicAdd(&(bar)[XB_TMO], 1u); break; } } } } while (0)
struct XcdBarrier { unsigned* bar; volatile LAS unsigned* st; };
__device__ __forceinline__ void xcd_barrier_setup(const XcdBarrier& b, const int wave_) {
    if (opaque_s(wave_) == 0 && lane_id() == 0) {
        unsigned* bar = b.bar; const unsigned x = xb_xcc_id();
        (void)xb_add(&bar[XB_XCNT(x)], 1u);
        const unsigned G = gridDim.x * gridDim.y * gridDim.z;
        unsigned sum, cnt, mine, sp = 0u;
        for (;;) {
            sum = 0u; cnt = 0u; mine = 0u;
            for (unsigned j = 0; j < 16; ++j) { const unsigned c = xb_ld(&bar[XB_XCNT(j)]); sum += c; cnt += (c > 0u) ? 1u : 0u; mine = (j == x) ? c : mine; }
            if (sum == G) break;
            __builtin_amdgcn_s_sleep(1);
            if ((++sp & 255u) == 0u) { if (xb_ld(&bar[XB_TMO])) break; if (sp > XB_SPIN_CAP) { atomicAdd(&bar[XB_TMO], 1u); break; } }
        }
        b.st[0] = mine > 0u ? mine : 1u; b.st[1] = cnt > 0u ? cnt : 1u; b.st[2] = x;
    }
    __syncthreads();
}
__device__ __forceinline__ void xcd_barrier(const XcdBarrier& b, const int wave_) {
    asm volatile("s_waitcnt vmcnt(0)" ::: "memory");
    __syncthreads();
    if (opaque_s(wave_) == 0 && lane_id() == 0) {
        unsigned* bar = b.bar;
        __builtin_amdgcn_s_waitcnt(0);
        const unsigned nloc = b.st[0], nx = b.st[1], x = b.st[2];
        const unsigned old = xb_add(&bar[XB_XSUB(x)], 1u);
        const unsigned gen = old / nloc;
        if (old + 1u == (gen + 1u) * nloc) {
            __builtin_amdgcn_fence(__ATOMIC_RELEASE, "agent");
            asm volatile("s_waitcnt vmcnt(0)" ::: "memory");
            const unsigned og = xb_add(&bar[XB_TOP], 1u);
            const unsigned tg = og / nx;
            if (og + 1u == (tg + 1u) * nx) xb_add(&bar[XB_TOPGEN], 1u);
            else XB_SPIN(xb_ld(&bar[XB_TOPGEN]) == tg, bar);
            __builtin_amdgcn_fence(__ATOMIC_ACQUIRE, "agent");
            xb_add(&bar[XB_XGEN(x)], 1u);
            asm volatile("s_waitcnt vmcnt(0)" ::: "memory");
        } else {
            XB_SPIN(xb_ld(&bar[XB_XGEN(x)]) == gen, bar);
            __builtin_amdgcn_fence(__ATOMIC_ACQUIRE, "agent");
            asm volatile("s_waitcnt vmcnt(0)" ::: "memory");
        }
    }
    __syncthreads();
}

namespace pg8 {
constexpr int BM = 256, BK = 64, HALF = 128, HTB = HALF * BK * 2, STAGE_BYTES = 8 * HTB, NXCD = 8, WGM = 8;
__host__ __device__ __forceinline__ int lds_byte(int r, int c) { const int st = (r >> 4) * 2 + (c >> 5), rr = r & 15, cc = c & 31, ob = rr * 64 + cc * 2; return st * 1024 + (ob ^ (((ob >> 9) & 1) << 5)); }
__host__ __device__ __forceinline__ void stage_rc(int b, int& R, int& C) { const int st = b / 1024, sb = b % 1024, swz = sb ^ (((sb >> 9) & 1) << 5); R = (st >> 1) * 16 + swz / 64; C = (st & 1) * 32 + (swz % 64) / 2; }
__host__ __device__ __forceinline__ int perm32(int rho) { const int n = rho >> 4, i = rho & 15; return 8 * (i >> 2) + 4 * n + (i & 3); }
struct Unit { int pm, pn; };
struct Gemm { const char* A; const char* Bt; };
template <int LDA_, int LDB_, int K_, int NM_, int NN_, int ASHIFT_ = 0, int ASTEP_ = 0, bool I8_ = false> struct Geo { static constexpr int LDA = LDA_, LDB = LDB_, K = K_, NM = NM_, NN = NN_, ASHIFT = ASHIFT_, ASTEP = ASTEP_; static constexpr bool I8 = I8_; };
template <bool I8> __device__ __forceinline__ f32x4 mma16(const bf16x8 a, const bf16x8 b, const f32x4 c) {
    if constexpr (I8) return __builtin_bit_cast(f32x4, __builtin_amdgcn_mfma_i32_16x16x64_i8(__builtin_bit_cast(i32x4, a), __builtin_bit_cast(i32x4, b), __builtin_bit_cast(i32x4, c), 0, 0, 0));
    else return __builtin_amdgcn_mfma_f32_16x16x32_bf16(a, b, c, 0, 0, 0); }
struct StaticOrder {
    int nM, nN, nwg, G, c;
    __device__ void init(int nM_, int nN_, int G_, int c_) { nM = nM_; nN = nN_; nwg = nM * nN; G = G_; c = c_; }
    __device__ bool next(int i, Unit& u) const {
        const long L = (long)i * G + c; if (L >= nwg) return false;
        int wgid = (int)L; { const int q = nwg / NXCD, r = nwg % NXCD, xcd = wgid % NXCD, off = wgid / NXCD; wgid = (xcd < r ? xcd * (q + 1) : r * (q + 1) + (xcd - r) * q) + off; }
        const int nig = WGM * nN, gid = wgid / nig, fm = gid * WGM, gsz = (nM - fm) < WGM ? (nM - fm) : WGM;
        u.pm = fm + ((wgid % nig) % gsz); u.pn = (wgid % nig) / gsz; return true;
    }
};
template <class GEO, class Epi>
__device__ __forceinline__ void gemm_phase(LAS unsigned char* lds, const Gemm g, const int G_, const int c_, const int wave_, const Epi& E) {
    StaticOrder S; S.init(GEO::NM, GEO::NN, opaque_s(G_), opaque_s(c_));
    const int wid = opaque_s(wave_), lane = lane_id(), tid = wid * 64 + lane, wr = wid >> 2, wc = wid & 3, fr = lane & 15, fq = lane >> 4;
    constexpr int nt = GEO::K / BK;
    unsigned voffA[2], voffB[2];
#pragma unroll
    for (int i = 0; i < 2; ++i) { int R, C; stage_rc(tid * 16 + i * 8192, R, C); const int Rb = Epi::PERM ? ((R & ~31) + perm32(R & 31)) : R;
        voffA[i] = (unsigned)(R * GEO::LDA + C * 2); voffB[i] = (unsigned)(Rb * GEO::LDB + C * 2); }
    constexpr size_t kstep = (size_t)(BK * 2);
    constexpr size_t hstepA = (size_t)HALF * GEO::LDA, hstepB = (size_t)HALF * GEO::LDB;
    const unsigned ldsw = (unsigned)wid * 1024u;
    const int aoff = lds_byte(wr * 64 + fr, fq * 8), boff = lds_byte(wc * 32 + fr, fq * 8);
#define PG8_SA(b, h) (((b) * 2 + (h)) * HTB)
#define PG8_SB(b, h) ((4 + (b) * 2 + (h)) * HTB)
#define PG8_STAGE(bufoff, gbase, voff) do { _Pragma("unroll") for (int _i = 0; _i < 2; ++_i) \
        __builtin_amdgcn_global_load_lds((const unsigned*)((const char*)(gbase) + (voff)[_i]), (LAS unsigned*)(lds + (bufoff) + ldsw + _i * 8192), 16, 0, 0); } while (0)
#define PG8_LDA(dst, b, h) do { _Pragma("unroll") for (int m = 0; m < 4; ++m) _Pragma("unroll") for (int k = 0; k < 2; ++k) dst[m][k] = *(const LAS bf16x8*)(lds + PG8_SA(b, h) + aoff + m * 2048 + k * 1024); } while (0)
#define PG8_LDB(dst, b, h) do { _Pragma("unroll") for (int n = 0; n < 2; ++n) _Pragma("unroll") for (int k = 0; k < 2; ++k) dst[n][k] = *(const LAS bf16x8*)(lds + PG8_SB(b, h) + boff + n * 2048 + k * 1024); } while (0)
#define PG8_MMA(ai, bj, At, Bt) do { __builtin_amdgcn_s_setprio(1); _Pragma("unroll") for (int m = 0; m < 4; ++m) _Pragma("unroll") for (int n = 0; n < 2; ++n) _Pragma("unroll") for (int k = 0; k < 2; ++k) \
        acc[ai][bj][m][n] = mma16<GEO::I8>(Bt[n][k], At[m][k], acc[ai][bj][m][n]); __builtin_amdgcn_s_setprio(0); } while (0)
#define PG8_WAIT_V(n) asm volatile("s_waitcnt vmcnt(" #n ")" ::: "memory")
#define PG8_WAIT_L(n) asm volatile("s_waitcnt lgkmcnt(" #n ")" ::: "memory")
#define PG8_BAR __builtin_amdgcn_s_barrier()
#define PG8_SCHED __builtin_amdgcn_sched_barrier(0)
    Unit cur, nxt; int ui = 0;
    if (!S.next(0, cur)) return;
    f32x4 acc[2][2][4][2];
#pragma unroll
    for (int a = 0; a < 2; ++a)
#pragma unroll
        for (int b = 0; b < 2; ++b)
#pragma unroll
            for (int m = 0; m < 4; ++m)
#pragma unroll
                for (int n = 0; n < 2; ++n) acc[a][b][m][n] = (f32x4){0.f, 0.f, 0.f, 0.f};
    bf16x8 At[4][2], B0[2][2], B1[2][2];
    const char* cA = g.A + (size_t)cur.pm * (BM * GEO::LDA) + (size_t)((cur.pn >> GEO::ASHIFT) * GEO::ASTEP);
    const char* cB = g.Bt + (size_t)cur.pn * (BM * GEO::LDB);
    PG8_STAGE(PG8_SB(0, 0), cB, voffB); PG8_STAGE(PG8_SB(0, 1), cB + hstepB, voffB); PG8_STAGE(PG8_SA(0, 0), cA, voffA); PG8_STAGE(PG8_SA(0, 1), cA + hstepA, voffA);
    if (wr == 1) PG8_BAR;
    PG8_WAIT_V(2); PG8_BAR;
    PG8_STAGE(PG8_SB(1, 0), cB + kstep, voffB); PG8_STAGE(PG8_SA(1, 0), cA + kstep, voffA); PG8_STAGE(PG8_SB(1, 1), cB + hstepB + kstep, voffB);
    PG8_WAIT_V(6); PG8_BAR;
    for (;;) {
        const bool has_next = S.next(ui + 1, nxt);
        const char* nA = has_next ? g.A + (size_t)nxt.pm * (BM * GEO::LDA) + (size_t)((nxt.pn >> GEO::ASHIFT) * GEO::ASTEP) : cA;
        const char* nB = has_next ? g.Bt + (size_t)nxt.pn * (BM * GEO::LDB) : cB;
#pragma unroll 1
        for (int t = 0; t < nt; t += 2) {
            const bool last = (t == nt - 2);
            const char* a1 = cA + (size_t)(t + 1) * kstep;
            const char* a2 = last ? nA : cA + (size_t)(t + 2) * kstep; const char* b2 = last ? nB : cB + (size_t)(t + 2) * kstep;
            const char* a3 = a2 + kstep; const char* b3 = b2 + kstep;
            if constexpr (Epi::HOOK) { if (t != 0 && (t & 31) == 0) E.hook(acc, cur, (t >> 5) - 1, wr, wc, fr, fq); }
            PG8_LDB(B0, 0, 0); PG8_LDB(B1, 0, 1); PG8_SCHED; PG8_LDA(At, 0, 0); PG8_STAGE(PG8_SA(1, 1), a1 + hstepA, voffA);
            PG8_WAIT_V(8); PG8_WAIT_L(0); PG8_BAR; PG8_MMA(0, 0, At, B0); PG8_MMA(0, 1, At, B1); PG8_BAR; PG8_SCHED;
            PG8_LDA(At, 0, 1); PG8_STAGE(PG8_SB(0, 0), b2, voffB); PG8_STAGE(PG8_SB(0, 1), b2 + hstepB, voffB); PG8_STAGE(PG8_SA(0, 0), a2, voffA);
            PG8_WAIT_V(8); PG8_WAIT_L(0); PG8_BAR; PG8_MMA(1, 0, At, B0); PG8_MMA(1, 1, At, B1); PG8_BAR; PG8_SCHED;
            PG8_LDB(B0, 1, 0); PG8_LDB(B1, 1, 1); PG8_SCHED; PG8_LDA(At, 1, 0); PG8_STAGE(PG8_SA(0, 1), a2 + hstepA, voffA);
            PG8_WAIT_V(8); PG8_WAIT_L(0); PG8_BAR; PG8_MMA(0, 0, At, B0); PG8_MMA(0, 1, At, B1); PG8_BAR; PG8_SCHED;
            PG8_LDA(At, 1, 1); PG8_STAGE(PG8_SB(1, 0), b3, voffB); PG8_STAGE(PG8_SB(1, 1), b3 + hstepB, voffB); PG8_STAGE(PG8_SA(1, 0), a3, voffA);
            PG8_WAIT_V(8); PG8_WAIT_L(0); PG8_BAR; PG8_MMA(1, 0, At, B0); PG8_MMA(1, 1, At, B1); PG8_BAR; PG8_SCHED;
        }
        if (wr == 0) PG8_BAR;
        E(acc, cur, wr, wc, fr, fq);
        if (!has_next) break;
#pragma unroll
        for (int a = 0; a < 2; ++a)
#pragma unroll
            for (int b = 0; b < 2; ++b)
#pragma unroll
                for (int m = 0; m < 4; ++m)
#pragma unroll
                    for (int n = 0; n < 2; ++n) acc[a][b][m][n] = (f32x4){0.f, 0.f, 0.f, 0.f};
        cur = nxt; cA = nA; cB = nB; ++ui;
        if (wr == 1) PG8_BAR;
    }
    PG8_WAIT_V(0);
    PG8_BAR;
#undef PG8_SA
#undef PG8_SB
#undef PG8_STAGE
#undef PG8_LDA
#undef PG8_LDB
#undef PG8_MMA
#undef PG8_WAIT_V
#undef PG8_WAIT_L
#undef PG8_BAR
#undef PG8_SCHED
}
}

struct Ctx { const float* in[34]; float* out; unsigned char* ws; };
enum { I_X = 0, I_MEM, I_NORM_G, I_MEMNORM_G, I_WIN, I_LRU_CW, I_LRU_CB, I_LRU_WA, I_LRU_BA, I_LRU_WX, I_LRU_BX, I_LRU_LAM, I_MU, I_W0, I_WUP, I_A0, I_AUP,
       I_KK, I_KA, I_RK, I_GNW, I_GNB, I_MCW, I_MCB, I_MBI, I_MBF, I_MGNW, I_WKV, I_WBA, I_WBB, I_WBC, I_WBX, I_WOUT, I_FNG };


typedef const __attribute__((address_space(4))) char* kargp_t;
template <int OFF> __device__ __forceinline__ unsigned long long karg_u64() {
    kargp_t kp = (kargp_t)__builtin_amdgcn_kernarg_segment_ptr(); unsigned long long v;
    asm volatile("s_load_dwordx2 %0, %1, %2\n\ts_waitcnt lgkmcnt(0)" : "=s"(v) : "s"(kp), "i"(OFF)); return v; }
#define KIN(i) ((const float*)(const GAS float*)karg_u64<(i) * 8>())
#define KOUT() ((float*)(GAS float*)karg_u64<34 * 8>())
#define KWS() ((unsigned char*)(GAS unsigned char*)karg_u64<35 * 8>())

template <int ldc, bool HAS_IF> struct EpiProj {
    static constexpr bool PERM = true, HOOK = false;
    bf16* O; float* ifb;
    __device__ __forceinline__ void operator()(const f32x4 (&acc)[2][2][4][2], const pg8::Unit& u, int wr, int wc, int fr, int fq) const {
        const int row0 = u.pm * 256 + wr * 64 + fr, col0 = u.pn * 256 + wc * 32 + 8 * fq;
#pragma unroll
        for (int ai = 0; ai < 2; ++ai)
#pragma unroll
            for (int m = 0; m < 4; ++m) { const int row = row0 + ai * 128 + m * 16; bf16* rowp = O + (size_t)row * ldc + col0;
#pragma unroll
                for (int bj = 0; bj < 2; ++bj) { const f32x4 v0 = acc[ai][bj][m][0], v1 = acc[ai][bj][m][1];
                    u32x4 w; w.x = cvt_pk_bf16(v0[0], v0[1]); w.y = cvt_pk_bf16(v0[2], v0[3]); w.z = cvt_pk_bf16(v1[0], v1[1]); w.w = cvt_pk_bf16(v1[2], v1[3]);
                    *(u32x4*)(rowp + bj * 128) = w; }
                if (HAS_IF && u.pn == PN_IF && wc == 0 && fq == 0) { *(f32x4*)(ifb + (size_t)row * 8) = acc[ai][0][m][0]; *(f32x4*)(ifb + (size_t)row * 8 + 4) = acc[ai][0][m][1]; }
            }
    }
};
__device__ __forceinline__ void gl2n_issue(u32x4& a0, u32x4& a1, const void* pa, unsigned voff) {
    asm volatile("s_nop 4\n\tglobal_load_dwordx4 %0, %2, %3\n\tglobal_load_dwordx4 %1, %2, %3 offset:16" : "=&v"(a0), "=&v"(a1) : "v"(voff), "s"(pa) : "memory"); }
#define GL_WAIT4(g) asm volatile("s_waitcnt vmcnt(0)" : "+v"(g[0]), "+v"(g[1]), "+v"(g[2]), "+v"(g[3]) :: "memory")
struct EpiGate8 {
    static constexpr bool PERM = true, HOOK = false;
    bf16* O; const float* hs; const unsigned* cmax;
    __device__ __forceinline__ void operator()(const f32x4 (&acc)[2][2][4][2], const pg8::Unit& u, int wr, int wc, int fr, int fq) const {
        const int row0 = u.pm * 256 + wr * 64 + fr, col0 = u.pn * 256 + wc * 32 + 8 * fq;
        u32x4 cs[4]; const unsigned coff = (unsigned)((wc * 32 + 8 * fq) * 4);
        gl2n_issue(cs[0], cs[1], cmax + u.pn * 256, coff); gl2n_issue(cs[2], cs[3], cmax + u.pn * 256 + 128, coff);
        float rsv[8]; { const float* hb = hs + u.pm * 256 + wr * 64; const unsigned roff = (unsigned)(fr * 4);
            asm volatile("s_nop 4\n\tglobal_load_dword %0, %8, %9\n\tglobal_load_dword %1, %8, %9 offset:64\n\tglobal_load_dword %2, %8, %9 offset:128\n\tglobal_load_dword %3, %8, %9 offset:192\n\t"
                         "global_load_dword %4, %8, %9 offset:512\n\tglobal_load_dword %5, %8, %9 offset:576\n\tglobal_load_dword %6, %8, %9 offset:640\n\tglobal_load_dword %7, %8, %9 offset:704\n\ts_waitcnt vmcnt(0)"
                         : "=&v"(rsv[0]), "=&v"(rsv[1]), "=&v"(rsv[2]), "=&v"(rsv[3]), "=&v"(rsv[4]), "=&v"(rsv[5]), "=&v"(rsv[6]), "=&v"(rsv[7]) : "v"(roff), "s"(hb) : "memory"); }
        GL_WAIT4(cs);
        float wsc[2][8];
#pragma unroll
        for (int bj = 0; bj < 2; ++bj)
#pragma unroll
            for (int j = 0; j < 8; ++j) wsc[bj][j] = __uint_as_float(cs[2 * bj + (j >> 2)][j & 3]) * (1.0f / 127.0f);
#pragma unroll
        for (int ai = 0; ai < 2; ++ai)
#pragma unroll
            for (int m = 0; m < 4; ++m) { const int row = row0 + ai * 128 + m * 16; const float rs = rsv[ai * 4 + m]; bf16* rowp = O + (size_t)row * NPJ + col0;
#pragma unroll
                for (int bj = 0; bj < 2; ++bj) { const i32x4 v0 = __builtin_bit_cast(i32x4, acc[ai][bj][m][0]), v1 = __builtin_bit_cast(i32x4, acc[ai][bj][m][1]);
                    u32x4 w; w.x = cvt_pk_bf16((float)v0[0] * (rs * wsc[bj][0]), (float)v0[1] * (rs * wsc[bj][1])); w.y = cvt_pk_bf16((float)v0[2] * (rs * wsc[bj][2]), (float)v0[3] * (rs * wsc[bj][3]));
                    w.z = cvt_pk_bf16((float)v1[0] * (rs * wsc[bj][4]), (float)v1[1] * (rs * wsc[bj][5])); w.w = cvt_pk_bf16((float)v1[2] * (rs * wsc[bj][6]), (float)v1[3] * (rs * wsc[bj][7]));
                    *(u32x4*)(rowp + bj * 128) = w; } }
    }
};
struct EpiLru {
    static constexpr bool PERM = true, HOOK = false;
    const bf16* U; float* LA; float* LB; const float* ba; const float* bx; const float* lam;
    __device__ __forceinline__ void operator()(const f32x4 (&acc)[2][2][4][2], const pg8::Unit& u, int wr, int wc, int fr, int fq) const {
        const int row0 = u.pm * 256 + wr * 64 + fr, ch0 = u.pn * 128 + wc * 32 + 8 * fq;
        float cba[8], cbx[8], csp[8];
#pragma unroll
        for (int j = 0; j < 8; ++j) { cba[j] = ba[ch0 + j]; cbx[j] = bx[ch0 + j]; csp[j] = -8.0f * softplusf_(-lam[ch0 + j]); }
        u32x4 uws[8];
#pragma unroll
        for (int i = 0; i < 8; ++i) uws[i] = *(const u32x4*)(U + (size_t)(row0 + (i >> 2) * 128 + (i & 3) * 16) * 2048 + ch0);
        asm volatile("" ::: "memory");
#pragma unroll
        for (int ai = 0; ai < 2; ++ai)
#pragma unroll
            for (int m = 0; m < 4; ++m) { const int row = row0 + ai * 128 + m * 16;
                float uf[8]; unpack8(uws[ai * 4 + m], uf);
                float a8[8], b8[8];
#pragma unroll
                for (int n = 0; n < 2; ++n)
#pragma unroll
                    for (int j = 0; j < 4; ++j) { const int q = 4 * n + j;
                        const float r = sigm(acc[ai][0][m][n][j] + cba[q]), ig = sigm(acc[ai][1][m][n][j] + cbx[q]);
                        const float la = csp[q] * r; a8[q] = __expf(la); b8[q] = sqrtf(-expm1s_(2.0f * la)) * (ig * uf[q]); }
                float* pa = LA + (size_t)row * 2048 + ch0; float* pb = LB + (size_t)row * 2048 + ch0;
                *(f32x4*)pa = (f32x4){a8[0], a8[1], a8[2], a8[3]}; *(f32x4*)(pa + 4) = (f32x4){a8[4], a8[5], a8[6], a8[7]};
                *(f32x4*)pb = (f32x4){b8[0], b8[1], b8[2], b8[3]}; *(f32x4*)(pb + 4) = (f32x4){b8[4], b8[5], b8[6], b8[7]};
            }
    }
};
struct EpiLora {
    static constexpr bool PERM = true, HOOK = false;
    float* WDEC; float* AA; const float* w0; const float* a0;
    __device__ __forceinline__ void operator()(const f32x4 (&acc)[2][2][4][2], const pg8::Unit& u, int wr, int wc, int fr, int fq) const {
        const int row0 = u.pm * 256 + wr * 64 + fr, ch0 = u.pn * 128 + wc * 32 + 8 * fq;
        float cw0[8], ca0[8];
#pragma unroll
        for (int j = 0; j < 8; ++j) { cw0[j] = w0[ch0 + j]; ca0[j] = a0[ch0 + j]; }
#pragma unroll
        for (int ai = 0; ai < 2; ++ai)
#pragma unroll
            for (int m = 0; m < 4; ++m) { const int row = row0 + ai * 128 + m * 16; float d8[8], a8[8];
#pragma unroll
                for (int n = 0; n < 2; ++n)
#pragma unroll
                    for (int j = 0; j < 4; ++j) { const int q = 4 * n + j;
                        const float wl = -softplusf_(-(cw0[q] + acc[ai][0][m][n][j])) - 0.5f; d8[q] = __expf(-__expf(wl)); a8[q] = sigm(ca0[q] + acc[ai][1][m][n][j]); }
                float* pd = WDEC + ((((size_t)((row >> 12) * 32 + (ch0 >> 6)) * SEQ + (row & (SEQ - 1))) * 5 + 1) * 64 + (ch0 & 63)); float* pa = AA + (size_t)row * 2048 + ch0;
                *(f32x4*)pd = (f32x4){d8[0], d8[1], d8[2], d8[3]}; *(f32x4*)(pd + 4) = (f32x4){d8[4], d8[5], d8[6], d8[7]};
                *(f32x4*)pa = (f32x4){a8[0], a8[1], a8[2], a8[3]}; *(f32x4*)(pa + 4) = (f32x4){a8[4], a8[5], a8[6], a8[7]};
            }
    }
};
__device__ __forceinline__ void gl2_issue(u32x4& a0, u32x4& a1, const void* pa, unsigned voff) {
    asm volatile("s_nop 4\n\tglobal_load_dwordx4 %0, %2, %3\n\tglobal_load_dwordx4 %1, %2, %3 offset:256" : "=&v"(a0), "=&v"(a1) : "v"(voff), "s"(pa) : "memory"); }
__device__ __forceinline__ void gl4f_issue(u32x4& a0, u32x4& a1, u32x4& a2, u32x4& a3, const void* pa, unsigned voff) {
    asm volatile("s_nop 4\n\tglobal_load_dwordx4 %0, %4, %5\n\tglobal_load_dwordx4 %1, %4, %5 offset:64\n\tglobal_load_dwordx4 %2, %4, %5 offset:512\n\tglobal_load_dwordx4 %3, %4, %5 offset:576"
                 : "=&v"(a0), "=&v"(a1), "=&v"(a2), "=&v"(a3) : "v"(voff), "s"(pa) : "memory"); }
#define GL_WAIT8(g) asm volatile("s_waitcnt vmcnt(0)" : "+v"(g[0]), "+v"(g[1]), "+v"(g[2]), "+v"(g[3]), "+v"(g[4]), "+v"(g[5]), "+v"(g[6]), "+v"(g[7]) :: "memory")
#define GL_WAIT16(g) asm volatile("s_waitcnt vmcnt(0)" : "+v"(g[0]), "+v"(g[1]), "+v"(g[2]), "+v"(g[3]), "+v"(g[4]), "+v"(g[5]), "+v"(g[6]), "+v"(g[7]), \
                                  "+v"(g[8]), "+v"(g[9]), "+v"(g[10]), "+v"(g[11]), "+v"(g[12]), "+v"(g[13]), "+v"(g[14]), "+v"(g[15]) :: "memory")
struct EpiMerge {
    static constexpr bool PERM = true, HOOK = true;
    const bf16* GL; bf16* O; static constexpr int ldg = NPJ;
    __device__ __forceinline__ void hook(f32x4 (&acc)[2][2][4][2], const pg8::Unit& u, int br, int wr, int wc, int fr, int fq) const {
        const unsigned voff = (unsigned)(fr * (ldg * 2) + (wc * 32 + 8 * fq) * 2);
        const char* base = (const char*)GL + ((size_t)(u.pm * 256 + wr * 64) * ldg + br * 4096 + u.pn * 256) * 2;
#pragma unroll
        for (int ai = 0; ai < 2; ++ai) { u32x4 g[16];
#pragma unroll
            for (int m = 0; m < 4; ++m) { const char* pm_ = base + (size_t)(ai * 128 + m * 16) * (ldg * 2); gl2_issue(g[4 * m], g[4 * m + 1], pm_, voff); gl2_issue(g[4 * m + 2], g[4 * m + 3], pm_ + 8192, voff); }
            GL_WAIT16(g);
#pragma unroll
            for (int m = 0; m < 4; ++m)
#pragma unroll
                for (int bj = 0; bj < 2; ++bj) { float f0[8], f1[8]; unpack8(g[4 * m + bj], f0); unpack8(g[4 * m + 2 + bj], f1);
#pragma unroll
                    for (int n = 0; n < 2; ++n)
#pragma unroll
                        for (int j = 0; j < 4; ++j) { const int q = 4 * n + j; acc[ai][bj][m][n][j] *= (1.0f + __expf(-f1[q])) * __builtin_amdgcn_rcpf(1.0f + __expf(-f0[q])); } } }
    }
    __device__ __forceinline__ void operator()(const f32x4 (&acc)[2][2][4][2], const pg8::Unit& u, int wr, int wc, int fr, int fq) const {
        const int row0 = u.pm * 256 + wr * 64 + fr, col0 = u.pn * 256 + wc * 32 + 8 * fq;
        const unsigned voff = (unsigned)(fr * (ldg * 2) + (wc * 32 + 8 * fq) * 2);
        const char* base = (const char*)GL + ((size_t)(u.pm * 256 + wr * 64) * ldg + 3 * 4096 + u.pn * 256) * 2;
#pragma unroll
        for (int ai = 0; ai < 2; ++ai) { u32x4 g[8];
#pragma unroll
            for (int m = 0; m < 4; ++m) gl2_issue(g[2 * m], g[2 * m + 1], base + (size_t)(ai * 128 + m * 16) * (ldg * 2), voff);
            GL_WAIT8(g);
#pragma unroll
            for (int m = 0; m < 4; ++m) { const int row = row0 + ai * 128 + m * 16;
#pragma unroll
                for (int bj = 0; bj < 2; ++bj) { float f[8]; unpack8(g[2 * m + bj], f);
                    const f32x4 v0 = acc[ai][bj][m][0], v1 = acc[ai][bj][m][1];
                    u32x4 w; w.x = cvt_pk_bf16(v0[0] * sigm(f[0]), v0[1] * sigm(f[1])); w.y = cvt_pk_bf16(v0[2] * sigm(f[2]), v0[3] * sigm(f[3]));
                    w.z = cvt_pk_bf16(v1[0] * sigm(f[4]), v1[1] * sigm(f[5])); w.w = cvt_pk_bf16(v1[2] * sigm(f[6]), v1[3] * sigm(f[7]));
                    *(u32x4*)(O + (size_t)row * 4096 + col0 + bj * 128) = w; } } }
    }
};
struct EpiOut {
    static constexpr bool PERM = false, HOOK = false;
    const float* XI; float* XO;
    __device__ __forceinline__ void operator()(const f32x4 (&acc)[2][2][4][2], const pg8::Unit& u, int wr, int wc, int fr, int fq) const {
        const int row0 = u.pm * 256 + wr * 64 + fr, col0 = u.pn * 256 + wc * 32 + 4 * fq;
        const unsigned voff = (unsigned)(fr * 16384 + (wc * 32 + 4 * fq) * 4);
        const char* base = (const char*)XI + ((size_t)(u.pm * 256 + wr * 64) * 4096 + u.pn * 256) * 4;
#pragma unroll
        for (int ai = 0; ai < 2; ++ai) { u32x4 g[16];
#pragma unroll
            for (int m = 0; m < 4; ++m) gl4f_issue(g[4 * m], g[4 * m + 1], g[4 * m + 2], g[4 * m + 3], base + (size_t)(ai * 128 + m * 16) * 16384, voff);
            GL_WAIT16(g);
#pragma unroll
            for (int m = 0; m < 4; ++m) { const size_t off = (size_t)(row0 + ai * 128 + m * 16) * 4096 + col0;
#pragma unroll
                for (int bj = 0; bj < 2; ++bj)
#pragma unroll
                    for (int n = 0; n < 2; ++n) { const f32x4 xi = __builtin_bit_cast(f32x4, g[4 * m + 2 * bj + n]); *(f32x4*)(XO + off + bj * 128 + n * 16) = xi + acc[ai][bj][m][n]; } } }
    }
};

struct Frame { LAS unsigned char* lds; int tid, lane, wave, bid, nblk; };
__device__ __forceinline__ Frame reframe(const Frame& G) { Frame F; F.lds = G.lds; F.wave = opaque_s(G.wave); F.lane = lane_id(); F.tid = F.wave * 64 + F.lane; F.bid = opaque_s(G.bid); F.nblk = opaque_s(G.nblk); return F; }

#define TR_PIN16(a, o) asm volatile("" : "+v"(a[o]), "+v"(a[o + 1]), "+v"(a[o + 2]), "+v"(a[o + 3]), "+v"(a[o + 4]), "+v"(a[o + 5]), "+v"(a[o + 6]), "+v"(a[o + 7]), "+v"(a[o + 8]), "+v"(a[o + 9]), "+v"(a[o + 10]), "+v"(a[o + 11]), "+v"(a[o + 12]), "+v"(a[o + 13]), "+v"(a[o + 14]), "+v"(a[o + 15]) :: "memory")
__device__ __forceinline__ void tr_load(float (&tv)[32], const float* W, size_t ldw, int k0, int n0, int lane) {
#pragma unroll
    for (int i = 0; i < 32; ++i) tv[i] = W[(size_t)(k0 + 2 * i + (lane >> 5)) * ldw + n0 + (lane & 31)];
}
__device__ __forceinline__ void tr_item(const float (&tv)[32], bf16* WT, size_t ldt, LAS float* scr, int k0, int n0, int lane) {
#pragma unroll
    for (int i = 0; i < 32; ++i) scr[(2 * i + (lane >> 5)) * 33 + (lane & 31)] = tv[i];
    LDS_WAIT(); asm volatile("" ::: "memory");
    const int c = lane & 7;
#pragma unroll
    for (int j = 0; j < 4; ++j) { const int n = (lane >> 3) + 8 * j; const LAS float* s = scr + (8 * c) * 33 + n;
        u32x4 o; o.x = pk2(s[0 * 33], s[1 * 33]); o.y = pk2(s[2 * 33], s[3 * 33]); o.z = pk2(s[4 * 33], s[5 * 33]); o.w = pk2(s[6 * 33], s[7 * 33]);
        *(u32x4*)(WT + (size_t)(n0 + n) * ldt + k0 + 8 * c) = o; }
    LDS_WAIT(); asm volatile("" ::: "memory");
}
__device__ __forceinline__ void tr_job(const Frame& F, const float* W, size_t ldw, int K, int ncols, bf16* WT, size_t ldt) {
    LAS float* scr = (LAS float*)(F.lds + F.wave * 16384);
    const int gw = F.bid * NWAVES + F.wave, NGW = F.nblk * NWAVES, nb = ncols / 32, items = (K / 64) * nb;
    for (int it = gw; it < items; it += 2 * NGW) { float tv[32], tn[32]; const int nx = it + NGW, nc = nx < items ? nx : it;
        tr_load(tv, W, ldw, 64 * (it / nb), 32 * (it % nb), F.lane); tr_load(tn, W, ldw, 64 * (nc / nb), 32 * (nc % nb), F.lane);
        TR_PIN16(tv, 0); TR_PIN16(tv, 16);
        tr_item(tv, WT, ldt, scr, 64 * (it / nb), 32 * (it % nb), F.lane);
        if (nx < items) tr_item(tn, WT, ldt, scr, 64 * (nx / nb), 32 * (nx % nb), F.lane); }
}
__device__ __forceinline__ void tr8_item(const float (&tv)[32], signed char* WT, const unsigned* cmax, LAS float* scr, int k0, int n0, int lane) {
#pragma unroll
    for (int i = 0; i < 32; ++i) scr[(2 * i + (lane >> 5)) * 33 + (lane & 31)] = tv[i];
    LDS_WAIT(); asm volatile("" ::: "memory");
    const int n = lane >> 1, hh = lane & 1; const float am = __uint_as_float(cmax[n0 + n]); const float inv = am > 0.f ? 127.0f / am : 0.f;
#pragma unroll
    for (int c = 0; c < 2; ++c) { const LAS float* sp = scr + (32 * hh + 16 * c) * 33 + n; unsigned wq[4];
#pragma unroll
        for (int q = 0; q < 4; ++q) { const int a0 = (int)rintf(sp[(4 * q) * 33] * inv), a1 = (int)rintf(sp[(4 * q + 1) * 33] * inv), a2 = (int)rintf(sp[(4 * q + 2) * 33] * inv), a3 = (int)rintf(sp[(4 * q + 3) * 33] * inv);
            wq[q] = (unsigned)(a0 & 255) | ((unsigned)(a1 & 255) << 8) | ((unsigned)(a2 & 255) << 16) | ((unsigned)(a3 & 255) << 24); }
        *(u32x4*)(WT + (size_t)(n0 + n) * 4096 + k0 + 32 * hh + 16 * c) = (u32x4){wq[0], wq[1], wq[2], wq[3]}; }
    LDS_WAIT(); asm volatile("" ::: "memory");
}
__device__ __forceinline__ void tr8_job(const Frame& F, const float* W, size_t ldw, int K, int ncols, signed char* WT, const unsigned* cmax) {
    LAS float* scr = (LAS float*)(F.lds + F.wave * 16384);
    const int gw = F.bid * NWAVES + F.wave, NGW = F.nblk * NWAVES, nb = ncols / 32, items = (K / 64) * nb;
    for (int it = gw; it < items; it += 2 * NGW) { float tv[32], tn[32]; const int nx = it + NGW, nc = nx < items ? nx : it;
        tr_load(tv, W, ldw, 64 * (it / nb), 32 * (it % nb), F.lane); tr_load(tn, W, ldw, 64 * (nc / nb), 32 * (nc % nb), F.lane);
        TR_PIN16(tv, 0); TR_PIN16(tv, 16);
        tr8_item(tv, WT, cmax, scr, 64 * (it / nb), 32 * (it % nb), F.lane);
        if (nx < items) tr8_item(tn, WT, cmax, scr, 64 * (nx / nb), 32 * (nx % nb), F.lane); }
}
__device__ __forceinline__ void phase_gate_absmax(const Frame& F0) {
    const Frame F = reframe(F0);
    unsigned* cmax = (unsigned*)(KWS() + WS_CTL) + CW_CMAX;
    const int gw = F.bid * NWAVES + F.wave, NGW = F.nblk * NWAVES, lane = F.lane, c4 = lane & 15, rsub = lane >> 4;
    for (int it = gw; it < DEPTH * (N8 / 64) * 32; it += NGW) { const int l = it / ((N8 / 64) * 32), g64 = (it >> 5) % (N8 / 64), kc = it & 31;
        const float* w = KIN(I_WIN) + (size_t)l * 4096 * CIN + (size_t)(kc * 128 + rsub) * CIN + (g64 < 32 ? 16576 + g64 * 64 : 21704 + (g64 - 32) * 64) + 4 * c4;
        f32x4 m = (f32x4){0.f, 0.f, 0.f, 0.f};
        for (int i0 = 0; i0 < 32; i0 += 16) { f32x4 tv[16];
#pragma unroll
            for (int i = 0; i < 16; ++i) tv[i] = *(const f32x4*)(w + (size_t)(4 * (i0 + i)) * CIN);
            asm volatile("" : "+v"(tv[0]), "+v"(tv[1]), "+v"(tv[2]), "+v"(tv[3]), "+v"(tv[4]), "+v"(tv[5]), "+v"(tv[6]), "+v"(tv[7]), "+v"(tv[8]), "+v"(tv[9]), "+v"(tv[10]), "+v"(tv[11]), "+v"(tv[12]), "+v"(tv[13]), "+v"(tv[14]), "+v"(tv[15]) :: "memory");
#pragma unroll
            for (int i = 0; i < 16; ++i) { m.x = fmaxf(m.x, fabsf(tv[i].x)); m.y = fmaxf(m.y, fabsf(tv[i].y)); m.z = fmaxf(m.z, fabsf(tv[i].z)); m.w = fmaxf(m.w, fabsf(tv[i].w)); } }
#pragma unroll
        for (int q = 0; q < 4; ++q) { float v = m[q]; v = fmaxf(v, __shfl_xor(v, 16)); v = fmaxf(v, __shfl_xor(v, 32)); m[q] = v; }
        if (lane < 16) { unsigned* cp = cmax + l * N8 + g64 * 64 + 4 * c4; atomicMax(cp, __float_as_uint(m.x)); atomicMax(cp + 1, __float_as_uint(m.y)); atomicMax(cp + 2, __float_as_uint(m.z)); atomicMax(cp + 3, __float_as_uint(m.w)); } }
}
__device__ __forceinline__ void rms_row_bf16(const float* x, const float* g, bf16* o, int lane, signed char* q8 = nullptr, float* qs = nullptr) {
    const f32x4* xr = (const f32x4*)x + lane; const f32x4* gr = (const f32x4*)g + lane; f32x4 v[16], gv[16]; float ss = 0.f;
#pragma unroll
    for (int j = 0; j < 16; ++j) v[j] = xr[64 * j];
#pragma unroll
    for (int j = 0; j < 16; ++j) gv[j] = gr[64 * j];
    asm volatile("" ::: "memory");
#pragma unroll
    for (int j = 0; j < 16; ++j) ss += (v[j].x * v[j].x + v[j].y * v[j].y) + (v[j].z * v[j].z + v[j].w * v[j].w);
    const float r = rsqrtf(wave_sum(ss) * (1.0f / 4096.0f) + 1e-6f);
    u32x2* o8 = (u32x2*)o + lane; float am = 0.f;
#pragma unroll
    for (int j = 0; j < 16; ++j) { const f32x4 gg = gv[j]; v[j] = (f32x4){v[j].x * r * gg.x, v[j].y * r * gg.y, v[j].z * r * gg.z, v[j].w * r * gg.w};
        u32x2 w; w.x = pk2(v[j].x, v[j].y); w.y = pk2(v[j].z, v[j].w); o8[64 * j] = w;
        am = fmaxf(fmaxf(am, fmaxf(fabsf(v[j].x), fabsf(v[j].y))), fmaxf(fabsf(v[j].z), fabsf(v[j].w))); }
    if (q8 != nullptr) {
        am = row16_max(am); am = fmaxf(am, __shfl_xor(am, 16)); am = fmaxf(am, __shfl_xor(am, 32));
        const float inv = am > 0.f ? 127.0f / am : 0.f; unsigned* q4 = (unsigned*)q8 + lane;
#pragma unroll
        for (int j = 0; j < 16; ++j) { const int a0 = (int)rintf(v[j].x * inv), a1 = (int)rintf(v[j].y * inv), a2 = (int)rintf(v[j].z * inv), a3 = (int)rintf(v[j].w * inv);
            q4[64 * j] = (unsigned)(a0 & 255) | ((unsigned)(a1 & 255) << 8) | ((unsigned)(a2 & 255) << 16) | ((unsigned)(a3 & 255) << 24); }
        if (lane == 0) *qs = am * (1.0f / 127.0f); }
}
__device__ __forceinline__ void rms_row_f32(const float* x, const float* g, float* o, int lane) {
    const f32x4* xr = (const f32x4*)x + lane; const f32x4* gr = (const f32x4*)g + lane; f32x4 v[16], gv[16]; float ss = 0.f;
#pragma unroll
    for (int j = 0; j < 16; ++j) v[j] = xr[64 * j];
#pragma unroll
    for (int j = 0; j < 16; ++j) gv[j] = gr[64 * j];
    asm volatile("" ::: "memory");
#pragma unroll
    for (int j = 0; j < 16; ++j) ss += (v[j].x * v[j].x + v[j].y * v[j].y) + (v[j].z * v[j].z + v[j].w * v[j].w);
    const float r = rsqrtf(wave_sum(ss) * (1.0f / 4096.0f) + 1e-6f);
    f32x4* o4 = (f32x4*)o + lane;
#pragma unroll
    for (int j = 0; j < 16; ++j) { const f32x4 gg = gv[j]; o4[64 * j] = (f32x4){v[j].x * r * gg.x, v[j].y * r * gg.y, v[j].z * r * gg.z, v[j].w * r * gg.w}; }
}

__device__ __forceinline__ void phase_convert_layer(const Frame& F0, int l, const int parts, const int vb, const int nvb) {
    Frame F = reframe(F0); F.bid = vb; F.nblk = nvb;
    unsigned char* wl = KWS() + WS_W + (size_t)l * SZ_WLAYER;
    bf16* WIN = (bf16*)(wl + WO_WIN); bf16* WCAT = (bf16*)(wl + WO_WCAT); bf16* WOUT = (bf16*)(wl + WO_WOUT); bf16* WKV = (bf16*)(wl + WO_WKV); bf16* WG = (bf16*)(wl + WO_WG); bf16* WL = (bf16*)(wl + WO_WL);
    const float* win = KIN(I_WIN) + (size_t)l * 4096 * CIN;
    if (parts & 2) {
    tr_job(F, win + 0, CIN, 4096, 4096, WIN + (size_t)0 * 4096, 4096);
    tr_job(F, win + 4096, CIN, 4096, 6144, WIN + (size_t)PC_BR * 4096, 4096);
    tr_job(F, win + 10240, CIN, 4096, 96, WIN + (size_t)PC_BWD * 4096, 4096);
    tr_job(F, win + 10336, CIN, 4096, 96, WIN + (size_t)PC_BAD * 4096, 4096);
    tr_job(F, win + 10432, CIN, 4096, 2048, WIN + (size_t)PC_BG * 4096, 4096);
    tr_job(F, win + 12480, CIN, 4096, 4096, WIN + (size_t)PC_CQK * 4096, 4096);
    tr_job(F, win + 18624, CIN, 4096, 2048, WIN + (size_t)PC_CG * 4096, 4096);
    tr_job(F, win + 20680, CIN, 4096, 1024, WIN + (size_t)PC_XQ * 4096, 4096);
    tr8_job(F, win + 16576, CIN, 4096, 2048, (signed char*)(WIN + (size_t)PC_I8 * 4096), (const unsigned*)(KWS() + WS_CTL) + CW_CMAX + l * N8);
    tr8_job(F, win + 21704, CIN, 4096, NGATE, (signed char*)(WIN + (size_t)PC_I8 * 4096) + (size_t)2048 * 4096, (const unsigned*)(KWS() + WS_CTL) + CW_CMAX + l * N8 + 2048);
    tr_job(F, KIN(I_WBA) + (size_t)l * 2048 * 4096, 4096, 2048, 4096, WCAT + YC_A, KCAT);
    tr_job(F, KIN(I_WBB) + (size_t)l * 2048 * 4096, 4096, 2048, 4096, WCAT + YC_B, KCAT);
    tr_job(F, KIN(I_WBC) + (size_t)l * 2048 * 4096, 4096, 2048, 4096, WCAT + YC_C, KCAT);
    tr_job(F, KIN(I_WBX) + (size_t)l * 512 * 4096, 4096, 512, 4096, WCAT + YC_X, KCAT);
    tr_job(F, KIN(I_WOUT) + (size_t)l * 4096 * 4096, 4096, 4096, 4096, WOUT, 4096);
    }
    if (parts & 1) tr_job(F, KIN(I_WKV) + (size_t)l * 4096 * 1024, 1024, 4096, 1024, WKV, 4096);
    if (parts & 2) {
    const size_t gt = (size_t)F.bid * NTHREADS + F.tid, NGT = (size_t)F.nblk * NTHREADS;
    for (size_t i = gt; i < (size_t)8 * 4096; i += NGT) { const int j = (int)(i >> 12), k = (int)(i & 4095); WIN[(size_t)(PC_IF + j) * 4096 + k] = (bf16)f2bf(win[(size_t)k * CIN + 20672 + j]); }
    for (size_t i = gt; i < (size_t)(32 + 32 + 248) * 4096; i += NGT) { const int r = (int)(i >> 12), k = (int)(i & 4095);
        const int row = r < 32 ? PC_BWD + 96 + r : (r < 64 ? PC_BAD + 96 + (r - 32) : PC_IF + 8 + (r - 64)); WIN[(size_t)row * 4096 + k] = 0; }
    const float* wa = KIN(I_LRU_WA) + (size_t)l * 8 * 256 * 256; const float* wx = KIN(I_LRU_WX) + (size_t)l * 8 * 256 * 256;
    for (size_t c = gt; c < (size_t)4096 * 32; c += NGT) { const int n = (int)(c >> 5), k0 = (int)(c & 31) * 8, pn = n >> 8, dd = n & 255, nb = pn >> 1, d = (pn & 1) * 128 + (dd & 127);
        const float* sp = (dd < 128 ? wa : wx) + ((size_t)nb * 256 + k0) * 256 + d; float v[8];
#pragma unroll
        for (int q = 0; q < 8; ++q) v[q] = sp[(size_t)q * 256];
        asm volatile("" : "+v"(v[0]), "+v"(v[1]), "+v"(v[2]), "+v"(v[3]), "+v"(v[4]), "+v"(v[5]), "+v"(v[6]), "+v"(v[7]) :: "memory");
        u32x4 o; o.x = pk2(v[0], v[1]); o.y = pk2(v[2], v[3]); o.z = pk2(v[4], v[5]); o.w = pk2(v[6], v[7]); *(u32x4*)(WG + (size_t)n * 256 + k0) = o; }
    const float* wup = KIN(I_WUP) + (size_t)l * 96 * 2048; const float* aup = KIN(I_AUP) + (size_t)l * 96 * 2048;
    for (size_t c = gt; c < (size_t)4096 * 32; c += NGT) { const int n = (int)(c >> 5), k0 = (int)(c & 31) * 8, pn = n >> 8, dd = n & 255, ch = pn * 128 + (dd & 127);
        const float* sp = nullptr; if (dd < 128) { if (k0 < 96) sp = wup + (size_t)k0 * 2048 + ch; } else { if (k0 >= 128 && k0 < 224) sp = aup + (size_t)(k0 - 128) * 2048 + ch; }
        u32x4 o = (u32x4){0u, 0u, 0u, 0u};
        if (sp != nullptr) { float v[8];
#pragma unroll
            for (int q = 0; q < 8; ++q) v[q] = sp[(size_t)q * 2048];
            asm volatile("" : "+v"(v[0]), "+v"(v[1]), "+v"(v[2]), "+v"(v[3]), "+v"(v[4]), "+v"(v[5]), "+v"(v[6]), "+v"(v[7]) :: "memory");
            o.x = pk2(v[0], v[1]); o.y = pk2(v[2], v[3]); o.z = pk2(v[4], v[5]); o.w = pk2(v[6], v[7]); }
        *(u32x4*)(WL + (size_t)n * 256 + k0) = o; }
    }
    if (parts & 1) {
    const int gw = F.bid * NWAVES + F.wave, NGW = F.nblk * NWAVES;
    bf16* MEMN = (bf16*)(KWS() + WS_MEMN) + (size_t)l * MM * 4096;
    for (int r = gw; r < MM; r += NGW) rms_row_bf16(KIN(I_MEM) + (size_t)r * 4096, KIN(I_MEMNORM_G) + (size_t)l * 4096, MEMN + (size_t)r * 4096, F.lane);
    }
}
__device__ __forceinline__ void phase_norm(const Frame& F0, const float* X, const float* g, bool final_out) {
    const Frame F = reframe(F0);
    const int gw = F.bid * NWAVES + F.wave, NGW = F.nblk * NWAVES;
    bf16* H = (bf16*)(KWS() + WS_H);
    for (int r = gw; r < M; r += NGW) { if (final_out) rms_row_f32(X + (size_t)r * 4096, g, KOUT() + (size_t)r * 4096, F.lane); else rms_row_bf16(X + (size_t)r * 4096, g, H + (size_t)r * 4096, F.lane, (signed char*)(KWS() + WS_H8) + (size_t)r * 4096, (float*)(KWS() + WS_HS) + r); }
}

__device__ __forceinline__ float logsigf_(float x) { return fminf(x, 0.f) - log1pf(__expf(-fabsf(x))); }
__device__ __forceinline__ void phase_prep(const Frame& F0, int l) {
    const Frame F = reframe(F0);
    const bf16* __restrict__ PROJ = (const bf16*)(KWS() + WS_PROJ);
    const size_t gt = (size_t)F.bid * NTHREADS + F.tid, NGT = (size_t)F.nblk * NTHREADS;
    bf16* __restrict__ U = (bf16*)(KWS() + WS_U); bf16* __restrict__ QC = (bf16*)(KWS() + WS_QC); bf16* __restrict__ KC = (bf16*)(KWS() + WS_KC);
    for (size_t id = gt; id < (size_t)2 * 256 * (M / 32); id += NGT) {
        const int which = (int)(id / ((size_t)256 * (M / 32))), rem = (int)(id % ((size_t)256 * (M / 32))), c8 = (rem & 255) * 8, t0 = (rem >> 8) * 32, ts0 = t0 & (SEQ - 1);
        const float* cw = (which == 0 ? KIN(I_LRU_CW) : KIN(I_MCW)) + (size_t)l * 4 * 2048 + c8; const float* cb = (which == 0 ? KIN(I_LRU_CB) : KIN(I_MCB)) + (size_t)l * 2048 + c8;
        const bf16* src = PROJ + (size_t)t0 * NPJ + (which == 0 ? PC_AX : PC_CQK) + c8;
        f32x4 wv[4][2];
#pragma unroll
        for (int j = 0; j < 4; ++j) { wv[j][0] = *(const f32x4*)(cw + j * 2048); wv[j][1] = *(const f32x4*)(cw + j * 2048 + 4); }
        const f32x4 b0 = *(const f32x4*)cb, b1 = *(const f32x4*)(cb + 4);
        u32x4 hw[3];
#pragma unroll
        for (int j = 0; j < 3; ++j) hw[j] = ts0 > 0 ? *(const u32x4*)(src - (size_t)(3 - j) * NPJ) : (u32x4){0u, 0u, 0u, 0u};
        float w0[8], w1[8], w2[8]; unpack8(hw[0], w0); unpack8(hw[1], w1); unpack8(hw[2], w2);
        const float sc = c8 < 1024 ? 1.0f : 0.0625f;
        for (int g = 0; g < 32; g += 8) { u32x4 x[8];
#pragma unroll
            for (int u = 0; u < 8; ++u) x[u] = *(const u32x4*)(src + (size_t)(g + u) * NPJ);
#pragma unroll
            for (int u = 0; u < 8; ++u) { float w3[8], a[8]; unpack8(x[u], w3);
#pragma unroll
                for (int q = 0; q < 8; ++q) a[q] = (q < 4 ? b0[q] : b1[q - 4]) + wv[0][q >> 2][q & 3] * w0[q] + wv[1][q >> 2][q & 3] * w1[q] + wv[2][q >> 2][q & 3] * w2[q] + wv[3][q >> 2][q & 3] * w3[q];
#pragma unroll
                for (int q = 0; q < 8; ++q) { w0[q] = w1[q]; w1[q] = w2[q]; w2[q] = w3[q]; }
                const size_t t = (size_t)t0 + g + u;
                if (which == 0) { u32x4 o; o.x = pk2(a[0], a[1]); o.y = pk2(a[2], a[3]); o.z = pk2(a[4], a[5]); o.w = pk2(a[6], a[7]); *(u32x4*)(U + t * 2048 + c8) = o; }
                else {
#pragma unroll
                    for (int q = 0; q < 8; ++q) a[q] = siluf_(a[q]) * sc;
                    u32x4 o; o.x = pk2(a[0], a[1]); o.y = pk2(a[2], a[3]); o.z = pk2(a[4], a[5]); o.w = pk2(a[6], a[7]);
                    if (c8 < 1024) *(u32x4*)(QC + t * 1024 + c8) = o; else *(u32x4*)(KC + t * 1024 + (c8 - 1024)) = o; } } }
    }
    bf16* LORA = (bf16*)(KWS() + WS_LORA); const float* mu = KIN(I_MU) + (size_t)l * 6336;
    for (size_t i = gt; i < (size_t)M * 32; i += NGT) { const int t = (int)(i >> 5), c8 = (int)(i & 31) * 8, ts = t & (SEQ - 1), seg = c8 >> 7, i0 = c8 & 127;
        u32x4 o = (u32x4){0u, 0u, 0u, 0u};
        if (i0 < 96) { const int pc = (seg == 0 ? PC_BWD : PC_BAD) + i0; const float* m8 = mu + 6144 + seg * 96 + i0;
            const u32x4 w = *(const u32x4*)(PROJ + (size_t)t * NPJ + pc); const u32x4 w2 = *(const u32x4*)(PROJ + (size_t)(ts > 0 ? t - 1 : t) * NPJ + pc);
            const f32x4 ma = *(const f32x4*)m8, mb = *(const f32x4*)(m8 + 4);
            float p[8], pv[8]; unpack8(w, p); unpack8(w2, pv);
            if (ts == 0) {
#pragma unroll
                for (int q = 0; q < 8; ++q) pv[q] = 0.f; }
            float r[8];
#pragma unroll
            for (int q = 0; q < 8; ++q) { const float s = p[q] + (pv[q] - p[q]) * (q < 4 ? ma[q] : mb[q - 4]); r[q] = seg == 0 ? tanhf(s) : s; }
            o.x = pk2(r[0], r[1]); o.y = pk2(r[2], r[3]); o.z = pk2(r[4], r[5]); o.w = pk2(r[6], r[7]); }
        *(u32x4*)(LORA + (size_t)t * 256 + c8) = o; }
    if (F.bid < 8) {
        const float* IFB = (const float*)(KWS() + WS_IFB); float* G = (float*)(KWS() + WS_SCAL); float* MX = G + (size_t)M * 4; float* MT = MX + (size_t)M * 4;
        const int b = F.bid >> 2, hd = F.bid & 3, lane = F.lane; const float bi = KIN(I_MBI)[l * 4 + hd], bfv = KIN(I_MBF)[l * 4 + hd];
        const size_t tok0 = (size_t)b * SEQ + (size_t)F.tid * 8; LAS float* sc = (LAS float*)F.lds;
        float lf[8], li[8];
#pragma unroll
        for (int j = 0; j < 8; ++j) { lf[j] = IFB[(tok0 + j) * 8 + 4 + hd]; li[j] = IFB[(tok0 + j) * 8 + hd]; }
        asm volatile("" ::: "memory");
#pragma unroll
        for (int j = 0; j < 8; ++j) { lf[j] = logsigf_(lf[j] + bfv); li[j] += bi; }
#pragma unroll
        for (int j = 1; j < 8; ++j) lf[j] += lf[j - 1];
        float incl = lf[7];
#pragma unroll
        for (int o = 1; o < 64; o <<= 1) { const float t = __shfl_up(incl, o); if (lane >= o) incl += t; }
        if (lane == 63) sc[F.wave] = incl;
        __syncthreads();
        float woff = 0.f;
        for (int w2 = 0; w2 < F.wave; ++w2) woff += sc[w2];
        const float excl = woff + incl - lf[7];
        float mx[8]; float run = -INFINITY;
#pragma unroll
        for (int j = 0; j < 8; ++j) { lf[j] += excl; li[j] -= lf[j]; run = fmaxf(run, li[j]); mx[j] = run; }
        float im = run;
#pragma unroll
        for (int o = 1; o < 64; o <<= 1) { const float t = __shfl_up(im, o); if (lane >= o) im = fmaxf(im, t); }
        if (lane == 63) sc[16 + F.wave] = im;
        float pm = __shfl_up(im, 1); if (lane == 0) pm = -INFINITY;
        __syncthreads();
        for (int w2 = 0; w2 < F.wave; ++w2) pm = fmaxf(pm, sc[16 + w2]);
#pragma unroll
        for (int j = 0; j < 8; ++j) { const float m = fmaxf(pm, mx[j]); G[(tok0 + j) * 4 + hd] = li[j]; MX[(tok0 + j) * 4 + hd] = m; MT[(tok0 + j) * 4 + hd] = lf[j] + m; }
        __syncthreads();
    }
}

__device__ __forceinline__ f32x4 ld_bf4(const bf16* p) { const u32x2 w = *(const u32x2*)p; return (f32x4){__uint_as_float(w.x << 16), __uint_as_float(w.x & 0xffff0000u), __uint_as_float(w.y << 16), __uint_as_float(w.y & 0xffff0000u)}; }
__device__ __forceinline__ f32x4 bf4_unpack(const u32x2 w) { return (f32x4){__uint_as_float(w.x << 16), __uint_as_float(w.x & 0xffff0000u), __uint_as_float(w.y << 16), __uint_as_float(w.y & 0xffff0000u)}; }
struct VecIn { u32x2 r, k, v, r1, k1, v1; f32x4 a; };
__device__ __forceinline__ void phase_rwkv_vec(const Frame& F0, int l) {
    const Frame F = reframe(F0);
    const bf16* __restrict__ PROJ = (const bf16*)(KWS() + WS_PROJ); const float* __restrict__ AA = (const float*)(KWS() + WS_AA);
    float* __restrict__ RV = (float*)(KWS() + WS_RV); float* __restrict__ VV = (float*)(KWS() + WS_VV); float* __restrict__ BON = (float*)(KWS() + WS_BON);
    const float* mu = KIN(I_MU) + (size_t)l * 6336; const float* kkw = KIN(I_KK) + (size_t)l * 2048; const float* kaw = KIN(I_KA) + (size_t)l * 2048; const float* rkw = KIN(I_RK) + (size_t)l * 2048;
    const int gw = F.bid * NWAVES + F.wave, NGW = F.nblk * NWAVES, lane = F.lane;
    const int hq = gw & 7, ch = hq * 256 + lane * 4, h = hq * 4 + (lane >> 4);
    const f32x4 mr = *(const f32x4*)(mu + ch), mk = *(const f32x4*)(mu + 2048 + ch), mv = *(const f32x4*)(mu + 4096 + ch), ckk = *(const f32x4*)(kkw + ch), cka = *(const f32x4*)(kaw + ch), crk = *(const f32x4*)(rkw + ch);
    auto vload = [&](const int it, VecIn& x) { const int t = it >> 3, ts = t & (SEQ - 1);
        const bf16* pr = PROJ + (size_t)t * NPJ + ch; const bf16* pp = ts > 0 ? pr - NPJ : pr;
        x.r = *(const u32x2*)(pr + PC_BR); x.k = *(const u32x2*)(pr + PC_BK); x.v = *(const u32x2*)(pr + PC_BV);
        x.r1 = *(const u32x2*)(pp + PC_BR); x.k1 = *(const u32x2*)(pp + PC_BK); x.v1 = *(const u32x2*)(pp + PC_BV);
        x.a = *(const f32x4*)(AA + (size_t)t * 2048 + ch); };
    auto vcomp = [&](const int it, const VecIn& x) { const int t = it >> 3, ts = t & (SEQ - 1), b = t >> 12;
        f32x4 r = bf4_unpack(x.r), k = bf4_unpack(x.k), v = bf4_unpack(x.v);
        const f32x4 z = (f32x4){0.f, 0.f, 0.f, 0.f}; const f32x4 r1 = ts > 0 ? bf4_unpack(x.r1) : z, k1 = ts > 0 ? bf4_unpack(x.k1) : z, v1 = ts > 0 ? bf4_unpack(x.v1) : z;
        r += (r1 - r) * mr; k += (k1 - k) * mk; v += (v1 - v) * mv;
        const f32x4 a = x.a;
        const f32x4 kku = k * ckk;
        const float n2 = row16_sum((kku.x * kku.x + kku.y * kku.y) + (kku.z * kku.z + kku.w * kku.w));
        const float inv = __builtin_amdgcn_rcpf(fmaxf(sqrtf(n2), 1e-12f)); const f32x4 kk = kku * inv;
        const f32x4 kmod = k * ((a - 1.0f) * cka + 1.0f);
        const f32x4 rkk = r * kmod * crk;
        const float bon = row16_sum((rkk.x + rkk.y) + (rkk.z + rkk.w));
        float* rv = RV + (((size_t)(b * 32 + h) * SEQ + ts) * 5) * 64 + (lane & 15) * 4;
        *(f32x4*)rv = kk; *(f32x4*)(rv + 128) = -(kk * a); *(f32x4*)(rv + 192) = kmod; *(f32x4*)(rv + 256) = r;
        *(f32x4*)(VV + (size_t)t * 2048 + ch) = v; if ((lane & 15) == 0) BON[(size_t)t * 32 + h] = bon; };
    int it = gw;
    for (; it + 3 * NGW < M * 8; it += 4 * NGW) { VecIn x0, x1, x2, x3; vload(it, x0); vload(it + NGW, x1); vload(it + 2 * NGW, x2); vload(it + 3 * NGW, x3);
        vcomp(it, x0); vcomp(it + NGW, x1); vcomp(it + 2 * NGW, x2); vcomp(it + 3 * NGW, x3); }
    for (; it < M * 8; it += NGW) { VecIn x0; vload(it, x0); vcomp(it, x0); }
}

#define SC_PIN(a) asm volatile("" : "+v"(a[0]), "+v"(a[1]), "+v"(a[2]), "+v"(a[3]), "+v"(a[4]), "+v"(a[5]), "+v"(a[6]), "+v"(a[7]), "+v"(a[8]), "+v"(a[9]), "+v"(a[10]), "+v"(a[11]), "+v"(a[12]), "+v"(a[13]), "+v"(a[14]), "+v"(a[15]) :: "memory")
__device__ __forceinline__ void phase_lru_scan1(const Frame& F0) {
    const Frame F = reframe(F0);
    const float* LA = (const float*)(KWS() + WS_LA); const float* LB = (const float*)(KWS() + WS_LB); float* CA = (float*)(KWS() + WS_CARRY); float* CH = CA + 2 * 32 * 2048;
    const size_t gt = (size_t)F.bid * NTHREADS + F.tid, NGT = (size_t)F.nblk * NTHREADS;
    for (size_t i = gt; i < (size_t)2 * 32 * 2048; i += NGT) { const int ch = (int)(i & 2047), chunk = (int)(i >> 11) & 31, b = (int)(i >> 16);
        const size_t base = ((size_t)b * SEQ + chunk * 128) * 2048 + ch; float A = 1.f, H = 0.f;
        for (int s0 = 0; s0 < 128; s0 += 16) { float la[16], lb[16];
#pragma unroll
            for (int u = 0; u < 16; ++u) { la[u] = LA[base + (size_t)(s0 + u) * 2048]; lb[u] = LB[base + (size_t)(s0 + u) * 2048]; }
            SC_PIN(la); SC_PIN(lb);
#pragma unroll
            for (int u = 0; u < 16; ++u) { H = la[u] * H + lb[u]; A *= la[u]; } }
        CA[i] = A; CH[i] = H; }
}
__device__ __forceinline__ void scan2_item(const Frame& F, const int vb) {
    const float* __restrict__ LA = (const float*)(KWS() + WS_LA); const float* __restrict__ LB = (const float*)(KWS() + WS_LB); const float* __restrict__ CA = (const float*)(KWS() + WS_CARRY); const float* __restrict__ CH = CA + 2 * 32 * 2048;
    const bf16* __restrict__ PROJ = (const bf16*)(KWS() + WS_PROJ); bf16* __restrict__ Y = (bf16*)(KWS() + WS_Y);
    { const size_t i = (size_t)vb * NTHREADS + F.tid; const int ch = (int)(i & 2047), chunk = (int)(i >> 11) & 31, b = (int)(i >> 16);
        float H = 0.f;
        for (int j0 = 0; j0 < chunk; j0 += 16) { float ca[16], chh[16];
#pragma unroll
            for (int u = 0; u < 16; ++u) { const int j = j0 + u < chunk ? j0 + u : chunk - 1; const size_t ci = ((size_t)b * 32 + j) * 2048 + ch; ca[u] = CA[ci]; chh[u] = CH[ci]; }
            SC_PIN(ca); SC_PIN(chh);
#pragma unroll
            for (int u = 0; u < 16; ++u) if (j0 + u < chunk) H = ca[u] * H + chh[u]; }
        const size_t row0 = (size_t)b * SEQ + chunk * 128;
        for (int s0 = 0; s0 < 128; s0 += 16) { float la[16], lb[16]; unsigned gg[16];
#pragma unroll
            for (int u = 0; u < 16; ++u) { const size_t row = row0 + s0 + u; la[u] = LA[row * 2048 + ch]; lb[u] = LB[row * 2048 + ch]; gg[u] = PROJ[row * NPJ + PC_AG + ch]; }
            SC_PIN(la); SC_PIN(lb); SC_PIN(gg);
#pragma unroll
            for (int u = 0; u < 16; ++u) { const size_t row = row0 + s0 + u; H = la[u] * H + lb[u]; Y[row * KCAT + YC_A + ch] = (bf16)f2bf(H * siluf_(bf2f((bf16)gg[u]))); } } }
}

constexpr int RW_CH = 32;
constexpr int RW_RVB = RW_CH * 1280, RW_VVB = RW_CH * 256;
struct RwVec { f32x4 kk, wv, nk, kv, rv; f32x2 vi; };
template <int S> __device__ __forceinline__ void rw_issue(RwVec& d, unsigned a, unsigned av) {
    asm volatile("ds_read_b128 %0, %6 offset:%8\n\tds_read_b128 %1, %6 offset:%9\n\tds_read_b128 %2, %6 offset:%10\n\tds_read_b128 %3, %6 offset:%11\n\tds_read_b128 %4, %6 offset:%12\n\tds_read_b64 %5, %7 offset:%13"
                 : "=&v"(d.kk), "=&v"(d.wv), "=&v"(d.nk), "=&v"(d.kv), "=&v"(d.rv), "=&v"(d.vi) : "v"(a), "v"(av), "n"(S * 1280), "n"(S * 1280 + 256), "n"(S * 1280 + 512), "n"(S * 1280 + 768), "n"(S * 1280 + 1024), "n"(S * 256) : "memory"); }
#define RW_OPS(d) "+v"(d.kk), "+v"(d.wv), "+v"(d.nk), "+v"(d.kv), "+v"(d.rv), "+v"(d.vi)
__device__ __forceinline__ void rw_wait6(RwVec& d) { asm volatile("s_waitcnt lgkmcnt(6)" : RW_OPS(d) :: "memory"); }
__device__ __forceinline__ void rw_wait0(RwVec& d) { asm volatile("s_waitcnt lgkmcnt(0)" : RW_OPS(d) :: "memory"); }
__device__ __forceinline__ void phase_rwkv_rec(const Frame& F0, const int first, const int stride) {
    const Frame F = reframe(F0);
    const char* RV = (const char*)(KWS() + WS_RV); const char* VV = (const char*)(KWS() + WS_VV); float* YR = (float*)(KWS() + WS_YR);
    LAS unsigned char* lds = F.lds;
    for (int item = first; item < 128; item += stride) {
        const int bh = item >> 1, hf = item & 1, b = bh >> 5, h = bh & 31, w = F.wave, lane = F.lane, cg = lane & 15, rl = lane >> 4;
        const int row = hf * 32 + (w & 3) * 8 + rl * 2;
        const char* rvg = RV + (size_t)bh * SEQ * 1280; const char* vvg = VV + ((size_t)b * SEQ * 2048 + h * 64) * 4;
        f32x2 Sa0 = (f32x2){0.f, 0.f}, Sa1 = Sa0, Sb0 = Sa0, Sb1 = Sa0;
#define RW_DMA(ck) do { const int _buf = (ck) & 1; _Pragma("unroll") for (int _p = 0; _p < 6; ++_p) { const int pc = w * 6 + _p; \
            if (pc < 40) __builtin_amdgcn_global_load_lds((const unsigned*)(rvg + (size_t)(ck) * RW_RVB + pc * 1024 + lane * 16), (LAS unsigned*)(lds + _buf * RW_RVB + pc * 1024), 16, 0, 0); \
            else { const int pv = pc - 40; __builtin_amdgcn_global_load_lds((const unsigned*)(vvg + ((size_t)((ck) * RW_CH + pv * 4 + (lane >> 4)) * 2048) * 4 + (lane & 15) * 16), (LAS unsigned*)(lds + 2 * RW_RVB + _buf * RW_VVB + pv * 1024), 16, 0, 0); } } } while (0)
        RW_DMA(0);
        VM_WAIT(); __syncthreads();
        for (int ck = 0; ck < SEQ / RW_CH; ++ck) {
            if (ck + 1 < SEQ / RW_CH) RW_DMA(ck + 1);
            if (w < 4) {
                const unsigned ra = (unsigned)(size_t)(lds + (ck & 1) * RW_RVB + cg * 16), va = (unsigned)(size_t)(lds + 2 * RW_RVB + (ck & 1) * RW_VVB + row * 4);
                float* yo = YR + ((size_t)b * SEQ + (size_t)ck * RW_CH + (cg & 3)) * 2048 + h * 64 + row;
                RwVec A_, B_;
                rw_issue<0>(A_, ra, va);
#define P2(v, hi) ((f32x2){(hi) ? v.z : v.x, (hi) ? v.w : v.y})
#define RW_STEP(CUR, NXT, s_) do { if ((s_) + 1 < RW_CH) { rw_issue<((s_) + 1) % RW_CH>(NXT, ra, va); rw_wait6(CUR); } else rw_wait0(CUR); \
                    const f32x2 via = (f32x2){CUR.vi.x, CUR.vi.x}, vib = (f32x2){CUR.vi.y, CUR.vi.y}; \
                    const f32x2 pa = Sa0 * P2(CUR.kk, 0) + Sa1 * P2(CUR.kk, 1), pb = Sb0 * P2(CUR.kk, 0) + Sb1 * P2(CUR.kk, 1); \
                    float sa = pa.x + pa.y, sb = pb.x + pb.y; \
                    sa += dpp_mov<0xB1>(sa); sb += dpp_mov<0xB1>(sb); sa += dpp_mov<0x4E>(sa); sb += dpp_mov<0x4E>(sb); sa += dpp_mov<0x141>(sa); sb += dpp_mov<0x141>(sb); sa += dpp_mov<0x140>(sa); sb += dpp_mov<0x140>(sb); \
                    const f32x2 sa2 = (f32x2){sa, sa}, sb2 = (f32x2){sb, sb}; \
                    Sa0 = sa2 * P2(CUR.nk, 0) + (via * P2(CUR.kv, 0) + Sa0 * P2(CUR.wv, 0)); Sa1 = sa2 * P2(CUR.nk, 1) + (via * P2(CUR.kv, 1) + Sa1 * P2(CUR.wv, 1)); \
                    Sb0 = sb2 * P2(CUR.nk, 0) + (vib * P2(CUR.kv, 0) + Sb0 * P2(CUR.wv, 0)); Sb1 = sb2 * P2(CUR.nk, 1) + (vib * P2(CUR.kv, 1) + Sb1 * P2(CUR.wv, 1)); \
                    const f32x2 qa = Sa0 * P2(CUR.rv, 0) + Sa1 * P2(CUR.rv, 1), qb = Sb0 * P2(CUR.rv, 0) + Sb1 * P2(CUR.rv, 1); \
                    ya[(s_) & 3] = qa.x + qa.y; yb[(s_) & 3] = qb.x + qb.y; } while (0)
#define RW_G4(g4) do { \
                    float ya[4], yb[4]; \
                    RW_STEP(A_, B_, g4 * 4 + 0); RW_STEP(B_, A_, g4 * 4 + 1); RW_STEP(A_, B_, g4 * 4 + 2); RW_STEP(B_, A_, g4 * 4 + 3); \
                      \
                    const bool o1 = cg & 1, o2 = cg & 2; \
                    const float uA = (o1 ? ya[1] : ya[0]) + dpp_mov<0xB1>(o1 ? ya[0] : ya[1]), uB = (o1 ? ya[3] : ya[2]) + dpp_mov<0xB1>(o1 ? ya[2] : ya[3]); \
                    const float wA = (o1 ? yb[1] : yb[0]) + dpp_mov<0xB1>(o1 ? yb[0] : yb[1]), wB = (o1 ? yb[3] : yb[2]) + dpp_mov<0xB1>(o1 ? yb[2] : yb[3]); \
                    float ysa = (o2 ? uB : uA) + dpp_mov<0x4E>(o2 ? uA : uB), ysb = (o2 ? wB : wA) + dpp_mov<0x4E>(o2 ? wA : wB); \
                    ysa += dpp_mov<0x114>(ysa); ysb += dpp_mov<0x114>(ysb); \
                    ysa += dpp_mov<0x118>(ysa); ysb += dpp_mov<0x118>(ysb); \
                    if (cg >= 12) *(f32x2*)(yo + (size_t)(g4) * 4 * 2048) = (f32x2){ysa, ysb}; } while (0)
                RW_G4(0); RW_G4(1); RW_G4(2); RW_G4(3); RW_G4(4); RW_G4(5); RW_G4(6); RW_G4(7);
                static_assert(RW_CH == 32, "eight groups of four steps");
#undef RW_G4
#undef RW_STEP
#undef P2
            }
            VM_WAIT(); __syncthreads();
        }
#undef RW_DMA
    }
}

__device__ __forceinline__ void phase_rwkv_post(const Frame& F0, int l) {
    const Frame F = reframe(F0);
    const float* __restrict__ YR = (const float*)(KWS() + WS_YR); const float* __restrict__ VV = (const float*)(KWS() + WS_VV); const float* __restrict__ BON = (const float*)(KWS() + WS_BON);
    const bf16* __restrict__ PROJ = (const bf16*)(KWS() + WS_PROJ); bf16* __restrict__ Y = (bf16*)(KWS() + WS_Y);
    const float* gw_ = KIN(I_GNW) + (size_t)l * 2048; const float* gb_ = KIN(I_GNB) + (size_t)l * 2048;
    const int gw = F.bid * NWAVES + F.wave, NGW = F.nblk * NWAVES, lane = F.lane;
    const int hq = gw & 7, ch = hq * 256 + lane * 4, h = hq * 4 + (lane >> 4);
    const f32x4 w4 = *(const f32x4*)(gw_ + ch), b4 = *(const f32x4*)(gb_ + ch);
    struct PostIn { f32x4 y, v; float bon; u32x2 g; };
    auto pload = [&](const int it, PostIn& x) { const int t = it >> 3; x.y = *(const f32x4*)(YR + (size_t)t * 2048 + ch); x.v = *(const f32x4*)(VV + (size_t)t * 2048 + ch); x.bon = BON[(size_t)t * 32 + h]; x.g = *(const u32x2*)(PROJ + (size_t)t * NPJ + PC_BG + ch); };
    auto pcomp = [&](const int it, const PostIn& x) { const int t = it >> 3; const f32x4 y = x.y, v = x.v, g = bf4_unpack(x.g); const float bon = x.bon;
        const float mean = row16_sum((y.x + y.y) + (y.z + y.w)) * (1.0f / 64.0f); const f32x4 d = y - mean;
        const float var = row16_sum((d.x * d.x + d.y * d.y) + (d.z * d.z + d.w * d.w)) * (1.0f / 64.0f); const float rs = rsqrtf(var + 64e-5f);
        const f32x4 o = (d * rs * w4 + b4 + v * bon);
        u32x2 pk; pk.x = pk2(o.x * siluf_(g.x), o.y * siluf_(g.y)); pk.y = pk2(o.z * siluf_(g.z), o.w * siluf_(g.w));
        *(u32x2*)(Y + (size_t)t * KCAT + YC_B + ch) = pk; };
    int it = gw;
    for (; it + 3 * NGW < M * 8; it += 4 * NGW) { PostIn x0, x1, x2, x3; pload(it, x0); pload(it + NGW, x1); pload(it + 2 * NGW, x2); pload(it + 3 * NGW, x3);
        pcomp(it, x0); pcomp(it + NGW, x1); pcomp(it + 2 * NGW, x2); pcomp(it + 3 * NGW, x3); }
    for (; it < M * 8; it += NGW) { PostIn x0; pload(it, x0); pcomp(it, x0); }
}
__device__ __forceinline__ void phase_mlstm_post(const Frame& F0, int l) {
    const Frame F = reframe(F0);
    const float* __restrict__ HC = (const float*)(KWS() + WS_HC); const bf16* __restrict__ PROJ = (const bf16*)(KWS() + WS_PROJ); bf16* __restrict__ Y = (bf16*)(KWS() + WS_Y);
    const float* gw_ = KIN(I_MGNW) + (size_t)l * 2048;
    const int gw = F.bid * NWAVES + F.wave, NGW = F.nblk * NWAVES, lane = F.lane;
#pragma unroll 2
    for (int it = gw; it < M * 4; it += NGW) { const int t = it >> 2, hd = it & 3, ch = hd * 512 + lane * 8;
        const f32x4 v0 = *(const f32x4*)(HC + (size_t)t * 2048 + ch), v1 = *(const f32x4*)(HC + (size_t)t * 2048 + ch + 4);
        float x[8] = {v0.x, v0.y, v0.z, v0.w, v1.x, v1.y, v1.z, v1.w}; float s = 0.f;
#pragma unroll
        for (int q = 0; q < 8; ++q) s += x[q];
        const float mean = wave_sum(s) * (1.0f / 512.0f); float s2 = 0.f;
#pragma unroll
        for (int q = 0; q < 8; ++q) { x[q] -= mean; s2 += x[q] * x[q]; }
        const float rstd = rsqrtf(wave_sum(s2) * (1.0f / 512.0f) + 1e-6f);
        const u32x4 gg = *(const u32x4*)(PROJ + (size_t)t * NPJ + PC_CG + ch); float gf[8]; unpack8(gg, gf); float o[8];
#pragma unroll
        for (int q = 0; q < 8; ++q) o[q] = x[q] * rstd * gw_[ch + q] * siluf_(gf[q]);
        u32x4 w; w.x = pk2(o[0], o[1]); w.y = pk2(o[2], o[3]); w.z = pk2(o[4], o[5]); w.w = pk2(o[6], o[7]);
        *(u32x4*)(Y + (size_t)t * KCAT + YC_C + ch) = w; }
}

__device__ __forceinline__ s16x4 tr16(const LAS unsigned char* p) { return __builtin_bit_cast(s16x4, __builtin_amdgcn_ds_read_tr16_b64_v4i16((LAS s16x4*)p)); }
constexpr int ML_SROW = 80;
constexpr int ML_K = 0, ML_V = 3 * 16384, ML_S = ML_V + 3 * 32768, ML_G = ML_S + 64 * ML_SROW, ML_DEN = ML_G + 1024, ML_END = ML_DEN + 512;
static_assert(ML_END <= RING_BYTES, "mLSTM LDS");
__device__ __forceinline__ void xattn_item(const Frame& F, int l, const int item);
__device__ __forceinline__ int ml_vswz(int row) { return ((row & 3) << 1) | (((row >> 3) & 1) << 3); }
__device__ __forceinline__ void phase_mlstm(const Frame& F0, int l, unsigned* queue, const int lim_lo = 0, const int lim_hi = 1 << 30) {
    const Frame F = reframe(F0);
    const bf16* PROJ = (const bf16*)(KWS() + WS_PROJ); const bf16* QC = (const bf16*)(KWS() + WS_QC); const bf16* KC = (const bf16*)(KWS() + WS_KC);
    const float* G = (const float*)(KWS() + WS_SCAL); const float* MX = G + (size_t)M * 4; const float* MT = MX + (size_t)M * 4; float* HC = (float*)(KWS() + WS_HC);
    LAS unsigned char* lds = F.lds; LAS float* denl = (LAS float*)(lds + ML_DEN);
    const int tid = F.tid, lane = F.lane, w = F.wave, l15 = lane & 15, lg = lane >> 4, rt = w >> 1, ctp = w & 1;
    volatile LAS unsigned* qslot = (volatile LAS unsigned*)(F.lds + MISC_OFF);
    const bool affine = (lim_lo == 0) && (lim_hi == (1 << 30)); bool ml_left = affine, cv_left = affine && CONV1_IN_QUEUE && (l == 0), flip = false;
    for (;;) {
        __syncthreads();
        if (tid == 0) { unsigned it = 0xffffffffu;
            if (cv_left && (flip || !ml_left)) { const unsigned t = __hip_atomic_fetch_add(queue + 16, 1u, __ATOMIC_RELAXED, __HIP_MEMORY_SCOPE_AGENT); if (t < (unsigned)CONV_NVB) it = 1024u + t; else cv_left = false; }
            if (it == 0xffffffffu && ml_left) { const unsigned x = xb_xcc_id() & 7u;
                for (unsigned j = 0; j < 8u; ++j) { const unsigned sidx = (x + j) & 7u; const unsigned t = __hip_atomic_fetch_add(queue + 8 + sidx, 1u, __ATOMIC_RELAXED, __HIP_MEMORY_SCOPE_AGENT); if (t < 64u) { it = (t << 3) | sidx; break; } }
                if (it == 0xffffffffu) ml_left = false; }
            if (it == 0xffffffffu && cv_left) { const unsigned t = __hip_atomic_fetch_add(queue + 16, 1u, __ATOMIC_RELAXED, __HIP_MEMORY_SCOPE_AGENT); if (t < (unsigned)CONV_NVB) it = 1024u + t; else cv_left = false; }
            flip = !flip;
            if (it == 0xffffffffu) { const unsigned t = __hip_atomic_fetch_add(queue, 1u, __ATOMIC_RELAXED, __HIP_MEMORY_SCOPE_AGENT); it = affine ? (t < 512u ? 512u + t : 0xfffffffeu) : t; }
            qslot[0] = it; }
        __syncthreads();
        if (affine && qslot[0] == 0xfffffffeu) break;
        const int item = (int)qslot[0] + lim_lo; if (item >= lim_hi || item >= 1024 + ((CONV1_IN_QUEUE && l == 0) ? CONV_NVB : 0)) break;
        if (item >= 1024) { phase_convert_layer(F, 1, 2, item - 1024, CONV_NVB); continue; }
        if (item >= 768) { scan2_item(F, item - 768); continue; }
        if (item >= 512) { xattn_item(F, l, item - 512); continue; }
        const int qt = 63 - (item >> 3), b = (item >> 2) & 1, hd = item & 3, t0 = qt * 64; const size_t rowb = (size_t)b * SEQ;
        const int tq = opaque_v(lane);
        const int q15 = tq & 15, qg = tq >> 4;
        bf16x8 qf[8];
#pragma unroll
        for (int ks = 0; ks < 8; ++ks) qf[ks] = *(const bf16x8*)(QC + (rowb + t0 + 16 * rt + q15) * 1024 + hd * 256 + 32 * ks + 8 * qg);
        float mxr[4];
#pragma unroll
        for (int j = 0; j < 4; ++j) mxr[j] = MX[(rowb + t0 + 16 * rt + qg * 4 + j) * 4 + hd];
        f32x4 num[4][4];
#pragma unroll
        for (int r4 = 0; r4 < 4; ++r4)
#pragma unroll
            for (int c4 = 0; c4 < 4; ++c4) num[r4][c4] = (f32x4){0.f, 0.f, 0.f, 0.f};
        float dacc[4] = {0.f, 0.f, 0.f, 0.f};
        asm volatile("s_waitcnt vmcnt(0)" ::: "memory");
        asm volatile("" : "+v"(qf[0]), "+v"(qf[1]), "+v"(qf[2]), "+v"(qf[3]), "+v"(qf[4]), "+v"(qf[5]), "+v"(qf[6]), "+v"(qf[7]));
        asm volatile("" : "+v"(mxr[0]), "+v"(mxr[1]), "+v"(mxr[2]), "+v"(mxr[3]));
#define ML_DMA_KV(kt_, bf_) do { const int s0_ = (kt_) * 32; const char* kb_ = (const char*)KC + ((rowb + s0_) * 1024 + hd * 256) * 2; const char* vb_ = (const char*)PROJ + ((rowb + s0_) * NPJ + PC_CV + hd * 512) * 2; \
            _Pragma("unroll") for (int i = 0; i < 2; ++i) { const int pc = w * 2 + i, row = 2 * pc + (lane >> 5), p = lane & 31; \
                __builtin_amdgcn_global_load_lds((const unsigned*)(kb_ + (size_t)row * 2048 + ((p ^ (row & 15)) * 16)), (LAS unsigned*)(lds + ML_K + (bf_) * 16384 + pc * 1024), 16, 0, 0); } \
            _Pragma("unroll") for (int i = 0; i < 4; ++i) { const int row = w * 4 + i; \
                __builtin_amdgcn_global_load_lds((const unsigned*)(vb_ + (size_t)row * (NPJ * 2) + ((lane ^ ml_vswz(row)) * 16)), (LAS unsigned*)(lds + ML_V + (bf_) * 32768 + row * 1024), 16, 0, 0); } \
            if (w == 0) __builtin_amdgcn_global_load_lds((const unsigned*)(G + (rowb + s0_ + (lane & 31)) * 4 + hd), (LAS unsigned*)(lds + ML_G + (bf_) * 256), 4, 0, 0); } while (0)
        const int nkt = 2 * qt + 2;
        ML_DMA_KV(0, 0); ML_DMA_KV(1, 1);
        int buf = 0;
        for (int kt = 0; kt < nkt; ++kt) {
            const int s0 = kt * 32;
            if (kt + 1 < nkt) { if (w == 0) asm volatile("s_waitcnt vmcnt(7) lgkmcnt(0)" ::: "memory"); else asm volatile("s_waitcnt vmcnt(6) lgkmcnt(0)" ::: "memory"); }
            else asm volatile("s_waitcnt vmcnt(0) lgkmcnt(0)" ::: "memory");
            __builtin_amdgcn_s_barrier(); asm volatile("" ::: "memory");
            { const int bf2 = buf >= 1 ? buf - 1 : 2; if (kt + 2 < nkt) ML_DMA_KV(kt + 2, bf2); }
            const LAS unsigned char* kb = lds + ML_K + buf * 16384; const LAS unsigned char* vbuf = lds + ML_V + buf * 32768; const LAS float* gl = (const LAS float*)(lds + ML_G + buf * 256);
            f32x4 sacc = (f32x4){0.f, 0.f, 0.f, 0.f};
            { bf16x8 kf[8];
#pragma unroll
              for (int ks = 0; ks < 8; ++ks) { const int r = 16 * ctp + l15; kf[ks] = *(const LAS bf16x8*)(kb + r * 512 + (((4 * ks + lg) ^ (r & 15)) * 16)); }
              asm volatile("" : "+v"(kf[0]), "+v"(kf[1]), "+v"(kf[2]), "+v"(kf[3]), "+v"(kf[4]), "+v"(kf[5]), "+v"(kf[6]), "+v"(kf[7]));
              f32x4 sacc1 = (f32x4){0.f, 0.f, 0.f, 0.f};
#pragma unroll
              for (int ks = 0; ks < 8; ks += 2) { sacc = __builtin_amdgcn_mfma_f32_16x16x32_bf16(qf[ks], kf[ks], sacc, 0, 0, 0); sacc1 = __builtin_amdgcn_mfma_f32_16x16x32_bf16(qf[ks + 1], kf[ks + 1], sacc1, 0, 0, 0); }
              sacc += sacc1; }
            { const int sl = 16 * ctp + l15; const float gs = gl[sl];
#pragma unroll
                for (int j = 0; j < 4; ++j) { const int tl = 16 * rt + lg * 4 + j;
                    const float wgt = (s0 + sl <= t0 + tl) ? __expf(gs - mxr[j]) : 0.f; const float val = sacc[j] * wgt;
                    *(LAS unsigned short*)(lds + ML_S + tl * ML_SROW + sl * 2) = (unsigned short)f2bf(val);
                    dacc[j] += row16_sum(val); } }
            asm volatile("s_waitcnt lgkmcnt(0)" ::: "memory"); __builtin_amdgcn_s_barrier(); asm volatile("" ::: "memory");
            { bf16x8 afr[4];
#pragma unroll
                for (int r4 = 0; r4 < 4; ++r4) afr[r4] = *(const LAS bf16x8*)(lds + ML_S + (16 * r4 + l15) * ML_SROW + (8 * lg) * 2);
                unsigned va[4];
#pragma unroll
                for (int c4 = 0; c4 < 4; ++c4) { const int r = 8 * lg + (l15 >> 2), ch = 8 * w + 2 * c4 + ((l15 & 3) >> 1); va[c4] = (unsigned)(size_t)(vbuf + r * 1024 + ((ch ^ ml_vswz(r)) * 16) + (l15 & 1) * 8); }
                s16x4 lo[4], hi[4];
                asm volatile("ds_read_b64_tr_b16 %0, %8\n\tds_read_b64_tr_b16 %1, %8 offset:4096\n\tds_read_b64_tr_b16 %2, %9\n\tds_read_b64_tr_b16 %3, %9 offset:4096\n\t"
                             "ds_read_b64_tr_b16 %4, %10\n\tds_read_b64_tr_b16 %5, %10 offset:4096\n\tds_read_b64_tr_b16 %6, %11\n\tds_read_b64_tr_b16 %7, %11 offset:4096\n\ts_waitcnt lgkmcnt(0)"
                             : "=&v"(lo[0]), "=&v"(hi[0]), "=&v"(lo[1]), "=&v"(hi[1]), "=&v"(lo[2]), "=&v"(hi[2]), "=&v"(lo[3]), "=&v"(hi[3]) : "v"(va[0]), "v"(va[1]), "v"(va[2]), "v"(va[3]) : "memory");
#pragma unroll
                for (int c4 = 0; c4 < 4; ++c4) { const bf16x8 bfr = __builtin_shufflevector(lo[c4], hi[c4], 0, 1, 2, 3, 4, 5, 6, 7);
#pragma unroll
                    for (int r4 = 0; r4 < 4; ++r4) num[r4][c4] = __builtin_amdgcn_mfma_f32_16x16x32_bf16(afr[r4], bfr, num[r4][c4], 0, 0, 0); } }
            buf = buf == 2 ? 0 : buf + 1;
        }
#undef ML_DMA_KV
        if (l15 == 0) {
#pragma unroll
            for (int j = 0; j < 4; ++j) denl[(16 * rt + lg * 4 + j) * 2 + ctp] = dacc[j]; }
        __syncthreads();
        { unsigned short co[4][4][4]; float mtv[4][4];
#pragma unroll
          for (int r4 = 0; r4 < 4; ++r4)
#pragma unroll
            for (int j = 0; j < 4; ++j) { const size_t row = rowb + t0 + 16 * r4 + lg * 4 + j; mtv[r4][j] = MT[row * 4 + hd];
#pragma unroll
                for (int c4 = 0; c4 < 4; ++c4) co[r4][j][c4] = PROJ[row * NPJ + PC_CO + hd * 512 + 64 * w + 16 * c4 + l15]; }
#pragma unroll
          for (int r4 = 0; r4 < 4; ++r4)
#pragma unroll
            for (int j = 0; j < 4; ++j) { const int tl = 16 * r4 + lg * 4 + j; const size_t row = rowb + t0 + tl;
                const float den = denl[2 * tl] + denl[2 * tl + 1], mt = mtv[r4][j]; const float inv = __builtin_amdgcn_rcpf(fmaxf(fabsf(den), __expf(-mt)));
#pragma unroll
                for (int c4 = 0; c4 < 4; ++c4) { const int dv = 64 * w + 16 * c4 + l15; const float o = sigm(bf2f(co[r4][j][c4]));
                    HC[row * 2048 + hd * 512 + dv] = num[r4][c4][j] * inv * o; } } }
        asm volatile("s_waitcnt vmcnt(0)" ::: "memory"); __syncthreads();
        { const float* gw_ = KIN(I_MGNW) + (size_t)l * 2048; bf16* Y = (bf16*)(KWS() + WS_Y); const int ch = hd * 512 + lane * 8;
          f32x4 hv0[8], hv1[8]; u32x4 hg[8]; const f32x4 gwa = *(const f32x4*)(gw_ + ch), gwb = *(const f32x4*)(gw_ + ch + 4);
#pragma unroll
          for (int rr = 0; rr < 8; ++rr) { const size_t t = rowb + t0 + w * 8 + rr; hv0[rr] = *(const f32x4*)(HC + t * 2048 + ch); hv1[rr] = *(const f32x4*)(HC + t * 2048 + ch + 4); hg[rr] = *(const u32x4*)(PROJ + t * NPJ + PC_CG + ch); }
          asm volatile("" ::: "memory");
#pragma unroll
          for (int rr = 0; rr < 8; ++rr) { const size_t t = rowb + t0 + w * 8 + rr;
            const f32x4 v0 = hv0[rr], v1 = hv1[rr];
            float x[8] = {v0.x, v0.y, v0.z, v0.w, v1.x, v1.y, v1.z, v1.w}; float sm_ = 0.f;
#pragma unroll
            for (int q = 0; q < 8; ++q) sm_ += x[q];
            const float mean = wave_sum(sm_) * (1.0f / 512.0f); float s2 = 0.f;
#pragma unroll
            for (int q = 0; q < 8; ++q) { x[q] -= mean; s2 += x[q] * x[q]; }
            const float rstd = rsqrtf(wave_sum(s2) * (1.0f / 512.0f) + 1e-6f);
            float gf[8]; unpack8(hg[rr], gf); float o[8];
#pragma unroll
            for (int q = 0; q < 8; ++q) o[q] = x[q] * rstd * (q < 4 ? gwa[q] : gwb[q - 4]) * siluf_(gf[q]);
            u32x4 wv; wv.x = pk2(o[0], o[1]); wv.y = pk2(o[2], o[3]); wv.z = pk2(o[4], o[5]); wv.w = pk2(o[6], o[7]);
            *(u32x4*)(Y + t * KCAT + YC_C + ch) = wv; } }
    }
    __syncthreads();
}

constexpr int XA_ROW = 272, XA_K = 0, XA_V = 256 * XA_ROW, XA_END = 2 * 256 * XA_ROW, XA_PROW = 528;
static_assert(XA_END <= RING_BYTES && 8 * 16 * XA_PROW <= XA_V, "x-attn LDS");
__device__ __forceinline__ void xattn_item(const Frame& F, int l, const int item) {
    const bf16* PROJ = (const bf16*)(KWS() + WS_PROJ); const bf16* KV = (const bf16*)(KWS() + WS_KV) + (size_t)l * MM * 1024; bf16* Y = (bf16*)(KWS() + WS_Y);
    LAS unsigned char* lds = F.lds; const int lane = opaque_v(F.lane), w = F.wave, tid = w * 64 + lane, l15 = lane & 15, lg = lane >> 4;
    {
        const int b = item >> 7, hd = (item >> 5) & 3, qb = item & 31; const size_t row0 = (size_t)b * SEQ + qb * 128 + 16 * w;
        __syncthreads();
        { u32x4 kq[8], vq[8];
#pragma unroll
          for (int i = 0; i < 8; ++i) { const int p = tid + 512 * i, r = p >> 4, c16 = p & 15; const bf16* src = KV + (size_t)(b * MEML + r) * 1024 + hd * 128 + c16 * 8; kq[i] = *(const u32x4*)src; vq[i] = *(const u32x4*)(src + 512); }
          asm volatile("" : "+v"(kq[0]), "+v"(kq[1]), "+v"(kq[2]), "+v"(kq[3]), "+v"(kq[4]), "+v"(kq[5]), "+v"(kq[6]), "+v"(kq[7]), "+v"(vq[0]), "+v"(vq[1]), "+v"(vq[2]), "+v"(vq[3]), "+v"(vq[4]), "+v"(vq[5]), "+v"(vq[6]), "+v"(vq[7]) :: "memory");
#pragma unroll
          for (int i = 0; i < 8; ++i) { const int p = tid + 512 * i, r = p >> 4, c16 = p & 15; *(LAS u32x4*)(lds + XA_K + r * XA_ROW + c16 * 16) = kq[i]; *(LAS u32x4*)(lds + XA_V + r * XA_ROW + c16 * 16) = vq[i]; } }
        bf16x8 qf[4];
#pragma unroll
        for (int ks = 0; ks < 4; ++ks) qf[ks] = *(const bf16x8*)(PROJ + (row0 + l15) * NPJ + PC_XQ + hd * 128 + 32 * ks + 8 * lg);
        unsigned short xg[4][8];
#pragma unroll
        for (int j = 0; j < 4; ++j)
#pragma unroll
            for (int cc = 0; cc < 8; ++cc) xg[j][cc] = PROJ[(row0 + lg * 4 + j) * NPJ + PC_XG + hd * 128 + 16 * cc + l15];
        __syncthreads();
        f32x4 sacc[16];
#pragma unroll
        for (int ct = 0; ct < 16; ++ct) { sacc[ct] = (f32x4){0.f, 0.f, 0.f, 0.f};
#pragma unroll
            for (int ks = 0; ks < 4; ++ks) { const bf16x8 bfr = *(const LAS bf16x8*)(lds + XA_K + (16 * ct + l15) * XA_ROW + (32 * ks + 8 * lg) * 2);
                sacc[ct] = __builtin_amdgcn_mfma_f32_16x16x32_bf16(qf[ks], bfr, sacc[ct], 0, 0, 0); } }
        float mx[4], sm[4];
#pragma unroll
        for (int j = 0; j < 4; ++j) { float m = sacc[0][j];
#pragma unroll
            for (int ct = 1; ct < 16; ++ct) m = fmaxf(m, sacc[ct][j]);
            mx[j] = row16_max(m); sm[j] = 0.f; }
        __syncthreads();
        LAS unsigned char* pw = lds + XA_K + w * 16 * XA_PROW;
#pragma unroll
        for (int ct = 0; ct < 16; ++ct)
#pragma unroll
            for (int j = 0; j < 4; ++j) { const float p = __expf((sacc[ct][j] - mx[j]) * 0.08838834764831845f); sm[j] += p;
                *(LAS unsigned short*)(pw + (lg * 4 + j) * XA_PROW + (16 * ct + l15) * 2) = (unsigned short)f2bf(p); }
#pragma unroll
        for (int j = 0; j < 4; ++j) sm[j] = row16_sum(sm[j]);
        LDS_WAIT(); asm volatile("" ::: "memory");
        f32x4 oacc[8];
#pragma unroll
        for (int cc = 0; cc < 8; ++cc) oacc[cc] = (f32x4){0.f, 0.f, 0.f, 0.f};
#pragma unroll
        for (int ks = 0; ks < 8; ++ks) { const bf16x8 afr = *(const LAS bf16x8*)(pw + l15 * XA_PROW + (32 * ks + 8 * lg) * 2);
#pragma unroll
            for (int cc = 0; cc < 8; ++cc) { const LAS unsigned char* vp = lds + XA_V + (32 * ks + 8 * lg + (l15 >> 2)) * XA_ROW + (16 * cc + 4 * (l15 & 3)) * 2;
                const s16x4 lo = tr16(vp), hi = tr16(vp + 4 * XA_ROW); const bf16x8 bfr = __builtin_shufflevector(lo, hi, 0, 1, 2, 3, 4, 5, 6, 7);
                oacc[cc] = __builtin_amdgcn_mfma_f32_16x16x32_bf16(afr, bfr, oacc[cc], 0, 0, 0); } }
#pragma unroll
        for (int j = 0; j < 4; ++j) { const size_t row = row0 + lg * 4 + j; const float inv = __builtin_amdgcn_rcpf(sm[j]);
#pragma unroll
            for (int cc = 0; cc < 8; ++cc) { const int d = 16 * cc + l15; const float gate = siluf_(bf2f(xg[j][cc]));
                Y[row * KCAT + YC_X + hd * 128 + d] = (bf16)f2bf(oacc[cc][j] * inv * gate); } }
    }
    __syncthreads();
}

constexpr int NPL = 9, NPHASE = 2 + DEPTH * NPL;
struct Args { Ctx c; int ph_lo, ph_hi; };
template <unsigned PH_MASK> __global__ void __launch_bounds__(NTHREADS, 2) mega(Args args) {
    extern __shared__ __attribute__((aligned(16))) unsigned char lds_raw[];
    Frame F; F.lds = (LAS unsigned char*)lds_raw; F.wave = __builtin_amdgcn_readfirstlane((int)threadIdx.x >> 6); F.lane = lane_id(); F.tid = F.wave * 64 + F.lane; F.bid = blockIdx.x; F.nblk = gridDim.x;
    volatile LAS unsigned* MISC = (volatile LAS unsigned*)(F.lds + MISC_OFF);
    if (F.tid < 16) MISC[F.tid] = 0u;
    __syncthreads();
    const int lo = args.ph_lo, hi = args.ph_hi;
    XcdBarrier bar; bar.bar = (unsigned*)(KWS() + WS_CTL) + CW_BAR; bar.st = MISC + 8;
    if (PH_MASK == 0x7FFu) { if (hi - lo > 1) xcd_barrier_setup(bar, F.wave); }
#ifndef PROBE_DUP
#define PROBE_DUP 0u
#endif
#define DUP(j) (((PROBE_DUP >> (j)) & 1u) ? 2 : 1)
#define IN(k) (lo <= (k) && (k) < hi)
#define EN(j) ((PH_MASK >> (j)) & 1u)
#define SEAM(k) do { if (PH_MASK == 0x7FFu) { if (IN(k) && IN((k) + 1)) xcd_barrier(bar, F.wave); } } while (0)
    if (IN(0) && EN(0)) for (int rep = 0; rep < DUP(0); ++rep) { phase_gate_absmax(F); phase_convert_layer(F, 0, 1, F.bid, F.nblk); phase_convert_layer(F, 1, 1, F.bid, F.nblk); phase_norm(F, KIN(I_X), KIN(I_NORM_G), false); }
    SEAM(0);
    if (IN(1) && EN(1)) for (int rep = 0; rep < DUP(1); ++rep) { phase_convert_layer(F, 0, 2, F.bid, F.nblk); if (!CONV1_IN_QUEUE) phase_convert_layer(F, 1, 2, F.bid, F.nblk); }
    SEAM(1);
    for (int l0 = 0; l0 < DEPTH; ++l0) {
        const int l = opaque_s(l0);
        const int pb = 2 + l * NPL;
        if (IN(pb + 0) && EN(2)) for (int rep = 0; rep < DUP(2); ++rep) {
            if (l == 0) {
                for (int l2 = 0; l2 < DEPTH; ++l2) { unsigned char* ws = KWS(); unsigned char* wl2 = ws + WS_W + (size_t)l2 * SZ_WLAYER;
                    pg8::Gemm g{(const char*)(ws + WS_MEMN) + (size_t)l2 * MM * 4096 * 2, (const char*)(wl2 + WO_WKV)};
                    EpiProj<1024, false> E{(bf16*)(ws + WS_KV) + (size_t)l2 * MM * 1024, nullptr};
                    const int cc = F.bid - (F.nblk - 16) - 8 * l2;
                    pg8::gemm_phase<pg8::Geo<8192, 8192, 4096, MM / 256, 4>, EpiProj<1024, false>>(F.lds, g, 8, (cc >= 0 && cc < 8) ? cc : 1000, F.wave, E); }
            }
            unsigned char* ws = KWS(); unsigned char* wl = ws + WS_W + (size_t)l * SZ_WLAYER;
            { pg8::Gemm g{(const char*)(ws + WS_H), (const char*)(wl + WO_WIN)};
              EpiProj<NPJ, true> E{(bf16*)(ws + WS_PROJ), (float*)(ws + WS_IFB)};
              pg8::gemm_phase<pg8::Geo<8192, 8192, 4096, M / 256, PN_I8>, EpiProj<NPJ, true>>(F.lds, g, F.nblk, F.bid, F.wave, E); }
            { pg8::Gemm g{(const char*)(ws + WS_H8), (const char*)(wl + WO_WIN) + (size_t)PC_I8 * 8192};
              EpiGate8 E{(bf16*)(ws + WS_PROJ) + PC_I8, (const float*)(ws + WS_HS), (const unsigned*)(ws + WS_CTL) + CW_CMAX + l * N8};
              pg8::gemm_phase<pg8::Geo<4096, 4096, 2048, M / 256, N8 / 256, 0, 0, true>, EpiGate8>(F.lds, g, F.nblk, F.bid, F.wave, E); }
        }
        SEAM(pb + 0);
        if (IN(pb + 1) && EN(3)) for (int rep = 0; rep < DUP(3); ++rep) { phase_prep(F, l); }
        SEAM(pb + 1);
        if (IN(pb + 2) && EN(4)) for (int rep = 0; rep < DUP(4); ++rep) {
            { unsigned char* ws = KWS(); unsigned char* wl = ws + WS_W + (size_t)l * SZ_WLAYER;
              pg8::Gemm g{(const char*)(ws + WS_U), (const char*)(wl + WO_WG)};
              EpiLru E{(const bf16*)(ws + WS_U), (float*)(ws + WS_LA), (float*)(ws + WS_LB), KIN(I_LRU_BA) + (size_t)l * 2048, KIN(I_LRU_BX) + (size_t)l * 2048, KIN(I_LRU_LAM) + (size_t)l * 2048};
              pg8::gemm_phase<pg8::Geo<4096, 512, 256, M / 256, 16, 1, 512>, EpiLru>(F.lds, g, F.nblk, F.bid, F.wave, E); }
            { unsigned char* ws = KWS(); unsigned char* wl = ws + WS_W + (size_t)l * SZ_WLAYER;
              pg8::Gemm g{(const char*)(ws + WS_LORA), (const char*)(wl + WO_WL)};
              EpiLora E{(float*)(ws + WS_RV), (float*)(ws + WS_AA), KIN(I_W0) + (size_t)l * 2048, KIN(I_A0) + (size_t)l * 2048};
              pg8::gemm_phase<pg8::Geo<512, 512, 256, M / 256, 16>, EpiLora>(F.lds, g, F.nblk, F.bid, F.wave, E); }
        }
        SEAM(pb + 2);
        if (IN(pb + 3) && EN(5)) for (int rep = 0; rep < DUP(5); ++rep) { phase_rwkv_vec(F, l); phase_lru_scan1(F); }
        SEAM(pb + 3);
        if (IN(pb + 4) && EN(6)) {
            for (int rep = 0; rep < DUP(6); ++rep) phase_rwkv_rec(F, F.bid, F.nblk);
#ifdef PROBE_Q
            phase_mlstm(F, l, (unsigned*)(KWS() + WS_CTL) + CW_QUEUE + 64 * l + 32, PROBE_Q_LO, PROBE_Q_HI);
#endif
            phase_mlstm(F, l, (unsigned*)(KWS() + WS_CTL) + CW_QUEUE + 64 * l);
        }
        SEAM(pb + 4);
        if (IN(pb + 5) && EN(7)) for (int rep = 0; rep < DUP(7); ++rep) { phase_rwkv_post(F, l); }
        SEAM(pb + 5);
        if (IN(pb + 6) && EN(8)) for (int rep = 0; rep < DUP(8); ++rep) {
            unsigned char* ws = KWS(); unsigned char* wl = ws + WS_W + (size_t)l * SZ_WLAYER;
            pg8::Gemm g{(const char*)(ws + WS_Y), (const char*)(wl + WO_WCAT)};
            EpiMerge E{(const bf16*)(ws + WS_PROJ) + PC_GATE, (bf16*)(ws + WS_MERGED)};
            pg8::gemm_phase<pg8::Geo<KCAT * 2, KCAT * 2, KCAT, M / 256, 16>, EpiMerge>(F.lds, g, F.nblk, F.bid, F.wave, E);
        }
        SEAM(pb + 6);
        if (IN(pb + 7) && EN(9)) for (int rep = 0; rep < ((l == 0) ? DUP(9) : 1); ++rep) {
            unsigned char* ws = KWS(); unsigned char* wl = ws + WS_W + (size_t)l * SZ_WLAYER;
            pg8::Gemm g{(const char*)(ws + WS_MERGED), (const char*)(wl + WO_WOUT)};
            EpiOut E{(l == 0) ? KIN(I_X) : (const float*)(ws + WS_X1), (float*)(ws + WS_X1)};
            pg8::gemm_phase<pg8::Geo<8192, 8192, 4096, M / 256, 16>, EpiOut>(F.lds, g, F.nblk, F.bid, F.wave, E);
        }
        SEAM(pb + 7);
        if (IN(pb + 8) && EN(10)) { const float* X1 = (const float*)(KWS() + WS_X1); if (l + 1 < DEPTH) phase_norm(F, X1, KIN(I_NORM_G) + (size_t)(l + 1) * 4096, false); else phase_norm(F, X1, KIN(I_FNG), true); }
        SEAM(pb + 8);
    }
#undef IN
#undef SEAM
}

typedef void (*kern_t)(Args);
static kern_t phase_kernel(int p) {
    const int j = p < 2 ? p : 2 + (p - 2) % NPL;
    switch (j) { case 0: return mega<1u << 0>; case 1: return mega<1u << 1>; case 2: return mega<1u << 2>; case 3: return mega<1u << 3>; case 4: return mega<1u << 4>; case 5: return mega<1u << 5>;
                 case 6: return mega<1u << 6>; case 7: return mega<1u << 7>; case 8: return mega<1u << 8>; case 9: return mega<1u << 9>; default: return mega<1u << 10>; }
}
extern "C" void kernel_launch(void* const* d_in, const int* in_sizes, int n_in, void* d_out, int out_size, void* d_ws, size_t ws_size, hipStream_t stream) {
    static int grid = 0;
    if (grid == 0) {
        if (n_in != 34 || ws_size < WS_END) { fprintf(stderr, "kernel_launch: unexpected problem (n_in %d, ws %zu, need %zu)\n", n_in, ws_size, (size_t)WS_END); grid = -1; return; }
        int dev = 0, cus = 0;
        if (hipGetDevice(&dev) != hipSuccess || hipDeviceGetAttribute(&cus, hipDeviceAttributeMultiprocessorCount, dev) != hipSuccess) { grid = -1; return; }
#if MK_PER_PHASE
        for (int p = 0; p < 2 + NPL; ++p) if (hipFuncSetAttribute((const void*)phase_kernel(p), hipFuncAttributeMaxDynamicSharedMemorySize, LDS_BYTES) != hipSuccess) { fprintf(stderr, "kernel_launch: hipFuncSetAttribute failed\n"); grid = -1; return; }
#else
        if (hipFuncSetAttribute((const void*)mega<0x7FFu>, hipFuncAttributeMaxDynamicSharedMemorySize, LDS_BYTES) != hipSuccess) { fprintf(stderr, "kernel_launch: hipFuncSetAttribute failed\n"); grid = -1; return; }
#endif
        int occ = 0;
#if MK_PER_PHASE
        occ = 1;
#else
        if (hipOccupancyMaxActiveBlocksPerMultiprocessor(&occ, mega<0x7FFu>, NTHREADS, LDS_BYTES) != hipSuccess || occ < 1) { fprintf(stderr, "kernel_launch: occupancy query reports %d workgroups per CU\n", occ); grid = -1; return; }
#endif
        (void)hipGetLastError();
        grid = cus;
    }
    if (grid < 0) return;
    (void)hipMemsetAsync((char*)d_ws + WS_CTL, 0, CTL_ZERO_BYTES, stream);
    Args a{};
    for (int i = 0; i < 34; ++i) a.c.in[i] = (const float*)d_in[i];
    a.c.out = (float*)d_out; a.c.ws = (unsigned char*)d_ws;
#if MK_PER_PHASE
    for (int p = 0; p < NPHASE; ++p) { a.ph_lo = p; a.ph_hi = p + 1; hipLaunchKernelGGL(phase_kernel(p), dim3(grid), dim3(NTHREADS), LDS_BYTES, stream, a); }
#else
    a.ph_lo = 0; a.ph_hi = NPHASE; hipLaunchKernelGGL(mega<0x7FFu>, dim3(grid), dim3(NTHREADS), LDS_BYTES, stream, a);
#endif
    (void)in_sizes; (void)out_size;
}
```

```cpp
#include <hip/hip_runtime.h>
#include <cstdio>
#include <cstdint>

#ifndef MK_PER_PHASE
#define MK_PER_PHASE 0
#endif

#define LAS __attribute__((address_space(3)))
#define GAS __attribute__((address_space(1)))
typedef unsigned short bf16;
typedef short bf16x8 __attribute__((ext_vector_type(8)));
typedef short s16x4 __attribute__((ext_vector_type(4)));
typedef float f32x4 __attribute__((ext_vector_type(4)));
typedef float f32x2 __attribute__((ext_vector_type(2)));
typedef unsigned u32x4 __attribute__((ext_vector_type(4)));
typedef unsigned u32x2 __attribute__((ext_vector_type(2)));
typedef int i32x4 __attribute__((ext_vector_type(4)));

constexpr int D = 4096, NBATCH = 2, SEQ = 4096, M = NBATCH * SEQ, DEPTH = 2, MEML = 256, MM = NBATCH * MEML;
constexpr int CIN = 38088;
constexpr int NPJ = 38400;
constexpr int PC_AX = 0, PC_AG = 2048, PC_BR = 4096, PC_BK = 6144, PC_BV = 8192, PC_BWD = 10240, PC_BAD = 10368, PC_BG = 10496,
              PC_CQK = 12544, PC_CV = 14592, PC_CG = 16640, PC_XQ = 18688, PC_XG = 19200, PC_IF = 19712, PC_CO = 19968, PC_GATE = 22016;
constexpr int PN_IF = PC_IF / 256;
constexpr int KCAT = 6656;
constexpr int YC_A = 0, YC_B = 2048, YC_C = 4096, YC_X = 6144;

constexpr size_t MiB = 1u << 20;
constexpr size_t WS_CTL = 0, CTL_ZERO_BYTES = 1 * MiB;
constexpr size_t SZ_WIN = 300 * MiB, SZ_WCAT = 52 * MiB, SZ_WOUT = 32 * MiB, SZ_WKV = 8 * MiB, SZ_WG = 2 * MiB, SZ_WL = 2 * MiB;
constexpr size_t SZ_WLAYER = SZ_WIN + SZ_WCAT + SZ_WOUT + SZ_WKV + SZ_WG + SZ_WL;
constexpr size_t WS_W = 1 * MiB;
constexpr size_t WO_WIN = 0, WO_WCAT = SZ_WIN, WO_WOUT = WO_WCAT + SZ_WCAT, WO_WKV = WO_WOUT + SZ_WOUT, WO_WG = WO_WKV + SZ_WKV, WO_WL = WO_WG + SZ_WG;
constexpr size_t WS_MEMN = WS_W + 2 * SZ_WLAYER;
constexpr size_t WS_KV = WS_MEMN + 8 * MiB;
constexpr size_t WS_H = WS_KV + 2 * MiB;
constexpr size_t WS_PROJ = WS_H + 64 * MiB;
constexpr size_t WS_IFB = WS_PROJ + 600 * MiB;
constexpr size_t WS_U = WS_IFB + 1 * MiB;
constexpr size_t WS_LA = WS_U + 32 * MiB;
constexpr size_t WS_LB = WS_LA + 64 * MiB;
constexpr size_t WS_CARRY = WS_LB + 64 * MiB;
constexpr size_t WS_LORA = WS_CARRY + 1 * MiB;
constexpr size_t WS_WDEC = WS_LORA + 4 * MiB;
constexpr size_t WS_AA = WS_WDEC + 64 * MiB;
constexpr size_t WS_RV = WS_AA + 64 * MiB;
constexpr size_t WS_VV = WS_RV + 320 * MiB;
constexpr size_t WS_BON = WS_VV + 64 * MiB;
constexpr size_t WS_YR = WS_BON + 1 * MiB;
constexpr size_t WS_QC = WS_YR + 64 * MiB;
constexpr size_t WS_KC = WS_QC + 16 * MiB;
constexpr size_t WS_SCAL = WS_KC + 16 * MiB;
constexpr size_t WS_HC = WS_SCAL + 1 * MiB;
constexpr size_t WS_Y = WS_HC + 64 * MiB;
constexpr size_t WS_MERGED = WS_Y + 104 * MiB;
constexpr size_t WS_X1 = WS_MERGED + 64 * MiB;
constexpr size_t WS_H8 = WS_X1 + 128 * MiB;
constexpr size_t WS_HS = WS_H8 + 32 * MiB;
constexpr size_t WS_END = WS_HS + 1 * MiB;
constexpr int CW_BAR = 4096, CW_QUEUE = 8192;
constexpr int CW_CMAX = 131072;
constexpr int NGATE = 16384, PC_I8 = PC_CO, N8 = 2048 + NGATE, PN_I8 = PC_I8 / 256;
#ifndef CONV1_IN_QUEUE
#define CONV1_IN_QUEUE 1
#endif
constexpr int CONV_NVB = 512;

constexpr int RING_BYTES = 155648;
constexpr int MISC_OFF = RING_BYTES;
constexpr int LDS_BYTES = 159744;
constexpr int NWAVES = 8, NTHREADS = 512;

__device__ __forceinline__ float bf2f(unsigned short b) { return __uint_as_float(((unsigned)b) << 16); }
__device__ __forceinline__ unsigned f2bf(float f) { unsigned u = __float_as_uint(f); return (u + 0x7fffu + ((u >> 16) & 1u)) >> 16; }
__device__ __forceinline__ unsigned pk2(float lo, float hi) { return f2bf(lo) | (f2bf(hi) << 16); }
__device__ __forceinline__ unsigned cvt_pk_bf16(float lo, float hi) { unsigned r; asm volatile("v_cvt_pk_bf16_f32 %0, %1, %2" : "=v"(r) : "v"(lo), "v"(hi)); return r; }
__device__ __forceinline__ float sigm(float x) { return __builtin_amdgcn_rcpf(1.0f + __expf(-x)); }
__device__ __forceinline__ float siluf_(float x) { return x * __builtin_amdgcn_rcpf(1.0f + __expf(-x)); }
__device__ __forceinline__ float softplusf_(float x) { return fmaxf(x, 0.f) + __logf(1.0f + __expf(-fabsf(x))); }
__device__ __forceinline__ float expm1s_(float x) { const float p = x * (1.0f + x * (0.5f + x * (0.16666667f + x * (0.041666668f + x * 0.0083333338f)))); return fabsf(x) < 0.25f ? p : __expf(x) - 1.0f; }

template <int CTRL> __device__ __forceinline__ float dpp_mov(float v) { return __int_as_float(__builtin_amdgcn_update_dpp(0, __float_as_int(v), CTRL, 0xf, 0xf, true)); }
__device__ __forceinline__ float row16_sum(float v) {
    v += dpp_mov<0xB1>(v); v += dpp_mov<0x4E>(v); v += dpp_mov<0x141>(v); v += dpp_mov<0x140>(v); return v;
}
__device__ __forceinline__ float wave_sum(float v) { v = row16_sum(v); v += __shfl_xor(v, 16); v += __shfl_xor(v, 32); return v; }
__device__ __forceinline__ float row16_max(float v) {
    v = fmaxf(v, dpp_mov<0xB1>(v)); v = fmaxf(v, dpp_mov<0x4E>(v)); v = fmaxf(v, dpp_mov<0x141>(v)); v = fmaxf(v, dpp_mov<0x140>(v)); return v;
}
__device__ __forceinline__ void unpack8(const u32x4 w, float* f) {
    f[0] = __uint_as_float(w.x << 16); f[1] = __uint_as_float(w.x & 0xffff0000u); f[2] = __uint_as_float(w.y << 16); f[3] = __uint_as_float(w.y & 0xffff0000u);
    f[4] = __uint_as_float(w.z << 16); f[5] = __uint_as_float(w.z & 0xffff0000u); f[6] = __uint_as_float(w.w << 16); f[7] = __uint_as_float(w.w & 0xffff0000u);
}
__device__ __forceinline__ int opaque_v(int v) { asm volatile("" : "+v"(v)); return v; }
template <class T> __device__ __forceinline__ const T* opaque_p(const T* p) { asm volatile("" : "+s"(p)); return p; }
__device__ __forceinline__ int opaque_s(int v) { asm volatile("" : "+s"(v)); return v; }
__device__ __forceinline__ int lane_id() { unsigned z; asm volatile("v_mov_b32 %0, 0" : "=v"(z)); return (int)__builtin_amdgcn_mbcnt_hi(~0u, __builtin_amdgcn_mbcnt_lo(~0u, z)); }
#define LDS_WAIT() asm volatile("s_waitcnt lgkmcnt(0)" ::: "memory")
#define VM_WAIT() asm volatile("s_waitcnt vmcnt(0)" ::: "memory")

#define XB_TMO      128
#define XB_XCNT(j)  (256  + 64 * (j))
#define XB_XSUB(j)  (1280 + 64 * (j))
#define XB_XGEN(j)  (2304 + 64 * (j))
#define XB_TOP      3328
#define XB_TOPGEN   3392
#define XCD_BAR_WORDS 3456
#define XB_SPIN_CAP (1u << 18)
__device__ __forceinline__ unsigned xb_ld(unsigned* p)              { return __hip_atomic_load(p, __ATOMIC_RELAXED, __HIP_MEMORY_SCOPE_AGENT); }
__device__ __forceinline__ unsigned xb_add(unsigned* p, unsigned v) { return __hip_atomic_fetch_add(p, v, __ATOMIC_RELAXED, __HIP_MEMORY_SCOPE_AGENT); }
__device__ __forceinline__ unsigned xb_xcc_id() { return (unsigned)__builtin_amdgcn_s_getreg((3 << 11) | 20) & 0xFu; }
#define XB_SPIN(cond, bar) do { unsigned _sp = 0; while (cond) { __builtin_amdgcn_s_sleep(1); \
    if ((++_sp & 255u) == 0u) { if (xb_ld(&(bar)[XB_TMO])) break; if (_sp > XB_SPIN_CAP) { atomicAdd(&(bar)[XB_TMO], 1u); break; } } } } while (0)
struct XcdBarrier { unsigned* bar; volatile LAS unsigned* st; };
__device__ __forceinline__ void xcd_barrier_setup(const XcdBarrier& b, const int wave_) {
    if (opaque_s(wave_) == 0 && lane_id() == 0) {
        unsigned* bar = b.bar; const unsigned x = xb_xcc_id();
        (void)xb_add(&bar[XB_XCNT(x)], 1u);
        const unsigned G = gridDim.x * gridDim.y * gridDim.z;
        unsigned sum, cnt, mine, sp = 0u;
        for (;;) {
            sum = 0u; cnt = 0u; mine = 0u;
            for (unsigned j = 0; j < 16; ++j) { const unsigned c = xb_ld(&bar[XB_XCNT(j)]); sum += c; cnt += (c > 0u) ? 1u : 0u; mine = (j == x) ? c : mine; }
            if (sum == G) break;
            __builtin_amdgcn_s_sleep(1);
            if ((++sp & 255u) == 0u) { if (xb_ld(&bar[XB_TMO])) break; if (sp > XB_SPIN_CAP) { atomicAdd(&bar[XB_TMO], 1u); break; } }
        }
        b.st[0] = mine > 0u ? mine : 1u; b.st[1] = cnt > 0u ? cnt : 1u; b.st[2] = x;
    }
    __syncthreads();
}
__device__ __forceinline__ void xcd_barrier(const XcdBarrier& b, const int wave_) {
    asm volatile("s_waitcnt vmcnt(0)" ::: "memory");
    __syncthreads();
    if (opaque_s(wave_) == 0 && lane_id() == 0) {
        unsigned* bar = b.bar;
        __builtin_amdgcn_s_waitcnt(0);
        const unsigned nloc = b.st[0], nx = b.st[1], x = b.st[2];
        const unsigned old = xb_add(&bar[XB_XSUB(x)], 1u);
        const unsigned gen = old / nloc;
        if (old + 1u == (gen + 1u) * nloc) {
            __builtin_amdgcn_fence(__ATOMIC_RELEASE, "agent");
            asm volatile("s_waitcnt vmcnt(0)" ::: "memory");
            const unsigned og = xb_add(&bar[XB_TOP], 1u);
            const unsigned tg = og / nx;
            if (og + 1u == (tg + 1u) * nx) xb_add(&bar[XB_TOPGEN], 1u);
            else XB_SPIN(xb_ld(&bar[XB_TOPGEN]) == tg, bar);
            __builtin_amdgcn_fence(__ATOMIC_ACQUIRE, "agent");
            xb_add(&bar[XB_XGEN(x)], 1u);
            asm volatile("s_waitcnt vmcnt(0)" ::: "memory");
        } else {
            XB_SPIN(xb_ld(&bar[XB_XGEN(x)]) == gen, bar);
            __builtin_amdgcn_fence(__ATOMIC_ACQUIRE, "agent");
            asm volatile("s_waitcnt vmcnt(0)" ::: "memory");
        }
    }
    __syncthreads();
}

namespace pg8 {
constexpr int BM = 256, BK = 64, HALF = 128, HTB = HALF * BK * 2, STAGE_BYTES = 8 * HTB, NXCD = 8, WGM = 8;
__host__ __device__ __forceinline__ int lds_byte(int r, int c) { const int st = (r >> 4) * 2 + (c >> 5), rr = r & 15, cc = c & 31, ob = rr * 64 + cc * 2; return st * 1024 + (ob ^ (((ob >> 9) & 1) << 5)); }
__host__ __device__ __forceinline__ void stage_rc(int b, int& R, int& C) { const int st = b / 1024, sb = b % 1024, swz = sb ^ (((sb >> 9) & 1) << 5); R = (st >> 1) * 16 + swz / 64; C = (st & 1) * 32 + (swz % 64) / 2; }
__host__ __device__ __forceinline__ int perm32(int rho) { const int n = rho >> 4, i = rho & 15; return 8 * (i >> 2) + 4 * n + (i & 3); }
struct Unit { int pm, pn; };
struct Gemm { const char* A; const char* Bt; };
template <int LDA_, int LDB_, int K_, int NM_, int NN_, int ASHIFT_ = 0, int ASTEP_ = 0, bool I8_ = false> struct Geo { static constexpr int LDA = LDA_, LDB = LDB_, K = K_, NM = NM_, NN = NN_, ASHIFT = ASHIFT_, ASTEP = ASTEP_; static constexpr bool I8 = I8_; };
template <bool I8> __device__ __forceinline__ f32x4 mma16(const bf16x8 a, const bf16x8 b, const f32x4 c) {
    if constexpr (I8) return __builtin_bit_cast(f32x4, __builtin_amdgcn_mfma_i32_16x16x64_i8(__builtin_bit_cast(i32x4, a), __builtin_bit_cast(i32x4, b), __builtin_bit_cast(i32x4, c), 0, 0, 0));
    else return __builtin_amdgcn_mfma_f32_16x16x32_bf16(a, b, c, 0, 0, 0); }
struct StaticOrder {
    int nM, nN, nwg, G, c;
    __device__ void init(int nM_, int nN_, int G_, int c_) { nM = nM_; nN = nN_; nwg = nM * nN; G = G_; c = c_; }
    __device__ bool next(int i, Unit& u) const {
        const long L = (long)i * G + c; if (L >= nwg) return false;
        int wgid = (int)L; { const int q = nwg / NXCD, r = nwg % NXCD, xcd = wgid % NXCD, off = wgid / NXCD; wgid = (xcd < r ? xcd * (q + 1) : r * (q + 1) + (xcd - r) * q) + off; }
        const int nig = WGM * nN, gid = wgid / nig, fm = gid * WGM, gsz = (nM - fm) < WGM ? (nM - fm) : WGM;
        u.pm = fm + ((wgid % nig) % gsz); u.pn = (wgid % nig) / gsz; return true;
    }
};
template <class GEO, class Epi>
__device__ __forceinline__ void gemm_phase(LAS unsigned char* lds, const Gemm g, const int G_, const int c_, const int wave_, const Epi& E) {
    StaticOrder S; S.init(GEO::NM, GEO::NN, opaque_s(G_), opaque_s(c_));
    const int wid = opaque_s(wave_), lane = lane_id(), tid = wid * 64 + lane, wr = wid >> 2, wc = wid & 3, fr = lane & 15, fq = lane >> 4;
    constexpr int nt = GEO::K / BK;
    unsigned voffA[2], voffB[2];
#pragma unroll
    for (int i = 0; i < 2; ++i) { int R, C; stage_rc(tid * 16 + i * 8192, R, C); const int Rb = Epi::PERM ? ((R & ~31) + perm32(R & 31)) : R;
        voffA[i] = (unsigned)(R * GEO::LDA + C * 2); voffB[i] = (unsigned)(Rb * GEO::LDB + C * 2); }
    constexpr size_t kstep = (size_t)(BK * 2);
    constexpr size_t hstepA = (size_t)HALF * GEO::LDA, hstepB = (size_t)HALF * GEO::LDB;
    const unsigned ldsw = (unsigned)wid * 1024u;
    const int aoff = lds_byte(wr * 64 + fr, fq * 8), boff = lds_byte(wc * 32 + fr, fq * 8);
#define PG8_SA(b, h) (((b) * 2 + (h)) * HTB)
#define PG8_SB(b, h) ((4 + (b) * 2 + (h)) * HTB)
#define PG8_STAGE(bufoff, gbase, voff) do { _Pragma("unroll") for (int _i = 0; _i < 2; ++_i) \
        __builtin_amdgcn_global_load_lds((const unsigned*)((const char*)(gbase) + (voff)[_i]), (LAS unsigned*)(lds + (bufoff) + ldsw + _i * 8192), 16, 0, 0); } while (0)
#define PG8_LDA(dst, b, h) do { _Pragma("unroll") for (int m = 0; m < 4; ++m) _Pragma("unroll") for (int k = 0; k < 2; ++k) dst[m][k] = *(const LAS bf16x8*)(lds + PG8_SA(b, h) + aoff + m * 2048 + k * 1024); } while (0)
#define PG8_LDB(dst, b, h) do { _Pragma("unroll") for (int n = 0; n < 2; ++n) _Pragma("unroll") for (int k = 0; k < 2; ++k) dst[n][k] = *(const LAS bf16x8*)(lds + PG8_SB(b, h) + boff + n * 2048 + k * 1024); } while (0)
#define PG8_MMA(ai, bj, At, Bt) do { __builtin_amdgcn_s_setprio(1); _Pragma("unroll") for (int m = 0; m < 4; ++m) _Pragma("unroll") for (int n = 0; n < 2; ++n) _Pragma("unroll") for (int k = 0; k < 2; ++k) \
        acc[ai][bj][m][n] = mma16<GEO::I8>(Bt[n][k], At[m][k], acc[ai][bj][m][n]); __builtin_amdgcn_s_setprio(0); } while (0)
#define PG8_WAIT_V(n) asm volatile("s_waitcnt vmcnt(" #n ")" ::: "memory")
#define PG8_WAIT_L(n) asm volatile("s_waitcnt lgkmcnt(" #n ")" ::: "memory")
#define PG8_BAR __builtin_amdgcn_s_barrier()
#define PG8_SCHED __builtin_amdgcn_sched_barrier(0)
    Unit cur, nxt; int ui = 0;
    if (!S.next(0, cur)) return;
    f32x4 acc[2][2][4][2];
#pragma unroll
    for (int a = 0; a < 2; ++a)
#pragma unroll
        for (int b = 0; b < 2; ++b)
#pragma unroll
            for (int m = 0; m < 4; ++m)
#pragma unroll
                for (int n = 0; n < 2; ++n) acc[a][b][m][n] = (f32x4){0.f, 0.f, 0.f, 0.f};
    bf16x8 At[4][2], B0[2][2], B1[2][2];
    const char* cA = g.A + (size_t)cur.pm * (BM * GEO::LDA) + (size_t)((cur.pn >> GEO::ASHIFT) * GEO::ASTEP);
    const char* cB = g.Bt + (size_t)cur.pn * (BM * GEO::LDB);
    PG8_STAGE(PG8_SB(0, 0), cB, voffB); PG8_STAGE(PG8_SB(0, 1), cB + hstepB, voffB); PG8_STAGE(PG8_SA(0, 0), cA, voffA); PG8_STAGE(PG8_SA(0, 1), cA + hstepA, voffA);
    if (wr == 1) PG8_BAR;
    PG8_WAIT_V(2); PG8_BAR;
    PG8_STAGE(PG8_SB(1, 0), cB + kstep, voffB); PG8_STAGE(PG8_SA(1, 0), cA + kstep, voffA); PG8_STAGE(PG8_SB(1, 1), cB + hstepB + kstep, voffB);
    PG8_WAIT_V(6); PG8_BAR;
    for (;;) {
        const bool has_next = S.next(ui + 1, nxt);
        const char* nA = has_next ? g.A + (size_t)nxt.pm * (BM * GEO::LDA) + (size_t)((nxt.pn >> GEO::ASHIFT) * GEO::ASTEP) : cA;
        const char* nB = has_next ? g.Bt + (size_t)nxt.pn * (BM * GEO::LDB) : cB;
#pragma unroll 1
        for (int t = 0; t < nt; t += 2) {
            const bool last = (t == nt - 2);
            const char* a1 = cA + (size_t)(t + 1) * kstep;
            const char* a2 = last ? nA : cA + (size_t)(t + 2) * kstep; const char* b2 = last ? nB : cB + (size_t)(t + 2) * kstep;
            const char* a3 = a2 + kstep; const char* b3 = b2 + kstep;
            if constexpr (Epi::HOOK) { if (t != 0 && (t & 31) == 0) E.hook(acc, cur, (t >> 5) - 1, wr, wc, fr, fq); }
            PG8_LDB(B0, 0, 0); PG8_LDB(B1, 0, 1); PG8_SCHED; PG8_LDA(At, 0, 0); PG8_STAGE(PG8_SA(1, 1), a1 + hstepA, voffA);
            PG8_WAIT_V(8); PG8_WAIT_L(0); PG8_BAR; PG8_MMA(0, 0, At, B0); PG8_MMA(0, 1, At, B1); PG8_BAR; PG8_SCHED;
            PG8_LDA(At, 0, 1); PG8_STAGE(PG8_SB(0, 0), b2, voffB); PG8_STAGE(PG8_SB(0, 1), b2 + hstepB, voffB); PG8_STAGE(PG8_SA(0, 0), a2, voffA);
            PG8_WAIT_V(8); PG8_WAIT_L(0); PG8_BAR; PG8_MMA(1, 0, At, B0); PG8_MMA(1, 1, At, B1); PG8_BAR; PG8_SCHED;
            PG8_LDB(B0, 1, 0); PG8_LDB(B1, 1, 1); PG8_SCHED; PG8_LDA(At, 1, 0); PG8_STAGE(PG8_SA(0, 1), a2 + hstepA, voffA);
            PG8_WAIT_V(8); PG8_WAIT_L(0); PG8_BAR; PG8_MMA(0, 0, At, B0); PG8_MMA(0, 1, At, B1); PG8_BAR; PG8_SCHED;
            PG8_LDA(At, 1, 1); PG8_STAGE(PG8_SB(1, 0), b3, voffB); PG8_STAGE(PG8_SB(1, 1), b3 + hstepB, voffB); PG8_STAGE(PG8_SA(1, 0), a3, voffA);
            PG8_WAIT_V(8); PG8_WAIT_L(0); PG8_BAR; PG8_MMA(1, 0, At, B0); PG8_MMA(1, 1, At, B1); PG8_BAR; PG8_SCHED;
        }
        if (wr == 0) PG8_BAR;
        E(acc, cur, wr, wc, fr, fq);
        if (!has_next) break;
#pragma unroll
        for (int a = 0; a < 2; ++a)
#pragma unroll
            for (int b = 0; b < 2; ++b)
#pragma unroll
                for (int m = 0; m < 4; ++m)
#pragma unroll
                    for (int n = 0; n < 2; ++n) acc[a][b][m][n] = (f32x4){0.f, 0.f, 0.f, 0.f};
        cur = nxt; cA = nA; cB = nB; ++ui;
        if (wr == 1) PG8_BAR;
    }
    PG8_WAIT_V(0);
    PG8_BAR;
#undef PG8_SA
#undef PG8_SB
#undef PG8_STAGE
#undef PG8_LDA
#undef PG8_LDB
#undef PG8_MMA
#undef PG8_WAIT_V
#undef PG8_WAIT_L
#undef PG8_BAR
#undef PG8_SCHED
}
}

struct Ctx { const float* in[34]; float* out; unsigned char* ws; };
enum { I_X = 0, I_MEM, I_NORM_G, I_MEMNORM_G, I_WIN, I_LRU_CW, I_LRU_CB, I_LRU_WA, I_LRU_BA, I_LRU_WX, I_LRU_BX, I_LRU_LAM, I_MU, I_W0, I_WUP, I_A0, I_AUP,
       I_KK, I_KA, I_RK, I_GNW, I_GNB, I_MCW, I_MCB, I_MBI, I_MBF, I_MGNW, I_WKV, I_WBA, I_WBB, I_WBC, I_WBX, I_WOUT, I_FNG };


typedef const __attribute__((address_space(4))) char* kargp_t;
template <int OFF> __device__ __forceinline__ unsigned long long karg_u64() {
    kargp_t kp = (kargp_t)__builtin_amdgcn_kernarg_segment_ptr(); unsigned long long v;
    asm volatile("s_load_dwordx2 %0, %1, %2\n\ts_waitcnt lgkmcnt(0)" : "=s"(v) : "s"(kp), "i"(OFF)); return v; }
#define KIN(i) ((const float*)(const GAS float*)karg_u64<(i) * 8>())
#define KOUT() ((float*)(GAS float*)karg_u64<34 * 8>())
#define KWS() ((unsigned char*)(GAS unsigned char*)karg_u64<35 * 8>())

template <int ldc, bool HAS_IF> struct EpiProj {
    static constexpr bool PERM = true, HOOK = false;
    bf16* O; float* ifb;
    __device__ __forceinline__ void operator()(const f32x4 (&acc)[2][2][4][2], const pg8::Unit& u, int wr, int wc, int fr, int fq) const {
        const int row0 = u.pm * 256 + wr * 64 + fr, col0 = u.pn * 256 + wc * 32 + 8 * fq;
#pragma unroll
        for (int ai = 0; ai < 2; ++ai)
#pragma unroll
            for (int m = 0; m < 4; ++m) { const int row = row0 + ai * 128 + m * 16; bf16* rowp = O + (size_t)row * ldc + col0;
#pragma unroll
                for (int bj = 0; bj < 2; ++bj) { const f32x4 v0 = acc[ai][bj][m][0], v1 = acc[ai][bj][m][1];
                    u32x4 w; w.x = cvt_pk_bf16(v0[0], v0[1]); w.y = cvt_pk_bf16(v0[2], v0[3]); w.z = cvt_pk_bf16(v1[0], v1[1]); w.w = cvt_pk_bf16(v1[2], v1[3]);
                    *(u32x4*)(rowp + bj * 128) = w; }
                if (HAS_IF && u.pn == PN_IF && wc == 0 && fq == 0) { *(f32x4*)(ifb + (size_t)row * 8) = acc[ai][0][m][0]; *(f32x4*)(ifb + (size_t)row * 8 + 4) = acc[ai][0][m][1]; }
            }
    }
};
__device__ __forceinline__ void gl2n_issue(u32x4& a0, u32x4& a1, const void* pa, unsigned voff) {
    asm volatile("s_nop 4\n\tglobal_load_dwordx4 %0, %2, %3\n\tglobal_load_dwordx4 %1, %2, %3 offset:16" : "=&v"(a0), "=&v"(a1) : "v"(voff), "s"(pa) : "memory"); }
#define GL_WAIT4(g) asm volatile("s_waitcnt vmcnt(0)" : "+v"(g[0]), "+v"(g[1]), "+v"(g[2]), "+v"(g[3]) :: "memory")
struct EpiGate8 {
    static constexpr bool PERM = true, HOOK = false;
    bf16* O; const float* hs; const unsigned* cmax;
    __device__ __forceinline__ void operator()(const f32x4 (&acc)[2][2][4][2], const pg8::Unit& u, int wr, int wc, int fr, int fq) const {
        const int row0 = u.pm * 256 + wr * 64 + fr, col0 = u.pn * 256 + wc * 32 + 8 * fq;
        u32x4 cs[4]; const unsigned coff = (unsigned)((wc * 32 + 8 * fq) * 4);
        gl2n_issue(cs[0], cs[1], cmax + u.pn * 256, coff); gl2n_issue(cs[2], cs[3], cmax + u.pn * 256 + 128, coff);
        float rsv[8]; { const float* hb = hs + u.pm * 256 + wr * 64; const unsigned roff = (unsigned)(fr * 4);
            asm volatile("s_nop 4\n\tglobal_load_dword %0, %8, %9\n\tglobal_load_dword %1, %8, %9 offset:64\n\tglobal_load_dword %2, %8, %9 offset:128\n\tglobal_load_dword %3, %8, %9 offset:192\n\t"
                         "global_load_dword %4, %8, %9 offset:512\n\tglobal_load_dword %5, %8, %9 offset:576\n\tglobal_load_dword %6, %8, %9 offset:640\n\tglobal_load_dword %7, %8, %9 offset:704\n\ts_waitcnt vmcnt(0)"
                         : "=&v"(rsv[0]), "=&v"(rsv[1]), "=&v"(rsv[2]), "=&v"(rsv[3]), "=&v"(rsv[4]), "=&v"(rsv[5]), "=&v"(rsv[6]), "=&v"(rsv[7]) : "v"(roff), "s"(hb) : "memory"); }
        GL_WAIT4(cs);
        float wsc[2][8];
#pragma unroll
        for (int bj = 0; bj < 2; ++bj)
#pragma unroll
            for (int j = 0; j < 8; ++j) wsc[bj][j] = __uint_as_float(cs[2 * bj + (j >> 2)][j & 3]) * (1.0f / 127.0f);
#pragma unroll
        for (int ai = 0; ai < 2; ++ai)
#pragma unroll
            for (int m = 0; m < 4; ++m) { const int row = row0 + ai * 128 + m * 16; const float rs = rsv[ai * 4 + m]; bf16* rowp = O + (size_t)row * NPJ + col0;
#pragma unroll
                for (int bj = 0; bj < 2; ++bj) { const i32x4 v0 = __builtin_bit_cast(i32x4, acc[ai][bj][m][0]), v1 = __builtin_bit_cast(i32x4, acc[ai][bj][m][1]);
                    u32x4 w; w.x = cvt_pk_bf16((float)v0[0] * (rs * wsc[bj][0]), (float)v0[1] * (rs * wsc[bj][1])); w.y = cvt_pk_bf16((float)v0[2] * (rs * wsc[bj][2]), (float)v0[3] * (rs * wsc[bj][3]));
                    w.z = cvt_pk_bf16((float)v1[0] * (rs * wsc[bj][4]), (float)v1[1] * (rs * wsc[bj][5])); w.w = cvt_pk_bf16((float)v1[2] * (rs * wsc[bj][6]), (float)v1[3] * (rs * wsc[bj][7]));
                    *(u32x4*)(rowp + bj * 128) = w; } }
    }
};
struct EpiLru {
    static constexpr bool PERM = true, HOOK = false;
    const bf16* U; float* LA; float* LB; const float* ba; const float* bx; const float* lam;
    __device__ __forceinline__ void operator()(const f32x4 (&acc)[2][2][4][2], const pg8::Unit& u, int wr, int wc, int fr, int fq) const {
        const int row0 = u.pm * 256 + wr * 64 + fr, ch0 = u.pn * 128 + wc * 32 + 8 * fq;
        float cba[8], cbx[8], csp[8];
#pragma unroll
        for (int j = 0; j < 8; ++j) { cba[j] = ba[ch0 + j]; cbx[j] = bx[ch0 + j]; csp[j] = -8.0f * softplusf_(-lam[ch0 + j]); }
        u32x4 uws[8];
#pragma unroll
        for (int i = 0; i < 8; ++i) uws[i] = *(const u32x4*)(U + (size_t)(row0 + (i >> 2) * 128 + (i & 3) * 16) * 2048 + ch0);
        asm volatile("" ::: "memory");
#pragma unroll
        for (int ai = 0; ai < 2; ++ai)
#pragma unroll
            for (int m = 0; m < 4; ++m) { const int row = row0 + ai * 128 + m * 16;
                float uf[8]; unpack8(uws[ai * 4 + m], uf);
                float a8[8], b8[8];
#pragma unroll
                for (int n = 0; n < 2; ++n)
#pragma unroll
                    for (int j = 0; j < 4; ++j) { const int q = 4 * n + j;
                        const float r = sigm(acc[ai][0][m][n][j] + cba[q]), ig = sigm(acc[ai][1][m][n][j] + cbx[q]);
                        const float la = csp[q] * r; a8[q] = __expf(la); b8[q] = sqrtf(-expm1s_(2.0f * la)) * (ig * uf[q]); }
                float* pa = LA + (size_t)row * 2048 + ch0; float* pb = LB + (size_t)row * 2048 + ch0;
                *(f32x4*)pa = (f32x4){a8[0], a8[1], a8[2], a8[3]}; *(f32x4*)(pa + 4) = (f32x4){a8[4], a8[5], a8[6], a8[7]};
                *(f32x4*)pb = (f32x4){b8[0], b8[1], b8[2], b8[3]}; *(f32x4*)(pb + 4) = (f32x4){b8[4], b8[5], b8[6], b8[7]};
            }
    }
};
struct EpiLora {
    static constexpr bool PERM = true, HOOK = false;
    float* WDEC; float* AA; const float* w0; const float* a0;
    __device__ __forceinline__ void operator()(const f32x4 (&acc)[2][2][4][2], const pg8::Unit& u, int wr, int wc, int fr, int fq) const {
        const int row0 = u.pm * 256 + wr * 64 + fr, ch0 = u.pn * 128 + wc * 32 + 8 * fq;
        float cw0[8], ca0[8];
#pragma unroll
        for (int j = 0; j < 8; ++j) { cw0[j] = w0[ch0 + j]; ca0[j] = a0[ch0 + j]; }
#pragma unroll
        for (int ai = 0; ai < 2; ++ai)
#pragma unroll
            for (int m = 0; m < 4; ++m) { const int row = row0 + ai * 128 + m * 16; float d8[8], a8[8];
#pragma unroll
                for (int n = 0; n < 2; ++n)
#pragma unroll
                    for (int j = 0; j < 4; ++j) { const int q = 4 * n + j;
                        const float wl = -softplusf_(-(cw0[q] + acc[ai][0][m][n][j])) - 0.5f; d8[q] = __expf(-__expf(wl)); a8[q] = sigm(ca0[q] + acc[ai][1][m][n][j]); }
                float* pd = WDEC + ((((size_t)((row >> 12) * 32 + (ch0 >> 6)) * SEQ + (row & (SEQ - 1))) * 5 + 1) * 64 + (ch0 & 63)); float* pa = AA + (size_t)row * 2048 + ch0;
                *(f32x4*)pd = (f32x4){d8[0], d8[1], d8[2], d8[3]}; *(f32x4*)(pd + 4) = (f32x4){d8[4], d8[5], d8[6], d8[7]};
                *(f32x4*)pa = (f32x4){a8[0], a8[1], a8[2], a8[3]}; *(f32x4*)(pa + 4) = (f32x4){a8[4], a8[5], a8[6], a8[7]};
            }
    }
};
__device__ __forceinline__ void gl2_issue(u32x4& a0, u32x4& a1, const void* pa, unsigned voff) {
    asm volatile("s_nop 4\n\tglobal_load_dwordx4 %0, %2, %3\n\tglobal_load_dwordx4 %1, %2, %3 offset:256" : "=&v"(a0), "=&v"(a1) : "v"(voff), "s"(pa) : "memory"); }
__device__ __forceinline__ void gl4f_issue(u32x4& a0, u32x4& a1, u32x4& a2, u32x4& a3, const void* pa, unsigned voff) {
    asm volatile("s_nop 4\n\tglobal_load_dwordx4 %0, %4, %5\n\tglobal_load_dwordx4 %1, %4, %5 offset:64\n\tglobal_load_dwordx4 %2, %4, %5 offset:512\n\tglobal_load_dwordx4 %3, %4, %5 offset:576"
                 : "=&v"(a0), "=&v"(a1), "=&v"(a2), "=&v"(a3) : "v"(voff), "s"(pa) : "memory"); }
#define GL_WAIT8(g) asm volatile("s_waitcnt vmcnt(0)" : "+v"(g[0]), "+v"(g[1]), "+v"(g[2]), "+v"(g[3]), "+v"(g[4]), "+v"(g[5]), "+v"(g[6]), "+v"(g[7]) :: "memory")
#define GL_WAIT16(g) asm volatile("s_waitcnt vmcnt(0)" : "+v"(g[0]), "+v"(g[1]), "+v"(g[2]), "+v"(g[3]), "+v"(g[4]), "+v"(g[5]), "+v"(g[6]), "+v"(g[7]), \
                                  "+v"(g[8]), "+v"(g[9]), "+v"(g[10]), "+v"(g[11]), "+v"(g[12]), "+v"(g[13]), "+v"(g[14]), "+v"(g[15]) :: "memory")
struct EpiMerge {
    static constexpr bool PERM = true, HOOK = true;
    const bf16* GL; bf16* O; static constexpr int ldg = NPJ;
    __device__ __forceinline__ void hook(f32x4 (&acc)[2][2][4][2], const pg8::Unit& u, int br, int wr, int wc, int fr, int fq) const {
        const unsigned voff = (unsigned)(fr * (ldg * 2) + (wc * 32 + 8 * fq) * 2);
        const char* base = (const char*)GL + ((size_t)(u.pm * 256 + wr * 64) * ldg + br * 4096 + u.pn * 256) * 2;
#pragma unroll
        for (int ai = 0; ai < 2; ++ai) { u32x4 g[16];
#pragma unroll
            for (int m = 0; m < 4; ++m) { const char* pm_ = base + (size_t)(ai * 128 + m * 16) * (ldg * 2); gl2_issue(g[4 * m], g[4 * m + 1], pm_, voff); gl2_issue(g[4 * m + 2], g[4 * m + 3], pm_ + 8192, voff); }
            GL_WAIT16(g);
#pragma unroll
            for (int m = 0; m < 4; ++m)
#pragma unroll
                for (int bj = 0; bj < 2; ++bj) { float f0[8], f1[8]; unpack8(g[4 * m + bj], f0); unpack8(g[4 * m + 2 + bj], f1);
#pragma unroll
                    for (int n = 0; n < 2; ++n)
#pragma unroll
                        for (int j = 0; j < 4; ++j) { const int q = 4 * n + j; acc[ai][bj][m][n][j] *= (1.0f + __expf(-f1[q])) * __builtin_amdgcn_rcpf(1.0f + __expf(-f0[q])); } } }
    }
    __device__ __forceinline__ void operator()(const f32x4 (&acc)[2][2][4][2], const pg8::Unit& u, int wr, int wc, int fr, int fq) const {
        const int row0 = u.pm * 256 + wr * 64 + fr, col0 = u.pn * 256 + wc * 32 + 8 * fq;
        const unsigned voff = (unsigned)(fr * (ldg * 2) + (wc * 32 + 8 * fq) * 2);
        const char* base = (const char*)GL + ((size_t)(u.pm * 256 + wr * 64) * ldg + 3 * 4096 + u.pn * 256) * 2;
#pragma unroll
        for (int ai = 0; ai < 2; ++ai) { u32x4 g[8];
#pragma unroll
            for (int m = 0; m < 4; ++m) gl2_issue(g[2 * m], g[2 * m + 1], base + (size_t)(ai * 128 + m * 16) * (ldg * 2), voff);
            GL_WAIT8(g);
#pragma unroll
            for (int m = 0; m < 4; ++m) { const int row = row0 + ai * 128 + m * 16;
#pragma unroll
                for (int bj = 0; bj < 2; ++bj) { float f[8]; unpack8(g[2 * m + bj], f);
                    const f32x4 v0 = acc[ai][bj][m][0], v1 = acc[ai][bj][m][1];
                    u32x4 w; w.x = cvt_pk_bf16(v0[0] * sigm(f[0]), v0[1] * sigm(f[1])); w.y = cvt_pk_bf16(v0[2] * sigm(f[2]), v0[3] * sigm(f[3]));
                    w.z = cvt_pk_bf16(v1[0] * sigm(f[4]), v1[1] * sigm(f[5])); w.w = cvt_pk_bf16(v1[2] * sigm(f[6]), v1[3] * sigm(f[7]));
                    *(u32x4*)(O + (size_t)row * 4096 + col0 + bj * 128) = w; } } }
    }
};
struct EpiOut {
    static constexpr bool PERM = false, HOOK = false;
    const float* XI; float* XO;
    __device__ __forceinline__ void operator()(const f32x4 (&acc)[2][2][4][2], const pg8::Unit& u, int wr, int wc, int fr, int fq) const {
        const int row0 = u.pm * 256 + wr * 64 + fr, col0 = u.pn * 256 + wc * 32 + 4 * fq;
        const unsigned voff = (unsigned)(fr * 16384 + (wc * 32 + 4 * fq) * 4);
        const char* base = (const char*)XI + ((size_t)(u.pm * 256 + wr * 64) * 4096 + u.pn * 256) * 4;
#pragma unroll
        for (int ai = 0; ai < 2; ++ai) { u32x4 g[16];
#pragma unroll
            for (int m = 0; m < 4; ++m) gl4f_issue(g[4 * m], g[4 * m + 1], g[4 * m + 2], g[4 * m + 3], base + (size_t)(ai * 128 + m * 16) * 16384, voff);
            GL_WAIT16(g);
#pragma unroll
            for (int m = 0; m < 4; ++m) { const size_t off = (size_t)(row0 + ai * 128 + m * 16) * 4096 + col0;
#pragma unroll
                for (int bj = 0; bj < 2; ++bj)
#pragma unroll
                    for (int n = 0; n < 2; ++n) { const f32x4 xi = __builtin_bit_cast(f32x4, g[4 * m + 2 * bj + n]); *(f32x4*)(XO + off + bj * 128 + n * 16) = xi + acc[ai][bj][m][n]; } } }
    }
};

struct Frame { LAS unsigned char* lds; int tid, lane, wave, bid, nblk; };
__device__ __forceinline__ Frame reframe(const Frame& G) { Frame F; F.lds = G.lds; F.wave = opaque_s(G.wave); F.lane = lane_id(); F.tid = F.wave * 64 + F.lane; F.bid = opaque_s(G.bid); F.nblk = opaque_s(G.nblk); return F; }

#define TR_PIN16(a, o) asm volatile("" : "+v"(a[o]), "+v"(a[o + 1]), "+v"(a[o + 2]), "+v"(a[o + 3]), "+v"(a[o + 4]), "+v"(a[o + 5]), "+v"(a[o + 6]), "+v"(a[o + 7]), "+v"(a[o + 8]), "+v"(a[o + 9]), "+v"(a[o + 10]), "+v"(a[o + 11]), "+v"(a[o + 12]), "+v"(a[o + 13]), "+v"(a[o + 14]), "+v"(a[o + 15]) :: "memory")
__device__ __forceinline__ void tr_load(float (&tv)[32], const float* W, size_t ldw, int k0, int n0, int lane) {
#pragma unroll
    for (int i = 0; i < 32; ++i) tv[i] = W[(size_t)(k0 + 2 * i + (lane >> 5)) * ldw + n0 + (lane & 31)];
}
__device__ __forceinline__ void tr_item(const float (&tv)[32], bf16* WT, size_t ldt, LAS float* scr, int k0, int n0, int lane) {
#pragma unroll
    for (int i = 0; i < 32; ++i) scr[(2 * i + (lane >> 5)) * 33 + (lane & 31)] = tv[i];
    LDS_WAIT(); asm volatile("" ::: "memory");
    const int c = lane & 7;
#pragma unroll
    for (int j = 0; j < 4; ++j) { const int n = (lane >> 3) + 8 * j; const LAS float* s = scr + (8 * c) * 33 + n;
        u32x4 o; o.x = pk2(s[0 * 33], s[1 * 33]); o.y = pk2(s[2 * 33], s[3 * 33]); o.z = pk2(s[4 * 33], s[5 * 33]); o.w = pk2(s[6 * 33], s[7 * 33]);
        *(u32x4*)(WT + (size_t)(n0 + n) * ldt + k0 + 8 * c) = o; }
    LDS_WAIT(); asm volatile("" ::: "memory");
}
__device__ __forceinline__ void tr_job(const Frame& F, const float* W, size_t ldw, int K, int ncols, bf16* WT, size_t ldt) {
    LAS float* scr = (LAS float*)(F.lds + F.wave * 16384);
    const int gw = F.bid * NWAVES + F.wave, NGW = F.nblk * NWAVES, nb = ncols / 32, items = (K / 64) * nb;
    for (int it = gw; it < items; it += 2 * NGW) { float tv[32], tn[32]; const int nx = it + NGW, nc = nx < items ? nx : it;
        tr_load(tv, W, ldw, 64 * (it / nb), 32 * (it % nb), F.lane); tr_load(tn, W, ldw, 64 * (nc / nb), 32 * (nc % nb), F.lane);
        TR_PIN16(tv, 0); TR_PIN16(tv, 16);
        tr_item(tv, WT, ldt, scr, 64 * (it / nb), 32 * (it % nb), F.lane);
        if (nx < items) tr_item(tn, WT, ldt, scr, 64 * (nx / nb), 32 * (nx % nb), F.lane); }
}
__device__ __forceinline__ void tr8_item(const float (&tv)[32], signed char* WT, const float inv, LAS float* scr, int k0, int n0, int lane) {
#pragma unroll
    for (int i = 0; i < 32; ++i) scr[(2 * i + (lane >> 5)) * 33 + (lane & 31)] = tv[i];
    LDS_WAIT(); asm volatile("" ::: "memory");
    const int n = lane >> 1, hh = lane & 1;
#pragma unroll
    for (int c = 0; c < 2; ++c) { const LAS float* sp = scr + (32 * hh + 16 * c) * 33 + n; unsigned wq[4];
#pragma unroll
        for (int q = 0; q < 4; ++q) { const int a0 = (int)rintf(sp[(4 * q) * 33] * inv), a1 = (int)rintf(sp[(4 * q + 1) * 33] * inv), a2 = (int)rintf(sp[(4 * q + 2) * 33] * inv), a3 = (int)rintf(sp[(4 * q + 3) * 33] * inv);
            wq[q] = (unsigned)(a0 & 255) | ((unsigned)(a1 & 255) << 8) | ((unsigned)(a2 & 255) << 16) | ((unsigned)(a3 & 255) << 24); }
        *(u32x4*)(WT + (size_t)(n0 + n) * 4096 + k0 + 32 * hh + 16 * c) = (u32x4){wq[0], wq[1], wq[2], wq[3]}; }
    LDS_WAIT(); asm volatile("" ::: "memory");
}
__device__ __forceinline__ void gate8_strips(const Frame& F, const float* win, signed char* WT, unsigned* cmaxl, const int first, const int stride) {
    LAS float* scr = (LAS float*)(F.lds + F.wave * 16384); LAS float* cm = (LAS float*)(F.lds + 8 * 16384);
    const int lane = F.lane, w = F.wave, c8 = lane & 7, rsub = lane >> 3;
    for (int strip = first; strip < N8 / 32; strip += stride) { const int n0 = strip * 32; const float* W = win + (n0 < 2048 ? 16576 + n0 : 21704 + (n0 - 2048));
        { const float* wp = W + (size_t)(512 * w + rsub) * CIN + 4 * c8; f32x4 m = (f32x4){0.f, 0.f, 0.f, 0.f};
          for (int i0 = 0; i0 < 64; i0 += 16) { f32x4 tv[16];
#pragma unroll
              for (int i = 0; i < 16; ++i) tv[i] = *(const f32x4*)(wp + (size_t)(8 * (i0 + i)) * CIN);
              asm volatile("" : "+v"(tv[0]), "+v"(tv[1]), "+v"(tv[2]), "+v"(tv[3]), "+v"(tv[4]), "+v"(tv[5]), "+v"(tv[6]), "+v"(tv[7]), "+v"(tv[8]), "+v"(tv[9]), "+v"(tv[10]), "+v"(tv[11]), "+v"(tv[12]), "+v"(tv[13]), "+v"(tv[14]), "+v"(tv[15]) :: "memory");
#pragma unroll
              for (int i = 0; i < 16; ++i) { m.x = fmaxf(m.x, fabsf(tv[i].x)); m.y = fmaxf(m.y, fabsf(tv[i].y)); m.z = fmaxf(m.z, fabsf(tv[i].z)); m.w = fmaxf(m.w, fabsf(tv[i].w)); } }
#pragma unroll
          for (int q = 0; q < 4; ++q) { float v = m[q]; v = fmaxf(v, __shfl_xor(v, 8)); v = fmaxf(v, __shfl_xor(v, 16)); v = fmaxf(v, __shfl_xor(v, 32)); m[q] = v; }
          __syncthreads();
          if (lane < 8) { cm[w * 32 + 4 * c8] = m.x; cm[w * 32 + 4 * c8 + 1] = m.y; cm[w * 32 + 4 * c8 + 2] = m.z; cm[w * 32 + 4 * c8 + 3] = m.w; } }
        __syncthreads();
        float am = 0.f;
#pragma unroll
        for (int w2 = 0; w2 < 8; ++w2) am = fmaxf(am, cm[w2 * 32 + (lane >> 1)]);
        if (w == 0 && (lane & 1) == 0) cmaxl[n0 + (lane >> 1)] = __float_as_uint(am);
        const float inv = am > 0.f ? 127.0f / am : 0.f;
        for (int kb = 0; kb < 8; kb += 2) { const int k0 = 512 * w + 64 * kb; float tv[32], tn[32];
            tr_load(tv, W, CIN, k0, 0, lane); tr_load(tn, W, CIN, k0 + 64, 0, lane);
            TR_PIN16(tv, 0); TR_PIN16(tv, 16);
            tr8_item(tv, WT, inv, scr, k0, n0, lane); tr8_item(tn, WT, inv, scr, k0 + 64, n0, lane); }
    }
}
__device__ __forceinline__ void rms_row_bf16(const float* x, const float* g, bf16* o, int lane, signed char* q8 = nullptr, float* qs = nullptr) {
    const f32x4* xr = (const f32x4*)x + lane; const f32x4* gr = (const f32x4*)g + lane; f32x4 v[16], gv[16]; float ss = 0.f;
#pragma unroll
    for (int j = 0; j < 16; ++j) v[j] = xr[64 * j];
#pragma unroll
    for (int j = 0; j < 16; ++j) gv[j] = gr[64 * j];
    asm volatile("" ::: "memory");
#pragma unroll
    for (int j = 0; j < 16; ++j) ss += (v[j].x * v[j].x + v[j].y * v[j].y) + (v[j].z * v[j].z + v[j].w * v[j].w);
    const float r = rsqrtf(wave_sum(ss) * (1.0f / 4096.0f) + 1e-6f);
    u32x2* o8 = (u32x2*)o + lane; float am = 0.f;
#pragma unroll
    for (int j = 0; j < 16; ++j) { const f32x4 gg = gv[j]; v[j] = (f32x4){v[j].x * r * gg.x, v[j].y * r * gg.y, v[j].z * r * gg.z, v[j].w * r * gg.w};
        u32x2 w; w.x = pk2(v[j].x, v[j].y); w.y = pk2(v[j].z, v[j].w); o8[64 * j] = w;
        am = fmaxf(fmaxf(am, fmaxf(fabsf(v[j].x), fabsf(v[j].y))), fmaxf(fabsf(v[j].z), fabsf(v[j].w))); }
    if (q8 != nullptr) {
        am = row16_max(am); am = fmaxf(am, __shfl_xor(am, 16)); am = fmaxf(am, __shfl_xor(am, 32));
        const float inv = am > 0.f ? 127.0f / am : 0.f; unsigned* q4 = (unsigned*)q8 + lane;
#pragma unroll
        for (int j = 0; j < 16; ++j) { const int a0 = (int)rintf(v[j].x * inv), a1 = (int)rintf(v[j].y * inv), a2 = (int)rintf(v[j].z * inv), a3 = (int)rintf(v[j].w * inv);
            q4[64 * j] = (unsigned)(a0 & 255) | ((unsigned)(a1 & 255) << 8) | ((unsigned)(a2 & 255) << 16) | ((unsigned)(a3 & 255) << 24); }
        if (lane == 0) *qs = am * (1.0f / 127.0f); }
}
__device__ __forceinline__ void rms_row_f32(const float* x, const float* g, float* o, int lane) {
    const f32x4* xr = (const f32x4*)x + lane; const f32x4* gr = (const f32x4*)g + lane; f32x4 v[16], gv[16]; float ss = 0.f;
#pragma unroll
    for (int j = 0; j < 16; ++j) v[j] = xr[64 * j];
#pragma unroll
    for (int j = 0; j < 16; ++j) gv[j] = gr[64 * j];
    asm volatile("" ::: "memory");
#pragma unroll
    for (int j = 0; j < 16; ++j) ss += (v[j].x * v[j].x + v[j].y * v[j].y) + (v[j].z * v[j].z + v[j].w * v[j].w);
    const float r = rsqrtf(wave_sum(ss) * (1.0f / 4096.0f) + 1e-6f);
    f32x4* o4 = (f32x4*)o + lane;
#pragma unroll
    for (int j = 0; j < 16; ++j) { const f32x4 gg = gv[j]; o4[64 * j] = (f32x4){v[j].x * r * gg.x, v[j].y * r * gg.y, v[j].z * r * gg.z, v[j].w * r * gg.w}; }
}

__device__ __forceinline__ void phase_convert_layer(const Frame& F0, int l, const int parts, const int vb, const int nvb) {
    Frame F = reframe(F0); F.bid = vb; F.nblk = nvb;
    unsigned char* wl = KWS() + WS_W + (size_t)l * SZ_WLAYER;
    bf16* WIN = (bf16*)(wl + WO_WIN); bf16* WCAT = (bf16*)(wl + WO_WCAT); bf16* WOUT = (bf16*)(wl + WO_WOUT); bf16* WKV = (bf16*)(wl + WO_WKV); bf16* WG = (bf16*)(wl + WO_WG); bf16* WL = (bf16*)(wl + WO_WL);
    const float* win = KIN(I_WIN) + (size_t)l * 4096 * CIN;
    if (parts & 2) {
    tr_job(F, win + 0, CIN, 4096, 4096, WIN + (size_t)0 * 4096, 4096);
    tr_job(F, win + 4096, CIN, 4096, 6144, WIN + (size_t)PC_BR * 4096, 4096);
    tr_job(F, win + 10240, CIN, 4096, 96, WIN + (size_t)PC_BWD * 4096, 4096);
    tr_job(F, win + 10336, CIN, 4096, 96, WIN + (size_t)PC_BAD * 4096, 4096);
    tr_job(F, win + 10432, CIN, 4096, 2048, WIN + (size_t)PC_BG * 4096, 4096);
    tr_job(F, win + 12480, CIN, 4096, 4096, WIN + (size_t)PC_CQK * 4096, 4096);
    tr_job(F, win + 18624, CIN, 4096, 2048, WIN + (size_t)PC_CG * 4096, 4096);
    tr_job(F, win + 20680, CIN, 4096, 1024, WIN + (size_t)PC_XQ * 4096, 4096);
    gate8_strips(F, win, (signed char*)(WIN + (size_t)PC_I8 * 4096), (unsigned*)(KWS() + WS_CTL) + CW_CMAX + l * N8, F.bid, F.nblk);
    tr_job(F, KIN(I_WBA) + (size_t)l * 2048 * 4096, 4096, 2048, 4096, WCAT + YC_A, KCAT);
    tr_job(F, KIN(I_WBB) + (size_t)l * 2048 * 4096, 4096, 2048, 4096, WCAT + YC_B, KCAT);
    tr_job(F, KIN(I_WBC) + (size_t)l * 2048 * 4096, 4096, 2048, 4096, WCAT + YC_C, KCAT);
    tr_job(F, KIN(I_WBX) + (size_t)l * 512 * 4096, 4096, 512, 4096, WCAT + YC_X, KCAT);
    tr_job(F, KIN(I_WOUT) + (size_t)l * 4096 * 4096, 4096, 4096, 4096, WOUT, 4096);
    }
    if (parts & 1) tr_job(F, KIN(I_WKV) + (size_t)l * 4096 * 1024, 1024, 4096, 1024, WKV, 4096);
    if (parts & 2) {
    const size_t gt = (size_t)F.bid * NTHREADS + F.tid, NGT = (size_t)F.nblk * NTHREADS;
    for (size_t i = gt; i < (size_t)8 * 4096; i += NGT) { const int j = (int)(i >> 12), k = (int)(i & 4095); WIN[(size_t)(PC_IF + j) * 4096 + k] = (bf16)f2bf(win[(size_t)k * CIN + 20672 + j]); }
    for (size_t i = gt; i < (size_t)(32 + 32 + 248) * 4096; i += NGT) { const int r = (int)(i >> 12), k = (int)(i & 4095);
        const int row = r < 32 ? PC_BWD + 96 + r : (r < 64 ? PC_BAD + 96 + (r - 32) : PC_IF + 8 + (r - 64)); WIN[(size_t)row * 4096 + k] = 0; }
    const float* wa = KIN(I_LRU_WA) + (size_t)l * 8 * 256 * 256; const float* wx = KIN(I_LRU_WX) + (size_t)l * 8 * 256 * 256;
    for (size_t c = gt; c < (size_t)4096 * 32; c += NGT) { const int n = (int)(c >> 5), k0 = (int)(c & 31) * 8, pn = n >> 8, dd = n & 255, nb = pn >> 1, d = (pn & 1) * 128 + (dd & 127);
        const float* sp = (dd < 128 ? wa : wx) + ((size_t)nb * 256 + k0) * 256 + d; float v[8];
#pragma unroll
        for (int q = 0; q < 8; ++q) v[q] = sp[(size_t)q * 256];
        asm volatile("" : "+v"(v[0]), "+v"(v[1]), "+v"(v[2]), "+v"(v[3]), "+v"(v[4]), "+v"(v[5]), "+v"(v[6]), "+v"(v[7]) :: "memory");
        u32x4 o; o.x = pk2(v[0], v[1]); o.y = pk2(v[2], v[3]); o.z = pk2(v[4], v[5]); o.w = pk2(v[6], v[7]); *(u32x4*)(WG + (size_t)n * 256 + k0) = o; }
    const float* wup = KIN(I_WUP) + (size_t)l * 96 * 2048; const float* aup = KIN(I_AUP) + (size_t)l * 96 * 2048;
    for (size_t c = gt; c < (size_t)4096 * 32; c += NGT) { const int n = (int)(c >> 5), k0 = (int)(c & 31) * 8, pn = n >> 8, dd = n & 255, ch = pn * 128 + (dd & 127);
        const float* sp = nullptr; if (dd < 128) { if (k0 < 96) sp = wup + (size_t)k0 * 2048 + ch; } else { if (k0 >= 128 && k0 < 224) sp = aup + (size_t)(k0 - 128) * 2048 + ch; }
        u32x4 o = (u32x4){0u, 0u, 0u, 0u};
        if (sp != nullptr) { float v[8];
#pragma unroll
            for (int q = 0; q < 8; ++q) v[q] = sp[(size_t)q * 2048];
            asm volatile("" : "+v"(v[0]), "+v"(v[1]), "+v"(v[2]), "+v"(v[3]), "+v"(v[4]), "+v"(v[5]), "+v"(v[6]), "+v"(v[7]) :: "memory");
            o.x = pk2(v[0], v[1]); o.y = pk2(v[2], v[3]); o.z = pk2(v[4], v[5]); o.w = pk2(v[6], v[7]); }
        *(u32x4*)(WL + (size_t)n * 256 + k0) = o; }
    }
    if (parts & 1) {
    const int gw = F.bid * NWAVES + F.wave, NGW = F.nblk * NWAVES;
    bf16* MEMN = (bf16*)(KWS() + WS_MEMN) + (size_t)l * MM * 4096;
    for (int r = gw; r < MM; r += NGW) rms_row_bf16(KIN(I_MEM) + (size_t)r * 4096, KIN(I_MEMNORM_G) + (size_t)l * 4096, MEMN + (size_t)r * 4096, F.lane);
    }
}
__device__ __forceinline__ void phase_norm(const Frame& F0, const float* X, const float* g, bool final_out) {
    const Frame F = reframe(F0);
    const int gw = F.bid * NWAVES + F.wave, NGW = F.nblk * NWAVES;
    bf16* H = (bf16*)(KWS() + WS_H);
    for (int r = gw; r < M; r += NGW) { if (final_out) rms_row_f32(X + (size_t)r * 4096, g, KOUT() + (size_t)r * 4096, F.lane); else rms_row_bf16(X + (size_t)r * 4096, g, H + (size_t)r * 4096, F.lane, (signed char*)(KWS() + WS_H8) + (size_t)r * 4096, (float*)(KWS() + WS_HS) + r); }
}

__device__ __forceinline__ float logsigf_(float x) { return fminf(x, 0.f) - log1pf(__expf(-fabsf(x))); }
__device__ __forceinline__ void phase_prep(const Frame& F0, int l) {
    const Frame F = reframe(F0);
    const bf16* __restrict__ PROJ = (const bf16*)(KWS() + WS_PROJ);
    const size_t gt = (size_t)F.bid * NTHREADS + F.tid, NGT = (size_t)F.nblk * NTHREADS;
    bf16* __restrict__ U = (bf16*)(KWS() + WS_U); bf16* __restrict__ QC = (bf16*)(KWS() + WS_QC); bf16* __restrict__ KC = (bf16*)(KWS() + WS_KC);
    for (size_t id = gt; id < (size_t)2 * 256 * (M / 32); id += NGT) {
        const int which = (int)(id / ((size_t)256 * (M / 32))), rem = (int)(id % ((size_t)256 * (M / 32))), c8 = (rem & 255) * 8, t0 = (rem >> 8) * 32, ts0 = t0 & (SEQ - 1);
        const float* cw = (which == 0 ? KIN(I_LRU_CW) : KIN(I_MCW)) + (size_t)l * 4 * 2048 + c8; const float* cb = (which == 0 ? KIN(I_LRU_CB) : KIN(I_MCB)) + (size_t)l * 2048 + c8;
        const bf16* src = PROJ + (size_t)t0 * NPJ + (which == 0 ? PC_AX : PC_CQK) + c8;
        f32x4 wv[4][2];
#pragma unroll
        for (int j = 0; j < 4; ++j) { wv[j][0] = *(const f32x4*)(cw + j * 2048); wv[j][1] = *(const f32x4*)(cw + j * 2048 + 4); }
        const f32x4 b0 = *(const f32x4*)cb, b1 = *(const f32x4*)(cb + 4);
        u32x4 hw[3];
#pragma unroll
        for (int j = 0; j < 3; ++j) hw[j] = ts0 > 0 ? *(const u32x4*)(src - (size_t)(3 - j) * NPJ) : (u32x4){0u, 0u, 0u, 0u};
        float w0[8], w1[8], w2[8]; unpack8(hw[0], w0); unpack8(hw[1], w1); unpack8(hw[2], w2);
        const float sc = c8 < 1024 ? 1.0f : 0.0625f;
        for (int g = 0; g < 32; g += 8) { u32x4 x[8];
#pragma unroll
            for (int u = 0; u < 8; ++u) x[u] = *(const u32x4*)(src + (size_t)(g + u) * NPJ);
#pragma unroll
            for (int u = 0; u < 8; ++u) { float w3[8], a[8]; unpack8(x[u], w3);
#pragma unroll
                for (int q = 0; q < 8; ++q) a[q] = (q < 4 ? b0[q] : b1[q - 4]) + wv[0][q >> 2][q & 3] * w0[q] + wv[1][q >> 2][q & 3] * w1[q] + wv[2][q >> 2][q & 3] * w2[q] + wv[3][q >> 2][q & 3] * w3[q];
#pragma unroll
                for (int q = 0; q < 8; ++q) { w0[q] = w1[q]; w1[q] = w2[q]; w2[q] = w3[q]; }
                const size_t t = (size_t)t0 + g + u;
                if (which == 0) { u32x4 o; o.x = pk2(a[0], a[1]); o.y = pk2(a[2], a[3]); o.z = pk2(a[4], a[5]); o.w = pk2(a[6], a[7]); *(u32x4*)(U + t * 2048 + c8) = o; }
                else {
#pragma unroll
                    for (int q = 0; q < 8; ++q) a[q] = siluf_(a[q]) * sc;
                    u32x4 o; o.x = pk2(a[0], a[1]); o.y = pk2(a[2], a[3]); o.z = pk2(a[4], a[5]); o.w = pk2(a[6], a[7]);
                    if (c8 < 1024) *(u32x4*)(QC + t * 1024 + c8) = o; else *(u32x4*)(KC + t * 1024 + (c8 - 1024)) = o; } } }
    }
    bf16* LORA = (bf16*)(KWS() + WS_LORA); const float* mu = KIN(I_MU) + (size_t)l * 6336;
    for (size_t i = gt; i < (size_t)M * 32; i += NGT) { const int t = (int)(i >> 5), c8 = (int)(i & 31) * 8, ts = t & (SEQ - 1), seg = c8 >> 7, i0 = c8 & 127;
        u32x4 o = (u32x4){0u, 0u, 0u, 0u};
        if (i0 < 96) { const int pc = (seg == 0 ? PC_BWD : PC_BAD) + i0; const float* m8 = mu + 6144 + seg * 96 + i0;
            const u32x4 w = *(const u32x4*)(PROJ + (size_t)t * NPJ + pc); const u32x4 w2 = *(const u32x4*)(PROJ + (size_t)(ts > 0 ? t - 1 : t) * NPJ + pc);
            const f32x4 ma = *(const f32x4*)m8, mb = *(const f32x4*)(m8 + 4);
            float p[8], pv[8]; unpack8(w, p); unpack8(w2, pv);
            if (ts == 0) {
#pragma unroll
                for (int q = 0; q < 8; ++q) pv[q] = 0.f; }
            float r[8];
#pragma unroll
            for (int q = 0; q < 8; ++q) { const float s = p[q] + (pv[q] - p[q]) * (q < 4 ? ma[q] : mb[q - 4]); r[q] = seg == 0 ? tanhf(s) : s; }
            o.x = pk2(r[0], r[1]); o.y = pk2(r[2], r[3]); o.z = pk2(r[4], r[5]); o.w = pk2(r[6], r[7]); }
        *(u32x4*)(LORA + (size_t)t * 256 + c8) = o; }
    if (F.bid < 8) {
        const float* IFB = (const float*)(KWS() + WS_IFB); float* G = (float*)(KWS() + WS_SCAL); float* MX = G + (size_t)M * 4; float* MT = MX + (size_t)M * 4;
        const int b = F.bid >> 2, hd = F.bid & 3, lane = F.lane; const float bi = KIN(I_MBI)[l * 4 + hd], bfv = KIN(I_MBF)[l * 4 + hd];
        const size_t tok0 = (size_t)b * SEQ + (size_t)F.tid * 8; LAS float* sc = (LAS float*)F.lds;
        float lf[8], li[8];
#pragma unroll
        for (int j = 0; j < 8; ++j) { lf[j] = IFB[(tok0 + j) * 8 + 4 + hd]; li[j] = IFB[(tok0 + j) * 8 + hd]; }
        asm volatile("" ::: "memory");
#pragma unroll
        for (int j = 0; j < 8; ++j) { lf[j] = logsigf_(lf[j] + bfv); li[j] += bi; }
#pragma unroll
        for (int j = 1; j < 8; ++j) lf[j] += lf[j - 1];
        float incl = lf[7];
#pragma unroll
        for (int o = 1; o < 64; o <<= 1) { const float t = __shfl_up(incl, o); if (lane >= o) incl += t; }
        if (lane == 63) sc[F.wave] = incl;
        __syncthreads();
        float woff = 0.f;
        for (int w2 = 0; w2 < F.wave; ++w2) woff += sc[w2];
        const float excl = woff + incl - lf[7];
        float mx[8]; float run = -INFINITY;
#pragma unroll
        for (int j = 0; j < 8; ++j) { lf[j] += excl; li[j] -= lf[j]; run = fmaxf(run, li[j]); mx[j] = run; }
        float im = run;
#pragma unroll
        for (int o = 1; o < 64; o <<= 1) { const float t = __shfl_up(im, o); if (lane >= o) im = fmaxf(im, t); }
        if (lane == 63) sc[16 + F.wave] = im;
        float pm = __shfl_up(im, 1); if (lane == 0) pm = -INFINITY;
        __syncthreads();
        for (int w2 = 0; w2 < F.wave; ++w2) pm = fmaxf(pm, sc[16 + w2]);
#pragma unroll
        for (int j = 0; j < 8; ++j) { const float m = fmaxf(pm, mx[j]); G[(tok0 + j) * 4 + hd] = li[j]; MX[(tok0 + j) * 4 + hd] = m; MT[(tok0 + j) * 4 + hd] = lf[j] + m; }
        __syncthreads();
    }
}

__device__ __forceinline__ f32x4 ld_bf4(const bf16* p) { const u32x2 w = *(const u32x2*)p; return (f32x4){__uint_as_float(w.x << 16), __uint_as_float(w.x & 0xffff0000u), __uint_as_float(w.y << 16), __uint_as_float(w.y & 0xffff0000u)}; }
__device__ __forceinline__ f32x4 bf4_unpack(const u32x2 w) { return (f32x4){__uint_as_float(w.x << 16), __uint_as_float(w.x & 0xffff0000u), __uint_as_float(w.y << 16), __uint_as_float(w.y & 0xffff0000u)}; }
struct VecIn { u32x2 r, k, v, r1, k1, v1; f32x4 a; };
__device__ __forceinline__ void phase_rwkv_vec(const Frame& F0, int l) {
    const Frame F = reframe(F0);
    const bf16* __restrict__ PROJ = (const bf16*)(KWS() + WS_PROJ); const float* __restrict__ AA = (const float*)(KWS() + WS_AA);
    float* __restrict__ RV = (float*)(KWS() + WS_RV); float* __restrict__ VV = (float*)(KWS() + WS_VV); float* __restrict__ BON = (float*)(KWS() + WS_BON);
    const float* mu = KIN(I_MU) + (size_t)l * 6336; const float* kkw = KIN(I_KK) + (size_t)l * 2048; const float* kaw = KIN(I_KA) + (size_t)l * 2048; const float* rkw = KIN(I_RK) + (size_t)l * 2048;
    const int gw = F.bid * NWAVES + F.wave, NGW = F.nblk * NWAVES, lane = F.lane;
    const int hq = gw & 7, ch = hq * 256 + lane * 4, h = hq * 4 + (lane >> 4);
    const f32x4 mr = *(const f32x4*)(mu + ch), mk = *(const f32x4*)(mu + 2048 + ch), mv = *(const f32x4*)(mu + 4096 + ch), ckk = *(const f32x4*)(kkw + ch), cka = *(const f32x4*)(kaw + ch), crk = *(const f32x4*)(rkw + ch);
    auto vload = [&](const int it, VecIn& x) { const int t = it >> 3, ts = t & (SEQ - 1);
        const bf16* pr = PROJ + (size_t)t * NPJ + ch; const bf16* pp = ts > 0 ? pr - NPJ : pr;
        x.r = *(const u32x2*)(pr + PC_BR); x.k = *(const u32x2*)(pr + PC_BK); x.v = *(const u32x2*)(pr + PC_BV);
        x.r1 = *(const u32x2*)(pp + PC_BR); x.k1 = *(const u32x2*)(pp + PC_BK); x.v1 = *(const u32x2*)(pp + PC_BV);
        x.a = *(const f32x4*)(AA + (size_t)t * 2048 + ch); };
    auto vcomp = [&](const int it, const VecIn& x) { const int t = it >> 3, ts = t & (SEQ - 1), b = t >> 12;
        f32x4 r = bf4_unpack(x.r), k = bf4_unpack(x.k), v = bf4_unpack(x.v);
        const f32x4 z = (f32x4){0.f, 0.f, 0.f, 0.f}; const f32x4 r1 = ts > 0 ? bf4_unpack(x.r1) : z, k1 = ts > 0 ? bf4_unpack(x.k1) : z, v1 = ts > 0 ? bf4_unpack(x.v1) : z;
        r += (r1 - r) * mr; k += (k1 - k) * mk; v += (v1 - v) * mv;
        const f32x4 a = x.a;
        const f32x4 kku = k * ckk;
        const float n2 = row16_sum((kku.x * kku.x + kku.y * kku.y) + (kku.z * kku.z + kku.w * kku.w));
        const float inv = __builtin_amdgcn_rcpf(fmaxf(sqrtf(n2), 1e-12f)); const f32x4 kk = kku * inv;
        const f32x4 kmod = k * ((a - 1.0f) * cka + 1.0f);
        const f32x4 rkk = r * kmod * crk;
        const float bon = row16_sum((rkk.x + rkk.y) + (rkk.z + rkk.w));
        float* rv = RV + (((size_t)(b * 32 + h) * SEQ + ts) * 5) * 64 + (lane & 15) * 4;
        *(f32x4*)rv = kk; *(f32x4*)(rv + 128) = -(kk * a); *(f32x4*)(rv + 192) = kmod; *(f32x4*)(rv + 256) = r;
        *(f32x4*)(VV + (size_t)t * 2048 + ch) = v; if ((lane & 15) == 0) BON[(size_t)t * 32 + h] = bon; };
    int it = gw;
    for (; it + 3 * NGW < M * 8; it += 4 * NGW) { VecIn x0, x1, x2, x3; vload(it, x0); vload(it + NGW, x1); vload(it + 2 * NGW, x2); vload(it + 3 * NGW, x3);
        vcomp(it, x0); vcomp(it + NGW, x1); vcomp(it + 2 * NGW, x2); vcomp(it + 3 * NGW, x3); }
    for (; it < M * 8; it += NGW) { VecIn x0; vload(it, x0); vcomp(it, x0); }
}

#define SC_PIN(a) asm volatile("" : "+v"(a[0]), "+v"(a[1]), "+v"(a[2]), "+v"(a[3]), "+v"(a[4]), "+v"(a[5]), "+v"(a[6]), "+v"(a[7]), "+v"(a[8]), "+v"(a[9]), "+v"(a[10]), "+v"(a[11]), "+v"(a[12]), "+v"(a[13]), "+v"(a[14]), "+v"(a[15]) :: "memory")
__device__ __forceinline__ void phase_lru_scan1(const Frame& F0) {
    const Frame F = reframe(F0);
    const float* LA = (const float*)(KWS() + WS_LA); const float* LB = (const float*)(KWS() + WS_LB); float* CA = (float*)(KWS() + WS_CARRY); float* CH = CA + 2 * 32 * 2048;
    const size_t gt = (size_t)F.bid * NTHREADS + F.tid, NGT = (size_t)F.nblk * NTHREADS;
    for (size_t i = gt; i < (size_t)2 * 32 * 2048; i += NGT) { const int ch = (int)(i & 2047), chunk = (int)(i >> 11) & 31, b = (int)(i >> 16);
        const size_t base = ((size_t)b * SEQ + chunk * 128) * 2048 + ch; float A = 1.f, H = 0.f;
        for (int s0 = 0; s0 < 128; s0 += 16) { float la[16], lb[16];
#pragma unroll
            for (int u = 0; u < 16; ++u) { la[u] = LA[base + (size_t)(s0 + u) * 2048]; lb[u] = LB[base + (size_t)(s0 + u) * 2048]; }
            SC_PIN(la); SC_PIN(lb);
#pragma unroll
            for (int u = 0; u < 16; ++u) { H = la[u] * H + lb[u]; A *= la[u]; } }
        CA[i] = A; CH[i] = H; }
}
__device__ __forceinline__ void scan2_item(const Frame& F, const int vb) {
    const float* __restrict__ LA = (const float*)(KWS() + WS_LA); const float* __restrict__ LB = (const float*)(KWS() + WS_LB); const float* __restrict__ CA = (const float*)(KWS() + WS_CARRY); const float* __restrict__ CH = CA + 2 * 32 * 2048;
    const bf16* __restrict__ PROJ = (const bf16*)(KWS() + WS_PROJ); bf16* __restrict__ Y = (bf16*)(KWS() + WS_Y);
    { const size_t i = (size_t)vb * NTHREADS + F.tid; const int ch = (int)(i & 2047), chunk = (int)(i >> 11) & 31, b = (int)(i >> 16);
        float H = 0.f;
        for (int j0 = 0; j0 < chunk; j0 += 16) { float ca[16], chh[16];
#pragma unroll
            for (int u = 0; u < 16; ++u) { const int j = j0 + u < chunk ? j0 + u : chunk - 1; const size_t ci = ((size_t)b * 32 + j) * 2048 + ch; ca[u] = CA[ci]; chh[u] = CH[ci]; }
            SC_PIN(ca); SC_PIN(chh);
#pragma unroll
            for (int u = 0; u < 16; ++u) if (j0 + u < chunk) H = ca[u] * H + chh[u]; }
        const size_t row0 = (size_t)b * SEQ + chunk * 128;
        for (int s0 = 0; s0 < 128; s0 += 16) { float la[16], lb[16]; unsigned gg[16];
#pragma unroll
            for (int u = 0; u < 16; ++u) { const size_t row = row0 + s0 + u; la[u] = LA[row * 2048 + ch]; lb[u] = LB[row * 2048 + ch]; gg[u] = PROJ[row * NPJ + PC_AG + ch]; }
            SC_PIN(la); SC_PIN(lb); SC_PIN(gg);
#pragma unroll
            for (int u = 0; u < 16; ++u) { const size_t row = row0 + s0 + u; H = la[u] * H + lb[u]; Y[row * KCAT + YC_A + ch] = (bf16)f2bf(H * siluf_(bf2f((bf16)gg[u]))); } } }
}

constexpr int RW_CH = 32;
constexpr int RW_RVB = RW_CH * 1280, RW_VVB = RW_CH * 256;
struct RwVec { f32x4 kk, wv, nk, kv, rv; f32x2 vi; };
template <int S> __device__ __forceinline__ void rw_issue(RwVec& d, unsigned a, unsigned av) {
    asm volatile("ds_read_b128 %0, %6 offset:%8\n\tds_read_b128 %1, %6 offset:%9\n\tds_read_b128 %2, %6 offset:%10\n\tds_read_b128 %3, %6 offset:%11\n\tds_read_b128 %4, %6 offset:%12\n\tds_read_b64 %5, %7 offset:%13"
                 : "=&v"(d.kk), "=&v"(d.wv), "=&v"(d.nk), "=&v"(d.kv), "=&v"(d.rv), "=&v"(d.vi) : "v"(a), "v"(av), "n"(S * 1280), "n"(S * 1280 + 256), "n"(S * 1280 + 512), "n"(S * 1280 + 768), "n"(S * 1280 + 1024), "n"(S * 256) : "memory"); }
#define RW_OPS(d) "+v"(d.kk), "+v"(d.wv), "+v"(d.nk), "+v"(d.kv), "+v"(d.rv), "+v"(d.vi)
__device__ __forceinline__ void rw_wait6(RwVec& d) { asm volatile("s_waitcnt lgkmcnt(6)" : RW_OPS(d) :: "memory"); }
__device__ __forceinline__ void rw_wait0(RwVec& d) { asm volatile("s_waitcnt lgkmcnt(0)" : RW_OPS(d) :: "memory"); }
__device__ __forceinline__ void phase_rwkv_rec(const Frame& F0, const int first, const int stride) {
    const Frame F = reframe(F0);
    const char* RV = (const char*)(KWS() + WS_RV); const char* VV = (const char*)(KWS() + WS_VV); float* YR = (float*)(KWS() + WS_YR);
    LAS unsigned char* lds = F.lds;
    for (int item = first; item < 128; item += stride) {
        const int bh = item >> 1, hf = item & 1, b = bh >> 5, h = bh & 31, w = F.wave, lane = F.lane, cg = lane & 15, rl = lane >> 4;
        const int row = hf * 32 + (w & 3) * 8 + rl * 2;
        const char* rvg = RV + (size_t)bh * SEQ * 1280; const char* vvg = VV + ((size_t)b * SEQ * 2048 + h * 64) * 4;
        f32x2 Sa0 = (f32x2){0.f, 0.f}, Sa1 = Sa0, Sb0 = Sa0, Sb1 = Sa0;
#define RW_DMA(ck) do { const int _buf = (ck) & 1; _Pragma("unroll") for (int _p = 0; _p < 6; ++_p) { const int pc = w * 6 + _p; \
            if (pc < 40) __builtin_amdgcn_global_load_lds((const unsigned*)(rvg + (size_t)(ck) * RW_RVB + pc * 1024 + lane * 16), (LAS unsigned*)(lds + _buf * RW_RVB + pc * 1024), 16, 0, 0); \
            else { const int pv = pc - 40; __builtin_amdgcn_global_load_lds((const unsigned*)(vvg + ((size_t)((ck) * RW_CH + pv * 4 + (lane >> 4)) * 2048) * 4 + (lane & 15) * 16), (LAS unsigned*)(lds + 2 * RW_RVB + _buf * RW_VVB + pv * 1024), 16, 0, 0); } } } while (0)
        RW_DMA(0);
        VM_WAIT(); __syncthreads();
        for (int ck = 0; ck < SEQ / RW_CH; ++ck) {
            if (ck + 1 < SEQ / RW_CH) RW_DMA(ck + 1);
            if (w < 4) {
                const unsigned ra = (unsigned)(size_t)(lds + (ck & 1) * RW_RVB + cg * 16), va = (unsigned)(size_t)(lds + 2 * RW_RVB + (ck & 1) * RW_VVB + row * 4);
                float* yo = YR + ((size_t)b * SEQ + (size_t)ck * RW_CH + (cg & 3)) * 2048 + h * 64 + row;
                RwVec A_, B_;
                rw_issue<0>(A_, ra, va);
#define P2(v, hi) ((f32x2){(hi) ? v.z : v.x, (hi) ? v.w : v.y})
#define RW_STEP(CUR, NXT, s_) do { if ((s_) + 1 < RW_CH) { rw_issue<((s_) + 1) % RW_CH>(NXT, ra, va); rw_wait6(CUR); } else rw_wait0(CUR); \
                    const f32x2 via = (f32x2){CUR.vi.x, CUR.vi.x}, vib = (f32x2){CUR.vi.y, CUR.vi.y}; \
                    const f32x2 pa = Sa0 * P2(CUR.kk, 0) + Sa1 * P2(CUR.kk, 1), pb = Sb0 * P2(CUR.kk, 0) + Sb1 * P2(CUR.kk, 1); \
                    float sa = pa.x + pa.y, sb = pb.x + pb.y; \
                    sa += dpp_mov<0xB1>(sa); sb += dpp_mov<0xB1>(sb); sa += dpp_mov<0x4E>(sa); sb += dpp_mov<0x4E>(sb); sa += dpp_mov<0x141>(sa); sb += dpp_mov<0x141>(sb); sa += dpp_mov<0x140>(sa); sb += dpp_mov<0x140>(sb); \
                    const f32x2 sa2 = (f32x2){sa, sa}, sb2 = (f32x2){sb, sb}; \
                    Sa0 = sa2 * P2(CUR.nk, 0) + (via * P2(CUR.kv, 0) + Sa0 * P2(CUR.wv, 0)); Sa1 = sa2 * P2(CUR.nk, 1) + (via * P2(CUR.kv, 1) + Sa1 * P2(CUR.wv, 1)); \
                    Sb0 = sb2 * P2(CUR.nk, 0) + (vib * P2(CUR.kv, 0) + Sb0 * P2(CUR.wv, 0)); Sb1 = sb2 * P2(CUR.nk, 1) + (vib * P2(CUR.kv, 1) + Sb1 * P2(CUR.wv, 1)); \
                    const f32x2 qa = Sa0 * P2(CUR.rv, 0) + Sa1 * P2(CUR.rv, 1), qb = Sb0 * P2(CUR.rv, 0) + Sb1 * P2(CUR.rv, 1); \
                    ya[(s_) & 3] = qa.x + qa.y; yb[(s_) & 3] = qb.x + qb.y; } while (0)
#define RW_G4(g4) do { \
                    float ya[4], yb[4]; \
                    RW_STEP(A_, B_, g4 * 4 + 0); RW_STEP(B_, A_, g4 * 4 + 1); RW_STEP(A_, B_, g4 * 4 + 2); RW_STEP(B_, A_, g4 * 4 + 3); \
                      \
                    const bool o1 = cg & 1, o2 = cg & 2; \
                    const float uA = (o1 ? ya[1] : ya[0]) + dpp_mov<0xB1>(o1 ? ya[0] : ya[1]), uB = (o1 ? ya[3] : ya[2]) + dpp_mov<0xB1>(o1 ? ya[2] : ya[3]); \
                    const float wA = (o1 ? yb[1] : yb[0]) + dpp_mov<0xB1>(o1 ? yb[0] : yb[1]), wB = (o1 ? yb[3] : yb[2]) + dpp_mov<0xB1>(o1 ? yb[2] : yb[3]); \
                    float ysa = (o2 ? uB : uA) + dpp_mov<0x4E>(o2 ? uA : uB), ysb = (o2 ? wB : wA) + dpp_mov<0x4E>(o2 ? wA : wB); \
                    ysa += dpp_mov<0x114>(ysa); ysb += dpp_mov<0x114>(ysb); \
                    ysa += dpp_mov<0x118>(ysa); ysb += dpp_mov<0x118>(ysb); \
                    if (cg >= 12) *(f32x2*)(yo + (size_t)(g4) * 4 * 2048) = (f32x2){ysa, ysb}; } while (0)
                RW_G4(0); RW_G4(1); RW_G4(2); RW_G4(3); RW_G4(4); RW_G4(5); RW_G4(6); RW_G4(7);
                static_assert(RW_CH == 32, "eight groups of four steps");
#undef RW_G4
#undef RW_STEP
#undef P2
            }
            VM_WAIT(); __syncthreads();
        }
#undef RW_DMA
    }
}

__device__ __forceinline__ void phase_rwkv_post(const Frame& F0, int l) {
    const Frame F = reframe(F0);
    const float* __restrict__ YR = (const float*)(KWS() + WS_YR); const float* __restrict__ VV = (const float*)(KWS() + WS_VV); const float* __restrict__ BON = (const float*)(KWS() + WS_BON);
    const bf16* __restrict__ PROJ = (const bf16*)(KWS() + WS_PROJ); bf16* __restrict__ Y = (bf16*)(KWS() + WS_Y);
    const float* gw_ = KIN(I_GNW) + (size_t)l * 2048; const float* gb_ = KIN(I_GNB) + (size_t)l * 2048;
    const int gw = F.bid * NWAVES + F.wave, NGW = F.nblk * NWAVES, lane = F.lane;
    const int hq = gw & 7, ch = hq * 256 + lane * 4, h = hq * 4 + (lane >> 4);
    const f32x4 w4 = *(const f32x4*)(gw_ + ch), b4 = *(const f32x4*)(gb_ + ch);
    struct PostIn { f32x4 y, v; float bon; u32x2 g; };
    auto pload = [&](const int it, PostIn& x) { const int t = it >> 3; x.y = *(const f32x4*)(YR + (size_t)t * 2048 + ch); x.v = *(const f32x4*)(VV + (size_t)t * 2048 + ch); x.bon = BON[(size_t)t * 32 + h]; x.g = *(const u32x2*)(PROJ + (size_t)t * NPJ + PC_BG + ch); };
    auto pcomp = [&](const int it, const PostIn& x) { const int t = it >> 3; const f32x4 y = x.y, v = x.v, g = bf4_unpack(x.g); const float bon = x.bon;
        const float mean = row16_sum((y.x + y.y) + (y.z + y.w)) * (1.0f / 64.0f); const f32x4 d = y - mean;
        const float var = row16_sum((d.x * d.x + d.y * d.y) + (d.z * d.z + d.w * d.w)) * (1.0f / 64.0f); const float rs = rsqrtf(var + 64e-5f);
        const f32x4 o = (d * rs * w4 + b4 + v * bon);
        u32x2 pk; pk.x = pk2(o.x * siluf_(g.x), o.y * siluf_(g.y)); pk.y = pk2(o.z * siluf_(g.z), o.w * siluf_(g.w));
        *(u32x2*)(Y + (size_t)t * KCAT + YC_B + ch) = pk; };
    int it = gw;
    for (; it + 3 * NGW < M * 8; it += 4 * NGW) { PostIn x0, x1, x2, x3; pload(it, x0); pload(it + NGW, x1); pload(it + 2 * NGW, x2); pload(it + 3 * NGW, x3);
        pcomp(it, x0); pcomp(it + NGW, x1); pcomp(it + 2 * NGW, x2); pcomp(it + 3 * NGW, x3); }
    for (; it < M * 8; it += NGW) { PostIn x0; pload(it, x0); pcomp(it, x0); }
}
__device__ __forceinline__ void phase_mlstm_post(const Frame& F0, int l) {
    const Frame F = reframe(F0);
    const float* __restrict__ HC = (const float*)(KWS() + WS_HC); const bf16* __restrict__ PROJ = (const bf16*)(KWS() + WS_PROJ); bf16* __restrict__ Y = (bf16*)(KWS() + WS_Y);
    const float* gw_ = KIN(I_MGNW) + (size_t)l * 2048;
    const int gw = F.bid * NWAVES + F.wave, NGW = F.nblk * NWAVES, lane = F.lane;
#pragma unroll 2
    for (int it = gw; it < M * 4; it += NGW) { const int t = it >> 2, hd = it & 3, ch = hd * 512 + lane * 8;
        const f32x4 v0 = *(const f32x4*)(HC + (size_t)t * 2048 + ch), v1 = *(const f32x4*)(HC + (size_t)t * 2048 + ch + 4);
        float x[8] = {v0.x, v0.y, v0.z, v0.w, v1.x, v1.y, v1.z, v1.w}; float s = 0.f;
#pragma unroll
        for (int q = 0; q < 8; ++q) s += x[q];
        const float mean = wave_sum(s) * (1.0f / 512.0f); float s2 = 0.f;
#pragma unroll
        for (int q = 0; q < 8; ++q) { x[q] -= mean; s2 += x[q] * x[q]; }
        const float rstd = rsqrtf(wave_sum(s2) * (1.0f / 512.0f) + 1e-6f);
        const u32x4 gg = *(const u32x4*)(PROJ + (size_t)t * NPJ + PC_CG + ch); float gf[8]; unpack8(gg, gf); float o[8];
#pragma unroll
        for (int q = 0; q < 8; ++q) o[q] = x[q] * rstd * gw_[ch + q] * siluf_(gf[q]);
        u32x4 w; w.x = pk2(o[0], o[1]); w.y = pk2(o[2], o[3]); w.z = pk2(o[4], o[5]); w.w = pk2(o[6], o[7]);
        *(u32x4*)(Y + (size_t)t * KCAT + YC_C + ch) = w; }
}

__device__ __forceinline__ s16x4 tr16(const LAS unsigned char* p) { return __builtin_bit_cast(s16x4, __builtin_amdgcn_ds_read_tr16_b64_v4i16((LAS s16x4*)p)); }
constexpr int ML_SROW = 80;
constexpr int ML_K = 0, ML_V = 3 * 16384, ML_S = ML_V + 3 * 32768, ML_G = ML_S + 64 * ML_SROW, ML_DEN = ML_G + 1024, ML_END = ML_DEN + 512;
static_assert(ML_END <= RING_BYTES, "mLSTM LDS");
__device__ __forceinline__ void xattn_item(const Frame& F, int l, const int item);
__device__ __forceinline__ int ml_vswz(int row) { return ((row & 3) << 1) | (((row >> 3) & 1) << 3); }
__device__ __forceinline__ void phase_mlstm(const Frame& F0, int l, unsigned* queue, const int lim_lo = 0, const int lim_hi = 1 << 30) {
    const Frame F = reframe(F0);
    const bf16* PROJ = (const bf16*)(KWS() + WS_PROJ); const bf16* QC = (const bf16*)(KWS() + WS_QC); const bf16* KC = (const bf16*)(KWS() + WS_KC);
    const float* G = (const float*)(KWS() + WS_SCAL); const float* MX = G + (size_t)M * 4; const float* MT = MX + (size_t)M * 4; float* HC = (float*)(KWS() + WS_HC);
    LAS unsigned char* lds = F.lds; LAS float* denl = (LAS float*)(lds + ML_DEN);
    const int tid = F.tid, lane = F.lane, w = F.wave, l15 = lane & 15, lg = lane >> 4, rt = w >> 1, ctp = w & 1;
    volatile LAS unsigned* qslot = (volatile LAS unsigned*)(F.lds + MISC_OFF);
    const bool affine = (lim_lo == 0) && (lim_hi == (1 << 30)); bool ml_left = affine, cv_left = affine && CONV1_IN_QUEUE && (l == 0), flip = false;
    for (;;) {
        __syncthreads();
        if (tid == 0) { unsigned it = 0xffffffffu;
            if (cv_left && (flip || !ml_left)) { const unsigned t = __hip_atomic_fetch_add(queue + 16, 1u, __ATOMIC_RELAXED, __HIP_MEMORY_SCOPE_AGENT); if (t < (unsigned)CONV_NVB) it = 1024u + t; else cv_left = false; }
            if (it == 0xffffffffu && ml_left) { const unsigned x = xb_xcc_id() & 7u;
                for (unsigned j = 0; j < 8u; ++j) { const unsigned sidx = (x + j) & 7u; const unsigned t = __hip_atomic_fetch_add(queue + 8 + sidx, 1u, __ATOMIC_RELAXED, __HIP_MEMORY_SCOPE_AGENT); if (t < 64u) { it = (t << 3) | sidx; break; } }
                if (it == 0xffffffffu) ml_left = false; }
            if (it == 0xffffffffu && cv_left) { const unsigned t = __hip_atomic_fetch_add(queue + 16, 1u, __ATOMIC_RELAXED, __HIP_MEMORY_SCOPE_AGENT); if (t < (unsigned)CONV_NVB) it = 1024u + t; else cv_left = false; }
            flip = !flip;
            if (it == 0xffffffffu) { const unsigned t = __hip_atomic_fetch_add(queue, 1u, __ATOMIC_RELAXED, __HIP_MEMORY_SCOPE_AGENT); it = affine ? (t < 512u ? 512u + t : 0xfffffffeu) : t; }
            qslot[0] = it; }
        __syncthreads();
        if (affine && qslot[0] == 0xfffffffeu) break;
        const int item = (int)qslot[0] + lim_lo; if (item >= lim_hi || item >= 1024 + ((CONV1_IN_QUEUE && l == 0) ? CONV_NVB : 0)) break;
        if (item >= 1024) { phase_convert_layer(F, 1, 2, item - 1024, CONV_NVB); continue; }
        if (item >= 768) { scan2_item(F, item - 768); continue; }
        if (item >= 512) { xattn_item(F, l, item - 512); continue; }
        const int qt = 63 - (item >> 3), b = (item >> 2) & 1, hd = item & 3, t0 = qt * 64; const size_t rowb = (size_t)b * SEQ;
        const int tq = opaque_v(lane);
        const int q15 = tq & 15, qg = tq >> 4;
        bf16x8 qf[8];
#pragma unroll
        for (int ks = 0; ks < 8; ++ks) qf[ks] = *(const bf16x8*)(QC + (rowb + t0 + 16 * rt + q15) * 1024 + hd * 256 + 32 * ks + 8 * qg);
        float mxr[4];
#pragma unroll
        for (int j = 0; j < 4; ++j) mxr[j] = MX[(rowb + t0 + 16 * rt + qg * 4 + j) * 4 + hd];
        f32x4 num[4][4];
#pragma unroll
        for (int r4 = 0; r4 < 4; ++r4)
#pragma unroll
            for (int c4 = 0; c4 < 4; ++c4) num[r4][c4] = (f32x4){0.f, 0.f, 0.f, 0.f};
        float dacc[4] = {0.f, 0.f, 0.f, 0.f};
        asm volatile("s_waitcnt vmcnt(0)" ::: "memory");
        asm volatile("" : "+v"(qf[0]), "+v"(qf[1]), "+v"(qf[2]), "+v"(qf[3]), "+v"(qf[4]), "+v"(qf[5]), "+v"(qf[6]), "+v"(qf[7]));
        asm volatile("" : "+v"(mxr[0]), "+v"(mxr[1]), "+v"(mxr[2]), "+v"(mxr[3]));
#define ML_DMA_KV(kt_, bf_) do { const int s0_ = (kt_) * 32; const char* kb_ = (const char*)KC + ((rowb + s0_) * 1024 + hd * 256) * 2; const char* vb_ = (const char*)PROJ + ((rowb + s0_) * NPJ + PC_CV + hd * 512) * 2; \
            _Pragma("unroll") for (int i = 0; i < 2; ++i) { const int pc = w * 2 + i, row = 2 * pc + (lane >> 5), p = lane & 31; \
                __builtin_amdgcn_global_load_lds((const unsigned*)(kb_ + (size_t)row * 2048 + ((p ^ (row & 15)) * 16)), (LAS unsigned*)(lds + ML_K + (bf_) * 16384 + pc * 1024), 16, 0, 0); } \
            _Pragma("unroll") for (int i = 0; i < 4; ++i) { const int row = w * 4 + i; \
                __builtin_amdgcn_global_load_lds((const unsigned*)(vb_ + (size_t)row * (NPJ * 2) + ((lane ^ ml_vswz(row)) * 16)), (LAS unsigned*)(lds + ML_V + (bf_) * 32768 + row * 1024), 16, 0, 0); } \
            if (w == 0) __builtin_amdgcn_global_load_lds((const unsigned*)(G + (rowb + s0_ + (lane & 31)) * 4 + hd), (LAS unsigned*)(lds + ML_G + (bf_) * 256), 4, 0, 0); } while (0)
        const int nkt = 2 * qt + 2;
        ML_DMA_KV(0, 0); ML_DMA_KV(1, 1);
        int buf = 0;
        for (int kt = 0; kt < nkt; ++kt) {
            const int s0 = kt * 32;
            if (kt + 1 < nkt) { if (w == 0) asm volatile("s_waitcnt vmcnt(7) lgkmcnt(0)" ::: "memory"); else asm volatile("s_waitcnt vmcnt(6) lgkmcnt(0)" ::: "memory"); }
            else asm volatile("s_waitcnt vmcnt(0) lgkmcnt(0)" ::: "memory");
            __builtin_amdgcn_s_barrier(); asm volatile("" ::: "memory");
            { const int bf2 = buf >= 1 ? buf - 1 : 2; if (kt + 2 < nkt) ML_DMA_KV(kt + 2, bf2); }
            const LAS unsigned char* kb = lds + ML_K + buf * 16384; const LAS unsigned char* vbuf = lds + ML_V + buf * 32768; const LAS float* gl = (const LAS float*)(lds + ML_G + buf * 256);
            f32x4 sacc = (f32x4){0.f, 0.f, 0.f, 0.f};
            { bf16x8 kf[8];
#pragma unroll
              for (int ks = 0; ks < 8; ++ks) { const int r = 16 * ctp + l15; kf[ks] = *(const LAS bf16x8*)(kb + r * 512 + (((4 * ks + lg) ^ (r & 15)) * 16)); }
              asm volatile("" : "+v"(kf[0]), "+v"(kf[1]), "+v"(kf[2]), "+v"(kf[3]), "+v"(kf[4]), "+v"(kf[5]), "+v"(kf[6]), "+v"(kf[7]));
              f32x4 sacc1 = (f32x4){0.f, 0.f, 0.f, 0.f};
#pragma unroll
              for (int ks = 0; ks < 8; ks += 2) { sacc = __builtin_amdgcn_mfma_f32_16x16x32_bf16(qf[ks], kf[ks], sacc, 0, 0, 0); sacc1 = __builtin_amdgcn_mfma_f32_16x16x32_bf16(qf[ks + 1], kf[ks + 1], sacc1, 0, 0, 0); }
              sacc += sacc1; }
            { const int sl = 16 * ctp + l15; const float gs = gl[sl];
#pragma unroll
                for (int j = 0; j < 4; ++j) { const int tl = 16 * rt + lg * 4 + j;
                    const float wgt = (s0 + sl <= t0 + tl) ? __expf(gs - mxr[j]) : 0.f; const float val = sacc[j] * wgt;
                    *(LAS unsigned short*)(lds + ML_S + tl * ML_SROW + sl * 2) = (unsigned short)f2bf(val);
                    dacc[j] += row16_sum(val); } }
            asm volatile("s_waitcnt lgkmcnt(0)" ::: "memory"); __builtin_amdgcn_s_barrier(); asm volatile("" ::: "memory");
            { bf16x8 afr[4];
#pragma unroll
                for (int r4 = 0; r4 < 4; ++r4) afr[r4] = *(const LAS bf16x8*)(lds + ML_S + (16 * r4 + l15) * ML_SROW + (8 * lg) * 2);
                unsigned va[4];
#pragma unroll
                for (int c4 = 0; c4 < 4; ++c4) { const int r = 8 * lg + (l15 >> 2), ch = 8 * w + 2 * c4 + ((l15 & 3) >> 1); va[c4] = (unsigned)(size_t)(vbuf + r * 1024 + ((ch ^ ml_vswz(r)) * 16) + (l15 & 1) * 8); }
                s16x4 lo[4], hi[4];
                asm volatile("ds_read_b64_tr_b16 %0, %8\n\tds_read_b64_tr_b16 %1, %8 offset:4096\n\tds_read_b64_tr_b16 %2, %9\n\tds_read_b64_tr_b16 %3, %9 offset:4096\n\t"
                             "ds_read_b64_tr_b16 %4, %10\n\tds_read_b64_tr_b16 %5, %10 offset:4096\n\tds_read_b64_tr_b16 %6, %11\n\tds_read_b64_tr_b16 %7, %11 offset:4096\n\ts_waitcnt lgkmcnt(0)"
                             : "=&v"(lo[0]), "=&v"(hi[0]), "=&v"(lo[1]), "=&v"(hi[1]), "=&v"(lo[2]), "=&v"(hi[2]), "=&v"(lo[3]), "=&v"(hi[3]) : "v"(va[0]), "v"(va[1]), "v"(va[2]), "v"(va[3]) : "memory");
#pragma unroll
                for (int c4 = 0; c4 < 4; ++c4) { const bf16x8 bfr = __builtin_shufflevector(lo[c4], hi[c4], 0, 1, 2, 3, 4, 5, 6, 7);
#pragma unroll
                    for (int r4 = 0; r4 < 4; ++r4) num[r4][c4] = __builtin_amdgcn_mfma_f32_16x16x32_bf16(afr[r4], bfr, num[r4][c4], 0, 0, 0); } }
            buf = buf == 2 ? 0 : buf + 1;
        }
#undef ML_DMA_KV
        if (l15 == 0) {
#pragma unroll
            for (int j = 0; j < 4; ++j) denl[(16 * rt + lg * 4 + j) * 2 + ctp] = dacc[j]; }
        __syncthreads();
        { unsigned short co[4][4][4]; float mtv[4][4];
#pragma unroll
          for (int r4 = 0; r4 < 4; ++r4)
#pragma unroll
            for (int j = 0; j < 4; ++j) { const size_t row = rowb + t0 + 16 * r4 + lg * 4 + j; mtv[r4][j] = MT[row * 4 + hd];
#pragma unroll
                for (int c4 = 0; c4 < 4; ++c4) co[r4][j][c4] = PROJ[row * NPJ + PC_CO + hd * 512 + 64 * w + 16 * c4 + l15]; }
#pragma unroll
          for (int r4 = 0; r4 < 4; ++r4)
#pragma unroll
            for (int j = 0; j < 4; ++j) { const int tl = 16 * r4 + lg * 4 + j; const size_t row = rowb + t0 + tl;
                const float den = denl[2 * tl] + denl[2 * tl + 1], mt = mtv[r4][j]; const float inv = __builtin_amdgcn_rcpf(fmaxf(fabsf(den), __expf(-mt)));
#pragma unroll
                for (int c4 = 0; c4 < 4; ++c4) { const int dv = 64 * w + 16 * c4 + l15; const float o = sigm(bf2f(co[r4][j][c4]));
                    HC[row * 2048 + hd * 512 + dv] = num[r4][c4][j] * inv * o; } } }
        asm volatile("s_waitcnt vmcnt(0)" ::: "memory"); __syncthreads();
        { const float* gw_ = KIN(I_MGNW) + (size_t)l * 2048; bf16* Y = (bf16*)(KWS() + WS_Y); const int ch = hd * 512 + lane * 8;
          f32x4 hv0[8], hv1[8]; u32x4 hg[8]; const f32x4 gwa = *(const f32x4*)(gw_ + ch), gwb = *(const f32x4*)(gw_ + ch + 4);
#pragma unroll
          for (int rr = 0; rr < 8; ++rr) { const size_t t = rowb + t0 + w * 8 + rr; hv0[rr] = *(const f32x4*)(HC + t * 2048 + ch); hv1[rr] = *(const f32x4*)(HC + t * 2048 + ch + 4); hg[rr] = *(const u32x4*)(PROJ + t * NPJ + PC_CG + ch); }
          asm volatile("" ::: "memory");
#pragma unroll
          for (int rr = 0; rr < 8; ++rr) { const size_t t = rowb + t0 + w * 8 + rr;
            const f32x4 v0 = hv0[rr], v1 = hv1[rr];
            float x[8] = {v0.x, v0.y, v0.z, v0.w, v1.x, v1.y, v1.z, v1.w}; float sm_ = 0.f;
#pragma unroll
            for (int q = 0; q < 8; ++q) sm_ += x[q];
            const float mean = wave_sum(sm_) * (1.0f / 512.0f); float s2 = 0.f;
#pragma unroll
            for (int q = 0; q < 8; ++q) { x[q] -= mean; s2 += x[q] * x[q]; }
            const float rstd = rsqrtf(wave_sum(s2) * (1.0f / 512.0f) + 1e-6f);
            float gf[8]; unpack8(hg[rr], gf); float o[8];
#pragma unroll
            for (int q = 0; q < 8; ++q) o[q] = x[q] * rstd * (q < 4 ? gwa[q] : gwb[q - 4]) * siluf_(gf[q]);
            u32x4 wv; wv.x = pk2(o[0], o[1]); wv.y = pk2(o[2], o[3]); wv.z = pk2(o[4], o[5]); wv.w = pk2(o[6], o[7]);
            *(u32x4*)(Y + t * KCAT + YC_C + ch) = wv; } }
    }
    __syncthreads();
}

constexpr int XA_ROW = 272, XA_K = 0, XA_V = 256 * XA_ROW, XA_END = 2 * 256 * XA_ROW, XA_PROW = 528;
static_assert(XA_END <= RING_BYTES && 8 * 16 * XA_PROW <= XA_V, "x-attn LDS");
__device__ __forceinline__ void xattn_item(const Frame& F, int l, const int item) {
    const bf16* PROJ = (const bf16*)(KWS() + WS_PROJ); const bf16* KV = (const bf16*)(KWS() + WS_KV) + (size_t)l * MM * 1024; bf16* Y = (bf16*)(KWS() + WS_Y);
    LAS unsigned char* lds = F.lds; const int lane = opaque_v(F.lane), w = F.wave, tid = w * 64 + lane, l15 = lane & 15, lg = lane >> 4;
    {
        const int b = item >> 7, hd = (item >> 5) & 3, qb = item & 31; const size_t row0 = (size_t)b * SEQ + qb * 128 + 16 * w;
        __syncthreads();
        { u32x4 kq[8], vq[8];
#pragma unroll
          for (int i = 0; i < 8; ++i) { const int p = tid + 512 * i, r = p >> 4, c16 = p & 15; const bf16* src = KV + (size_t)(b * MEML + r) * 1024 + hd * 128 + c16 * 8; kq[i] = *(const u32x4*)src; vq[i] = *(const u32x4*)(src + 512); }
          asm volatile("" : "+v"(kq[0]), "+v"(kq[1]), "+v"(kq[2]), "+v"(kq[3]), "+v"(kq[4]), "+v"(kq[5]), "+v"(kq[6]), "+v"(kq[7]), "+v"(vq[0]), "+v"(vq[1]), "+v"(vq[2]), "+v"(vq[3]), "+v"(vq[4]), "+v"(vq[5]), "+v"(vq[6]), "+v"(vq[7]) :: "memory");
#pragma unroll
          for (int i = 0; i < 8; ++i) { const int p = tid + 512 * i, r = p >> 4, c16 = p & 15; *(LAS u32x4*)(lds + XA_K + r * XA_ROW + c16 * 16) = kq[i]; *(LAS u32x4*)(lds + XA_V + r * XA_ROW + c16 * 16) = vq[i]; } }
        bf16x8 qf[4];
#pragma unroll
        for (int ks = 0; ks < 4; ++ks) qf[ks] = *(const bf16x8*)(PROJ + (row0 + l15) * NPJ + PC_XQ + hd * 128 + 32 * ks + 8 * lg);
        unsigned short xg[4][8];
#pragma unroll
        for (int j = 0; j < 4; ++j)
#pragma unroll
            for (int cc = 0; cc < 8; ++cc) xg[j][cc] = PROJ[(row0 + lg * 4 + j) * NPJ + PC_XG + hd * 128 + 16 * cc + l15];
        __syncthreads();
        f32x4 sacc[16];
#pragma unroll
        for (int ct = 0; ct < 16; ++ct) { sacc[ct] = (f32x4){0.f, 0.f, 0.f, 0.f};
#pragma unroll
            for (int ks = 0; ks < 4; ++ks) { const bf16x8 bfr = *(const LAS bf16x8*)(lds + XA_K + (16 * ct + l15) * XA_ROW + (32 * ks + 8 * lg) * 2);
                sacc[ct] = __builtin_amdgcn_mfma_f32_16x16x32_bf16(qf[ks], bfr, sacc[ct], 0, 0, 0); } }
        float mx[4], sm[4];
#pragma unroll
        for (int j = 0; j < 4; ++j) { float m = sacc[0][j];
#pragma unroll
            for (int ct = 1; ct < 16; ++ct) m = fmaxf(m, sacc[ct][j]);
            mx[j] = row16_max(m); sm[j] = 0.f; }
        __syncthreads();
        LAS unsigned char* pw = lds + XA_K + w * 16 * XA_PROW;
#pragma unroll
        for (int ct = 0; ct < 16; ++ct)
#pragma unroll
            for (int j = 0; j < 4; ++j) { const float p = __expf((sacc[ct][j] - mx[j]) * 0.08838834764831845f); sm[j] += p;
                *(LAS unsigned short*)(pw + (lg * 4 + j) * XA_PROW + (16 * ct + l15) * 2) = (unsigned short)f2bf(p); }
#pragma unroll
        for (int j = 0; j < 4; ++j) sm[j] = row16_sum(sm[j]);
        LDS_WAIT(); asm volatile("" ::: "memory");
        f32x4 oacc[8];
#pragma unroll
        for (int cc = 0; cc < 8; ++cc) oacc[cc] = (f32x4){0.f, 0.f, 0.f, 0.f};
#pragma unroll
        for (int ks = 0; ks < 8; ++ks) { const bf16x8 afr = *(const LAS bf16x8*)(pw + l15 * XA_PROW + (32 * ks + 8 * lg) * 2);
#pragma unroll
            for (int cc = 0; cc < 8; ++cc) { const LAS unsigned char* vp = lds + XA_V + (32 * ks + 8 * lg + (l15 >> 2)) * XA_ROW + (16 * cc + 4 * (l15 & 3)) * 2;
                const s16x4 lo = tr16(vp), hi = tr16(vp + 4 * XA_ROW); const bf16x8 bfr = __builtin_shufflevector(lo, hi, 0, 1, 2, 3, 4, 5, 6, 7);
                oacc[cc] = __builtin_amdgcn_mfma_f32_16x16x32_bf16(afr, bfr, oacc[cc], 0, 0, 0); } }
#pragma unroll
        for (int j = 0; j < 4; ++j) { const size_t row = row0 + lg * 4 + j; const float inv = __builtin_amdgcn_rcpf(sm[j]);
#pragma unroll
            for (int cc = 0; cc < 8; ++cc) { const int d = 16 * cc + l15; const float gate = siluf_(bf2f(xg[j][cc]));
                Y[row * KCAT + YC_X + hd * 128 + d] = (bf16)f2bf(oacc[cc][j] * inv * gate); } }
    }
    __syncthreads();
}

constexpr int NPL = 9, NPHASE = 2 + DEPTH * NPL;
struct Args { Ctx c; int ph_lo, ph_hi; };
template <unsigned PH_MASK> __global__ void __launch_bounds__(NTHREADS, 2) mega(Args args) {
    extern __shared__ __attribute__((aligned(16))) unsigned char lds_raw[];
    Frame F; F.lds = (LAS unsigned char*)lds_raw; F.wave = __builtin_amdgcn_readfirstlane((int)threadIdx.x >> 6); F.lane = lane_id(); F.tid = F.wave * 64 + F.lane; F.bid = blockIdx.x; F.nblk = gridDim.x;
    volatile LAS unsigned* MISC = (volatile LAS unsigned*)(F.lds + MISC_OFF);
    if (F.tid < 16) MISC[F.tid] = 0u;
    __syncthreads();
    const int lo = args.ph_lo, hi = args.ph_hi;
    XcdBarrier bar; bar.bar = (unsigned*)(KWS() + WS_CTL) + CW_BAR; bar.st = MISC + 8;
    if (PH_MASK == 0x7FFu) { if (hi - lo > 1) xcd_barrier_setup(bar, F.wave); }
#ifndef PROBE_DUP
#define PROBE_DUP 0u
#endif
#define DUP(j) (((PROBE_DUP >> (j)) & 1u) ? 2 : 1)
#define IN(k) (lo <= (k) && (k) < hi)
#define EN(j) ((PH_MASK >> (j)) & 1u)
#define SEAM(k) do { if (PH_MASK == 0x7FFu) { if (IN(k) && IN((k) + 1)) xcd_barrier(bar, F.wave); } } while (0)
    if (IN(0) && EN(0)) for (int rep = 0; rep < DUP(0); ++rep) { phase_convert_layer(F, 0, 1, F.bid, F.nblk); phase_convert_layer(F, 1, CONV1_IN_QUEUE ? 1 : 3, F.bid, F.nblk); phase_norm(F, KIN(I_X), KIN(I_NORM_G), false);
        { unsigned* ctr = (unsigned*)(KWS() + WS_CTL) + CW_QUEUE + 128 + 16 * rep; volatile LAS unsigned* qs = MISC;
          for (;;) { __syncthreads(); if (F.tid == 0) qs[0] = __hip_atomic_fetch_add(ctr, 1u, __ATOMIC_RELAXED, __HIP_MEMORY_SCOPE_AGENT); __syncthreads();
              const int vb = (int)qs[0]; if (vb >= CONV_NVB) break; phase_convert_layer(F, 0, 2, vb, CONV_NVB); } } }
    SEAM(0);
    for (int l0 = 0; l0 < DEPTH; ++l0) {
        const int l = opaque_s(l0);
        const int pb = 2 + l * NPL;
        if (IN(pb + 0) && EN(2)) for (int rep = 0; rep < DUP(2); ++rep) {
            if (l == 0) {
                for (int l2 = 0; l2 < DEPTH; ++l2) { unsigned char* ws = KWS(); unsigned char* wl2 = ws + WS_W + (size_t)l2 * SZ_WLAYER;
                    pg8::Gemm g{(const char*)(ws + WS_MEMN) + (size_t)l2 * MM * 4096 * 2, (const char*)(wl2 + WO_WKV)};
                    EpiProj<1024, false> E{(bf16*)(ws + WS_KV) + (size_t)l2 * MM * 1024, nullptr};
                    const int cc = F.bid - (F.nblk - 16) - 8 * l2;
                    pg8::gemm_phase<pg8::Geo<8192, 8192, 4096, MM / 256, 4>, EpiProj<1024, false>>(F.lds, g, 8, (cc >= 0 && cc < 8) ? cc : 1000, F.wave, E); }
            }
            unsigned char* ws = KWS(); unsigned char* wl = ws + WS_W + (size_t)l * SZ_WLAYER;
            { pg8::Gemm g{(const char*)(ws + WS_H), (const char*)(wl + WO_WIN)};
              EpiProj<NPJ, true> E{(bf16*)(ws + WS_PROJ), (float*)(ws + WS_IFB)};
              pg8::gemm_phase<pg8::Geo<8192, 8192, 4096, M / 256, PN_I8>, EpiProj<NPJ, true>>(F.lds, g, F.nblk, F.bid, F.wave, E); }
            { pg8::Gemm g{(const char*)(ws + WS_H8), (const char*)(wl + WO_WIN) + (size_t)PC_I8 * 8192};
              EpiGate8 E{(bf16*)(ws + WS_PROJ) + PC_I8, (const float*)(ws + WS_HS), (const unsigned*)(ws + WS_CTL) + CW_CMAX + l * N8};
              pg8::gemm_phase<pg8::Geo<4096, 4096, 2048, M / 256, N8 / 256, 0, 0, true>, EpiGate8>(F.lds, g, F.nblk, F.bid, F.wave, E); }
        }
        SEAM(pb + 0);
        if (IN(pb + 1) && EN(3)) for (int rep = 0; rep < DUP(3); ++rep) { phase_prep(F, l); }
        SEAM(pb + 1);
        if (IN(pb + 2) && EN(4)) for (int rep = 0; rep < DUP(4); ++rep) {
            { unsigned char* ws = KWS(); unsigned char* wl = ws + WS_W + (size_t)l * SZ_WLAYER;
              pg8::Gemm g{(const char*)(ws + WS_U), (const char*)(wl + WO_WG)};
              EpiLru E{(const bf16*)(ws + WS_U), (float*)(ws + WS_LA), (float*)(ws + WS_LB), KIN(I_LRU_BA) + (size_t)l * 2048, KIN(I_LRU_BX) + (size_t)l * 2048, KIN(I_LRU_LAM) + (size_t)l * 2048};
              pg8::gemm_phase<pg8::Geo<4096, 512, 256, M / 256, 16, 1, 512>, EpiLru>(F.lds, g, F.nblk, F.bid, F.wave, E); }
            { unsigned char* ws = KWS(); unsigned char* wl = ws + WS_W + (size_t)l * SZ_WLAYER;
              pg8::Gemm g{(const char*)(ws + WS_LORA), (const char*)(wl + WO_WL)};
              EpiLora E{(float*)(ws + WS_RV), (float*)(ws + WS_AA), KIN(I_W0) + (size_t)l * 2048, KIN(I_A0) + (size_t)l * 2048};
              pg8::gemm_phase<pg8::Geo<512, 512, 256, M / 256, 16>, EpiLora>(F.lds, g, F.nblk, F.bid, F.wave, E); }
        }
        SEAM(pb + 2);
        if (IN(pb + 3) && EN(5)) for (int rep = 0; rep < DUP(5); ++rep) { phase_rwkv_vec(F, l); phase_lru_scan1(F); }
        SEAM(pb + 3);
        if (IN(pb + 4) && EN(6)) {
            for (int rep = 0; rep < DUP(6); ++rep) phase_rwkv_rec(F, F.bid, F.nblk);
#ifdef PROBE_Q
            phase_mlstm(F, l, (unsigned*)(KWS() + WS_CTL) + CW_QUEUE + 64 * l + 32, PROBE_Q_LO, PROBE_Q_HI);
#endif
            phase_mlstm(F, l, (unsigned*)(KWS() + WS_CTL) + CW_QUEUE + 64 * l);
        }
        SEAM(pb + 4);
        if (IN(pb + 5) && EN(7)) for (int rep = 0; rep < DUP(7); ++rep) { phase_rwkv_post(F, l); }
        SEAM(pb + 5);
        if (IN(pb + 6) && EN(8)) for (int rep = 0; rep < DUP(8); ++rep) {
            unsigned char* ws = KWS(); unsigned char* wl = ws + WS_W + (size_t)l * SZ_WLAYER;
            pg8::Gemm g{(const char*)(ws + WS_Y), (const char*)(wl + WO_WCAT)};
            EpiMerge E{(const bf16*)(ws + WS_PROJ) + PC_GATE, (bf16*)(ws + WS_MERGED)};
            pg8::gemm_phase<pg8::Geo<KCAT * 2, KCAT * 2, KCAT, M / 256, 16>, EpiMerge>(F.lds, g, F.nblk, F.bid, F.wave, E);
        }
        SEAM(pb + 6);
        if (IN(pb + 7) && EN(9)) for (int rep = 0; rep < ((l == 0) ? DUP(9) : 1); ++rep) {
            unsigned char* ws = KWS(); unsigned char* wl = ws + WS_W + (size_t)l * SZ_WLAYER;
            pg8::Gemm g{(const char*)(ws + WS_MERGED), (const char*)(wl + WO_WOUT)};
            EpiOut E{(l == 0) ? KIN(I_X) : (const float*)(ws + WS_X1), (float*)(ws + WS_X1)};
            pg8::gemm_phase<pg8::Geo<8192, 8192, 4096, M / 256, 16>, EpiOut>(F.lds, g, F.nblk, F.bid, F.wave, E);
        }
        SEAM(pb + 7);
        if (IN(pb + 8) && EN(10)) { const float* X1 = (const float*)(KWS() + WS_X1); if (l + 1 < DEPTH) phase_norm(F, X1, KIN(I_NORM_G) + (size_t)(l + 1) * 4096, false); else phase_norm(F, X1, KIN(I_FNG), true); }
        SEAM(pb + 8);
    }
#undef IN
#undef SEAM
}

typedef void (*kern_t)(Args);
static kern_t phase_kernel(int p) {
    const int j = p < 2 ? p : 2 + (p - 2) % NPL;
    switch (j) { case 0: return mega<1u << 0>; case 1: return mega<1u << 1>; case 2: return mega<1u << 2>; case 3: return mega<1u << 3>; case 4: return mega<1u << 4>; case 5: return mega<1u << 5>;
                 case 6: return mega<1u << 6>; case 7: return mega<1u << 7>; case 8: return mega<1u << 8>; case 9: return mega<1u << 9>; default: return mega<1u << 10>; }
}
extern "C" void kernel_launch(void* const* d_in, const int* in_sizes, int n_in, void* d_out, int out_size, void* d_ws, size_t ws_size, hipStream_t stream) {
    static int grid = 0;
    if (grid == 0) {
        if (n_in != 34 || ws_size < WS_END) { fprintf(stderr, "kernel_launch: unexpected problem (n_in %d, ws %zu, need %zu)\n", n_in, ws_size, (size_t)WS_END); grid = -1; return; }
        int dev = 0, cus = 0;
        if (hipGetDevice(&dev) != hipSuccess || hipDeviceGetAttribute(&cus, hipDeviceAttributeMultiprocessorCount, dev) != hipSuccess) { grid = -1; return; }
#if MK_PER_PHASE
        for (int p = 0; p < 2 + NPL; ++p) if (hipFuncSetAttribute((const void*)phase_kernel(p), hipFuncAttributeMaxDynamicSharedMemorySize, LDS_BYTES) != hipSuccess) { fprintf(stderr, "kernel_launch: hipFuncSetAttribute failed\n"); grid = -1; return; }
#else
        if (hipFuncSetAttribute((const void*)mega<0x7FFu>, hipFuncAttributeMaxDynamicSharedMemorySize, LDS_BYTES) != hipSuccess) { fprintf(stderr, "kernel_launch: hipFuncSetAttribute failed\n"); grid = -1; return; }
#endif
        int occ = 0;
#if MK_PER_PHASE
        occ = 1;
#else
        if (hipOccupancyMaxActiveBlocksPerMultiprocessor(&occ, mega<0x7FFu>, NTHREADS, LDS_BYTES) != hipSuccess || occ < 1) { fprintf(stderr, "kernel_launch: occupancy query reports %d workgroups per CU\n", occ); grid = -1; return; }
#endif
        (void)hipGetLastError();
        grid = cus;
    }
    if (grid < 0) return;
    (void)hipMemsetAsync((char*)d_ws + WS_CTL, 0, CTL_ZERO_BYTES, stream);
    Args a{};
    for (int i = 0; i < 34; ++i) a.c.in[i] = (const float*)d_in[i];
    a.c.out = (float*)d_out; a.c.ws = (unsigned char*)d_ws;
#if MK_PER_PHASE
    for (int p = 0; p < NPHASE; ++p) { a.ph_lo = p; a.ph_hi = p + 1; hipLaunchKernelGGL(phase_kernel(p), dim3(grid), dim3(NTHREADS), LDS_BYTES, stream, a); }
#else
    a.ph_lo = 0; a.ph_hi = NPHASE; hipLaunchKernelGGL(mega<0x7FFu>, dim3(grid), dim3(NTHREADS), LDS_BYTES, stream, a);
#endif
    (void)in_sizes; (void)out_size;
}
```

```cpp
#include <hip/hip_runtime.h>
#include <cstdio>
#include <cstdint>

#ifndef MK_PER_PHASE
#define MK_PER_PHASE 0
#endif

#define LAS __attribute__((address_space(3)))
#define GAS __attribute__((address_space(1)))
typedef unsigned short bf16;
typedef short bf16x8 __attribute__((ext_vector_type(8)));
typedef short s16x4 __attribute__((ext_vector_type(4)));
typedef float f32x4 __attribute__((ext_vector_type(4)));
typedef float f32x2 __attribute__((ext_vector_type(2)));
typedef unsigned u32x4 __attribute__((ext_vector_type(4)));
typedef unsigned u32x2 __attribute__((ext_vector_type(2)));
typedef int i32x4 __attribute__((ext_vector_type(4)));

constexpr int D = 4096, NBATCH = 2, SEQ = 4096, M = NBATCH * SEQ, DEPTH = 2, MEML = 256, MM = NBATCH * MEML;
constexpr int CIN = 38088;
constexpr int NPJ = 38400;
constexpr int PC_AX = 0, PC_AG = 2048, PC_BR = 4096, PC_BK = 6144, PC_BV = 8192, PC_BWD = 10240, PC_BAD = 10368, PC_BG = 10496,
              PC_CQK = 12544, PC_CV = 14592, PC_CG = 16640, PC_XQ = 18688, PC_XG = 19200, PC_IF = 19712, PC_CO = 19968, PC_GATE = 22016;
constexpr int PN_IF = PC_IF / 256;
constexpr int KCAT = 6656;
constexpr int YC_A = 0, YC_B = 2048, YC_C = 4096, YC_X = 6144;

constexpr size_t MiB = 1u << 20;
constexpr size_t WS_CTL = 0, CTL_ZERO_BYTES = 1 * MiB;
constexpr size_t SZ_WIN = 300 * MiB, SZ_WCAT = 52 * MiB, SZ_WOUT = 32 * MiB, SZ_WKV = 8 * MiB, SZ_WG = 2 * MiB, SZ_WL = 2 * MiB;
constexpr size_t SZ_WLAYER = SZ_WIN + SZ_WCAT + SZ_WOUT + SZ_WKV + SZ_WG + SZ_WL;
constexpr size_t WS_W = 1 * MiB;
constexpr size_t WO_WIN = 0, WO_WCAT = SZ_WIN, WO_WOUT = WO_WCAT + SZ_WCAT, WO_WKV = WO_WOUT + SZ_WOUT, WO_WG = WO_WKV + SZ_WKV, WO_WL = WO_WG + SZ_WG;
constexpr size_t WS_MEMN = WS_W + 2 * SZ_WLAYER;
constexpr size_t WS_KV = WS_MEMN + 8 * MiB;
constexpr size_t WS_H = WS_KV + 2 * MiB;
constexpr size_t WS_PROJ = WS_H + 64 * MiB;
constexpr size_t WS_IFB = WS_PROJ + 600 * MiB;
constexpr size_t WS_U = WS_IFB + 1 * MiB;
constexpr size_t WS_LA = WS_U + 32 * MiB;
constexpr size_t WS_LB = WS_LA + 64 * MiB;
constexpr size_t WS_CARRY = WS_LB + 64 * MiB;
constexpr size_t WS_LORA = WS_CARRY + 1 * MiB;
constexpr size_t WS_WDEC = WS_LORA + 4 * MiB;
constexpr size_t WS_AA = WS_WDEC + 64 * MiB;
constexpr size_t WS_RV = WS_AA + 64 * MiB;
constexpr size_t WS_VV = WS_RV + 320 * MiB;
constexpr size_t WS_BON = WS_VV + 64 * MiB;
constexpr size_t WS_YR = WS_BON + 1 * MiB;
constexpr size_t WS_QC = WS_YR + 64 * MiB;
constexpr size_t WS_KC = WS_QC + 16 * MiB;
constexpr size_t WS_SCAL = WS_KC + 16 * MiB;
constexpr size_t WS_HC = WS_SCAL + 1 * MiB;
constexpr size_t WS_Y = WS_HC + 64 * MiB;
constexpr size_t WS_MERGED = WS_Y + 104 * MiB;
constexpr size_t WS_X1 = WS_MERGED + 64 * MiB;
constexpr size_t WS_H8 = WS_X1 + 128 * MiB;
constexpr size_t WS_HS = WS_H8 + 32 * MiB;
constexpr size_t WS_END = WS_HS + 1 * MiB;
constexpr int CW_BAR = 4096, CW_QUEUE = 8192;
constexpr int CW_CMAX = 131072;
constexpr int NGATE = 16384, PC_I8 = PC_CO, N8 = 2048 + NGATE, PN_I8 = PC_I8 / 256;
#ifndef CONV1_IN_QUEUE
#define CONV1_IN_QUEUE 1
#endif
constexpr int CONV_NVB = 512;

constexpr int RING_BYTES = 155648;
constexpr int MISC_OFF = RING_BYTES;
constexpr int LDS_BYTES = 159744;
constexpr int NWAVES = 8, NTHREADS = 512;

__device__ __forceinline__ float bf2f(unsigned short b) { return __uint_as_float(((unsigned)b) << 16); }
__device__ __forceinline__ unsigned f2bf(float f) { unsigned u = __float_as_uint(f); return (u + 0x7fffu + ((u >> 16) & 1u)) >> 16; }
__device__ __forceinline__ unsigned pk2(float lo, float hi) { return f2bf(lo) | (f2bf(hi) << 16); }
__device__ __forceinline__ unsigned cvt_pk_bf16(float lo, float hi) { unsigned r; asm volatile("v_cvt_pk_bf16_f32 %0, %1, %2" : "=v"(r) : "v"(lo), "v"(hi)); return r; }
__device__ __forceinline__ float sigm(float x) { return __builtin_amdgcn_rcpf(1.0f + __expf(-x)); }
__device__ __forceinline__ float siluf_(float x) { return x * __builtin_amdgcn_rcpf(1.0f + __expf(-x)); }
__device__ __forceinline__ float softplusf_(float x) { return fmaxf(x, 0.f) + __logf(1.0f + __expf(-fabsf(x))); }
__device__ __forceinline__ float expm1s_(float x) { const float p = x * (1.0f + x * (0.5f + x * (0.16666667f + x * (0.041666668f + x * 0.0083333338f)))); return fabsf(x) < 0.25f ? p : __expf(x) - 1.0f; }

template <int CTRL> __device__ __forceinline__ float dpp_mov(float v) { return __int_as_float(__builtin_amdgcn_update_dpp(0, __float_as_int(v), CTRL, 0xf, 0xf, true)); }
__device__ __forceinline__ float row16_sum(float v) {
    v += dpp_mov<0xB1>(v); v += dpp_mov<0x4E>(v); v += dpp_mov<0x141>(v); v += dpp_mov<0x140>(v); return v;
}
__device__ __forceinline__ float wave_sum(float v) { v = row16_sum(v); v += __shfl_xor(v, 16); v += __shfl_xor(v, 32); return v; }
__device__ __forceinline__ float row16_max(float v) {
    v = fmaxf(v, dpp_mov<0xB1>(v)); v = fmaxf(v, dpp_mov<0x4E>(v)); v = fmaxf(v, dpp_mov<0x141>(v)); v = fmaxf(v, dpp_mov<0x140>(v)); return v;
}
__device__ __forceinline__ void unpack8(const u32x4 w, float* f) {
    f[0] = __uint_as_float(w.x << 16); f[1] = __uint_as_float(w.x & 0xffff0000u); f[2] = __uint_as_float(w.y << 16); f[3] = __uint_as_float(w.y & 0xffff0000u);
    f[4] = __uint_as_float(w.z << 16); f[5] = __uint_as_float(w.z & 0xffff0000u); f[6] = __uint_as_float(w.w << 16); f[7] = __uint_as_float(w.w & 0xffff0000u);
}
__device__ __forceinline__ int opaque_v(int v) { asm volatile("" : "+v"(v)); return v; }
template <class T> __device__ __forceinline__ const T* opaque_p(const T* p) { asm volatile("" : "+s"(p)); return p; }
__device__ __forceinline__ int opaque_s(int v) { asm volatile("" : "+s"(v)); return v; }
__device__ __forceinline__ int lane_id() { unsigned z; asm volatile("v_mov_b32 %0, 0" : "=v"(z)); return (int)__builtin_amdgcn_mbcnt_hi(~0u, __builtin_amdgcn_mbcnt_lo(~0u, z)); }
#define LDS_WAIT() asm volatile("s_waitcnt lgkmcnt(0)" ::: "memory")
#define VM_WAIT() asm volatile("s_waitcnt vmcnt(0)" ::: "memory")

#define XB_TMO      128
#define XB_XCNT(j)  (256  + 64 * (j))
#define XB_XSUB(j)  (1280 + 64 * (j))
#define XB_XGEN(j)  (2304 + 64 * (j))
#define XB_TOP      3328
#define XB_TOPGEN   3392
#define XCD_BAR_WORDS 3456
#define XB_SPIN_CAP (1u << 18)
__device__ __forceinline__ unsigned xb_ld(unsigned* p)              { return __hip_atomic_load(p, __ATOMIC_RELAXED, __HIP_MEMORY_SCOPE_AGENT); }
__device__ __forceinline__ unsigned xb_add(unsigned* p, unsigned v) { return __hip_atomic_fetch_add(p, v, __ATOMIC_RELAXED, __HIP_MEMORY_SCOPE_AGENT); }
__device__ __forceinline__ unsigned xb_xcc_id() { return (unsigned)__builtin_amdgcn_s_getreg((3 << 11) | 20) & 0xFu; }
#define XB_SPIN(cond, bar) do { unsigned _sp = 0; while (cond) { __builtin_amdgcn_s_sleep(1); \
    if ((++_sp & 255u) == 0u) { if (xb_ld(&(bar)[XB_TMO])) break; if (_sp > XB_SPIN_CAP) { atomicAdd(&(bar)[XB_TMO], 1u); break; } } } } while (0)
struct XcdBarrier { unsigned* bar; volatile LAS unsigned* st; };
__device__ __forceinline__ void xcd_barrier_setup(const XcdBarrier& b, const int wave_) {
    if (opaque_s(wave_) == 0 && lane_id() == 0) {
        unsigned* bar = b.bar; const unsigned x = xb_xcc_id();
        (void)xb_add(&bar[XB_XCNT(x)], 1u);
        const unsigned G = gridDim.x * gridDim.y * gridDim.z;
        unsigned sum, cnt, mine, sp = 0u;
        for (;;) {
            sum = 0u; cnt = 0u; mine = 0u;
            for (unsigned j = 0; j < 16; ++j) { const unsigned c = xb_ld(&bar[XB_XCNT(j)]); sum += c; cnt += (c > 0u) ? 1u : 0u; mine = (j == x) ? c : mine; }
            if (sum == G) break;
            __builtin_amdgcn_s_sleep(1);
            if ((++sp & 255u) == 0u) { if (xb_ld(&bar[XB_TMO])) break; if (sp > XB_SPIN_CAP) { atomicAdd(&bar[XB_TMO], 1u); break; } }
        }
        b.st[0] = mine > 0u ? mine : 1u; b.st[1] = cnt > 0u ? cnt : 1u; b.st[2] = x;
    }
    __syncthreads();
}
__device__ __forceinline__ void xcd_barrier(const XcdBarrier& b, const int wave_) {
    asm volatile("s_waitcnt vmcnt(0)" ::: "memory");
    __syncthreads();
    if (opaque_s(wave_) == 0 && lane_id() == 0) {
        unsigned* bar = b.bar;
        __builtin_amdgcn_s_waitcnt(0);
        const unsigned nloc = b.st[0], nx = b.st[1], x = b.st[2];
        const unsigned old = xb_add(&bar[XB_XSUB(x)], 1u);
        const unsigned gen = old / nloc;
        if (old + 1u == (gen + 1u) * nloc) {
            __builtin_amdgcn_fence(__ATOMIC_RELEASE, "agent");
            asm volatile("s_waitcnt vmcnt(0)" ::: "memory");
            const unsigned og = xb_add(&bar[XB_TOP], 1u);
            const unsigned tg = og / nx;
            if (og + 1u == (tg + 1u) * nx) xb_add(&bar[XB_TOPGEN], 1u);
            else XB_SPIN(xb_ld(&bar[XB_TOPGEN]) == tg, bar);
            __builtin_amdgcn_fence(__ATOMIC_ACQUIRE, "agent");
            xb_add(&bar[XB_XGEN(x)], 1u);
            asm volatile("s_waitcnt vmcnt(0)" ::: "memory");
        } else {
            XB_SPIN(xb_ld(&bar[XB_XGEN(x)]) == gen, bar);
            __builtin_amdgcn_fence(__ATOMIC_ACQUIRE, "agent");
            asm volatile("s_waitcnt vmcnt(0)" ::: "memory");
        }
    }
    __syncthreads();
}

namespace pg8 {
constexpr int BM = 256, BK = 64, HALF = 128, HTB = HALF * BK * 2, STAGE_BYTES = 8 * HTB, NXCD = 8, WGM = 8;
__host__ __device__ __forceinline__ int lds_byte(int r, int c) { const int st = (r >> 4) * 2 + (c >> 5), rr = r & 15, cc = c & 31, ob = rr * 64 + cc * 2; return st * 1024 + (ob ^ (((ob >> 9) & 1) << 5)); }
__host__ __device__ __forceinline__ void stage_rc(int b, int& R, int& C) { const int st = b / 1024, sb = b % 1024, swz = sb ^ (((sb >> 9) & 1) << 5); R = (st >> 1) * 16 + swz / 64; C = (st & 1) * 32 + (swz % 64) / 2; }
__host__ __device__ __forceinline__ int perm32(int rho) { const int n = rho >> 4, i = rho & 15; return 8 * (i >> 2) + 4 * n + (i & 3); }
struct Unit { int pm, pn; };
struct Gemm { const char* A; const char* Bt; };
template <int LDA_, int LDB_, int K_, int NM_, int NN_, int ASHIFT_ = 0, int ASTEP_ = 0, bool I8_ = false> struct Geo { static constexpr int LDA = LDA_, LDB = LDB_, K = K_, NM = NM_, NN = NN_, ASHIFT = ASHIFT_, ASTEP = ASTEP_; static constexpr bool I8 = I8_; };
template <bool I8> __device__ __forceinline__ f32x4 mma16(const bf16x8 a, const bf16x8 b, const f32x4 c) {
    if constexpr (I8) return __builtin_bit_cast(f32x4, __builtin_amdgcn_mfma_i32_16x16x64_i8(__builtin_bit_cast(i32x4, a), __builtin_bit_cast(i32x4, b), __builtin_bit_cast(i32x4, c), 0, 0, 0));
    else return __builtin_amdgcn_mfma_f32_16x16x32_bf16(a, b, c, 0, 0, 0); }
struct StaticOrder {
    int nM, nN, nwg, G, c;
    __device__ void init(int nM_, int nN_, int G_, int c_) { nM = nM_; nN = nN_; nwg = nM * nN; G = G_; c = c_; }
    __device__ bool next(int i, Unit& u) const {
        const long L = (long)i * G + c; if (L >= nwg) return false;
        int wgid = (int)L; { const int q = nwg / NXCD, r = nwg % NXCD, xcd = wgid % NXCD, off = wgid / NXCD; wgid = (xcd < r ? xcd * (q + 1) : r * (q + 1) + (xcd - r) * q) + off; }
        const int nig = WGM * nN, gid = wgid / nig, fm = gid * WGM, gsz = (nM - fm) < WGM ? (nM - fm) : WGM;
        u.pm = fm + ((wgid % nig) % gsz); u.pn = (wgid % nig) / gsz; return true;
    }
};
template <class GEO, class Epi>
__device__ __forceinline__ void gemm_phase(LAS unsigned char* lds, const Gemm g, const int G_, const int c_, const int wave_, const Epi& E) {
    StaticOrder S; S.init(GEO::NM, GEO::NN, opaque_s(G_), opaque_s(c_));
    const int wid = opaque_s(wave_), lane = lane_id(), tid = wid * 64 + lane, wr = wid >> 2, wc = wid & 3, fr = lane & 15, fq = lane >> 4;
    constexpr int nt = GEO::K / BK;
    unsigned voffA[2], voffB[2];
#pragma unroll
    for (int i = 0; i < 2; ++i) { int R, C; stage_rc(tid * 16 + i * 8192, R, C); const int Rb = Epi::PERM ? ((R & ~31) + perm32(R & 31)) : R;
        voffA[i] = (unsigned)(R * GEO::LDA + C * 2); voffB[i] = (unsigned)(Rb * GEO::LDB + C * 2); }
    constexpr size_t kstep = (size_t)(BK * 2);
    constexpr size_t hstepA = (size_t)HALF * GEO::LDA, hstepB = (size_t)HALF * GEO::LDB;
    const unsigned ldsw = (unsigned)wid * 1024u;
    const int aoff = lds_byte(wr * 64 + fr, fq * 8), boff = lds_byte(wc * 32 + fr, fq * 8);
#define PG8_SA(b, h) (((b) * 2 + (h)) * HTB)
#define PG8_SB(b, h) ((4 + (b) * 2 + (h)) * HTB)
#define PG8_STAGE(bufoff, gbase, voff) do { _Pragma("unroll") for (int _i = 0; _i < 2; ++_i) \
        __builtin_amdgcn_global_load_lds((const unsigned*)((const char*)(gbase) + (voff)[_i]), (LAS unsigned*)(lds + (bufoff) + ldsw + _i * 8192), 16, 0, 0); } while (0)
#define PG8_LDA(dst, b, h) do { _Pragma("unroll") for (int m = 0; m < 4; ++m) _Pragma("unroll") for (int k = 0; k < 2; ++k) dst[m][k] = *(const LAS bf16x8*)(lds + PG8_SA(b, h) + aoff + m * 2048 + k * 1024); } while (0)
#define PG8_LDB(dst, b, h) do { _Pragma("unroll") for (int n = 0; n < 2; ++n) _Pragma("unroll") for (int k = 0; k < 2; ++k) dst[n][k] = *(const LAS bf16x8*)(lds + PG8_SB(b, h) + boff + n * 2048 + k * 1024); } while (0)
#define PG8_MMA(ai, bj, At, Bt) do { __builtin_amdgcn_s_setprio(1); _Pragma("unroll") for (int m = 0; m < 4; ++m) _Pragma("unroll") for (int n = 0; n < 2; ++n) _Pragma("unroll") for (int k = 0; k < 2; ++k) \
        acc[ai][bj][m][n] = mma16<GEO::I8>(Bt[n][k], At[m][k], acc[ai][bj][m][n]); __builtin_amdgcn_s_setprio(0); } while (0)
#define PG8_WAIT_V(n) asm volatile("s_waitcnt vmcnt(" #n ")" ::: "memory")
#define PG8_WAIT_L(n) asm volatile("s_waitcnt lgkmcnt(" #n ")" ::: "memory")
#define PG8_BAR __builtin_amdgcn_s_barrier()
#define PG8_SCHED __builtin_amdgcn_sched_barrier(0)
    Unit cur, nxt; int ui = 0;
    if (!S.next(0, cur)) return;
    f32x4 acc[2][2][4][2];
#pragma unroll
    for (int a = 0; a < 2; ++a)
#pragma unroll
        for (int b = 0; b < 2; ++b)
#pragma unroll
            for (int m = 0; m < 4; ++m)
#pragma unroll
                for (int n = 0; n < 2; ++n) acc[a][b][m][n] = (f32x4){0.f, 0.f, 0.f, 0.f};
    bf16x8 At[4][2], B0[2][2], B1[2][2];
    const char* cA = g.A + (size_t)cur.pm * (BM * GEO::LDA) + (size_t)((cur.pn >> GEO::ASHIFT) * GEO::ASTEP);
    const char* cB = g.Bt + (size_t)cur.pn * (BM * GEO::LDB);
    PG8_STAGE(PG8_SB(0, 0), cB, voffB); PG8_STAGE(PG8_SB(0, 1), cB + hstepB, voffB); PG8_STAGE(PG8_SA(0, 0), cA, voffA); PG8_STAGE(PG8_SA(0, 1), cA + hstepA, voffA);
    if (wr == 1) PG8_BAR;
    PG8_WAIT_V(2); PG8_BAR;
    PG8_STAGE(PG8_SB(1, 0), cB + kstep, voffB); PG8_STAGE(PG8_SA(1, 0), cA + kstep, voffA); PG8_STAGE(PG8_SB(1, 1), cB + hstepB + kstep, voffB);
    PG8_WAIT_V(6); PG8_BAR;
    for (;;) {
        const bool has_next = S.next(ui + 1, nxt);
        const char* nA = has_next ? g.A + (size_t)nxt.pm * (BM * GEO::LDA) + (size_t)((nxt.pn >> GEO::ASHIFT) * GEO::ASTEP) : cA;
        const char* nB = has_next ? g.Bt + (size_t)nxt.pn * (BM * GEO::LDB) : cB;
#pragma unroll 1
        for (int t = 0; t < nt; t += 2) {
            const bool last = (t == nt - 2);
            const char* a1 = cA + (size_t)(t + 1) * kstep;
            const char* a2 = last ? nA : cA + (size_t)(t + 2) * kstep; const char* b2 = last ? nB : cB + (size_t)(t + 2) * kstep;
            const char* a3 = a2 + kstep; const char* b3 = b2 + kstep;
            if constexpr (Epi::HOOK) { if (t != 0 && (t & 31) == 0) E.hook(acc, cur, (t >> 5) - 1, wr, wc, fr, fq); }
            PG8_LDB(B0, 0, 0); PG8_LDB(B1, 0, 1); PG8_SCHED; PG8_LDA(At, 0, 0); PG8_STAGE(PG8_SA(1, 1), a1 + hstepA, voffA);
            PG8_WAIT_V(8); PG8_WAIT_L(0); PG8_BAR; PG8_MMA(0, 0, At, B0); PG8_MMA(0, 1, At, B1); PG8_BAR; PG8_SCHED;
            PG8_LDA(At, 0, 1); PG8_STAGE(PG8_SB(0, 0), b2, voffB); PG8_STAGE(PG8_SB(0, 1), b2 + hstepB, voffB); PG8_STAGE(PG8_SA(0, 0), a2, voffA);
            PG8_WAIT_V(8); PG8_WAIT_L(0); PG8_BAR; PG8_MMA(1, 0, At, B0); PG8_MMA(1, 1, At, B1); PG8_BAR; PG8_SCHED;
            PG8_LDB(B0, 1, 0); PG8_LDB(B1, 1, 1); PG8_SCHED; PG8_LDA(At, 1, 0); PG8_STAGE(PG8_SA(0, 1), a2 + hstepA, voffA);
            PG8_WAIT_V(8); PG8_WAIT_L(0); PG8_BAR; PG8_MMA(0, 0, At, B0); PG8_MMA(0, 1, At, B1); PG8_BAR; PG8_SCHED;
            PG8_LDA(At, 1, 1); PG8_STAGE(PG8_SB(1, 0), b3, voffB); PG8_STAGE(PG8_SB(1, 1), b3 + hstepB, voffB); PG8_STAGE(PG8_SA(1, 0), a3, voffA);
            PG8_WAIT_V(8); PG8_WAIT_L(0); PG8_BAR; PG8_MMA(1, 0, At, B0); PG8_MMA(1, 1, At, B1); PG8_BAR; PG8_SCHED;
        }
        if (wr == 0) PG8_BAR;
        E(acc, cur, wr, wc, fr, fq);
        if (!has_next) break;
#pragma unroll
        for (int a = 0; a < 2; ++a)
#pragma unroll
            for (int b = 0; b < 2; ++b)
#pragma unroll
                for (int m = 0; m < 4; ++m)
#pragma unroll
                    for (int n = 0; n < 2; ++n) acc[a][b][m][n] = (f32x4){0.f, 0.f, 0.f, 0.f};
        cur = nxt; cA = nA; cB = nB; ++ui;
        if (wr == 1) PG8_BAR;
    }
    PG8_WAIT_V(0);
    PG8_BAR;
#undef PG8_SA
#undef PG8_SB
#undef PG8_STAGE
#undef PG8_LDA
#undef PG8_LDB
#undef PG8_MMA
#undef PG8_WAIT_V
#undef PG8_WAIT_L
#undef PG8_BAR
#undef PG8_SCHED
}
}

struct Ctx { const float* in[34]; float* out; unsigned char* ws; };
enum { I_X = 0, I_MEM, I_NORM_G, I_MEMNORM_G, I_WIN, I_LRU_CW, I_LRU_CB, I_LRU_WA, I_LRU_BA, I_LRU_WX, I_LRU_BX, I_LRU_LAM, I_MU, I_W0, I_WUP, I_A0, I_AUP,
       I_KK, I_KA, I_RK, I_GNW, I_GNB, I_MCW, I_MCB, I_MBI, I_MBF, I_MGNW, I_WKV, I_WBA, I_WBB, I_WBC, I_WBX, I_WOUT, I_FNG };


typedef const __attribute__((address_space(4))) char* kargp_t;
template <int OFF> __device__ __forceinline__ unsigned long long karg_u64() {
    kargp_t kp = (kargp_t)__builtin_amdgcn_kernarg_segment_ptr(); unsigned long long v;
    asm volatile("s_load_dwordx2 %0, %1, %2\n\ts_waitcnt lgkmcnt(0)" : "=s"(v) : "s"(kp), "i"(OFF)); return v; }
#define KIN(i) ((const float*)(const GAS float*)karg_u64<(i) * 8>())
#define KOUT() ((float*)(GAS float*)karg_u64<34 * 8>())
#define KWS() ((unsigned char*)(GAS unsigned char*)karg_u64<35 * 8>())

template <int ldc, bool HAS_IF> struct EpiProj {
    static constexpr bool PERM = true, HOOK = false;
    bf16* O; float* ifb;
    __device__ __forceinline__ void operator()(const f32x4 (&acc)[2][2][4][2], const pg8::Unit& u, int wr, int wc, int fr, int fq) const {
        const int row0 = u.pm * 256 + wr * 64 + fr, col0 = u.pn * 256 + wc * 32 + 8 * fq;
#pragma unroll
        for (int ai = 0; ai < 2; ++ai)
#pragma unroll
            for (int m = 0; m < 4; ++m) { const int row = row0 + ai * 128 + m * 16; bf16* rowp = O + (size_t)row * ldc + col0;
#pragma unroll
                for (int bj = 0; bj < 2; ++bj) { const f32x4 v0 = acc[ai][bj][m][0], v1 = acc[ai][bj][m][1];
                    u32x4 w; w.x = cvt_pk_bf16(v0[0], v0[1]); w.y = cvt_pk_bf16(v0[2], v0[3]); w.z = cvt_pk_bf16(v1[0], v1[1]); w.w = cvt_pk_bf16(v1[2], v1[3]);
                    *(u32x4*)(rowp + bj * 128) = w; }
                if (HAS_IF && u.pn == PN_IF && wc == 0 && fq == 0) { *(f32x4*)(ifb + (size_t)row * 8) = acc[ai][0][m][0]; *(f32x4*)(ifb + (size_t)row * 8 + 4) = acc[ai][0][m][1]; }
            }
    }
};
__device__ __forceinline__ void gl2n_issue(u32x4& a0, u32x4& a1, const void* pa, unsigned voff) {
    asm volatile("s_nop 4\n\tglobal_load_dwordx4 %0, %2, %3\n\tglobal_load_dwordx4 %1, %2, %3 offset:16" : "=&v"(a0), "=&v"(a1) : "v"(voff), "s"(pa) : "memory"); }
#define GL_WAIT4(g) asm volatile("s_waitcnt vmcnt(0)" : "+v"(g[0]), "+v"(g[1]), "+v"(g[2]), "+v"(g[3]) :: "memory")
struct EpiGate8 {
    static constexpr bool PERM = true, HOOK = false;
    bf16* O; const float* hs; const unsigned* cmax;
    __device__ __forceinline__ void operator()(const f32x4 (&acc)[2][2][4][2], const pg8::Unit& u, int wr, int wc, int fr, int fq) const {
        const int row0 = u.pm * 256 + wr * 64 + fr, col0 = u.pn * 256 + wc * 32 + 8 * fq;
        u32x4 cs[4]; const unsigned coff = (unsigned)((wc * 32 + 8 * fq) * 4);
        gl2n_issue(cs[0], cs[1], cmax + u.pn * 256, coff); gl2n_issue(cs[2], cs[3], cmax + u.pn * 256 + 128, coff);
        float rsv[8]; { const float* hb = hs + u.pm * 256 + wr * 64; const unsigned roff = (unsigned)(fr * 4);
            asm volatile("s_nop 4\n\tglobal_load_dword %0, %8, %9\n\tglobal_load_dword %1, %8, %9 offset:64\n\tglobal_load_dword %2, %8, %9 offset:128\n\tglobal_load_dword %3, %8, %9 offset:192\n\t"
                         "global_load_dword %4, %8, %9 offset:512\n\tglobal_load_dword %5, %8, %9 offset:576\n\tglobal_load_dword %6, %8, %9 offset:640\n\tglobal_load_dword %7, %8, %9 offset:704\n\ts_waitcnt vmcnt(0)"
                         : "=&v"(rsv[0]), "=&v"(rsv[1]), "=&v"(rsv[2]), "=&v"(rsv[3]), "=&v"(rsv[4]), "=&v"(rsv[5]), "=&v"(rsv[6]), "=&v"(rsv[7]) : "v"(roff), "s"(hb) : "memory"); }
        GL_WAIT4(cs);
        float wsc[2][8];
#pragma unroll
        for (int bj = 0; bj < 2; ++bj)
#pragma unroll
            for (int j = 0; j < 8; ++j) wsc[bj][j] = __uint_as_float(cs[2 * bj + (j >> 2)][j & 3]) * (1.0f / 127.0f);
#pragma unroll
        for (int ai = 0; ai < 2; ++ai)
#pragma unroll
            for (int m = 0; m < 4; ++m) { const int row = row0 + ai * 128 + m * 16; const float rs = rsv[ai * 4 + m]; bf16* rowp = O + (size_t)row * NPJ + col0;
#pragma unroll
                for (int bj = 0; bj < 2; ++bj) { const i32x4 v0 = __builtin_bit_cast(i32x4, acc[ai][bj][m][0]), v1 = __builtin_bit_cast(i32x4, acc[ai][bj][m][1]);
                    u32x4 w; w.x = cvt_pk_bf16((float)v0[0] * (rs * wsc[bj][0]), (float)v0[1] * (rs * wsc[bj][1])); w.y = cvt_pk_bf16((float)v0[2] * (rs * wsc[bj][2]), (float)v0[3] * (rs * wsc[bj][3]));
                    w.z = cvt_pk_bf16((float)v1[0] * (rs * wsc[bj][4]), (float)v1[1] * (rs * wsc[bj][5])); w.w = cvt_pk_bf16((float)v1[2] * (rs * wsc[bj][6]), (float)v1[3] * (rs * wsc[bj][7]));
                    *(u32x4*)(rowp + bj * 128) = w; } }
    }
};
struct EpiLru {
    static constexpr bool PERM = true, HOOK = false;
    const bf16* U; float* LA; float* LB; const float* ba; const float* bx; const float* lam;
    __device__ __forceinline__ void operator()(const f32x4 (&acc)[2][2][4][2], const pg8::Unit& u, int wr, int wc, int fr, int fq) const {
        const int row0 = u.pm * 256 + wr * 64 + fr, ch0 = u.pn * 128 + wc * 32 + 8 * fq;
        float cba[8], cbx[8], csp[8];
#pragma unroll
        for (int j = 0; j < 8; ++j) { cba[j] = ba[ch0 + j]; cbx[j] = bx[ch0 + j]; csp[j] = -8.0f * softplusf_(-lam[ch0 + j]); }
        u32x4 uws[8];
#pragma unroll
        for (int i = 0; i < 8; ++i) uws[i] = *(const u32x4*)(U + (size_t)(row0 + (i >> 2) * 128 + (i & 3) * 16) * 2048 + ch0);
        asm volatile("" ::: "memory");
#pragma unroll
        for (int ai = 0; ai < 2; ++ai)
#pragma unroll
            for (int m = 0; m < 4; ++m) { const int row = row0 + ai * 128 + m * 16;
                float uf[8]; unpack8(uws[ai * 4 + m], uf);
                float a8[8], b8[8];
#pragma unroll
                for (int n = 0; n < 2; ++n)
#pragma unroll
                    for (int j = 0; j < 4; ++j) { const int q = 4 * n + j;
                        const float r = sigm(acc[ai][0][m][n][j] + cba[q]), ig = sigm(acc[ai][1][m][n][j] + cbx[q]);
                        const float la = csp[q] * r; a8[q] = __expf(la); b8[q] = sqrtf(-expm1s_(2.0f * la)) * (ig * uf[q]); }
                float* pa = LA + (size_t)row * 2048 + ch0; float* pb = LB + (size_t)row * 2048 + ch0;
                *(f32x4*)pa = (f32x4){a8[0], a8[1], a8[2], a8[3]}; *(f32x4*)(pa + 4) = (f32x4){a8[4], a8[5], a8[6], a8[7]};
                *(f32x4*)pb = (f32x4){b8[0], b8[1], b8[2], b8[3]}; *(f32x4*)(pb + 4) = (f32x4){b8[4], b8[5], b8[6], b8[7]};
            }
    }
};
struct EpiLora {
    static constexpr bool PERM = true, HOOK = false;
    float* WDEC; float* AA; const float* w0; const float* a0;
    __device__ __forceinline__ void operator()(const f32x4 (&acc)[2][2][4][2], const pg8::Unit& u, int wr, int wc, int fr, int fq) const {
        const int row0 = u.pm * 256 + wr * 64 + fr, ch0 = u.pn * 128 + wc * 32 + 8 * fq;
        float cw0[8], ca0[8];
#pragma unroll
        for (int j = 0; j < 8; ++j) { cw0[j] = w0[ch0 + j]; ca0[j] = a0[ch0 + j]; }
#pragma unroll
        for (int ai = 0; ai < 2; ++ai)
#pragma unroll
            for (int m = 0; m < 4; ++m) { const int row = row0 + ai * 128 + m * 16; float d8[8], a8[8];
#pragma unroll
                for (int n = 0; n < 2; ++n)
#pragma unroll
                    for (int j = 0; j < 4; ++j) { const int q = 4 * n + j;
                        const float wl = -softplusf_(-(cw0[q] + acc[ai][0][m][n][j])) - 0.5f; d8[q] = __expf(-__expf(wl)); a8[q] = sigm(ca0[q] + acc[ai][1][m][n][j]); }
                float* pd = WDEC + ((((size_t)((row >> 12) * 32 + (ch0 >> 6)) * SEQ + (row & (SEQ - 1))) * 5 + 1) * 64 + (ch0 & 63)); float* pa = AA + (size_t)row * 2048 + ch0;
                *(f32x4*)pd = (f32x4){d8[0], d8[1], d8[2], d8[3]}; *(f32x4*)(pd + 4) = (f32x4){d8[4], d8[5], d8[6], d8[7]};
                *(f32x4*)pa = (f32x4){a8[0], a8[1], a8[2], a8[3]}; *(f32x4*)(pa + 4) = (f32x4){a8[4], a8[5], a8[6], a8[7]};
            }
    }
};
__device__ __forceinline__ void gl2_issue(u32x4& a0, u32x4& a1, const void* pa, unsigned voff) {
    asm volatile("s_nop 4\n\tglobal_load_dwordx4 %0, %2, %3\n\tglobal_load_dwordx4 %1, %2, %3 offset:256" : "=&v"(a0), "=&v"(a1) : "v"(voff), "s"(pa) : "memory"); }
__device__ __forceinline__ void gl4f_issue(u32x4& a0, u32x4& a1, u32x4& a2, u32x4& a3, const void* pa, unsigned voff) {
    asm volatile("s_nop 4\n\tglobal_load_dwordx4 %0, %4, %5\n\tglobal_load_dwordx4 %1, %4, %5 offset:64\n\tglobal_load_dwordx4 %2, %4, %5 offset:512\n\tglobal_load_dwordx4 %3, %4, %5 offset:576"
                 : "=&v"(a0), "=&v"(a1), "=&v"(a2), "=&v"(a3) : "v"(voff), "s"(pa) : "memory"); }
#define GL_WAIT8(g) asm volatile("s_waitcnt vmcnt(0)" : "+v"(g[0]), "+v"(g[1]), "+v"(g[2]), "+v"(g[3]), "+v"(g[4]), "+v"(g[5]), "+v"(g[6]), "+v"(g[7]) :: "memory")
#define GL_WAIT16(g) asm volatile("s_waitcnt vmcnt(0)" : "+v"(g[0]), "+v"(g[1]), "+v"(g[2]), "+v"(g[3]), "+v"(g[4]), "+v"(g[5]), "+v"(g[6]), "+v"(g[7]), \
                                  "+v"(g[8]), "+v"(g[9]), "+v"(g[10]), "+v"(g[11]), "+v"(g[12]), "+v"(g[13]), "+v"(g[14]), "+v"(g[15]) :: "memory")
struct EpiMerge {
    static constexpr bool PERM = true, HOOK = true;
    const bf16* GL; bf16* O; static constexpr int ldg = NPJ;
    __device__ __forceinline__ void hook(f32x4 (&acc)[2][2][4][2], const pg8::Unit& u, int br, int wr, int wc, int fr, int fq) const {
        const unsigned voff = (unsigned)(fr * (ldg * 2) + (wc * 32 + 8 * fq) * 2);
        const char* base = (const char*)GL + ((size_t)(u.pm * 256 + wr * 64) * ldg + br * 4096 + u.pn * 256) * 2;
#pragma unroll
        for (int ai = 0; ai < 2; ++ai) { u32x4 g[16];
#pragma unroll
            for (int m = 0; m < 4; ++m) { const char* pm_ = base + (size_t)(ai * 128 + m * 16) * (ldg * 2); gl2_issue(g[4 * m], g[4 * m + 1], pm_, voff); gl2_issue(g[4 * m + 2], g[4 * m + 3], pm_ + 8192, voff); }
            GL_WAIT16(g);
#pragma unroll
            for (int m = 0; m < 4; ++m)
#pragma unroll
                for (int bj = 0; bj < 2; ++bj) { float f0[8], f1[8]; unpack8(g[4 * m + bj], f0); unpack8(g[4 * m + 2 + bj], f1);
#pragma unroll
                    for (int n = 0; n < 2; ++n)
#pragma unroll
                        for (int j = 0; j < 4; ++j) { const int q = 4 * n + j; acc[ai][bj][m][n][j] *= (1.0f + __expf(-f1[q])) * __builtin_amdgcn_rcpf(1.0f + __expf(-f0[q])); } } }
    }
    __device__ __forceinline__ void operator()(const f32x4 (&acc)[2][2][4][2], const pg8::Unit& u, int wr, int wc, int fr, int fq) const {
        const int row0 = u.pm * 256 + wr * 64 + fr, col0 = u.pn * 256 + wc * 32 + 8 * fq;
        const unsigned voff = (unsigned)(fr * (ldg * 2) + (wc * 32 + 8 * fq) * 2);
        const char* base = (const char*)GL + ((size_t)(u.pm * 256 + wr * 64) * ldg + 3 * 4096 + u.pn * 256) * 2;
#pragma unroll
        for (int ai = 0; ai < 2; ++ai) { u32x4 g[8];
#pragma unroll
            for (int m = 0; m < 4; ++m) gl2_issue(g[2 * m], g[2 * m + 1], base + (size_t)(ai * 128 + m * 16) * (ldg * 2), voff);
            GL_WAIT8(g);
#pragma unroll
            for (int m = 0; m < 4; ++m) { const int row = row0 + ai * 128 + m * 16;
#pragma unroll
                for (int bj = 0; bj < 2; ++bj) { float f[8]; unpack8(g[2 * m + bj], f);
                    const f32x4 v0 = acc[ai][bj][m][0], v1 = acc[ai][bj][m][1];
                    u32x4 w; w.x = cvt_pk_bf16(v0[0] * sigm(f[0]), v0[1] * sigm(f[1])); w.y = cvt_pk_bf16(v0[2] * sigm(f[2]), v0[3] * sigm(f[3]));
                    w.z = cvt_pk_bf16(v1[0] * sigm(f[4]), v1[1] * sigm(f[5])); w.w = cvt_pk_bf16(v1[2] * sigm(f[6]), v1[3] * sigm(f[7]));
                    *(u32x4*)(O + (size_t)row * 4096 + col0 + bj * 128) = w; } } }
    }
};
struct EpiOut {
    static constexpr bool PERM = false, HOOK = false;
    const float* XI; float* XO;
    __device__ __forceinline__ void operator()(const f32x4 (&acc)[2][2][4][2], const pg8::Unit& u, int wr, int wc, int fr, int fq) const {
        const int row0 = u.pm * 256 + wr * 64 + fr, col0 = u.pn * 256 + wc * 32 + 4 * fq;
        const unsigned voff = (unsigned)(fr * 16384 + (wc * 32 + 4 * fq) * 4);
        const char* base = (const char*)XI + ((size_t)(u.pm * 256 + wr * 64) * 4096 + u.pn * 256) * 4;
#pragma unroll
        for (int ai = 0; ai < 2; ++ai) { u32x4 g[16];
#pragma unroll
            for (int m = 0; m < 4; ++m) gl4f_issue(g[4 * m], g[4 * m + 1], g[4 * m + 2], g[4 * m + 3], base + (size_t)(ai * 128 + m * 16) * 16384, voff);
            GL_WAIT16(g);
#pragma unroll
            for (int m = 0; m < 4; ++m) { const size_t off = (size_t)(row0 + ai * 128 + m * 16) * 4096 + col0;
#pragma unroll
                for (int bj = 0; bj < 2; ++bj)
#pragma unroll
                    for (int n = 0; n < 2; ++n) { const f32x4 xi = __builtin_bit_cast(f32x4, g[4 * m + 2 * bj + n]); *(f32x4*)(XO + off + bj * 128 + n * 16) = xi + acc[ai][bj][m][n]; } } }
    }
};

struct Frame { LAS unsigned char* lds; int tid, lane, wave, bid, nblk; };
__device__ __forceinline__ Frame reframe(const Frame& G) { Frame F; F.lds = G.lds; F.wave = opaque_s(G.wave); F.lane = lane_id(); F.tid = F.wave * 64 + F.lane; F.bid = opaque_s(G.bid); F.nblk = opaque_s(G.nblk); return F; }

#define TR_PIN16(a, o) asm volatile("" : "+v"(a[o]), "+v"(a[o + 1]), "+v"(a[o + 2]), "+v"(a[o + 3]), "+v"(a[o + 4]), "+v"(a[o + 5]), "+v"(a[o + 6]), "+v"(a[o + 7]), "+v"(a[o + 8]), "+v"(a[o + 9]), "+v"(a[o + 10]), "+v"(a[o + 11]), "+v"(a[o + 12]), "+v"(a[o + 13]), "+v"(a[o + 14]), "+v"(a[o + 15]) :: "memory")
__device__ __forceinline__ void tr_load(float (&tv)[32], const float* W, size_t ldw, int k0, int n0, int lane) {
#pragma unroll
    for (int i = 0; i < 32; ++i) tv[i] = W[(size_t)(k0 + 2 * i + (lane >> 5)) * ldw + n0 + (lane & 31)];
}
__device__ __forceinline__ void tr_item(const float (&tv)[32], bf16* WT, size_t ldt, LAS float* scr, int k0, int n0, int lane) {
#pragma unroll
    for (int i = 0; i < 32; ++i) scr[(2 * i + (lane >> 5)) * 33 + (lane & 31)] = tv[i];
    LDS_WAIT(); asm volatile("" ::: "memory");
    const int c = lane & 7;
#pragma unroll
    for (int j = 0; j < 4; ++j) { const int n = (lane >> 3) + 8 * j; const LAS float* s = scr + (8 * c) * 33 + n;
        u32x4 o; o.x = pk2(s[0 * 33], s[1 * 33]); o.y = pk2(s[2 * 33], s[3 * 33]); o.z = pk2(s[4 * 33], s[5 * 33]); o.w = pk2(s[6 * 33], s[7 * 33]);
        *(u32x4*)(WT + (size_t)(n0 + n) * ldt + k0 + 8 * c) = o; }
    LDS_WAIT(); asm volatile("" ::: "memory");
}
__device__ __forceinline__ void tr_job(const Frame& F, const float* W, size_t ldw, int K, int ncols, bf16* WT, size_t ldt) {
    LAS float* scr = (LAS float*)(F.lds + F.wave * 16384);
    const int gw = F.bid * NWAVES + F.wave, NGW = F.nblk * NWAVES, nb = ncols / 32, items = (K / 64) * nb;
    for (int it = gw; it < items; it += 2 * NGW) { float tv[32], tn[32]; const int nx = it + NGW, nc = nx < items ? nx : it;
        tr_load(tv, W, ldw, 64 * (it / nb), 32 * (it % nb), F.lane); tr_load(tn, W, ldw, 64 * (nc / nb), 32 * (nc % nb), F.lane);
        TR_PIN16(tv, 0); TR_PIN16(tv, 16);
        tr_item(tv, WT, ldt, scr, 64 * (it / nb), 32 * (it % nb), F.lane);
        if (nx < items) tr_item(tn, WT, ldt, scr, 64 * (nx / nb), 32 * (nx % nb), F.lane); }
}
__device__ __forceinline__ void tr8_item(const float (&tv)[32], signed char* WT, const float inv, LAS float* scr, int k0, int n0, int lane) {
#pragma unroll
    for (int i = 0; i < 32; ++i) scr[(2 * i + (lane >> 5)) * 33 + (lane & 31)] = tv[i];
    LDS_WAIT(); asm volatile("" ::: "memory");
    const int n = lane >> 1, hh = lane & 1;
#pragma unroll
    for (int c = 0; c < 2; ++c) { const LAS float* sp = scr + (32 * hh + 16 * c) * 33 + n; unsigned wq[4];
#pragma unroll
        for (int q = 0; q < 4; ++q) { const int a0 = (int)rintf(sp[(4 * q) * 33] * inv), a1 = (int)rintf(sp[(4 * q + 1) * 33] * inv), a2 = (int)rintf(sp[(4 * q + 2) * 33] * inv), a3 = (int)rintf(sp[(4 * q + 3) * 33] * inv);
            wq[q] = (unsigned)(a0 & 255) | ((unsigned)(a1 & 255) << 8) | ((unsigned)(a2 & 255) << 16) | ((unsigned)(a3 & 255) << 24); }
        *(u32x4*)(WT + (size_t)(n0 + n) * 4096 + k0 + 32 * hh + 16 * c) = (u32x4){wq[0], wq[1], wq[2], wq[3]}; }
    LDS_WAIT(); asm volatile("" ::: "memory");
}
__device__ __forceinline__ void gate8_strips(const Frame& F, const float* win, signed char* WT, unsigned* cmaxl, const int first, const int stride) {
    LAS float* scr = (LAS float*)(F.lds + F.wave * 16384); LAS float* cm = (LAS float*)(F.lds + 8 * 16384);
    const int lane = F.lane, w = F.wave, c8 = lane & 7, rsub = lane >> 3;
    for (int strip = first; strip < N8 / 32; strip += stride) { const int n0 = strip * 32; const float* W = win + (n0 < 2048 ? 16576 + n0 : 21704 + (n0 - 2048));
        { const float* wp = W + (size_t)(512 * w + rsub) * CIN + 4 * c8; f32x4 m = (f32x4){0.f, 0.f, 0.f, 0.f};
          for (int i0 = 0; i0 < 64; i0 += 16) { f32x4 tv[16];
#pragma unroll
              for (int i = 0; i < 16; ++i) tv[i] = *(const f32x4*)(wp + (size_t)(8 * (i0 + i)) * CIN);
              asm volatile("" : "+v"(tv[0]), "+v"(tv[1]), "+v"(tv[2]), "+v"(tv[3]), "+v"(tv[4]), "+v"(tv[5]), "+v"(tv[6]), "+v"(tv[7]), "+v"(tv[8]), "+v"(tv[9]), "+v"(tv[10]), "+v"(tv[11]), "+v"(tv[12]), "+v"(tv[13]), "+v"(tv[14]), "+v"(tv[15]) :: "memory");
#pragma unroll
              for (int i = 0; i < 16; ++i) { m.x = fmaxf(m.x, fabsf(tv[i].x)); m.y = fmaxf(m.y, fabsf(tv[i].y)); m.z = fmaxf(m.z, fabsf(tv[i].z)); m.w = fmaxf(m.w, fabsf(tv[i].w)); } }
#pragma unroll
          for (int q = 0; q < 4; ++q) { float v = m[q]; v = fmaxf(v, __shfl_xor(v, 8)); v = fmaxf(v, __shfl_xor(v, 16)); v = fmaxf(v, __shfl_xor(v, 32)); m[q] = v; }
          __syncthreads();
          if (lane < 8) { cm[w * 32 + 4 * c8] = m.x; cm[w * 32 + 4 * c8 + 1] = m.y; cm[w * 32 + 4 * c8 + 2] = m.z; cm[w * 32 + 4 * c8 + 3] = m.w; } }
        __syncthreads();
        float am = 0.f;
#pragma unroll
        for (int w2 = 0; w2 < 8; ++w2) am = fmaxf(am, cm[w2 * 32 + (lane >> 1)]);
        if (w == 0 && (lane & 1) == 0) cmaxl[n0 + (lane >> 1)] = __float_as_uint(am);
        const float inv = am > 0.f ? 127.0f / am : 0.f;
        for (int kb = 0; kb < 8; kb += 2) { const int k0 = 512 * w + 64 * kb; float tv[32], tn[32];
            tr_load(tv, W, CIN, k0, 0, lane); tr_load(tn, W, CIN, k0 + 64, 0, lane);
            TR_PIN16(tv, 0); TR_PIN16(tv, 16);
            tr8_item(tv, WT, inv, scr, k0, n0, lane); tr8_item(tn, WT, inv, scr, k0 + 64, n0, lane); }
    }
}
__device__ __forceinline__ void rms_row_bf16(const float* x, const float* g, bf16* o, int lane, signed char* q8 = nullptr, float* qs = nullptr) {
    const f32x4* xr = (const f32x4*)x + lane; const f32x4* gr = (const f32x4*)g + lane; f32x4 v[16], gv[16]; float ss = 0.f;
#pragma unroll
    for (int j = 0; j < 16; ++j) v[j] = xr[64 * j];
#pragma unroll
    for (int j = 0; j < 16; ++j) gv[j] = gr[64 * j];
    asm volatile("" ::: "memory");
#pragma unroll
    for (int j = 0; j < 16; ++j) ss += (v[j].x * v[j].x + v[j].y * v[j].y) + (v[j].z * v[j].z + v[j].w * v[j].w);
    const float r = rsqrtf(wave_sum(ss) * (1.0f / 4096.0f) + 1e-6f);
    u32x2* o8 = (u32x2*)o + lane; float am = 0.f;
#pragma unroll
    for (int j = 0; j < 16; ++j) { const f32x4 gg = gv[j]; v[j] = (f32x4){v[j].x * r * gg.x, v[j].y * r * gg.y, v[j].z * r * gg.z, v[j].w * r * gg.w};
        u32x2 w; w.x = pk2(v[j].x, v[j].y); w.y = pk2(v[j].z, v[j].w); o8[64 * j] = w;
        am = fmaxf(fmaxf(am, fmaxf(fabsf(v[j].x), fabsf(v[j].y))), fmaxf(fabsf(v[j].z), fabsf(v[j].w))); }
    if (q8 != nullptr) {
        am = row16_max(am); am = fmaxf(am, __shfl_xor(am, 16)); am = fmaxf(am, __shfl_xor(am, 32));
        const float inv = am > 0.f ? 127.0f / am : 0.f; unsigned* q4 = (unsigned*)q8 + lane;
#pragma unroll
        for (int j = 0; j < 16; ++j) { const int a0 = (int)rintf(v[j].x * inv), a1 = (int)rintf(v[j].y * inv), a2 = (int)rintf(v[j].z * inv), a3 = (int)rintf(v[j].w * inv);
            q4[64 * j] = (unsigned)(a0 & 255) | ((unsigned)(a1 & 255) << 8) | ((unsigned)(a2 & 255) << 16) | ((unsigned)(a3 & 255) << 24); }
        if (lane == 0) *qs = am * (1.0f / 127.0f); }
}
__device__ __forceinline__ void rms_row_f32(const float* x, const float* g, float* o, int lane) {
    const f32x4* xr = (const f32x4*)x + lane; const f32x4* gr = (const f32x4*)g + lane; f32x4 v[16], gv[16]; float ss = 0.f;
#pragma unroll
    for (int j = 0; j < 16; ++j) v[j] = xr[64 * j];
#pragma unroll
    for (int j = 0; j < 16; ++j) gv[j] = gr[64 * j];
    asm volatile("" ::: "memory");
#pragma unroll
    for (int j = 0; j < 16; ++j) ss += (v[j].x * v[j].x + v[j].y * v[j].y) + (v[j].z * v[j].z + v[j].w * v[j].w);
    const float r = rsqrtf(wave_sum(ss) * (1.0f / 4096.0f) + 1e-6f);
    f32x4* o4 = (f32x4*)o + lane;
#pragma unroll
    for (int j = 0; j < 16; ++j) { const f32x4 gg = gv[j]; o4[64 * j] = (f32x4){v[j].x * r * gg.x, v[j].y * r * gg.y, v[j].z * r * gg.z, v[j].w * r * gg.w}; }
}

__device__ __forceinline__ void phase_convert_layer(const Frame& F0, int l, const int parts, const int vb, const int nvb) {
    Frame F = reframe(F0); F.bid = vb; F.nblk = nvb;
    unsigned char* wl = KWS() + WS_W + (size_t)l * SZ_WLAYER;
    bf16* WIN = (bf16*)(wl + WO_WIN); bf16* WCAT = (bf16*)(wl + WO_WCAT); bf16* WOUT = (bf16*)(wl + WO_WOUT); bf16* WKV = (bf16*)(wl + WO_WKV); bf16* WG = (bf16*)(wl + WO_WG); bf16* WL = (bf16*)(wl + WO_WL);
    const float* win = KIN(I_WIN) + (size_t)l * 4096 * CIN;
    if (parts & 2) {
    tr_job(F, win + 0, CIN, 4096, 4096, WIN + (size_t)0 * 4096, 4096);
    tr_job(F, win + 4096, CIN, 4096, 6144, WIN + (size_t)PC_BR * 4096, 4096);
    tr_job(F, win + 10240, CIN, 4096, 96, WIN + (size_t)PC_BWD * 4096, 4096);
    tr_job(F, win + 10336, CIN, 4096, 96, WIN + (size_t)PC_BAD * 4096, 4096);
    tr_job(F, win + 10432, CIN, 4096, 2048, WIN + (size_t)PC_BG * 4096, 4096);
    tr_job(F, win + 12480, CIN, 4096, 4096, WIN + (size_t)PC_CQK * 4096, 4096);
    tr_job(F, win + 18624, CIN, 4096, 2048, WIN + (size_t)PC_CG * 4096, 4096);
    tr_job(F, win + 20680, CIN, 4096, 1024, WIN + (size_t)PC_XQ * 4096, 4096);
    gate8_strips(F, win, (signed char*)(WIN + (size_t)PC_I8 * 4096), (unsigned*)(KWS() + WS_CTL) + CW_CMAX + l * N8, F.bid, F.nblk);
    tr_job(F, KIN(I_WBA) + (size_t)l * 2048 * 4096, 4096, 2048, 4096, WCAT + YC_A, KCAT);
    tr_job(F, KIN(I_WBB) + (size_t)l * 2048 * 4096, 4096, 2048, 4096, WCAT + YC_B, KCAT);
    tr_job(F, KIN(I_WBC) + (size_t)l * 2048 * 4096, 4096, 2048, 4096, WCAT + YC_C, KCAT);
    tr_job(F, KIN(I_WBX) + (size_t)l * 512 * 4096, 4096, 512, 4096, WCAT + YC_X, KCAT);
    tr_job(F, KIN(I_WOUT) + (size_t)l * 4096 * 4096, 4096, 4096, 4096, WOUT, 4096);
    }
    if (parts & 1) tr_job(F, KIN(I_WKV) + (size_t)l * 4096 * 1024, 1024, 4096, 1024, WKV, 4096);
    if (parts & 2) {
    const size_t gt = (size_t)F.bid * NTHREADS + F.tid, NGT = (size_t)F.nblk * NTHREADS;
    for (size_t i = gt; i < (size_t)8 * 4096; i += NGT) { const int j = (int)(i >> 12), k = (int)(i & 4095); WIN[(size_t)(PC_IF + j) * 4096 + k] = (bf16)f2bf(win[(size_t)k * CIN + 20672 + j]); }
    for (size_t i = gt; i < (size_t)(32 + 32 + 248) * 4096; i += NGT) { const int r = (int)(i >> 12), k = (int)(i & 4095);
        const int row = r < 32 ? PC_BWD + 96 + r : (r < 64 ? PC_BAD + 96 + (r - 32) : PC_IF + 8 + (r - 64)); WIN[(size_t)row * 4096 + k] = 0; }
    const float* wa = KIN(I_LRU_WA) + (size_t)l * 8 * 256 * 256; const float* wx = KIN(I_LRU_WX) + (size_t)l * 8 * 256 * 256;
    for (size_t c = gt; c < (size_t)4096 * 32; c += NGT) { const int n = (int)(c >> 5), k0 = (int)(c & 31) * 8, pn = n >> 8, dd = n & 255, nb = pn >> 1, d = (pn & 1) * 128 + (dd & 127);
        const float* sp = (dd < 128 ? wa : wx) + ((size_t)nb * 256 + k0) * 256 + d; float v[8];
#pragma unroll
        for (int q = 0; q < 8; ++q) v[q] = sp[(size_t)q * 256];
        asm volatile("" : "+v"(v[0]), "+v"(v[1]), "+v"(v[2]), "+v"(v[3]), "+v"(v[4]), "+v"(v[5]), "+v"(v[6]), "+v"(v[7]) :: "memory");
        u32x4 o; o.x = pk2(v[0], v[1]); o.y = pk2(v[2], v[3]); o.z = pk2(v[4], v[5]); o.w = pk2(v[6], v[7]); *(u32x4*)(WG + (size_t)n * 256 + k0) = o; }
    const float* wup = KIN(I_WUP) + (size_t)l * 96 * 2048; const float* aup = KIN(I_AUP) + (size_t)l * 96 * 2048;
    for (size_t c = gt; c < (size_t)4096 * 32; c += NGT) { const int n = (int)(c >> 5), k0 = (int)(c & 31) * 8, pn = n >> 8, dd = n & 255, ch = pn * 128 + (dd & 127);
        const float* sp = nullptr; if (dd < 128) { if (k0 < 96) sp = wup + (size_t)k0 * 2048 + ch; } else { if (k0 >= 128 && k0 < 224) sp = aup + (size_t)(k0 - 128) * 2048 + ch; }
        u32x4 o = (u32x4){0u, 0u, 0u, 0u};
        if (sp != nullptr) { float v[8];
#pragma unroll
            for (int q = 0; q < 8; ++q) v[q] = sp[(size_t)q * 2048];
            asm volatile("" : "+v"(v[0]), "+v"(v[1]), "+v"(v[2]), "+v"(v[3]), "+v"(v[4]), "+v"(v[5]), "+v"(v[6]), "+v"(v[7]) :: "memory");
            o.x = pk2(v[0], v[1]); o.y = pk2(v[2], v[3]); o.z = pk2(v[4], v[5]); o.w = pk2(v[6], v[7]); }
        *(u32x4*)(WL + (size_t)n * 256 + k0) = o; }
    }
    if (parts & 1) {
    const int gw = F.bid * NWAVES + F.wave, NGW = F.nblk * NWAVES;
    bf16* MEMN = (bf16*)(KWS() + WS_MEMN) + (size_t)l * MM * 4096;
    for (int r = gw; r < MM; r += NGW) rms_row_bf16(KIN(I_MEM) + (size_t)r * 4096, KIN(I_MEMNORM_G) + (size_t)l * 4096, MEMN + (size_t)r * 4096, F.lane);
    }
}
__device__ __forceinline__ void phase_norm(const Frame& F0, const float* X, const float* g, bool final_out) {
    const Frame F = reframe(F0);
    const int gw = F.bid * NWAVES + F.wave, NGW = F.nblk * NWAVES;
    bf16* H = (bf16*)(KWS() + WS_H);
    for (int r = gw; r < M; r += NGW) { if (final_out) rms_row_f32(X + (size_t)r * 4096, g, KOUT() + (size_t)r * 4096, F.lane); else rms_row_bf16(X + (size_t)r * 4096, g, H + (size_t)r * 4096, F.lane, (signed char*)(KWS() + WS_H8) + (size_t)r * 4096, (float*)(KWS() + WS_HS) + r); }
}

__device__ __forceinline__ float logsigf_(float x) { return fminf(x, 0.f) - log1pf(__expf(-fabsf(x))); }
__device__ __forceinline__ void phase_prep(const Frame& F0, int l) {
    const Frame F = reframe(F0);
    const bf16* __restrict__ PROJ = (const bf16*)(KWS() + WS_PROJ);
    const size_t gt = (size_t)F.bid * NTHREADS + F.tid, NGT = (size_t)F.nblk * NTHREADS;
    bf16* __restrict__ U = (bf16*)(KWS() + WS_U); bf16* __restrict__ QC = (bf16*)(KWS() + WS_QC); bf16* __restrict__ KC = (bf16*)(KWS() + WS_KC);
    for (size_t id = gt; id < (size_t)2 * 256 * (M / 32); id += NGT) {
        const int which = (int)(id / ((size_t)256 * (M / 32))), rem = (int)(id % ((size_t)256 * (M / 32))), c8 = (rem & 255) * 8, t0 = (rem >> 8) * 32, ts0 = t0 & (SEQ - 1);
        const float* cw = (which == 0 ? KIN(I_LRU_CW) : KIN(I_MCW)) + (size_t)l * 4 * 2048 + c8; const float* cb = (which == 0 ? KIN(I_LRU_CB) : KIN(I_MCB)) + (size_t)l * 2048 + c8;
        const bf16* src = PROJ + (size_t)t0 * NPJ + (which == 0 ? PC_AX : PC_CQK) + c8;
        f32x4 wv[4][2];
#pragma unroll
        for (int j = 0; j < 4; ++j) { wv[j][0] = *(const f32x4*)(cw + j * 2048); wv[j][1] = *(const f32x4*)(cw + j * 2048 + 4); }
        const f32x4 b0 = *(const f32x4*)cb, b1 = *(const f32x4*)(cb + 4);
        u32x4 hw[3];
#pragma unroll
        for (int j = 0; j < 3; ++j) hw[j] = ts0 > 0 ? *(const u32x4*)(src - (size_t)(3 - j) * NPJ) : (u32x4){0u, 0u, 0u, 0u};
        float w0[8], w1[8], w2[8]; unpack8(hw[0], w0); unpack8(hw[1], w1); unpack8(hw[2], w2);
        const float sc = c8 < 1024 ? 1.0f : 0.0625f;
        for (int g = 0; g < 32; g += 8) { u32x4 x[8];
#pragma unroll
            for (int u = 0; u < 8; ++u) x[u] = *(const u32x4*)(src + (size_t)(g + u) * NPJ);
#pragma unroll
            for (int u = 0; u < 8; ++u) { float w3[8], a[8]; unpack8(x[u], w3);
#pragma unroll
                for (int q = 0; q < 8; ++q) a[q] = (q < 4 ? b0[q] : b1[q - 4]) + wv[0][q >> 2][q & 3] * w0[q] + wv[1][q >> 2][q & 3] * w1[q] + wv[2][q >> 2][q & 3] * w2[q] + wv[3][q >> 2][q & 3] * w3[q];
#pragma unroll
                for (int q = 0; q < 8; ++q) { w0[q] = w1[q]; w1[q] = w2[q]; w2[q] = w3[q]; }
                const size_t t = (size_t)t0 + g + u;
                if (which == 0) { u32x4 o; o.x = pk2(a[0], a[1]); o.y = pk2(a[2], a[3]); o.z = pk2(a[4], a[5]); o.w = pk2(a[6], a[7]); *(u32x4*)(U + t * 2048 + c8) = o; }
                else {
#pragma unroll
                    for (int q = 0; q < 8; ++q) a[q] = siluf_(a[q]) * sc;
                    u32x4 o; o.x = pk2(a[0], a[1]); o.y = pk2(a[2], a[3]); o.z = pk2(a[4], a[5]); o.w = pk2(a[6], a[7]);
                    if (c8 < 1024) *(u32x4*)(QC + t * 1024 + c8) = o; else *(u32x4*)(KC + t * 1024 + (c8 - 1024)) = o; } } }
    }
    bf16* LORA = (bf16*)(KWS() + WS_LORA); const float* mu = KIN(I_MU) + (size_t)l * 6336;
    for (size_t i = gt; i < (size_t)M * 32; i += NGT) { const int t = (int)(i >> 5), c8 = (int)(i & 31) * 8, ts = t & (SEQ - 1), seg = c8 >> 7, i0 = c8 & 127;
        u32x4 o = (u32x4){0u, 0u, 0u, 0u};
        if (i0 < 96) { const int pc = (seg == 0 ? PC_BWD : PC_BAD) + i0; const float* m8 = mu + 6144 + seg * 96 + i0;
            const u32x4 w = *(const u32x4*)(PROJ + (size_t)t * NPJ + pc); const u32x4 w2 = *(const u32x4*)(PROJ + (size_t)(ts > 0 ? t - 1 : t) * NPJ + pc);
            const f32x4 ma = *(const f32x4*)m8, mb = *(const f32x4*)(m8 + 4);
            float p[8], pv[8]; unpack8(w, p); unpack8(w2, pv);
            if (ts == 0) {
#pragma unroll
                for (int q = 0; q < 8; ++q) pv[q] = 0.f; }
            float r[8];
#pragma unroll
            for (int q = 0; q < 8; ++q) { const float s = p[q] + (pv[q] - p[q]) * (q < 4 ? ma[q] : mb[q - 4]); r[q] = seg == 0 ? tanhf(s) : s; }
            o.x = pk2(r[0], r[1]); o.y = pk2(r[2], r[3]); o.z = pk2(r[4], r[5]); o.w = pk2(r[6], r[7]); }
        *(u32x4*)(LORA + (size_t)t * 256 + c8) = o; }
    if (F.bid < 8) {
        const float* IFB = (const float*)(KWS() + WS_IFB); float* G = (float*)(KWS() + WS_SCAL); float* MX = G + (size_t)M * 4; float* MT = MX + (size_t)M * 4;
        const int b = F.bid >> 2, hd = F.bid & 3, lane = F.lane; const float bi = KIN(I_MBI)[l * 4 + hd], bfv = KIN(I_MBF)[l * 4 + hd];
        const size_t tok0 = (size_t)b * SEQ + (size_t)F.tid * 8; LAS float* sc = (LAS float*)F.lds;
        float lf[8], li[8];
#pragma unroll
        for (int j = 0; j < 8; ++j) { lf[j] = IFB[(tok0 + j) * 8 + 4 + hd]; li[j] = IFB[(tok0 + j) * 8 + hd]; }
        asm volatile("" ::: "memory");
#pragma unroll
        for (int j = 0; j < 8; ++j) { lf[j] = logsigf_(lf[j] + bfv); li[j] += bi; }
#pragma unroll
        for (int j = 1; j < 8; ++j) lf[j] += lf[j - 1];
        float incl = lf[7];
#pragma unroll
        for (int o = 1; o < 64; o <<= 1) { const float t = __shfl_up(incl, o); if (lane >= o) incl += t; }
        if (lane == 63) sc[F.wave] = incl;
        __syncthreads();
        float woff = 0.f;
        for (int w2 = 0; w2 < F.wave; ++w2) woff += sc[w2];
        const float excl = woff + incl - lf[7];
        float mx[8]; float run = -INFINITY;
#pragma unroll
        for (int j = 0; j < 8; ++j) { lf[j] += excl; li[j] -= lf[j]; run = fmaxf(run, li[j]); mx[j] = run; }
        float im = run;
#pragma unroll
        for (int o = 1; o < 64; o <<= 1) { const float t = __shfl_up(im, o); if (lane >= o) im = fmaxf(im, t); }
        if (lane == 63) sc[16 + F.wave] = im;
        float pm = __shfl_up(im, 1); if (lane == 0) pm = -INFINITY;
        __syncthreads();
        for (int w2 = 0; w2 < F.wave; ++w2) pm = fmaxf(pm, sc[16 + w2]);
#pragma unroll
        for (int j = 0; j < 8; ++j) { const float m = fmaxf(pm, mx[j]); G[(tok0 + j) * 4 + hd] = li[j]; MX[(tok0 + j) * 4 + hd] = m; MT[(tok0 + j) * 4 + hd] = lf[j] + m; }
        __syncthreads();
    }
}

__device__ __forceinline__ f32x4 ld_bf4(const bf16* p) { const u32x2 w = *(const u32x2*)p; return (f32x4){__uint_as_float(w.x << 16), __uint_as_float(w.x & 0xffff0000u), __uint_as_float(w.y << 16), __uint_as_float(w.y & 0xffff0000u)}; }
__device__ __forceinline__ f32x4 bf4_unpack(const u32x2 w) { return (f32x4){__uint_as_float(w.x << 16), __uint_as_float(w.x & 0xffff0000u), __uint_as_float(w.y << 16), __uint_as_float(w.y & 0xffff0000u)}; }
struct VecIn { u32x2 r, k, v, r1, k1, v1; f32x4 a; };
__device__ __forceinline__ void phase_rwkv_vec(const Frame& F0, int l) {
    const Frame F = reframe(F0);
    const bf16* __restrict__ PROJ = (const bf16*)(KWS() + WS_PROJ); const float* __restrict__ AA = (const float*)(KWS() + WS_AA);
    float* __restrict__ RV = (float*)(KWS() + WS_RV); float* __restrict__ VV = (float*)(KWS() + WS_VV); float* __restrict__ BON = (float*)(KWS() + WS_BON);
    const float* mu = KIN(I_MU) + (size_t)l * 6336; const float* kkw = KIN(I_KK) + (size_t)l * 2048; const float* kaw = KIN(I_KA) + (size_t)l * 2048; const float* rkw = KIN(I_RK) + (size_t)l * 2048;
    const int gw = F.bid * NWAVES + F.wave, NGW = F.nblk * NWAVES, lane = F.lane;
    const int hq = gw & 7, ch = hq * 256 + lane * 4, h = hq * 4 + (lane >> 4);
    const f32x4 mr = *(const f32x4*)(mu + ch), mk = *(const f32x4*)(mu + 2048 + ch), mv = *(const f32x4*)(mu + 4096 + ch), ckk = *(const f32x4*)(kkw + ch), cka = *(const f32x4*)(kaw + ch), crk = *(const f32x4*)(rkw + ch);
    auto vload = [&](const int it, VecIn& x) { const int t = it >> 3, ts = t & (SEQ - 1);
        const bf16* pr = PROJ + (size_t)t * NPJ + ch; const bf16* pp = ts > 0 ? pr - NPJ : pr;
        x.r = *(const u32x2*)(pr + PC_BR); x.k = *(const u32x2*)(pr + PC_BK); x.v = *(const u32x2*)(pr + PC_BV);
        x.r1 = *(const u32x2*)(pp + PC_BR); x.k1 = *(const u32x2*)(pp + PC_BK); x.v1 = *(const u32x2*)(pp + PC_BV);
        x.a = *(const f32x4*)(AA + (size_t)t * 2048 + ch); };
    auto vcomp = [&](const int it, const VecIn& x) { const int t = it >> 3, ts = t & (SEQ - 1), b = t >> 12;
        f32x4 r = bf4_unpack(x.r), k = bf4_unpack(x.k), v = bf4_unpack(x.v);
        const f32x4 z = (f32x4){0.f, 0.f, 0.f, 0.f}; const f32x4 r1 = ts > 0 ? bf4_unpack(x.r1) : z, k1 = ts > 0 ? bf4_unpack(x.k1) : z, v1 = ts > 0 ? bf4_unpack(x.v1) : z;
        r += (r1 - r) * mr; k += (k1 - k) * mk; v += (v1 - v) * mv;
        const f32x4 a = x.a;
        const f32x4 kku = k * ckk;
        const float n2 = row16_sum((kku.x * kku.x + kku.y * kku.y) + (kku.z * kku.z + kku.w * kku.w));
        const float inv = __builtin_amdgcn_rcpf(fmaxf(sqrtf(n2), 1e-12f)); const f32x4 kk = kku * inv;
        const f32x4 kmod = k * ((a - 1.0f) * cka + 1.0f);
        const f32x4 rkk = r * kmod * crk;
        const float bon = row16_sum((rkk.x + rkk.y) + (rkk.z + rkk.w));
        float* rv = RV + (((size_t)(b * 32 + h) * SEQ + ts) * 5) * 64 + (lane & 15) * 4;
        *(f32x4*)rv = kk; *(f32x4*)(rv + 128) = -(kk * a); *(f32x4*)(rv + 192) = kmod; *(f32x4*)(rv + 256) = r;
        *(f32x4*)(VV + (size_t)t * 2048 + ch) = v; if ((lane & 15) == 0) BON[(size_t)t * 32 + h] = bon; };
    int it = gw;
    for (; it + 3 * NGW < M * 8; it += 4 * NGW) { VecIn x0, x1, x2, x3; vload(it, x0); vload(it + NGW, x1); vload(it + 2 * NGW, x2); vload(it + 3 * NGW, x3);
        vcomp(it, x0); vcomp(it + NGW, x1); vcomp(it + 2 * NGW, x2); vcomp(it + 3 * NGW, x3); }
    for (; it < M * 8; it += NGW) { VecIn x0; vload(it, x0); vcomp(it, x0); }
}

#define SC_PIN(a) asm volatile("" : "+v"(a[0]), "+v"(a[1]), "+v"(a[2]), "+v"(a[3]), "+v"(a[4]), "+v"(a[5]), "+v"(a[6]), "+v"(a[7]), "+v"(a[8]), "+v"(a[9]), "+v"(a[10]), "+v"(a[11]), "+v"(a[12]), "+v"(a[13]), "+v"(a[14]), "+v"(a[15]) :: "memory")
__device__ __forceinline__ void phase_lru_scan1(const Frame& F0) {
    const Frame F = reframe(F0);
    const float* LA = (const float*)(KWS() + WS_LA); const float* LB = (const float*)(KWS() + WS_LB); float* CA = (float*)(KWS() + WS_CARRY); float* CH = CA + 2 * 32 * 2048;
    const size_t gt = (size_t)F.bid * NTHREADS + F.tid, NGT = (size_t)F.nblk * NTHREADS;
    for (size_t i = gt; i < (size_t)2 * 32 * 2048; i += NGT) { const int ch = (int)(i & 2047), chunk = (int)(i >> 11) & 31, b = (int)(i >> 16);
        const size_t base = ((size_t)b * SEQ + chunk * 128) * 2048 + ch; float A = 1.f, H = 0.f;
        for (int s0 = 0; s0 < 128; s0 += 16) { float la[16], lb[16];
#pragma unroll
            for (int u = 0; u < 16; ++u) { la[u] = LA[base + (size_t)(s0 + u) * 2048]; lb[u] = LB[base + (size_t)(s0 + u) * 2048]; }
            SC_PIN(la); SC_PIN(lb);
#pragma unroll
            for (int u = 0; u < 16; ++u) { H = la[u] * H + lb[u]; A *= la[u]; } }
        CA[i] = A; CH[i] = H; }
}
__device__ __forceinline__ void scan2_item(const Frame& F, const int vb) {
    const float* __restrict__ LA = (const float*)(KWS() + WS_LA); const float* __restrict__ LB = (const float*)(KWS() + WS_LB); const float* __restrict__ CA = (const float*)(KWS() + WS_CARRY); const float* __restrict__ CH = CA + 2 * 32 * 2048;
    const bf16* __restrict__ PROJ = (const bf16*)(KWS() + WS_PROJ); bf16* __restrict__ Y = (bf16*)(KWS() + WS_Y);
    { const size_t i = (size_t)vb * NTHREADS + F.tid; const int ch = (int)(i & 2047), chunk = (int)(i >> 11) & 31, b = (int)(i >> 16);
        float H = 0.f;
        for (int j0 = 0; j0 < chunk; j0 += 16) { float ca[16], chh[16];
#pragma unroll
            for (int u = 0; u < 16; ++u) { const int j = j0 + u < chunk ? j0 + u : chunk - 1; const size_t ci = ((size_t)b * 32 + j) * 2048 + ch; ca[u] = CA[ci]; chh[u] = CH[ci]; }
            SC_PIN(ca); SC_PIN(chh);
#pragma unroll
            for (int u = 0; u < 16; ++u) if (j0 + u < chunk) H = ca[u] * H + chh[u]; }
        const size_t row0 = (size_t)b * SEQ + chunk * 128;
        for (int s0 = 0; s0 < 128; s0 += 16) { float la[16], lb[16]; unsigned gg[16];
#pragma unroll
            for (int u = 0; u < 16; ++u) { const size_t row = row0 + s0 + u; la[u] = LA[row * 2048 + ch]; lb[u] = LB[row * 2048 + ch]; gg[u] = PROJ[row * NPJ + PC_AG + ch]; }
            SC_PIN(la); SC_PIN(lb); SC_PIN(gg);
#pragma unroll
            for (int u = 0; u < 16; ++u) { const size_t row = row0 + s0 + u; H = la[u] * H + lb[u]; Y[row * KCAT + YC_A + ch] = (bf16)f2bf(H * siluf_(bf2f((bf16)gg[u]))); } } }
}

constexpr int RW_CH = 32;
constexpr int RW_RVB = RW_CH * 1280, RW_VVB = RW_CH * 256;
struct RwVec { f32x4 kk, wv, nk, kv, rv; f32x2 vi; };
template <int S> __device__ __forceinline__ void rw_issue(RwVec& d, unsigned a, unsigned av) {
    asm volatile("ds_read_b128 %0, %6 offset:%8\n\tds_read_b128 %1, %6 offset:%9\n\tds_read_b128 %2, %6 offset:%10\n\tds_read_b128 %3, %6 offset:%11\n\tds_read_b128 %4, %6 offset:%12\n\tds_read_b64 %5, %7 offset:%13"
                 : "=&v"(d.kk), "=&v"(d.wv), "=&v"(d.nk), "=&v"(d.kv), "=&v"(d.rv), "=&v"(d.vi) : "v"(a), "v"(av), "n"(S * 1280), "n"(S * 1280 + 256), "n"(S * 1280 + 512), "n"(S * 1280 + 768), "n"(S * 1280 + 1024), "n"(S * 256) : "memory"); }
#define RW_OPS(d) "+v"(d.kk), "+v"(d.wv), "+v"(d.nk), "+v"(d.kv), "+v"(d.rv), "+v"(d.vi)
__device__ __forceinline__ void rw_wait6(RwVec& d) { asm volatile("s_waitcnt lgkmcnt(6)" : RW_OPS(d) :: "memory"); }
__device__ __forceinline__ void rw_wait0(RwVec& d) { asm volatile("s_waitcnt lgkmcnt(0)" : RW_OPS(d) :: "memory"); }
__device__ __forceinline__ void phase_rwkv_rec(const Frame& F0, const int first, const int stride) {
    const Frame F = reframe(F0);
    const char* RV = (const char*)(KWS() + WS_RV); const char* VV = (const char*)(KWS() + WS_VV); float* YR = (float*)(KWS() + WS_YR);
    LAS unsigned char* lds = F.lds;
    for (int item = first; item < 128; item += stride) {
        const int bh = item >> 1, hf = item & 1, b = bh >> 5, h = bh & 31, w = F.wave, lane = F.lane, cg = lane & 15, rl = lane >> 4;
        const int row = hf * 32 + (w & 3) * 8 + rl * 2;
        const char* rvg = RV + (size_t)bh * SEQ * 1280; const char* vvg = VV + ((size_t)b * SEQ * 2048 + h * 64) * 4;
        f32x2 Sa0 = (f32x2){0.f, 0.f}, Sa1 = Sa0, Sb0 = Sa0, Sb1 = Sa0;
#define RW_DMA(ck) do { const int _buf = (ck) & 1; _Pragma("unroll") for (int _p = 0; _p < 6; ++_p) { const int pc = w * 6 + _p; \
            if (pc < 40) __builtin_amdgcn_global_load_lds((const unsigned*)(rvg + (size_t)(ck) * RW_RVB + pc * 1024 + lane * 16), (LAS unsigned*)(lds + _buf * RW_RVB + pc * 1024), 16, 0, 0); \
            else { const int pv = pc - 40; __builtin_amdgcn_global_load_lds((const unsigned*)(vvg + ((size_t)((ck) * RW_CH + pv * 4 + (lane >> 4)) * 2048) * 4 + (lane & 15) * 16), (LAS unsigned*)(lds + 2 * RW_RVB + _buf * RW_VVB + pv * 1024), 16, 0, 0); } } } while (0)
        RW_DMA(0);
        VM_WAIT(); __syncthreads();
        for (int ck = 0; ck < SEQ / RW_CH; ++ck) {
            if (ck + 1 < SEQ / RW_CH) RW_DMA(ck + 1);
            if (w < 4) {
                const unsigned ra = (unsigned)(size_t)(lds + (ck & 1) * RW_RVB + cg * 16), va = (unsigned)(size_t)(lds + 2 * RW_RVB + (ck & 1) * RW_VVB + row * 4);
                float* yo = YR + ((size_t)b * SEQ + (size_t)ck * RW_CH + (cg & 3)) * 2048 + h * 64 + row;
                RwVec A_, B_;
                rw_issue<0>(A_, ra, va);
#define P2(v, hi) ((f32x2){(hi) ? v.z : v.x, (hi) ? v.w : v.y})
#define RW_STEP(CUR, NXT, s_) do { if ((s_) + 1 < RW_CH) { rw_issue<((s_) + 1) % RW_CH>(NXT, ra, va); rw_wait6(CUR); } else rw_wait0(CUR); \
                    const f32x2 via = (f32x2){CUR.vi.x, CUR.vi.x}, vib = (f32x2){CUR.vi.y, CUR.vi.y}; \
                    const f32x2 pa = Sa0 * P2(CUR.kk, 0) + Sa1 * P2(CUR.kk, 1), pb = Sb0 * P2(CUR.kk, 0) + Sb1 * P2(CUR.kk, 1); \
                    float sa = pa.x + pa.y, sb = pb.x + pb.y; \
                    sa += dpp_mov<0xB1>(sa); sb += dpp_mov<0xB1>(sb); sa += dpp_mov<0x4E>(sa); sb += dpp_mov<0x4E>(sb); sa += dpp_mov<0x141>(sa); sb += dpp_mov<0x141>(sb); sa += dpp_mov<0x140>(sa); sb += dpp_mov<0x140>(sb); \
                    const f32x2 sa2 = (f32x2){sa, sa}, sb2 = (f32x2){sb, sb}; \
                    Sa0 = sa2 * P2(CUR.nk, 0) + (via * P2(CUR.kv, 0) + Sa0 * P2(CUR.wv, 0)); Sa1 = sa2 * P2(CUR.nk, 1) + (via * P2(CUR.kv, 1) + Sa1 * P2(CUR.wv, 1)); \
                    Sb0 = sb2 * P2(CUR.nk, 0) + (vib * P2(CUR.kv, 0) + Sb0 * P2(CUR.wv, 0)); Sb1 = sb2 * P2(CUR.nk, 1) + (vib * P2(CUR.kv, 1) + Sb1 * P2(CUR.wv, 1)); \
                    const f32x2 qa = Sa0 * P2(CUR.rv, 0) + Sa1 * P2(CUR.rv, 1), qb = Sb0 * P2(CUR.rv, 0) + Sb1 * P2(CUR.rv, 1); \
                    ya[(s_) & 3] = qa.x + qa.y; yb[(s_) & 3] = qb.x + qb.y; } while (0)
#define RW_G4(g4) do { \
                    float ya[4], yb[4]; \
                    RW_STEP(A_, B_, g4 * 4 + 0); RW_STEP(B_, A_, g4 * 4 + 1); RW_STEP(A_, B_, g4 * 4 + 2); RW_STEP(B_, A_, g4 * 4 + 3); \
                      \
                    const bool o1 = cg & 1, o2 = cg & 2; \
                    const float uA = (o1 ? ya[1] : ya[0]) + dpp_mov<0xB1>(o1 ? ya[0] : ya[1]), uB = (o1 ? ya[3] : ya[2]) + dpp_mov<0xB1>(o1 ? ya[2] : ya[3]); \
                    const float wA = (o1 ? yb[1] : yb[0]) + dpp_mov<0xB1>(o1 ? yb[0] : yb[1]), wB = (o1 ? yb[3] : yb[2]) + dpp_mov<0xB1>(o1 ? yb[2] : yb[3]); \
                    float ysa = (o2 ? uB : uA) + dpp_mov<0x4E>(o2 ? uA : uB), ysb = (o2 ? wB : wA) + dpp_mov<0x4E>(o2 ? wA : wB); \
                    ysa += dpp_mov<0x114>(ysa); ysb += dpp_mov<0x114>(ysb); \
                    ysa += dpp_mov<0x118>(ysa); ysb += dpp_mov<0x118>(ysb); \
                    if (cg >= 12) *(f32x2*)(yo + (size_t)(g4) * 4 * 2048) = (f32x2){ysa, ysb}; } while (0)
                RW_G4(0); RW_G4(1); RW_G4(2); RW_G4(3); RW_G4(4); RW_G4(5); RW_G4(6); RW_G4(7);
                static_assert(RW_CH == 32, "eight groups of four steps");
#undef RW_G4
#undef RW_STEP
#undef P2
            }
            VM_WAIT(); __syncthreads();
        }
#undef RW_DMA
    }
}

__device__ __forceinline__ void phase_rwkv_post(const Frame& F0, int l) {
    const Frame F = reframe(F0);
    const float* __restrict__ YR = (const float*)(KWS() + WS_YR); const float* __restrict__ VV = (const float*)(KWS() + WS_VV); const float* __restrict__ BON = (const float*)(KWS() + WS_BON);
    const bf16* __restrict__ PROJ = (const bf16*)(KWS() + WS_PROJ); bf16* __restrict__ Y = (bf16*)(KWS() + WS_Y);
    const float* gw_ = KIN(I_GNW) + (size_t)l * 2048; const float* gb_ = KIN(I_GNB) + (size_t)l * 2048;
    const int gw = F.bid * NWAVES + F.wave, NGW = F.nblk * NWAVES, lane = F.lane;
    const int hq = gw & 7, ch = hq * 256 + lane * 4, h = hq * 4 + (lane >> 4);
    const f32x4 w4 = *(const f32x4*)(gw_ + ch), b4 = *(const f32x4*)(gb_ + ch);
    struct PostIn { f32x4 y, v; float bon; u32x2 g; };
    auto pload = [&](const int it, PostIn& x) { const int t = it >> 3; x.y = *(const f32x4*)(YR + (size_t)t * 2048 + ch); x.v = *(const f32x4*)(VV + (size_t)t * 2048 + ch); x.bon = BON[(size_t)t * 32 + h]; x.g = *(const u32x2*)(PROJ + (size_t)t * NPJ + PC_BG + ch); };
    auto pcomp = [&](const int it, const PostIn& x) { const int t = it >> 3; const f32x4 y = x.y, v = x.v, g = bf4_unpack(x.g); const float bon = x.bon;
        const float mean = row16_sum((y.x + y.y) + (y.z + y.w)) * (1.0f / 64.0f); const f32x4 d = y - mean;
        const float var = row16_sum((d.x * d.x + d.y * d.y) + (d.z * d.z + d.w * d.w)) * (1.0f / 64.0f); const float rs = rsqrtf(var + 64e-5f);
        const f32x4 o = (d * rs * w4 + b4 + v * bon);
        u32x2 pk; pk.x = pk2(o.x * siluf_(g.x), o.y * siluf_(g.y)); pk.y = pk2(o.z * siluf_(g.z), o.w * siluf_(g.w));
        *(u32x2*)(Y + (size_t)t * KCAT + YC_B + ch) = pk; };
    int it = gw;
    for (; it + 3 * NGW < M * 8; it += 4 * NGW) { PostIn x0, x1, x2, x3; pload(it, x0); pload(it + NGW, x1); pload(it + 2 * NGW, x2); pload(it + 3 * NGW, x3);
        pcomp(it, x0); pcomp(it + NGW, x1); pcomp(it + 2 * NGW, x2); pcomp(it + 3 * NGW, x3); }
    for (; it < M * 8; it += NGW) { PostIn x0; pload(it, x0); pcomp(it, x0); }
}
__device__ __forceinline__ void phase_mlstm_post(const Frame& F0, int l) {
    const Frame F = reframe(F0);
    const float* __restrict__ HC = (const float*)(KWS() + WS_HC); const bf16* __restrict__ PROJ = (const bf16*)(KWS() + WS_PROJ); bf16* __restrict__ Y = (bf16*)(KWS() + WS_Y);
    const float* gw_ = KIN(I_MGNW) + (size_t)l * 2048;
    const int gw = F.bid * NWAVES + F.wave, NGW = F.nblk * NWAVES, lane = F.lane;
#pragma unroll 2
    for (int it = gw; it < M * 4; it += NGW) { const int t = it >> 2, hd = it & 3, ch = hd * 512 + lane * 8;
        const f32x4 v0 = *(const f32x4*)(HC + (size_t)t * 2048 + ch), v1 = *(const f32x4*)(HC + (size_t)t * 2048 + ch + 4);
        float x[8] = {v0.x, v0.y, v0.z, v0.w, v1.x, v1.y, v1.z, v1.w}; float s = 0.f;
#pragma unroll
        for (int q = 0; q < 8; ++q) s += x[q];
        const float mean = wave_sum(s) * (1.0f / 512.0f); float s2 = 0.f;
#pragma unroll
        for (int q = 0; q < 8; ++q) { x[q] -= mean; s2 += x[q] * x[q]; }
        const float rstd = rsqrtf(wave_sum(s2) * (1.0f / 512.0f) + 1e-6f);
        const u32x4 gg = *(const u32x4*)(PROJ + (size_t)t * NPJ + PC_CG + ch); float gf[8]; unpack8(gg, gf); float o[8];
#pragma unroll
        for (int q = 0; q < 8; ++q) o[q] = x[q] * rstd * gw_[ch + q] * siluf_(gf[q]);
        u32x4 w; w.x = pk2(o[0], o[1]); w.y = pk2(o[2], o[3]); w.z = pk2(o[4], o[5]); w.w = pk2(o[6], o[7]);
        *(u32x4*)(Y + (size_t)t * KCAT + YC_C + ch) = w; }
}

__device__ __forceinline__ s16x4 tr16(const LAS unsigned char* p) { return __builtin_bit_cast(s16x4, __builtin_amdgcn_ds_read_tr16_b64_v4i16((LAS s16x4*)p)); }
constexpr int ML_SROW = 80;
constexpr int ML_K = 0, ML_V = 3 * 16384, ML_S = ML_V + 3 * 32768, ML_G = ML_S + 64 * ML_SROW, ML_DEN = ML_G + 1024, ML_END = ML_DEN + 512;
static_assert(ML_END <= RING_BYTES, "mLSTM LDS");
__device__ __forceinline__ void xattn_item(const Frame& F, int l, const int item);
__device__ __forceinline__ int ml_vswz(int row) { return ((row & 3) << 1) | (((row >> 3) & 1) << 3); }
__device__ __forceinline__ void phase_mlstm(const Frame& F0, int l, unsigned* queue, const int lim_lo = 0, const int lim_hi = 1 << 30) {
    const Frame F = reframe(F0);
    const bf16* PROJ = (const bf16*)(KWS() + WS_PROJ); const bf16* QC = (const bf16*)(KWS() + WS_QC); const bf16* KC = (const bf16*)(KWS() + WS_KC);
    const float* G = (const float*)(KWS() + WS_SCAL); const float* MX = G + (size_t)M * 4; const float* MT = MX + (size_t)M * 4; float* HC = (float*)(KWS() + WS_HC);
    LAS unsigned char* lds = F.lds; LAS float* denl = (LAS float*)(lds + ML_DEN);
    const int tid = F.tid, lane = F.lane, w = F.wave, l15 = lane & 15, lg = lane >> 4, rt = w >> 1, ctp = w & 1;
    volatile LAS unsigned* qslot = (volatile LAS unsigned*)(F.lds + MISC_OFF);
    const bool affine = (lim_lo == 0) && (lim_hi == (1 << 30)); bool ml_left = affine, cv_left = affine && CONV1_IN_QUEUE && (l == 0), flip = false;
    for (;;) {
        __syncthreads();
        if (tid == 0) { unsigned it = 0xffffffffu;
            if (cv_left && (flip || !ml_left)) { const unsigned t = __hip_atomic_fetch_add(queue + 16, 1u, __ATOMIC_RELAXED, __HIP_MEMORY_SCOPE_AGENT); if (t < (unsigned)CONV_NVB) it = 1024u + t; else cv_left = false; }
            if (it == 0xffffffffu && ml_left) { const unsigned x = xb_xcc_id() & 7u;
                for (unsigned j = 0; j < 8u; ++j) { const unsigned sidx = (x + j) & 7u; const unsigned t = __hip_atomic_fetch_add(queue + 8 + sidx, 1u, __ATOMIC_RELAXED, __HIP_MEMORY_SCOPE_AGENT); if (t < 64u) { it = (t << 3) | sidx; break; } }
                if (it == 0xffffffffu) ml_left = false; }
            if (it == 0xffffffffu && cv_left) { const unsigned t = __hip_atomic_fetch_add(queue + 16, 1u, __ATOMIC_RELAXED, __HIP_MEMORY_SCOPE_AGENT); if (t < (unsigned)CONV_NVB) it = 1024u + t; else cv_left = false; }
            flip = !flip;
            if (it == 0xffffffffu) { const unsigned t = __hip_atomic_fetch_add(queue, 1u, __ATOMIC_RELAXED, __HIP_MEMORY_SCOPE_AGENT); it = affine ? (t < 512u ? 512u + t : 0xfffffffeu) : t; }
            qslot[0] = it; }
        __syncthreads();
        if (affine && qslot[0] == 0xfffffffeu) break;
        const int item = (int)qslot[0] + lim_lo; if (item >= lim_hi || item >= 1024 + ((CONV1_IN_QUEUE && l == 0) ? CONV_NVB : 0)) break;
        if (item >= 1024) { phase_convert_layer(F, 1, 2, item - 1024, CONV_NVB); continue; }
        if (item >= 768) { scan2_item(F, item - 768); continue; }
        if (item >= 512) { xattn_item(F, l, item - 512); continue; }
        const int qt = 63 - (item >> 3), b = (item >> 2) & 1, hd = item & 3, t0 = qt * 64; const size_t rowb = (size_t)b * SEQ;
        const int tq = opaque_v(lane);
        const int q15 = tq & 15, qg = tq >> 4;
        bf16x8 qf[8];
#pragma unroll
        for (int ks = 0; ks < 8; ++ks) qf[ks] = *(const bf16x8*)(QC + (rowb + t0 + 16 * rt + q15) * 1024 + hd * 256 + 32 * ks + 8 * qg);
        float mxr[4];
#pragma unroll
        for (int j = 0; j < 4; ++j) mxr[j] = MX[(rowb + t0 + 16 * rt + qg * 4 + j) * 4 + hd];
        f32x4 num[4][4];
#pragma unroll
        for (int r4 = 0; r4 < 4; ++r4)
#pragma unroll
            for (int c4 = 0; c4 < 4; ++c4) num[r4][c4] = (f32x4){0.f, 0.f, 0.f, 0.f};
        float dacc[4] = {0.f, 0.f, 0.f, 0.f};
        asm volatile("s_waitcnt vmcnt(0)" ::: "memory");
        asm volatile("" : "+v"(qf[0]), "+v"(qf[1]), "+v"(qf[2]), "+v"(qf[3]), "+v"(qf[4]), "+v"(qf[5]), "+v"(qf[6]), "+v"(qf[7]));
        asm volatile("" : "+v"(mxr[0]), "+v"(mxr[1]), "+v"(mxr[2]), "+v"(mxr[3]));
#define ML_DMA_KV(kt_, bf_) do { const int s0_ = (kt_) * 32; const char* kb_ = (const char*)KC + ((rowb + s0_) * 1024 + hd * 256) * 2; const char* vb_ = (const char*)PROJ + ((rowb + s0_) * NPJ + PC_CV + hd * 512) * 2; \
            _Pragma("unroll") for (int i = 0; i < 2; ++i) { const int pc = w * 2 + i, row = 2 * pc + (lane >> 5), p = lane & 31; \
                __builtin_amdgcn_global_load_lds((const unsigned*)(kb_ + (size_t)row * 2048 + ((p ^ (row & 15)) * 16)), (LAS unsigned*)(lds + ML_K + (bf_) * 16384 + pc * 1024), 16, 0, 0); } \
            _Pragma("unroll") for (int i = 0; i < 4; ++i) { const int row = w * 4 + i; \
                __builtin_amdgcn_global_load_lds((const unsigned*)(vb_ + (size_t)row * (NPJ * 2) + ((lane ^ ml_vswz(row)) * 16)), (LAS unsigned*)(lds + ML_V + (bf_) * 32768 + row * 1024), 16, 0, 0); } \
            if (w == 0) __builtin_amdgcn_global_load_lds((const unsigned*)(G + (rowb + s0_ + (lane & 31)) * 4 + hd), (LAS unsigned*)(lds + ML_G + (bf_) * 256), 4, 0, 0); } while (0)
        const int nkt = 2 * qt + 2;
        ML_DMA_KV(0, 0); ML_DMA_KV(1, 1);
        int buf = 0;
        for (int kt = 0; kt < nkt; ++kt) {
            const int s0 = kt * 32;
            if (kt + 1 < nkt) { if (w == 0) asm volatile("s_waitcnt vmcnt(7) lgkmcnt(0)" ::: "memory"); else asm volatile("s_waitcnt vmcnt(6) lgkmcnt(0)" ::: "memory"); }
            else asm volatile("s_waitcnt vmcnt(0) lgkmcnt(0)" ::: "memory");
            __builtin_amdgcn_s_barrier(); asm volatile("" ::: "memory");
            { const int bf2 = buf >= 1 ? buf - 1 : 2; if (kt + 2 < nkt) ML_DMA_KV(kt + 2, bf2); }
            const LAS unsigned char* kb = lds + ML_K + buf * 16384; const LAS unsigned char* vbuf = lds + ML_V + buf * 32768; const LAS float* gl = (const LAS float*)(lds + ML_G + buf * 256);
            f32x4 sacc = (f32x4){0.f, 0.f, 0.f, 0.f};
            { bf16x8 kf[8];
#pragma unroll
              for (int ks = 0; ks < 8; ++ks) { const int r = 16 * ctp + l15; kf[ks] = *(const LAS bf16x8*)(kb + r * 512 + (((4 * ks + lg) ^ (r & 15)) * 16)); }
              asm volatile("" : "+v"(kf[0]), "+v"(kf[1]), "+v"(kf[2]), "+v"(kf[3]), "+v"(kf[4]), "+v"(kf[5]), "+v"(kf[6]), "+v"(kf[7]));
              f32x4 sacc1 = (f32x4){0.f, 0.f, 0.f, 0.f};
#pragma unroll
              for (int ks = 0; ks < 8; ks += 2) { sacc = __builtin_amdgcn_mfma_f32_16x16x32_bf16(qf[ks], kf[ks], sacc, 0, 0, 0); sacc1 = __builtin_amdgcn_mfma_f32_16x16x32_bf16(qf[ks + 1], kf[ks + 1], sacc1, 0, 0, 0); }
              sacc += sacc1; }
            { const int sl = 16 * ctp + l15; const float gs = gl[sl];
#pragma unroll
                for (int j = 0; j < 4; ++j) { const int tl = 16 * rt + lg * 4 + j;
                    const float wgt = (s0 + sl <= t0 + tl) ? __expf(gs - mxr[j]) : 0.f; const float val = sacc[j] * wgt;
                    *(LAS unsigned short*)(lds + ML_S + tl * ML_SROW + sl * 2) = (unsigned short)f2bf(val);
                    dacc[j] += row16_sum(val); } }
            asm volatile("s_waitcnt lgkmcnt(0)" ::: "memory"); __builtin_amdgcn_s_barrier(); asm volatile("" ::: "memory");
            { bf16x8 afr[4];
#pragma unroll
                for (int r4 = 0; r4 < 4; ++r4) afr[r4] = *(const LAS bf16x8*)(lds + ML_S + (16 * r4 + l15) * ML_SROW + (8 * lg) * 2);
                unsigned va[4];
#pragma unroll
                for (int c4 = 0; c4 < 4; ++c4) { const int r = 8 * lg + (l15 >> 2), ch = 8 * w + 2 * c4 + ((l15 & 3) >> 1); va[c4] = (unsigned)(size_t)(vbuf + r * 1024 + ((ch ^ ml_vswz(r)) * 16) + (l15 & 1) * 8); }
                s16x4 lo[4], hi[4];
                asm volatile("ds_read_b64_tr_b16 %0, %8\n\tds_read_b64_tr_b16 %1, %8 offset:4096\n\tds_read_b64_tr_b16 %2, %9\n\tds_read_b64_tr_b16 %3, %9 offset:4096\n\t"
                             "ds_read_b64_tr_b16 %4, %10\n\tds_read_b64_tr_b16 %5, %10 offset:4096\n\tds_read_b64_tr_b16 %6, %11\n\tds_read_b64_tr_b16 %7, %11 offset:4096\n\ts_waitcnt lgkmcnt(0)"
                             : "=&v"(lo[0]), "=&v"(hi[0]), "=&v"(lo[1]), "=&v"(hi[1]), "=&v"(lo[2]), "=&v"(hi[2]), "=&v"(lo[3]), "=&v"(hi[3]) : "v"(va[0]), "v"(va[1]), "v"(va[2]), "v"(va[3]) : "memory");
#pragma unroll
                for (int c4 = 0; c4 < 4; ++c4) { const bf16x8 bfr = __builtin_shufflevector(lo[c4], hi[c4], 0, 1, 2, 3, 4, 5, 6, 7);
#pragma unroll
                    for (int r4 = 0; r4 < 4; ++r4) num[r4][c4] = __builtin_amdgcn_mfma_f32_16x16x32_bf16(afr[r4], bfr, num[r4][c4], 0, 0, 0); } }
            buf = buf == 2 ? 0 : buf + 1;
        }
#undef ML_DMA_KV
        if (l15 == 0) {
#pragma unroll
            for (int j = 0; j < 4; ++j) denl[(16 * rt + lg * 4 + j) * 2 + ctp] = dacc[j]; }
        __syncthreads();
        { unsigned short co[4][4][4]; float mtv[4][4];
#pragma unroll
          for (int r4 = 0; r4 < 4; ++r4)
#pragma unroll
            for (int j = 0; j < 4; ++j) { const size_t row = rowb + t0 + 16 * r4 + lg * 4 + j; mtv[r4][j] = MT[row * 4 + hd];
#pragma unroll
                for (int c4 = 0; c4 < 4; ++c4) co[r4][j][c4] = PROJ[row * NPJ + PC_CO + hd * 512 + 64 * w + 16 * c4 + l15]; }
#pragma unroll
          for (int r4 = 0; r4 < 4; ++r4)
#pragma unroll
            for (int j = 0; j < 4; ++j) { const int tl = 16 * r4 + lg * 4 + j; const size_t row = rowb + t0 + tl;
                const float den = denl[2 * tl] + denl[2 * tl + 1], mt = mtv[r4][j]; const float inv = __builtin_amdgcn_rcpf(fmaxf(fabsf(den), __expf(-mt)));
#pragma unroll
                for (int c4 = 0; c4 < 4; ++c4) { const int dv = 64 * w + 16 * c4 + l15; const float o = sigm(bf2f(co[r4][j][c4]));
                    HC[row * 2048 + hd * 512 + dv] = num[r4][c4][j] * inv * o; } } }
        asm volatile("s_waitcnt vmcnt(0)" ::: "memory"); __syncthreads();
        { const float* gw_ = KIN(I_MGNW) + (size_t)l * 2048; bf16* Y = (bf16*)(KWS() + WS_Y); const int ch = hd * 512 + lane * 8;
          f32x4 hv0[8], hv1[8]; u32x4 hg[8]; const f32x4 gwa = *(const f32x4*)(gw_ + ch), gwb = *(const f32x4*)(gw_ + ch + 4);
#pragma unroll
          for (int rr = 0; rr < 8; ++rr) { const size_t t = rowb + t0 + w * 8 + rr; hv0[rr] = *(const f32x4*)(HC + t * 2048 + ch); hv1[rr] = *(const f32x4*)(HC + t * 2048 + ch + 4); hg[rr] = *(const u32x4*)(PROJ + t * NPJ + PC_CG + ch); }
          asm volatile("" ::: "memory");
#pragma unroll
          for (int rr = 0; rr < 8; ++rr) { const size_t t = rowb + t0 + w * 8 + rr;
            const f32x4 v0 = hv0[rr], v1 = hv1[rr];
            float x[8] = {v0.x, v0.y, v0.z, v0.w, v1.x, v1.y, v1.z, v1.w}; float sm_ = 0.f;
#pragma unroll
            for (int q = 0; q < 8; ++q) sm_ += x[q];
            const float mean = wave_sum(sm_) * (1.0f / 512.0f); float s2 = 0.f;
#pragma unroll
            for (int q = 0; q < 8; ++q) { x[q] -= mean; s2 += x[q] * x[q]; }
            const float rstd = rsqrtf(wave_sum(s2) * (1.0f / 512.0f) + 1e-6f);
            float gf[8]; unpack8(hg[rr], gf); float o[8];
#pragma unroll
            for (int q = 0; q < 8; ++q) o[q] = x[q] * rstd * (q < 4 ? gwa[q] : gwb[q - 4]) * siluf_(gf[q]);
            u32x4 wv; wv.x = pk2(o[0], o[1]); wv.y = pk2(o[2], o[3]); wv.z = pk2(o[4], o[5]); wv.w = pk2(o[6], o[7]);
            *(u32x4*)(Y + t * KCAT + YC_C + ch) = wv; } }
    }
    __syncthreads();
}

constexpr int XA_ROW = 272, XA_K = 0, XA_V = 256 * XA_ROW, XA_END = 2 * 256 * XA_ROW, XA_PROW = 528;
static_assert(XA_END <= RING_BYTES && 8 * 16 * XA_PROW <= XA_V, "x-attn LDS");
__device__ __forceinline__ void xattn_item(const Frame& F, int l, const int item) {
    const bf16* PROJ = (const bf16*)(KWS() + WS_PROJ); const bf16* KV = (const bf16*)(KWS() + WS_KV) + (size_t)l * MM * 1024; bf16* Y = (bf16*)(KWS() + WS_Y);
    LAS unsigned char* lds = F.lds; const int lane = opaque_v(F.lane), w = F.wave, tid = w * 64 + lane, l15 = lane & 15, lg = lane >> 4;
    {
        const int b = item >> 7, hd = (item >> 5) & 3, qb = item & 31; const size_t row0 = (size_t)b * SEQ + qb * 128 + 16 * w;
        __syncthreads();
        { u32x4 kq[8], vq[8];
#pragma unroll
          for (int i = 0; i < 8; ++i) { const int p = tid + 512 * i, r = p >> 4, c16 = p & 15; const bf16* src = KV + (size_t)(b * MEML + r) * 1024 + hd * 128 + c16 * 8; kq[i] = *(const u32x4*)src; vq[i] = *(const u32x4*)(src + 512); }
          asm volatile("" : "+v"(kq[0]), "+v"(kq[1]), "+v"(kq[2]), "+v"(kq[3]), "+v"(kq[4]), "+v"(kq[5]), "+v"(kq[6]), "+v"(kq[7]), "+v"(vq[0]), "+v"(vq[1]), "+v"(vq[2]), "+v"(vq[3]), "+v"(vq[4]), "+v"(vq[5]), "+v"(vq[6]), "+v"(vq[7]) :: "memory");
#pragma unroll
          for (int i = 0; i < 8; ++i) { const int p = tid + 512 * i, r = p >> 4, c16 = p & 15; *(LAS u32x4*)(lds + XA_K + r * XA_ROW + c16 * 16) = kq[i]; *(LAS u32x4*)(lds + XA_V + r * XA_ROW + c16 * 16) = vq[i]; } }
        bf16x8 qf[4];
#pragma unroll
        for (int ks = 0; ks < 4; ++ks) qf[ks] = *(const bf16x8*)(PROJ + (row0 + l15) * NPJ + PC_XQ + hd * 128 + 32 * ks + 8 * lg);
        unsigned short xg[4][8];
#pragma unroll
        for (int j = 0; j < 4; ++j)
#pragma unroll
            for (int cc = 0; cc < 8; ++cc) xg[j][cc] = PROJ[(row0 + lg * 4 + j) * NPJ + PC_XG + hd * 128 + 16 * cc + l15];
        __syncthreads();
        f32x4 sacc[16];
#pragma unroll
        for (int ct = 0; ct < 16; ++ct) { sacc[ct] = (f32x4){0.f, 0.f, 0.f, 0.f};
#pragma unroll
            for (int ks = 0; ks < 4; ++ks) { const bf16x8 bfr = *(const LAS bf16x8*)(lds + XA_K + (16 * ct + l15) * XA_ROW + (32 * ks + 8 * lg) * 2);
                sacc[ct] = __builtin_amdgcn_mfma_f32_16x16x32_bf16(qf[ks], bfr, sacc[ct], 0, 0, 0); } }
        float mx[4], sm[4];
#pragma unroll
        for (int j = 0; j < 4; ++j) { float m = sacc[0][j];
#pragma unroll
            for (int ct = 1; ct < 16; ++ct) m = fmaxf(m, sacc[ct][j]);
            mx[j] = row16_max(m); sm[j] = 0.f; }
        __syncthreads();
        LAS unsigned char* pw = lds + XA_K + w * 16 * XA_PROW;
#pragma unroll
        for (int ct = 0; ct < 16; ++ct)
#pragma unroll
            for (int j = 0; j < 4; ++j) { const float p = __expf((sacc[ct][j] - mx[j]) * 0.08838834764831845f); sm[j] += p;
                *(LAS unsigned short*)(pw + (lg * 4 + j) * XA_PROW + (16 * ct + l15) * 2) = (unsigned short)f2bf(p); }
#pragma unroll
        for (int j = 0; j < 4; ++j) sm[j] = row16_sum(sm[j]);
        LDS_WAIT(); asm volatile("" ::: "memory");
        f32x4 oacc[8];
#pragma unroll
        for (int cc = 0; cc < 8; ++cc) oacc[cc] = (f32x4){0.f, 0.f, 0.f, 0.f};
#pragma unroll
        for (int ks = 0; ks < 8; ++ks) { const bf16x8 afr = *(const LAS bf16x8*)(pw + l15 * XA_PROW + (32 * ks + 8 * lg) * 2);
#pragma unroll
            for (int cc = 0; cc < 8; ++cc) { const LAS unsigned char* vp = lds + XA_V + (32 * ks + 8 * lg + (l15 >> 2)) * XA_ROW + (16 * cc + 4 * (l15 & 3)) * 2;
                const s16x4 lo = tr16(vp), hi = tr16(vp + 4 * XA_ROW); const bf16x8 bfr = __builtin_shufflevector(lo, hi, 0, 1, 2, 3, 4, 5, 6, 7);
                oacc[cc] = __builtin_amdgcn_mfma_f32_16x16x32_bf16(afr, bfr, oacc[cc], 0, 0, 0); } }
#pragma unroll
        for (int j = 0; j < 4; ++j) { const size_t row = row0 + lg * 4 + j; const float inv = __builtin_amdgcn_rcpf(sm[j]);
#pragma unroll
            for (int cc = 0; cc < 8; ++cc) { const int d = 16 * cc + l15; const float gate = siluf_(bf2f(xg[j][cc]));
                Y[row * KCAT + YC_X + hd * 128 + d] = (bf16)f2bf(oacc[cc][j] * inv * gate); } }
    }
    __syncthreads();
}

constexpr int NPL = 9, NPHASE = 2 + DEPTH * NPL;
struct Args { Ctx c; int ph_lo, ph_hi; };
template <unsigned PH_MASK> __global__ void __launch_bounds__(NTHREADS, 2) mega(Args args) {
    extern __shared__ __attribute__((aligned(16))) unsigned char lds_raw[];
    Frame F; F.lds = (LAS unsigned char*)lds_raw; F.wave = __builtin_amdgcn_readfirstlane((int)threadIdx.x >> 6); F.lane = lane_id(); F.tid = F.wave * 64 + F.lane; F.bid = blockIdx.x; F.nblk = gridDim.x;
    volatile LAS unsigned* MISC = (volatile LAS unsigned*)(F.lds + MISC_OFF);
    if (F.tid < 16) MISC[F.tid] = 0u;
    __syncthreads();
    const int lo = args.ph_lo, hi = args.ph_hi;
    XcdBarrier bar; bar.bar = (unsigned*)(KWS() + WS_CTL) + CW_BAR; bar.st = MISC + 8;
    if (PH_MASK == 0x7FFu) { if (hi - lo > 1) xcd_barrier_setup(bar, F.wave); }
#ifndef PROBE_DUP
#define PROBE_DUP 0u
#endif
#define DUP(j) (((PROBE_DUP >> (j)) & 1u) ? 2 : 1)
#define IN(k) (lo <= (k) && (k) < hi)
#define EN(j) ((PH_MASK >> (j)) & 1u)
#define SEAM(k) do { if (PH_MASK == 0x7FFu) { if (IN(k) && IN((k) + 1)) xcd_barrier(bar, F.wave); } } while (0)
    if (IN(0) && EN(0)) for (int rep = 0; rep < DUP(0); ++rep) { phase_convert_layer(F, 0, 1, F.bid, F.nblk); phase_convert_layer(F, 1, CONV1_IN_QUEUE ? 1 : 3, F.bid, F.nblk);
        { unsigned* ctr = (unsigned*)(KWS() + WS_CTL) + CW_QUEUE + 128 + 16 * rep; volatile LAS unsigned* qs = MISC;
          for (;;) { __syncthreads(); if (F.tid == 0) qs[0] = __hip_atomic_fetch_add(ctr, 1u, __ATOMIC_RELAXED, __HIP_MEMORY_SCOPE_AGENT); __syncthreads();
              const int vb = (int)qs[0]; if (vb >= CONV_NVB + 256) break;
              if (vb < CONV_NVB) phase_convert_layer(F, 0, 2, vb, CONV_NVB);
              else { Frame Fv = F; Fv.bid = vb - CONV_NVB; Fv.nblk = 256; phase_norm(Fv, KIN(I_X), KIN(I_NORM_G), false); } } } }
    SEAM(0);
    for (int l0 = 0; l0 < DEPTH; ++l0) {
        const int l = opaque_s(l0);
        const int pb = 2 + l * NPL;
        if (IN(pb + 0) && EN(2)) for (int rep = 0; rep < DUP(2); ++rep) {
            if (l == 0) {
                for (int l2 = 0; l2 < DEPTH; ++l2) { unsigned char* ws = KWS(); unsigned char* wl2 = ws + WS_W + (size_t)l2 * SZ_WLAYER;
                    pg8::Gemm g{(const char*)(ws + WS_MEMN) + (size_t)l2 * MM * 4096 * 2, (const char*)(wl2 + WO_WKV)};
                    EpiProj<1024, false> E{(bf16*)(ws + WS_KV) + (size_t)l2 * MM * 1024, nullptr};
                    const int cc = F.bid - (F.nblk - 16) - 8 * l2;
                    pg8::gemm_phase<pg8::Geo<8192, 8192, 4096, MM / 256, 4>, EpiProj<1024, false>>(F.lds, g, 8, (cc >= 0 && cc < 8) ? cc : 1000, F.wave, E); }
            }
            unsigned char* ws = KWS(); unsigned char* wl = ws + WS_W + (size_t)l * SZ_WLAYER;
            { pg8::Gemm g{(const char*)(ws + WS_H), (const char*)(wl + WO_WIN)};
              EpiProj<NPJ, true> E{(bf16*)(ws + WS_PROJ), (float*)(ws + WS_IFB)};
              pg8::gemm_phase<pg8::Geo<8192, 8192, 4096, M / 256, PN_I8>, EpiProj<NPJ, true>>(F.lds, g, F.nblk, F.bid, F.wave, E); }
            { pg8::Gemm g{(const char*)(ws + WS_H8), (const char*)(wl + WO_WIN) + (size_t)PC_I8 * 8192};
              EpiGate8 E{(bf16*)(ws + WS_PROJ) + PC_I8, (const float*)(ws + WS_HS), (const unsigned*)(ws + WS_CTL) + CW_CMAX + l * N8};
              pg8::gemm_phase<pg8::Geo<4096, 4096, 2048, M / 256, N8 / 256, 0, 0, true>, EpiGate8>(F.lds, g, F.nblk, F.bid, F.wave, E); }
        }
        SEAM(pb + 0);
        if (IN(pb + 1) && EN(3)) for (int rep = 0; rep < DUP(3); ++rep) { phase_prep(F, l); }
        SEAM(pb + 1);
        if (IN(pb + 2) && EN(4)) for (int rep = 0; rep < DUP(4); ++rep) {
            { unsigned char* ws = KWS(); unsigned char* wl = ws + WS_W + (size_t)l * SZ_WLAYER;
              pg8::Gemm g{(const char*)(ws + WS_U), (const char*)(wl + WO_WG)};
              EpiLru E{(const bf16*)(ws + WS_U), (float*)(ws + WS_LA), (float*)(ws + WS_LB), KIN(I_LRU_BA) + (size_t)l * 2048, KIN(I_LRU_BX) + (size_t)l * 2048, KIN(I_LRU_LAM) + (size_t)l * 2048};
              pg8::gemm_phase<pg8::Geo<4096, 512, 256, M / 256, 16, 1, 512>, EpiLru>(F.lds, g, F.nblk, F.bid, F.wave, E); }
            { unsigned char* ws = KWS(); unsigned char* wl = ws + WS_W + (size_t)l * SZ_WLAYER;
              pg8::Gemm g{(const char*)(ws + WS_LORA), (const char*)(wl + WO_WL)};
              EpiLora E{(float*)(ws + WS_RV), (float*)(ws + WS_AA), KIN(I_W0) + (size_t)l * 2048, KIN(I_A0) + (size_t)l * 2048};
              pg8::gemm_phase<pg8::Geo<512, 512, 256, M / 256, 16>, EpiLora>(F.lds, g, F.nblk, F.bid, F.wave, E); }
        }
        SEAM(pb + 2);
        if (IN(pb + 3) && EN(5)) for (int rep = 0; rep < DUP(5); ++rep) { phase_rwkv_vec(F, l); phase_lru_scan1(F); }
        SEAM(pb + 3);
        if (IN(pb + 4) && EN(6)) {
            for (int rep = 0; rep < DUP(6); ++rep) phase_rwkv_rec(F, F.bid, F.nblk);
#ifdef PROBE_Q
            phase_mlstm(F, l, (unsigned*)(KWS() + WS_CTL) + CW_QUEUE + 64 * l + 32, PROBE_Q_LO, PROBE_Q_HI);
#endif
            phase_mlstm(F, l, (unsigned*)(KWS() + WS_CTL) + CW_QUEUE + 64 * l);
        }
        SEAM(pb + 4);
        if (IN(pb + 5) && EN(7)) for (int rep = 0; rep < DUP(7); ++rep) { phase_rwkv_post(F, l); }
        SEAM(pb + 5);
        if (IN(pb + 6) && EN(8)) for (int rep = 0; rep < DUP(8); ++rep) {
            unsigned char* ws = KWS(); unsigned char* wl = ws + WS_W + (size_t)l * SZ_WLAYER;
            pg8::Gemm g{(const char*)(ws + WS_Y), (const char*)(wl + WO_WCAT)};
            EpiMerge E{(const bf16*)(ws + WS_PROJ) + PC_GATE, (bf16*)(ws + WS_MERGED)};
            pg8::gemm_phase<pg8::Geo<KCAT * 2, KCAT * 2, KCAT, M / 256, 16>, EpiMerge>(F.lds, g, F.nblk, F.bid, F.wave, E);
        }
        SEAM(pb + 6);
        if (IN(pb + 7) && EN(9)) for (int rep = 0; rep < ((l == 0) ? DUP(9) : 1); ++rep) {
            unsigned char* ws = KWS(); unsigned char* wl = ws + WS_W + (size_t)l * SZ_WLAYER;
            pg8::Gemm g{(const char*)(ws + WS_MERGED), (const char*)(wl + WO_WOUT)};
            EpiOut E{(l == 0) ? KIN(I_X) : (const float*)(ws + WS_X1), (float*)(ws + WS_X1)};
            pg8::gemm_phase<pg8::Geo<8192, 8192, 4096, M / 256, 16>, EpiOut>(F.lds, g, F.nblk, F.bid, F.wave, E);
        }
        SEAM(pb + 7);
        if (IN(pb + 8) && EN(10)) { const float* X1 = (const float*)(KWS() + WS_X1); if (l + 1 < DEPTH) phase_norm(F, X1, KIN(I_NORM_G) + (size_t)(l + 1) * 4096, false); else phase_norm(F, X1, KIN(I_FNG), true); }
        SEAM(pb + 8);
    }
#undef IN
#undef SEAM
}

typedef void (*kern_t)(Args);
static kern_t phase_kernel(int p) {
    const int j = p < 2 ? p : 2 + (p - 2) % NPL;
    switch (j) { case 0: return mega<1u << 0>; case 1: return mega<1u << 1>; case 2: return mega<1u << 2>; case 3: return mega<1u << 3>; case 4: return mega<1u << 4>; case 5: return mega<1u << 5>;
                 case 6: return mega<1u << 6>; case 7: return mega<1u << 7>; case 8: return mega<1u << 8>; case 9: return mega<1u << 9>; default: return mega<1u << 10>; }
}
extern "C" void kernel_launch(void* const* d_in, const int* in_sizes, int n_in, void* d_out, int out_size, void* d_ws, size_t ws_size, hipStream_t stream) {
    static int grid = 0;
    if (grid == 0) {
        if (n_in != 34 || ws_size < WS_END) { fprintf(stderr, "kernel_launch: unexpected problem (n_in %d, ws %zu, need %zu)\n", n_in, ws_size, (size_t)WS_END); grid = -1; return; }
        int dev = 0, cus = 0;
        if (hipGetDevice(&dev) != hipSuccess || hipDeviceGetAttribute(&cus, hipDeviceAttributeMultiprocessorCount, dev) != hipSuccess) { grid = -1; return; }
#if MK_PER_PHASE
        for (int p = 0; p < 2 + NPL; ++p) if (hipFuncSetAttribute((const void*)phase_kernel(p), hipFuncAttributeMaxDynamicSharedMemorySize, LDS_BYTES) != hipSuccess) { fprintf(stderr, "kernel_launch: hipFuncSetAttribute failed\n"); grid = -1; return; }
#else
        if (hipFuncSetAttribute((const void*)mega<0x7FFu>, hipFuncAttributeMaxDynamicSharedMemorySize, LDS_BYTES) != hipSuccess) { fprintf(stderr, "kernel_launch: hipFuncSetAttribute failed\n"); grid = -1; return; }
#endif
        int occ = 0;
#if MK_PER_PHASE
        occ = 1;
#else
        if (hipOccupancyMaxActiveBlocksPerMultiprocessor(&occ, mega<0x7FFu>, NTHREADS, LDS_BYTES) != hipSuccess || occ < 1) { fprintf(stderr, "kernel_launch: occupancy query reports %d workgroups per CU\n", occ); grid = -1; return; }
#endif
        (void)hipGetLastError();
        grid = cus;
    }
    if (grid < 0) return;
    (void)hipMemsetAsync((char*)d_ws + WS_CTL, 0, CTL_ZERO_BYTES, stream);
    Args a{};
    for (int i = 0; i < 34; ++i) a.c.in[i] = (const float*)d_in[i];
    a.c.out = (float*)d_out; a.c.ws = (unsigned char*)d_ws;
#if MK_PER_PHASE
    for (int p = 0; p < NPHASE; ++p) { a.ph_lo = p; a.ph_hi = p + 1; hipLaunchKernelGGL(phase_kernel(p), dim3(grid), dim3(NTHREADS), LDS_BYTES, stream, a); }
#else
    a.ph_lo = 0; a.ph_hi = NPHASE; hipLaunchKernelGGL(mega<0x7FFu>, dim3(grid), dim3(NTHREADS), LDS_BYTES, stream, a);
#endif
    (void)in_sizes; (void)out_size;
}
```

```cpp
#include <hip/hip_runtime.h>
#include <cstdio>
#include <cstdint>

#ifndef MK_PER_PHASE
#define MK_PER_PHASE 0
#endif

#define LAS __attribute__((address_space(3)))
#define GAS __attribute__((address_space(1)))
typedef unsigned short bf16;
typedef short bf16x8 __attribute__((ext_vector_type(8)));
typedef short s16x4 __attribute__((ext_vector_type(4)));
typedef float f32x4 __attribute__((ext_vector_type(4)));
typedef float f32x2 __attribute__((ext_vector_type(2)));
typedef unsigned u32x4 __attribute__((ext_vector_type(4)));
typedef unsigned u32x2 __attribute__((ext_vector_type(2)));
typedef int i32x4 __attribute__((ext_vector_type(4)));

constexpr int D = 4096, NBATCH = 2, SEQ = 4096, M = NBATCH * SEQ, DEPTH = 2, MEML = 256, MM = NBATCH * MEML;
constexpr int CIN = 38088;
constexpr int NPJ = 38400;
constexpr int PC_AX = 0, PC_AG = 2048, PC_BR = 4096, PC_BK = 6144, PC_BV = 8192, PC_BWD = 10240, PC_BAD = 10368, PC_BG = 10496,
              PC_CQK = 12544, PC_CV = 14592, PC_CG = 16640, PC_XQ = 18688, PC_XG = 19200, PC_IF = 19712, PC_CO = 19968, PC_GATE = 22016;
constexpr int PN_IF = PC_IF / 256;
constexpr int KCAT = 6656;
constexpr int YC_A = 0, YC_B = 2048, YC_C = 4096, YC_X = 6144;

constexpr size_t MiB = 1u << 20;
constexpr size_t WS_CTL = 0, CTL_ZERO_BYTES = 1 * MiB;
constexpr size_t SZ_WIN = 300 * MiB, SZ_WCAT = 52 * MiB, SZ_WOUT = 32 * MiB, SZ_WKV = 8 * MiB, SZ_WG = 2 * MiB, SZ_WL = 2 * MiB;
constexpr size_t SZ_WLAYER = SZ_WIN + SZ_WCAT + SZ_WOUT + SZ_WKV + SZ_WG + SZ_WL;
constexpr size_t WS_W = 1 * MiB;
constexpr size_t WO_WIN = 0, WO_WCAT = SZ_WIN, WO_WOUT = WO_WCAT + SZ_WCAT, WO_WKV = WO_WOUT + SZ_WOUT, WO_WG = WO_WKV + SZ_WKV, WO_WL = WO_WG + SZ_WG;
constexpr size_t WS_MEMN = WS_W + 2 * SZ_WLAYER;
constexpr size_t WS_KV = WS_MEMN + 8 * MiB;
constexpr size_t WS_H = WS_KV + 2 * MiB;
constexpr size_t WS_PROJ = WS_H + 64 * MiB;
constexpr size_t WS_IFB = WS_PROJ + 600 * MiB;
constexpr size_t WS_U = WS_IFB + 1 * MiB;
constexpr size_t WS_LA = WS_U + 32 * MiB;
constexpr size_t WS_LB = WS_LA + 64 * MiB;
constexpr size_t WS_CARRY = WS_LB + 64 * MiB;
constexpr size_t WS_LORA = WS_CARRY + 1 * MiB;
constexpr size_t WS_WDEC = WS_LORA + 4 * MiB;
constexpr size_t WS_AA = WS_WDEC + 64 * MiB;
constexpr size_t WS_RV = WS_AA + 64 * MiB;
constexpr size_t WS_VV = WS_RV + 320 * MiB;
constexpr size_t WS_BON = WS_VV + 64 * MiB;
constexpr size_t WS_YR = WS_BON + 1 * MiB;
constexpr size_t WS_QC = WS_YR + 64 * MiB;
constexpr size_t WS_KC = WS_QC + 16 * MiB;
constexpr size_t WS_SCAL = WS_KC + 16 * MiB;
constexpr size_t WS_HC = WS_SCAL + 1 * MiB;
constexpr size_t WS_Y = WS_HC + 64 * MiB;
constexpr size_t WS_MERGED = WS_Y + 104 * MiB;
constexpr size_t WS_X1 = WS_MERGED + 64 * MiB;
constexpr size_t WS_H8 = WS_X1 + 128 * MiB;
constexpr size_t WS_HS = WS_H8 + 32 * MiB;
constexpr size_t WS_END = WS_HS + 1 * MiB;
constexpr int CW_BAR = 4096, CW_QUEUE = 8192;
constexpr int CW_CMAX = 131072;
constexpr int NGATE = 16384, PC_I8 = PC_CO, N8 = 2048 + NGATE, PN_I8 = PC_I8 / 256;
#ifndef CONV1_IN_QUEUE
#define CONV1_IN_QUEUE 1
#endif
constexpr int CAT_NVB = 128;
constexpr int CONV_NVB = 512;

constexpr int RING_BYTES = 155648;
constexpr int MISC_OFF = RING_BYTES;
constexpr int LDS_BYTES = 159744;
constexpr int NWAVES = 8, NTHREADS = 512;

__device__ __forceinline__ float bf2f(unsigned short b) { return __uint_as_float(((unsigned)b) << 16); }
__device__ __forceinline__ unsigned f2bf(float f) { unsigned u = __float_as_uint(f); return (u + 0x7fffu + ((u >> 16) & 1u)) >> 16; }
__device__ __forceinline__ unsigned pk2(float lo, float hi) { return f2bf(lo) | (f2bf(hi) << 16); }
__device__ __forceinline__ unsigned cvt_pk_bf16(float lo, float hi) { unsigned r; asm volatile("v_cvt_pk_bf16_f32 %0, %1, %2" : "=v"(r) : "v"(lo), "v"(hi)); return r; }
__device__ __forceinline__ float sigm(float x) { return __builtin_amdgcn_rcpf(1.0f + __expf(-x)); }
__device__ __forceinline__ float siluf_(float x) { return x * __builtin_amdgcn_rcpf(1.0f + __expf(-x)); }
__device__ __forceinline__ float softplusf_(float x) { return fmaxf(x, 0.f) + __logf(1.0f + __expf(-fabsf(x))); }
__device__ __forceinline__ float expm1s_(float x) { const float p = x * (1.0f + x * (0.5f + x * (0.16666667f + x * (0.041666668f + x * 0.0083333338f)))); return fabsf(x) < 0.25f ? p : __expf(x) - 1.0f; }

template <int CTRL> __device__ __forceinline__ float dpp_mov(float v) { return __int_as_float(__builtin_amdgcn_update_dpp(0, __float_as_int(v), CTRL, 0xf, 0xf, true)); }
__device__ __forceinline__ float row16_sum(float v) {
    v += dpp_mov<0xB1>(v); v += dpp_mov<0x4E>(v); v += dpp_mov<0x141>(v); v += dpp_mov<0x140>(v); return v;
}
__device__ __forceinline__ float wave_sum(float v) { v = row16_sum(v); v += __shfl_xor(v, 16); v += __shfl_xor(v, 32); return v; }
__device__ __forceinline__ float row16_max(float v) {
    v = fmaxf(v, dpp_mov<0xB1>(v)); v = fmaxf(v, dpp_mov<0x4E>(v)); v = fmaxf(v, dpp_mov<0x141>(v)); v = fmaxf(v, dpp_mov<0x140>(v)); return v;
}
__device__ __forceinline__ void unpack8(const u32x4 w, float* f) {
    f[0] = __uint_as_float(w.x << 16); f[1] = __uint_as_float(w.x & 0xffff0000u); f[2] = __uint_as_float(w.y << 16); f[3] = __uint_as_float(w.y & 0xffff0000u);
    f[4] = __uint_as_float(w.z << 16); f[5] = __uint_as_float(w.z & 0xffff0000u); f[6] = __uint_as_float(w.w << 16); f[7] = __uint_as_float(w.w & 0xffff0000u);
}
__device__ __forceinline__ int opaque_v(int v) { asm volatile("" : "+v"(v)); return v; }
template <class T> __device__ __forceinline__ const T* opaque_p(const T* p) { asm volatile("" : "+s"(p)); return p; }
__device__ __forceinline__ int opaque_s(int v) { asm volatile("" : "+s"(v)); return v; }
__device__ __forceinline__ int lane_id() { unsigned z; asm volatile("v_mov_b32 %0, 0" : "=v"(z)); return (int)__builtin_amdgcn_mbcnt_hi(~0u, __builtin_amdgcn_mbcnt_lo(~0u, z)); }
#define LDS_WAIT() asm volatile("s_waitcnt lgkmcnt(0)" ::: "memory")
#define VM_WAIT() asm volatile("s_waitcnt vmcnt(0)" ::: "memory")

#define XB_TMO      128
#define XB_XCNT(j)  (256  + 64 * (j))
#define XB_XSUB(j)  (1280 + 64 * (j))
#define XB_XGEN(j)  (2304 + 64 * (j))
#define XB_TOP      3328
#define XB_TOPGEN   3392
#define XCD_BAR_WORDS 3456
#define XB_SPIN_CAP (1u << 18)
__device__ __forceinline__ unsigned xb_ld(unsigned* p)              { return __hip_atomic_load(p, __ATOMIC_RELAXED, __HIP_MEMORY_SCOPE_AGENT); }
__device__ __forceinline__ unsigned xb_add(unsigned* p, unsigned v) { return __hip_atomic_fetch_add(p, v, __ATOMIC_RELAXED, __HIP_MEMORY_SCOPE_AGENT); }
__device__ __forceinline__ unsigned xb_xcc_id() { return (unsigned)__builtin_amdgcn_s_getreg((3 << 11) | 20) & 0xFu; }
#define XB_SPIN(cond, bar) do { unsigned _sp = 0; while (cond) { __builtin_amdgcn_s_sleep(1); \
    if ((++_sp & 255u) == 0u) { if (xb_ld(&(bar)[XB_TMO])) break; if (_sp > XB_SPIN_CAP) { atomicAdd(&(bar)[XB_TMO], 1u); break; } } } } while (0)
struct XcdBarrier { unsigned* bar; volatile LAS unsigned* st; };
__device__ __forceinline__ void xcd_barrier_setup(const XcdBarrier& b, const int wave_) {
    if (opaque_s(wave_) == 0 && lane_id() == 0) {
        unsigned* bar = b.bar; const unsigned x = xb_xcc_id();
        (void)xb_add(&bar[XB_XCNT(x)], 1u);
        const unsigned G = gridDim.x * gridDim.y * gridDim.z;
        unsigned sum, cnt, mine, sp = 0u;
        for (;;) {
            sum = 0u; cnt = 0u; mine = 0u;
            for (unsigned j = 0; j < 16; ++j) { const unsigned c = xb_ld(&bar[XB_XCNT(j)]); sum += c; cnt += (c > 0u) ? 1u : 0u; mine = (j == x) ? c : mine; }
            if (sum == G) break;
            __builtin_amdgcn_s_sleep(1);
            if ((++sp & 255u) == 0u) { if (xb_ld(&bar[XB_TMO])) break; if (sp > XB_SPIN_CAP) { atomicAdd(&bar[XB_TMO], 1u); break; } }
        }
        b.st[0] = mine > 0u ? mine : 1u; b.st[1] = cnt > 0u ? cnt : 1u; b.st[2] = x;
    }
    __syncthreads();
}
__device__ __forceinline__ void xcd_barrier(const XcdBarrier& b, const int wave_) {
    asm volatile("s_waitcnt vmcnt(0)" ::: "memory");
    __syncthreads();
    if (opaque_s(wave_) == 0 && lane_id() == 0) {
        unsigned* bar = b.bar;
        __builtin_amdgcn_s_waitcnt(0);
        const unsigned nloc = b.st[0], nx = b.st[1], x = b.st[2];
        const unsigned old = xb_add(&bar[XB_XSUB(x)], 1u);
        const unsigned gen = old / nloc;
        if (old + 1u == (gen + 1u) * nloc) {
            __builtin_amdgcn_fence(__ATOMIC_RELEASE, "agent");
            asm volatile("s_waitcnt vmcnt(0)" ::: "memory");
            const unsigned og = xb_add(&bar[XB_TOP], 1u);
            const unsigned tg = og / nx;
            if (og + 1u == (tg + 1u) * nx) xb_add(&bar[XB_TOPGEN], 1u);
            else XB_SPIN(xb_ld(&bar[XB_TOPGEN]) == tg, bar);
            __builtin_amdgcn_fence(__ATOMIC_ACQUIRE, "agent");
            xb_add(&bar[XB_XGEN(x)], 1u);
            asm volatile("s_waitcnt vmcnt(0)" ::: "memory");
        } else {
            XB_SPIN(xb_ld(&bar[XB_XGEN(x)]) == gen, bar);
            __builtin_amdgcn_fence(__ATOMIC_ACQUIRE, "agent");
            asm volatile("s_waitcnt vmcnt(0)" ::: "memory");
        }
    }
    __syncthreads();
}

namespace pg8 {
constexpr int BM = 256, BK = 64, HALF = 128, HTB = HALF * BK * 2, STAGE_BYTES = 8 * HTB, NXCD = 8, WGM = 8;
__host__ __device__ __forceinline__ int lds_byte(int r, int c) { const int st = (r >> 4) * 2 + (c >> 5), rr = r & 15, cc = c & 31, ob = rr * 64 + cc * 2; return st * 1024 + (ob ^ (((ob >> 9) & 1) << 5)); }
__host__ __device__ __forceinline__ void stage_rc(int b, int& R, int& C) { const int st = b / 1024, sb = b % 1024, swz = sb ^ (((sb >> 9) & 1) << 5); R = (st >> 1) * 16 + swz / 64; C = (st & 1) * 32 + (swz % 64) / 2; }
__host__ __device__ __forceinline__ int perm32(int rho) { const int n = rho >> 4, i = rho & 15; return 8 * (i >> 2) + 4 * n + (i & 3); }
struct Unit { int pm, pn; };
struct Gemm { const char* A; const char* Bt; };
template <int LDA_, int LDB_, int K_, int NM_, int NN_, int ASHIFT_ = 0, int ASTEP_ = 0, bool I8_ = false> struct Geo { static constexpr int LDA = LDA_, LDB = LDB_, K = K_, NM = NM_, NN = NN_, ASHIFT = ASHIFT_, ASTEP = ASTEP_; static constexpr bool I8 = I8_; };
template <bool I8> __device__ __forceinline__ f32x4 mma16(const bf16x8 a, const bf16x8 b, const f32x4 c) {
    if constexpr (I8) return __builtin_bit_cast(f32x4, __builtin_amdgcn_mfma_i32_16x16x64_i8(__builtin_bit_cast(i32x4, a), __builtin_bit_cast(i32x4, b), __builtin_bit_cast(i32x4, c), 0, 0, 0));
    else return __builtin_amdgcn_mfma_f32_16x16x32_bf16(a, b, c, 0, 0, 0); }
struct StaticOrder {
    int nM, nN, nwg, G, c;
    __device__ void init(int nM_, int nN_, int G_, int c_) { nM = nM_; nN = nN_; nwg = nM * nN; G = G_; c = c_; }
    __device__ bool next(int i, Unit& u) const {
        const long L = (long)i * G + c; if (L >= nwg) return false;
        int wgid = (int)L; { const int q = nwg / NXCD, r = nwg % NXCD, xcd = wgid % NXCD, off = wgid / NXCD; wgid = (xcd < r ? xcd * (q + 1) : r * (q + 1) + (xcd - r) * q) + off; }
        const int nig = WGM * nN, gid = wgid / nig, fm = gid * WGM, gsz = (nM - fm) < WGM ? (nM - fm) : WGM;
        u.pm = fm + ((wgid % nig) % gsz); u.pn = (wgid % nig) / gsz; return true;
    }
};
template <class GEO, class Epi>
__device__ __forceinline__ void gemm_phase(LAS unsigned char* lds, const Gemm g, const int G_, const int c_, const int wave_, const Epi& E) {
    StaticOrder S; S.init(GEO::NM, GEO::NN, opaque_s(G_), opaque_s(c_));
    const int wid = opaque_s(wave_), lane = lane_id(), tid = wid * 64 + lane, wr = wid >> 2, wc = wid & 3, fr = lane & 15, fq = lane >> 4;
    constexpr int nt = GEO::K / BK;
    unsigned voffA[2], voffB[2];
#pragma unroll
    for (int i = 0; i < 2; ++i) { int R, C; stage_rc(tid * 16 + i * 8192, R, C); const int Rb = Epi::PERM ? ((R & ~31) + perm32(R & 31)) : R;
        voffA[i] = (unsigned)(R * GEO::LDA + C * 2); voffB[i] = (unsigned)(Rb * GEO::LDB + C * 2); }
    constexpr size_t kstep = (size_t)(BK * 2);
    constexpr size_t hstepA = (size_t)HALF * GEO::LDA, hstepB = (size_t)HALF * GEO::LDB;
    const unsigned ldsw = (unsigned)wid * 1024u;
    const int aoff = lds_byte(wr * 64 + fr, fq * 8), boff = lds_byte(wc * 32 + fr, fq * 8);
#define PG8_SA(b, h) (((b) * 2 + (h)) * HTB)
#define PG8_SB(b, h) ((4 + (b) * 2 + (h)) * HTB)
#define PG8_STAGE(bufoff, gbase, voff) do { _Pragma("unroll") for (int _i = 0; _i < 2; ++_i) \
        __builtin_amdgcn_global_load_lds((const unsigned*)((const char*)(gbase) + (voff)[_i]), (LAS unsigned*)(lds + (bufoff) + ldsw + _i * 8192), 16, 0, 0); } while (0)
#define PG8_LDA(dst, b, h) do { _Pragma("unroll") for (int m = 0; m < 4; ++m) _Pragma("unroll") for (int k = 0; k < 2; ++k) dst[m][k] = *(const LAS bf16x8*)(lds + PG8_SA(b, h) + aoff + m * 2048 + k * 1024); } while (0)
#define PG8_LDB(dst, b, h) do { _Pragma("unroll") for (int n = 0; n < 2; ++n) _Pragma("unroll") for (int k = 0; k < 2; ++k) dst[n][k] = *(const LAS bf16x8*)(lds + PG8_SB(b, h) + boff + n * 2048 + k * 1024); } while (0)
#define PG8_MMA(ai, bj, At, Bt) do { __builtin_amdgcn_s_setprio(1); _Pragma("unroll") for (int m = 0; m < 4; ++m) _Pragma("unroll") for (int n = 0; n < 2; ++n) _Pragma("unroll") for (int k = 0; k < 2; ++k) \
        acc[ai][bj][m][n] = mma16<GEO::I8>(Bt[n][k], At[m][k], acc[ai][bj][m][n]); __builtin_amdgcn_s_setprio(0); } while (0)
#define PG8_WAIT_V(n) asm volatile("s_waitcnt vmcnt(" #n ")" ::: "memory")
#define PG8_WAIT_L(n) asm volatile("s_waitcnt lgkmcnt(" #n ")" ::: "memory")
#define PG8_BAR __builtin_amdgcn_s_barrier()
#define PG8_SCHED __builtin_amdgcn_sched_barrier(0)
    Unit cur, nxt; int ui = 0;
    if (!S.next(0, cur)) return;
    f32x4 acc[2][2][4][2];
#pragma unroll
    for (int a = 0; a < 2; ++a)
#pragma unroll
        for (int b = 0; b < 2; ++b)
#pragma unroll
            for (int m = 0; m < 4; ++m)
#pragma unroll
                for (int n = 0; n < 2; ++n) acc[a][b][m][n] = (f32x4){0.f, 0.f, 0.f, 0.f};
    bf16x8 At[4][2], B0[2][2], B1[2][2];
    const char* cA = g.A + (size_t)cur.pm * (BM * GEO::LDA) + (size_t)((cur.pn >> GEO::ASHIFT) * GEO::ASTEP);
    const char* cB = g.Bt + (size_t)cur.pn * (BM * GEO::LDB);
    PG8_STAGE(PG8_SB(0, 0), cB, voffB); PG8_STAGE(PG8_SB(0, 1), cB + hstepB, voffB); PG8_STAGE(PG8_SA(0, 0), cA, voffA); PG8_STAGE(PG8_SA(0, 1), cA + hstepA, voffA);
    if (wr == 1) PG8_BAR;
    PG8_WAIT_V(2); PG8_BAR;
    PG8_STAGE(PG8_SB(1, 0), cB + kstep, voffB); PG8_STAGE(PG8_SA(1, 0), cA + kstep, voffA); PG8_STAGE(PG8_SB(1, 1), cB + hstepB + kstep, voffB);
    PG8_WAIT_V(6); PG8_BAR;
    for (;;) {
        const bool has_next = S.next(ui + 1, nxt);
        const char* nA = has_next ? g.A + (size_t)nxt.pm * (BM * GEO::LDA) + (size_t)((nxt.pn >> GEO::ASHIFT) * GEO::ASTEP) : cA;
        const char* nB = has_next ? g.Bt + (size_t)nxt.pn * (BM * GEO::LDB) : cB;
#pragma unroll 1
        for (int t = 0; t < nt; t += 2) {
            const bool last = (t == nt - 2);
            const char* a1 = cA + (size_t)(t + 1) * kstep;
            const char* a2 = last ? nA : cA + (size_t)(t + 2) * kstep; const char* b2 = last ? nB : cB + (size_t)(t + 2) * kstep;
            const char* a3 = a2 + kstep; const char* b3 = b2 + kstep;
            if constexpr (Epi::HOOK) { if (t != 0 && (t & 31) == 0) E.hook(acc, cur, (t >> 5) - 1, wr, wc, fr, fq); }
            PG8_LDB(B0, 0, 0); PG8_LDB(B1, 0, 1); PG8_SCHED; PG8_LDA(At, 0, 0); PG8_STAGE(PG8_SA(1, 1), a1 + hstepA, voffA);
            PG8_WAIT_V(8); PG8_WAIT_L(0); PG8_BAR; PG8_MMA(0, 0, At, B0); PG8_MMA(0, 1, At, B1); PG8_BAR; PG8_SCHED;
            PG8_LDA(At, 0, 1); PG8_STAGE(PG8_SB(0, 0), b2, voffB); PG8_STAGE(PG8_SB(0, 1), b2 + hstepB, voffB); PG8_STAGE(PG8_SA(0, 0), a2, voffA);
            PG8_WAIT_V(8); PG8_WAIT_L(0); PG8_BAR; PG8_MMA(1, 0, At, B0); PG8_MMA(1, 1, At, B1); PG8_BAR; PG8_SCHED;
            PG8_LDB(B0, 1, 0); PG8_LDB(B1, 1, 1); PG8_SCHED; PG8_LDA(At, 1, 0); PG8_STAGE(PG8_SA(0, 1), a2 + hstepA, voffA);
            PG8_WAIT_V(8); PG8_WAIT_L(0); PG8_BAR; PG8_MMA(0, 0, At, B0); PG8_MMA(0, 1, At, B1); PG8_BAR; PG8_SCHED;
            PG8_LDA(At, 1, 1); PG8_STAGE(PG8_SB(1, 0), b3, voffB); PG8_STAGE(PG8_SB(1, 1), b3 + hstepB, voffB); PG8_STAGE(PG8_SA(1, 0), a3, voffA);
            PG8_WAIT_V(8); PG8_WAIT_L(0); PG8_BAR; PG8_MMA(1, 0, At, B0); PG8_MMA(1, 1, At, B1); PG8_BAR; PG8_SCHED;
        }
        if (wr == 0) PG8_BAR;
        E(acc, cur, wr, wc, fr, fq);
        if (!has_next) break;
#pragma unroll
        for (int a = 0; a < 2; ++a)
#pragma unroll
            for (int b = 0; b < 2; ++b)
#pragma unroll
                for (int m = 0; m < 4; ++m)
#pragma unroll
                    for (int n = 0; n < 2; ++n) acc[a][b][m][n] = (f32x4){0.f, 0.f, 0.f, 0.f};
        cur = nxt; cA = nA; cB = nB; ++ui;
        if (wr == 1) PG8_BAR;
    }
    PG8_WAIT_V(0);
    PG8_BAR;
#undef PG8_SA
#undef PG8_SB
#undef PG8_STAGE
#undef PG8_LDA
#undef PG8_LDB
#undef PG8_MMA
#undef PG8_WAIT_V
#undef PG8_WAIT_L
#undef PG8_BAR
#undef PG8_SCHED
}
}

struct Ctx { const float* in[34]; float* out; unsigned char* ws; };
enum { I_X = 0, I_MEM, I_NORM_G, I_MEMNORM_G, I_WIN, I_LRU_CW, I_LRU_CB, I_LRU_WA, I_LRU_BA, I_LRU_WX, I_LRU_BX, I_LRU_LAM, I_MU, I_W0, I_WUP, I_A0, I_AUP,
       I_KK, I_KA, I_RK, I_GNW, I_GNB, I_MCW, I_MCB, I_MBI, I_MBF, I_MGNW, I_WKV, I_WBA, I_WBB, I_WBC, I_WBX, I_WOUT, I_FNG };


typedef const __attribute__((address_space(4))) char* kargp_t;
template <int OFF> __device__ __forceinline__ unsigned long long karg_u64() {
    kargp_t kp = (kargp_t)__builtin_amdgcn_kernarg_segment_ptr(); unsigned long long v;
    asm volatile("s_load_dwordx2 %0, %1, %2\n\ts_waitcnt lgkmcnt(0)" : "=s"(v) : "s"(kp), "i"(OFF)); return v; }
#define KIN(i) ((const float*)(const GAS float*)karg_u64<(i) * 8>())
#define KOUT() ((float*)(GAS float*)karg_u64<34 * 8>())
#define KWS() ((unsigned char*)(GAS unsigned char*)karg_u64<35 * 8>())

template <int ldc, bool HAS_IF> struct EpiProj {
    static constexpr bool PERM = true, HOOK = false;
    bf16* O; float* ifb;
    __device__ __forceinline__ void operator()(const f32x4 (&acc)[2][2][4][2], const pg8::Unit& u, int wr, int wc, int fr, int fq) const {
        const int row0 = u.pm * 256 + wr * 64 + fr, col0 = u.pn * 256 + wc * 32 + 8 * fq;
#pragma unroll
        for (int ai = 0; ai < 2; ++ai)
#pragma unroll
            for (int m = 0; m < 4; ++m) { const int row = row0 + ai * 128 + m * 16; bf16* rowp = O + (size_t)row * ldc + col0;
#pragma unroll
                for (int bj = 0; bj < 2; ++bj) { const f32x4 v0 = acc[ai][bj][m][0], v1 = acc[ai][bj][m][1];
                    u32x4 w; w.x = cvt_pk_bf16(v0[0], v0[1]); w.y = cvt_pk_bf16(v0[2], v0[3]); w.z = cvt_pk_bf16(v1[0], v1[1]); w.w = cvt_pk_bf16(v1[2], v1[3]);
                    *(u32x4*)(rowp + bj * 128) = w; }
                if (HAS_IF && u.pn == PN_IF && wc == 0 && fq == 0) { *(f32x4*)(ifb + (size_t)row * 8) = acc[ai][0][m][0]; *(f32x4*)(ifb + (size_t)row * 8 + 4) = acc[ai][0][m][1]; }
            }
    }
};
__device__ __forceinline__ void gl2n_issue(u32x4& a0, u32x4& a1, const void* pa, unsigned voff) {
    asm volatile("s_nop 4\n\tglobal_load_dwordx4 %0, %2, %3\n\tglobal_load_dwordx4 %1, %2, %3 offset:16" : "=&v"(a0), "=&v"(a1) : "v"(voff), "s"(pa) : "memory"); }
#define GL_WAIT4(g) asm volatile("s_waitcnt vmcnt(0)" : "+v"(g[0]), "+v"(g[1]), "+v"(g[2]), "+v"(g[3]) :: "memory")
struct EpiGate8 {
    static constexpr bool PERM = true, HOOK = false;
    bf16* O; const float* hs; const unsigned* cmax;
    __device__ __forceinline__ void operator()(const f32x4 (&acc)[2][2][4][2], const pg8::Unit& u, int wr, int wc, int fr, int fq) const {
        const int row0 = u.pm * 256 + wr * 64 + fr, col0 = u.pn * 256 + wc * 32 + 8 * fq;
        u32x4 cs[4]; const unsigned coff = (unsigned)((wc * 32 + 8 * fq) * 4);
        gl2n_issue(cs[0], cs[1], cmax + u.pn * 256, coff); gl2n_issue(cs[2], cs[3], cmax + u.pn * 256 + 128, coff);
        float rsv[8]; { const float* hb = hs + u.pm * 256 + wr * 64; const unsigned roff = (unsigned)(fr * 4);
            asm volatile("s_nop 4\n\tglobal_load_dword %0, %8, %9\n\tglobal_load_dword %1, %8, %9 offset:64\n\tglobal_load_dword %2, %8, %9 offset:128\n\tglobal_load_dword %3, %8, %9 offset:192\n\t"
                         "global_load_dword %4, %8, %9 offset:512\n\tglobal_load_dword %5, %8, %9 offset:576\n\tglobal_load_dword %6, %8, %9 offset:640\n\tglobal_load_dword %7, %8, %9 offset:704\n\ts_waitcnt vmcnt(0)"
                         : "=&v"(rsv[0]), "=&v"(rsv[1]), "=&v"(rsv[2]), "=&v"(rsv[3]), "=&v"(rsv[4]), "=&v"(rsv[5]), "=&v"(rsv[6]), "=&v"(rsv[7]) : "v"(roff), "s"(hb) : "memory"); }
        GL_WAIT4(cs);
        float wsc[2][8];
#pragma unroll
        for (int bj = 0; bj < 2; ++bj)
#pragma unroll
            for (int j = 0; j < 8; ++j) wsc[bj][j] = __uint_as_float(cs[2 * bj + (j >> 2)][j & 3]) * (1.0f / 127.0f);
#pragma unroll
        for (int ai = 0; ai < 2; ++ai)
#pragma unroll
            for (int m = 0; m < 4; ++m) { const int row = row0 + ai * 128 + m * 16; const float rs = rsv[ai * 4 + m]; bf16* rowp = O + (size_t)row * NPJ + col0;
#pragma unroll
                for (int bj = 0; bj < 2; ++bj) { const i32x4 v0 = __builtin_bit_cast(i32x4, acc[ai][bj][m][0]), v1 = __builtin_bit_cast(i32x4, acc[ai][bj][m][1]);
                    u32x4 w; w.x = cvt_pk_bf16((float)v0[0] * (rs * wsc[bj][0]), (float)v0[1] * (rs * wsc[bj][1])); w.y = cvt_pk_bf16((float)v0[2] * (rs * wsc[bj][2]), (float)v0[3] * (rs * wsc[bj][3]));
                    w.z = cvt_pk_bf16((float)v1[0] * (rs * wsc[bj][4]), (float)v1[1] * (rs * wsc[bj][5])); w.w = cvt_pk_bf16((float)v1[2] * (rs * wsc[bj][6]), (float)v1[3] * (rs * wsc[bj][7]));
                    *(u32x4*)(rowp + bj * 128) = w; } }
    }
};
struct EpiLru {
    static constexpr bool PERM = true, HOOK = false;
    const bf16* U; float* LA; float* LB; const float* ba; const float* bx; const float* lam;
    __device__ __forceinline__ void operator()(const f32x4 (&acc)[2][2][4][2], const pg8::Unit& u, int wr, int wc, int fr, int fq) const {
        const int row0 = u.pm * 256 + wr * 64 + fr, ch0 = u.pn * 128 + wc * 32 + 8 * fq;
        float cba[8], cbx[8], csp[8];
#pragma unroll
        for (int j = 0; j < 8; ++j) { cba[j] = ba[ch0 + j]; cbx[j] = bx[ch0 + j]; csp[j] = -8.0f * softplusf_(-lam[ch0 + j]); }
        u32x4 uws[8];
#pragma unroll
        for (int i = 0; i < 8; ++i) uws[i] = *(const u32x4*)(U + (size_t)(row0 + (i >> 2) * 128 + (i & 3) * 16) * 2048 + ch0);
        asm volatile("" ::: "memory");
#pragma unroll
        for (int ai = 0; ai < 2; ++ai)
#pragma unroll
            for (int m = 0; m < 4; ++m) { const int row = row0 + ai * 128 + m * 16;
                float uf[8]; unpack8(uws[ai * 4 + m], uf);
                float a8[8], b8[8];
#pragma unroll
                for (int n = 0; n < 2; ++n)
#pragma unroll
                    for (int j = 0; j < 4; ++j) { const int q = 4 * n + j;
                        const float r = sigm(acc[ai][0][m][n][j] + cba[q]), ig = sigm(acc[ai][1][m][n][j] + cbx[q]);
                        const float la = csp[q] * r; a8[q] = __expf(la); b8[q] = sqrtf(-expm1s_(2.0f * la)) * (ig * uf[q]); }
                float* pa = LA + (size_t)row * 2048 + ch0; float* pb = LB + (size_t)row * 2048 + ch0;
                *(f32x4*)pa = (f32x4){a8[0], a8[1], a8[2], a8[3]}; *(f32x4*)(pa + 4) = (f32x4){a8[4], a8[5], a8[6], a8[7]};
                *(f32x4*)pb = (f32x4){b8[0], b8[1], b8[2], b8[3]}; *(f32x4*)(pb + 4) = (f32x4){b8[4], b8[5], b8[6], b8[7]};
            }
    }
};
struct EpiLora {
    static constexpr bool PERM = true, HOOK = false;
    float* WDEC; float* AA; const float* w0; const float* a0;
    __device__ __forceinline__ void operator()(const f32x4 (&acc)[2][2][4][2], const pg8::Unit& u, int wr, int wc, int fr, int fq) const {
        const int row0 = u.pm * 256 + wr * 64 + fr, ch0 = u.pn * 128 + wc * 32 + 8 * fq;
        float cw0[8], ca0[8];
#pragma unroll
        for (int j = 0; j < 8; ++j) { cw0[j] = w0[ch0 + j]; ca0[j] = a0[ch0 + j]; }
#pragma unroll
        for (int ai = 0; ai < 2; ++ai)
#pragma unroll
            for (int m = 0; m < 4; ++m) { const int row = row0 + ai * 128 + m * 16; float d8[8], a8[8];
#pragma unroll
                for (int n = 0; n < 2; ++n)
#pragma unroll
                    for (int j = 0; j < 4; ++j) { const int q = 4 * n + j;
                        const float wl = -softplusf_(-(cw0[q] + acc[ai][0][m][n][j])) - 0.5f; d8[q] = __expf(-__expf(wl)); a8[q] = sigm(ca0[q] + acc[ai][1][m][n][j]); }
                float* pd = WDEC + ((((size_t)((row >> 12) * 32 + (ch0 >> 6)) * SEQ + (row & (SEQ - 1))) * 5 + 1) * 64 + (ch0 & 63)); float* pa = AA + (size_t)row * 2048 + ch0;
                *(f32x4*)pd = (f32x4){d8[0], d8[1], d8[2], d8[3]}; *(f32x4*)(pd + 4) = (f32x4){d8[4], d8[5], d8[6], d8[7]};
                *(f32x4*)pa = (f32x4){a8[0], a8[1], a8[2], a8[3]}; *(f32x4*)(pa + 4) = (f32x4){a8[4], a8[5], a8[6], a8[7]};
            }
    }
};
__device__ __forceinline__ void gl2_issue(u32x4& a0, u32x4& a1, const void* pa, unsigned voff) {
    asm volatile("s_nop 4\n\tglobal_load_dwordx4 %0, %2, %3\n\tglobal_load_dwordx4 %1, %2, %3 offset:256" : "=&v"(a0), "=&v"(a1) : "v"(voff), "s"(pa) : "memory"); }
__device__ __forceinline__ void gl4f_issue(u32x4& a0, u32x4& a1, u32x4& a2, u32x4& a3, const void* pa, unsigned voff) {
    asm volatile("s_nop 4\n\tglobal_load_dwordx4 %0, %4, %5\n\tglobal_load_dwordx4 %1, %4, %5 offset:64\n\tglobal_load_dwordx4 %2, %4, %5 offset:512\n\tglobal_load_dwordx4 %3, %4, %5 offset:576"
                 : "=&v"(a0), "=&v"(a1), "=&v"(a2), "=&v"(a3) : "v"(voff), "s"(pa) : "memory"); }
#define GL_WAIT8(g) asm volatile("s_waitcnt vmcnt(0)" : "+v"(g[0]), "+v"(g[1]), "+v"(g[2]), "+v"(g[3]), "+v"(g[4]), "+v"(g[5]), "+v"(g[6]), "+v"(g[7]) :: "memory")
#define GL_WAIT16(g) asm volatile("s_waitcnt vmcnt(0)" : "+v"(g[0]), "+v"(g[1]), "+v"(g[2]), "+v"(g[3]), "+v"(g[4]), "+v"(g[5]), "+v"(g[6]), "+v"(g[7]), \
                                  "+v"(g[8]), "+v"(g[9]), "+v"(g[10]), "+v"(g[11]), "+v"(g[12]), "+v"(g[13]), "+v"(g[14]), "+v"(g[15]) :: "memory")
struct EpiMerge {
    static constexpr bool PERM = true, HOOK = true;
    const bf16* GL; bf16* O; static constexpr int ldg = NPJ;
    __device__ __forceinline__ void hook(f32x4 (&acc)[2][2][4][2], const pg8::Unit& u, int br, int wr, int wc, int fr, int fq) const {
        const unsigned voff = (unsigned)(fr * (ldg * 2) + (wc * 32 + 8 * fq) * 2);
        const char* base = (const char*)GL + ((size_t)(u.pm * 256 + wr * 64) * ldg + br * 4096 + u.pn * 256) * 2;
#pragma unroll
        for (int ai = 0; ai < 2; ++ai) { u32x4 g[16];
#pragma unroll
            for (int m = 0; m < 4; ++m) { const char* pm_ = base + (size_t)(ai * 128 + m * 16) * (ldg * 2); gl2_issue(g[4 * m], g[4 * m + 1], pm_, voff); gl2_issue(g[4 * m + 2], g[4 * m + 3], pm_ + 8192, voff); }
            GL_WAIT16(g);
#pragma unroll
            for (int m = 0; m < 4; ++m)
#pragma unroll
                for (int bj = 0; bj < 2; ++bj) { float f0[8], f1[8]; unpack8(g[4 * m + bj], f0); unpack8(g[4 * m + 2 + bj], f1);
#pragma unroll
                    for (int n = 0; n < 2; ++n)
#pragma unroll
                        for (int j = 0; j < 4; ++j) { const int q = 4 * n + j; acc[ai][bj][m][n][j] *= (1.0f + __expf(-f1[q])) * __builtin_amdgcn_rcpf(1.0f + __expf(-f0[q])); } } }
    }
    __device__ __forceinline__ void operator()(const f32x4 (&acc)[2][2][4][2], const pg8::Unit& u, int wr, int wc, int fr, int fq) const {
        const int row0 = u.pm * 256 + wr * 64 + fr, col0 = u.pn * 256 + wc * 32 + 8 * fq;
        const unsigned voff = (unsigned)(fr * (ldg * 2) + (wc * 32 + 8 * fq) * 2);
        const char* base = (const char*)GL + ((size_t)(u.pm * 256 + wr * 64) * ldg + 3 * 4096 + u.pn * 256) * 2;
#pragma unroll
        for (int ai = 0; ai < 2; ++ai) { u32x4 g[8];
#pragma unroll
            for (int m = 0; m < 4; ++m) gl2_issue(g[2 * m], g[2 * m + 1], base + (size_t)(ai * 128 + m * 16) * (ldg * 2), voff);
            GL_WAIT8(g);
#pragma unroll
            for (int m = 0; m < 4; ++m) { const int row = row0 + ai * 128 + m * 16;
#pragma unroll
                for (int bj = 0; bj < 2; ++bj) { float f[8]; unpack8(g[2 * m + bj], f);
                    const f32x4 v0 = acc[ai][bj][m][0], v1 = acc[ai][bj][m][1];
                    u32x4 w; w.x = cvt_pk_bf16(v0[0] * sigm(f[0]), v0[1] * sigm(f[1])); w.y = cvt_pk_bf16(v0[2] * sigm(f[2]), v0[3] * sigm(f[3]));
                    w.z = cvt_pk_bf16(v1[0] * sigm(f[4]), v1[1] * sigm(f[5])); w.w = cvt_pk_bf16(v1[2] * sigm(f[6]), v1[3] * sigm(f[7]));
                    *(u32x4*)(O + (size_t)row * 4096 + col0 + bj * 128) = w; } } }
    }
};
struct EpiOut {
    static constexpr bool PERM = false, HOOK = false;
    const float* XI; float* XO;
    __device__ __forceinline__ void operator()(const f32x4 (&acc)[2][2][4][2], const pg8::Unit& u, int wr, int wc, int fr, int fq) const {
        const int row0 = u.pm * 256 + wr * 64 + fr, col0 = u.pn * 256 + wc * 32 + 4 * fq;
        const unsigned voff = (unsigned)(fr * 16384 + (wc * 32 + 4 * fq) * 4);
        const char* base = (const char*)XI + ((size_t)(u.pm * 256 + wr * 64) * 4096 + u.pn * 256) * 4;
#pragma unroll
        for (int ai = 0; ai < 2; ++ai) { u32x4 g[16];
#pragma unroll
            for (int m = 0; m < 4; ++m) gl4f_issue(g[4 * m], g[4 * m + 1], g[4 * m + 2], g[4 * m + 3], base + (size_t)(ai * 128 + m * 16) * 16384, voff);
            GL_WAIT16(g);
#pragma unroll
            for (int m = 0; m < 4; ++m) { const size_t off = (size_t)(row0 + ai * 128 + m * 16) * 4096 + col0;
#pragma unroll
                for (int bj = 0; bj < 2; ++bj)
#pragma unroll
                    for (int n = 0; n < 2; ++n) { const f32x4 xi = __builtin_bit_cast(f32x4, g[4 * m + 2 * bj + n]); *(f32x4*)(XO + off + bj * 128 + n * 16) = xi + acc[ai][bj][m][n]; } } }
    }
};

struct Frame { LAS unsigned char* lds; int tid, lane, wave, bid, nblk; };
__device__ __forceinline__ Frame reframe(const Frame& G) { Frame F; F.lds = G.lds; F.wave = opaque_s(G.wave); F.lane = lane_id(); F.tid = F.wave * 64 + F.lane; F.bid = opaque_s(G.bid); F.nblk = opaque_s(G.nblk); return F; }

#define TR_PIN16(a, o) asm volatile("" : "+v"(a[o]), "+v"(a[o + 1]), "+v"(a[o + 2]), "+v"(a[o + 3]), "+v"(a[o + 4]), "+v"(a[o + 5]), "+v"(a[o + 6]), "+v"(a[o + 7]), "+v"(a[o + 8]), "+v"(a[o + 9]), "+v"(a[o + 10]), "+v"(a[o + 11]), "+v"(a[o + 12]), "+v"(a[o + 13]), "+v"(a[o + 14]), "+v"(a[o + 15]) :: "memory")
__device__ __forceinline__ void tr_load(float (&tv)[32], const float* W, size_t ldw, int k0, int n0, int lane) {
#pragma unroll
    for (int i = 0; i < 32; ++i) tv[i] = W[(size_t)(k0 + 2 * i + (lane >> 5)) * ldw + n0 + (lane & 31)];
}
__device__ __forceinline__ void tr_item(const float (&tv)[32], bf16* WT, size_t ldt, LAS float* scr, int k0, int n0, int lane) {
#pragma unroll
    for (int i = 0; i < 32; ++i) scr[(2 * i + (lane >> 5)) * 33 + (lane & 31)] = tv[i];
    LDS_WAIT(); asm volatile("" ::: "memory");
    const int c = lane & 7;
#pragma unroll
    for (int j = 0; j < 4; ++j) { const int n = (lane >> 3) + 8 * j; const LAS float* s = scr + (8 * c) * 33 + n;
        u32x4 o; o.x = pk2(s[0 * 33], s[1 * 33]); o.y = pk2(s[2 * 33], s[3 * 33]); o.z = pk2(s[4 * 33], s[5 * 33]); o.w = pk2(s[6 * 33], s[7 * 33]);
        *(u32x4*)(WT + (size_t)(n0 + n) * ldt + k0 + 8 * c) = o; }
    LDS_WAIT(); asm volatile("" ::: "memory");
}
__device__ __forceinline__ void tr_job(const Frame& F, const float* W, size_t ldw, int K, int ncols, bf16* WT, size_t ldt) {
    LAS float* scr = (LAS float*)(F.lds + F.wave * 16384);
    const int gw = F.bid * NWAVES + F.wave, NGW = F.nblk * NWAVES, nb = ncols / 32, items = (K / 64) * nb;
    for (int it = gw; it < items; it += 2 * NGW) { float tv[32], tn[32]; const int nx = it + NGW, nc = nx < items ? nx : it;
        tr_load(tv, W, ldw, 64 * (it / nb), 32 * (it % nb), F.lane); tr_load(tn, W, ldw, 64 * (nc / nb), 32 * (nc % nb), F.lane);
        TR_PIN16(tv, 0); TR_PIN16(tv, 16);
        tr_item(tv, WT, ldt, scr, 64 * (it / nb), 32 * (it % nb), F.lane);
        if (nx < items) tr_item(tn, WT, ldt, scr, 64 * (nx / nb), 32 * (nx % nb), F.lane); }
}
__device__ __forceinline__ void tr8_item(const float (&tv)[32], signed char* WT, const float inv, LAS float* scr, int k0, int n0, int lane) {
#pragma unroll
    for (int i = 0; i < 32; ++i) scr[(2 * i + (lane >> 5)) * 33 + (lane & 31)] = tv[i];
    LDS_WAIT(); asm volatile("" ::: "memory");
    const int n = lane >> 1, hh = lane & 1;
#pragma unroll
    for (int c = 0; c < 2; ++c) { const LAS float* sp = scr + (32 * hh + 16 * c) * 33 + n; unsigned wq[4];
#pragma unroll
        for (int q = 0; q < 4; ++q) { const int a0 = (int)rintf(sp[(4 * q) * 33] * inv), a1 = (int)rintf(sp[(4 * q + 1) * 33] * inv), a2 = (int)rintf(sp[(4 * q + 2) * 33] * inv), a3 = (int)rintf(sp[(4 * q + 3) * 33] * inv);
            wq[q] = (unsigned)(a0 & 255) | ((unsigned)(a1 & 255) << 8) | ((unsigned)(a2 & 255) << 16) | ((unsigned)(a3 & 255) << 24); }
        *(u32x4*)(WT + (size_t)(n0 + n) * 4096 + k0 + 32 * hh + 16 * c) = (u32x4){wq[0], wq[1], wq[2], wq[3]}; }
    LDS_WAIT(); asm volatile("" ::: "memory");
}
__device__ __forceinline__ void gate8_strips(const Frame& F, const float* win, signed char* WT, unsigned* cmaxl, const int first, const int stride) {
    LAS float* scr = (LAS float*)(F.lds + F.wave * 16384); LAS float* cm = (LAS float*)(F.lds + 8 * 16384);
    const int lane = F.lane, w = F.wave, c8 = lane & 7, rsub = lane >> 3;
    for (int strip = first; strip < N8 / 32; strip += stride) { const int n0 = strip * 32; const float* W = win + (n0 < 2048 ? 16576 + n0 : 21704 + (n0 - 2048));
        { const float* wp = W + (size_t)(512 * w + rsub) * CIN + 4 * c8; f32x4 m = (f32x4){0.f, 0.f, 0.f, 0.f};
          for (int i0 = 0; i0 < 64; i0 += 16) { f32x4 tv[16];
#pragma unroll
              for (int i = 0; i < 16; ++i) tv[i] = *(const f32x4*)(wp + (size_t)(8 * (i0 + i)) * CIN);
              asm volatile("" : "+v"(tv[0]), "+v"(tv[1]), "+v"(tv[2]), "+v"(tv[3]), "+v"(tv[4]), "+v"(tv[5]), "+v"(tv[6]), "+v"(tv[7]), "+v"(tv[8]), "+v"(tv[9]), "+v"(tv[10]), "+v"(tv[11]), "+v"(tv[12]), "+v"(tv[13]), "+v"(tv[14]), "+v"(tv[15]) :: "memory");
#pragma unroll
              for (int i = 0; i < 16; ++i) { m.x = fmaxf(m.x, fabsf(tv[i].x)); m.y = fmaxf(m.y, fabsf(tv[i].y)); m.z = fmaxf(m.z, fabsf(tv[i].z)); m.w = fmaxf(m.w, fabsf(tv[i].w)); } }
#pragma unroll
          for (int q = 0; q < 4; ++q) { float v = m[q]; v = fmaxf(v, __shfl_xor(v, 8)); v = fmaxf(v, __shfl_xor(v, 16)); v = fmaxf(v, __shfl_xor(v, 32)); m[q] = v; }
          __syncthreads();
          if (lane < 8) { cm[w * 32 + 4 * c8] = m.x; cm[w * 32 + 4 * c8 + 1] = m.y; cm[w * 32 + 4 * c8 + 2] = m.z; cm[w * 32 + 4 * c8 + 3] = m.w; } }
        __syncthreads();
        float am = 0.f;
#pragma unroll
        for (int w2 = 0; w2 < 8; ++w2) am = fmaxf(am, cm[w2 * 32 + (lane >> 1)]);
        if (w == 0 && (lane & 1) == 0) cmaxl[n0 + (lane >> 1)] = __float_as_uint(am);
        const float inv = am > 0.f ? 127.0f / am : 0.f;
        for (int kb = 0; kb < 8; kb += 2) { const int k0 = 512 * w + 64 * kb; float tv[32], tn[32];
            tr_load(tv, W, CIN, k0, 0, lane); tr_load(tn, W, CIN, k0 + 64, 0, lane);
            TR_PIN16(tv, 0); TR_PIN16(tv, 16);
            tr8_item(tv, WT, inv, scr, k0, n0, lane); tr8_item(tn, WT, inv, scr, k0 + 64, n0, lane); }
    }
}
__device__ __forceinline__ void rms_row_bf16(const float* x, const float* g, bf16* o, int lane, signed char* q8 = nullptr, float* qs = nullptr) {
    const f32x4* xr = (const f32x4*)x + lane; const f32x4* gr = (const f32x4*)g + lane; f32x4 v[16], gv[16]; float ss = 0.f;
#pragma unroll
    for (int j = 0; j < 16; ++j) v[j] = xr[64 * j];
#pragma unroll
    for (int j = 0; j < 16; ++j) gv[j] = gr[64 * j];
    asm volatile("" ::: "memory");
#pragma unroll
    for (int j = 0; j < 16; ++j) ss += (v[j].x * v[j].x + v[j].y * v[j].y) + (v[j].z * v[j].z + v[j].w * v[j].w);
    const float r = rsqrtf(wave_sum(ss) * (1.0f / 4096.0f) + 1e-6f);
    u32x2* o8 = (u32x2*)o + lane; float am = 0.f;
#pragma unroll
    for (int j = 0; j < 16; ++j) { const f32x4 gg = gv[j]; v[j] = (f32x4){v[j].x * r * gg.x, v[j].y * r * gg.y, v[j].z * r * gg.z, v[j].w * r * gg.w};
        u32x2 w; w.x = pk2(v[j].x, v[j].y); w.y = pk2(v[j].z, v[j].w); o8[64 * j] = w;
        am = fmaxf(fmaxf(am, fmaxf(fabsf(v[j].x), fabsf(v[j].y))), fmaxf(fabsf(v[j].z), fabsf(v[j].w))); }
    if (q8 != nullptr) {
        am = row16_max(am); am = fmaxf(am, __shfl_xor(am, 16)); am = fmaxf(am, __shfl_xor(am, 32));
        const float inv = am > 0.f ? 127.0f / am : 0.f; unsigned* q4 = (unsigned*)q8 + lane;
#pragma unroll
        for (int j = 0; j < 16; ++j) { const int a0 = (int)rintf(v[j].x * inv), a1 = (int)rintf(v[j].y * inv), a2 = (int)rintf(v[j].z * inv), a3 = (int)rintf(v[j].w * inv);
            q4[64 * j] = (unsigned)(a0 & 255) | ((unsigned)(a1 & 255) << 8) | ((unsigned)(a2 & 255) << 16) | ((unsigned)(a3 & 255) << 24); }
        if (lane == 0) *qs = am * (1.0f / 127.0f); }
}
__device__ __forceinline__ void rms_row_f32(const float* x, const float* g, float* o, int lane) {
    const f32x4* xr = (const f32x4*)x + lane; const f32x4* gr = (const f32x4*)g + lane; f32x4 v[16], gv[16]; float ss = 0.f;
#pragma unroll
    for (int j = 0; j < 16; ++j) v[j] = xr[64 * j];
#pragma unroll
    for (int j = 0; j < 16; ++j) gv[j] = gr[64 * j];
    asm volatile("" ::: "memory");
#pragma unroll
    for (int j = 0; j < 16; ++j) ss += (v[j].x * v[j].x + v[j].y * v[j].y) + (v[j].z * v[j].z + v[j].w * v[j].w);
    const float r = rsqrtf(wave_sum(ss) * (1.0f / 4096.0f) + 1e-6f);
    f32x4* o4 = (f32x4*)o + lane;
#pragma unroll
    for (int j = 0; j < 16; ++j) { const f32x4 gg = gv[j]; o4[64 * j] = (f32x4){v[j].x * r * gg.x, v[j].y * r * gg.y, v[j].z * r * gg.z, v[j].w * r * gg.w}; }
}

__device__ __forceinline__ void phase_convert_layer(const Frame& F0, int l, const int parts, const int vb, const int nvb) {
    Frame F = reframe(F0); F.bid = vb; F.nblk = nvb;
    unsigned char* wl = KWS() + WS_W + (size_t)l * SZ_WLAYER;
    bf16* WIN = (bf16*)(wl + WO_WIN); bf16* WCAT = (bf16*)(wl + WO_WCAT); bf16* WOUT = (bf16*)(wl + WO_WOUT); bf16* WKV = (bf16*)(wl + WO_WKV); bf16* WG = (bf16*)(wl + WO_WG); bf16* WL = (bf16*)(wl + WO_WL);
    const float* win = KIN(I_WIN) + (size_t)l * 4096 * CIN;
    if (parts & 2) {
    tr_job(F, win + 0, CIN, 4096, 4096, WIN + (size_t)0 * 4096, 4096);
    tr_job(F, win + 4096, CIN, 4096, 6144, WIN + (size_t)PC_BR * 4096, 4096);
    tr_job(F, win + 10240, CIN, 4096, 96, WIN + (size_t)PC_BWD * 4096, 4096);
    tr_job(F, win + 10336, CIN, 4096, 96, WIN + (size_t)PC_BAD * 4096, 4096);
    tr_job(F, win + 10432, CIN, 4096, 2048, WIN + (size_t)PC_BG * 4096, 4096);
    tr_job(F, win + 12480, CIN, 4096, 4096, WIN + (size_t)PC_CQK * 4096, 4096);
    tr_job(F, win + 18624, CIN, 4096, 2048, WIN + (size_t)PC_CG * 4096, 4096);
    tr_job(F, win + 20680, CIN, 4096, 1024, WIN + (size_t)PC_XQ * 4096, 4096);
    gate8_strips(F, win, (signed char*)(WIN + (size_t)PC_I8 * 4096), (unsigned*)(KWS() + WS_CTL) + CW_CMAX + l * N8, F.bid, F.nblk);
    }
    if (parts & 4) {
    tr_job(F, KIN(I_WBA) + (size_t)l * 2048 * 4096, 4096, 2048, 4096, WCAT + YC_A, KCAT);
    tr_job(F, KIN(I_WBB) + (size_t)l * 2048 * 4096, 4096, 2048, 4096, WCAT + YC_B, KCAT);
    tr_job(F, KIN(I_WBC) + (size_t)l * 2048 * 4096, 4096, 2048, 4096, WCAT + YC_C, KCAT);
    tr_job(F, KIN(I_WBX) + (size_t)l * 512 * 4096, 4096, 512, 4096, WCAT + YC_X, KCAT);
    tr_job(F, KIN(I_WOUT) + (size_t)l * 4096 * 4096, 4096, 4096, 4096, WOUT, 4096);
    }
    if (parts & 1) tr_job(F, KIN(I_WKV) + (size_t)l * 4096 * 1024, 1024, 4096, 1024, WKV, 4096);
    if (parts & 2) {
    const size_t gt = (size_t)F.bid * NTHREADS + F.tid, NGT = (size_t)F.nblk * NTHREADS;
    for (size_t i = gt; i < (size_t)8 * 4096; i += NGT) { const int j = (int)(i >> 12), k = (int)(i & 4095); WIN[(size_t)(PC_IF + j) * 4096 + k] = (bf16)f2bf(win[(size_t)k * CIN + 20672 + j]); }
    for (size_t i = gt; i < (size_t)(32 + 32 + 248) * 4096; i += NGT) { const int r = (int)(i >> 12), k = (int)(i & 4095);
        const int row = r < 32 ? PC_BWD + 96 + r : (r < 64 ? PC_BAD + 96 + (r - 32) : PC_IF + 8 + (r - 64)); WIN[(size_t)row * 4096 + k] = 0; }
    const float* wa = KIN(I_LRU_WA) + (size_t)l * 8 * 256 * 256; const float* wx = KIN(I_LRU_WX) + (size_t)l * 8 * 256 * 256;
    for (size_t c = gt; c < (size_t)4096 * 32; c += NGT) { const int n = (int)(c >> 5), k0 = (int)(c & 31) * 8, pn = n >> 8, dd = n & 255, nb = pn >> 1, d = (pn & 1) * 128 + (dd & 127);
        const float* sp = (dd < 128 ? wa : wx) + ((size_t)nb * 256 + k0) * 256 + d; float v[8];
#pragma unroll
        for (int q = 0; q < 8; ++q) v[q] = sp[(size_t)q * 256];
        asm volatile("" : "+v"(v[0]), "+v"(v[1]), "+v"(v[2]), "+v"(v[3]), "+v"(v[4]), "+v"(v[5]), "+v"(v[6]), "+v"(v[7]) :: "memory");
        u32x4 o; o.x = pk2(v[0], v[1]); o.y = pk2(v[2], v[3]); o.z = pk2(v[4], v[5]); o.w = pk2(v[6], v[7]); *(u32x4*)(WG + (size_t)n * 256 + k0) = o; }
    const float* wup = KIN(I_WUP) + (size_t)l * 96 * 2048; const float* aup = KIN(I_AUP) + (size_t)l * 96 * 2048;
    for (size_t c = gt; c < (size_t)4096 * 32; c += NGT) { const int n = (int)(c >> 5), k0 = (int)(c & 31) * 8, pn = n >> 8, dd = n & 255, ch = pn * 128 + (dd & 127);
        const float* sp = nullptr; if (dd < 128) { if (k0 < 96) sp = wup + (size_t)k0 * 2048 + ch; } else { if (k0 >= 128 && k0 < 224) sp = aup + (size_t)(k0 - 128) * 2048 + ch; }
        u32x4 o = (u32x4){0u, 0u, 0u, 0u};
        if (sp != nullptr) { float v[8];
#pragma unroll
            for (int q = 0; q < 8; ++q) v[q] = sp[(size_t)q * 2048];
            asm volatile("" : "+v"(v[0]), "+v"(v[1]), "+v"(v[2]), "+v"(v[3]), "+v"(v[4]), "+v"(v[5]), "+v"(v[6]), "+v"(v[7]) :: "memory");
            o.x = pk2(v[0], v[1]); o.y = pk2(v[2], v[3]); o.z = pk2(v[4], v[5]); o.w = pk2(v[6], v[7]); }
        *(u32x4*)(WL + (size_t)n * 256 + k0) = o; }
    }
    if (parts & 1) {
    const int gw = F.bid * NWAVES + F.wave, NGW = F.nblk * NWAVES;
    bf16* MEMN = (bf16*)(KWS() + WS_MEMN) + (size_t)l * MM * 4096;
    for (int r = gw; r < MM; r += NGW) rms_row_bf16(KIN(I_MEM) + (size_t)r * 4096, KIN(I_MEMNORM_G) + (size_t)l * 4096, MEMN + (size_t)r * 4096, F.lane);
    }
}
__device__ __forceinline__ void phase_norm(const Frame& F0, const float* X, const float* g, bool final_out) {
    const Frame F = reframe(F0);
    const int gw = F.bid * NWAVES + F.wave, NGW = F.nblk * NWAVES;
    bf16* H = (bf16*)(KWS() + WS_H);
    for (int r = gw; r < M; r += NGW) { if (final_out) rms_row_f32(X + (size_t)r * 4096, g, KOUT() + (size_t)r * 4096, F.lane); else rms_row_bf16(X + (size_t)r * 4096, g, H + (size_t)r * 4096, F.lane, (signed char*)(KWS() + WS_H8) + (size_t)r * 4096, (float*)(KWS() + WS_HS) + r); }
}

__device__ __forceinline__ float logsigf_(float x) { return fminf(x, 0.f) - log1pf(__expf(-fabsf(x))); }
__device__ __forceinline__ void phase_prep(const Frame& F0, int l) {
    const Frame F = reframe(F0);
    const bf16* __restrict__ PROJ = (const bf16*)(KWS() + WS_PROJ);
    const size_t gt = (size_t)F.bid * NTHREADS + F.tid, NGT = (size_t)F.nblk * NTHREADS;
    bf16* __restrict__ U = (bf16*)(KWS() + WS_U); bf16* __restrict__ QC = (bf16*)(KWS() + WS_QC); bf16* __restrict__ KC = (bf16*)(KWS() + WS_KC);
    for (size_t id = gt; id < (size_t)2 * 256 * (M / 32); id += NGT) {
        const int which = (int)(id / ((size_t)256 * (M / 32))), rem = (int)(id % ((size_t)256 * (M / 32))), c8 = (rem & 255) * 8, t0 = (rem >> 8) * 32, ts0 = t0 & (SEQ - 1);
        const float* cw = (which == 0 ? KIN(I_LRU_CW) : KIN(I_MCW)) + (size_t)l * 4 * 2048 + c8; const float* cb = (which == 0 ? KIN(I_LRU_CB) : KIN(I_MCB)) + (size_t)l * 2048 + c8;
        const bf16* src = PROJ + (size_t)t0 * NPJ + (which == 0 ? PC_AX : PC_CQK) + c8;
        f32x4 wv[4][2];
#pragma unroll
        for (int j = 0; j < 4; ++j) { wv[j][0] = *(const f32x4*)(cw + j * 2048); wv[j][1] = *(const f32x4*)(cw + j * 2048 + 4); }
        const f32x4 b0 = *(const f32x4*)cb, b1 = *(const f32x4*)(cb + 4);
        u32x4 hw[3];
#pragma unroll
        for (int j = 0; j < 3; ++j) hw[j] = ts0 > 0 ? *(const u32x4*)(src - (size_t)(3 - j) * NPJ) : (u32x4){0u, 0u, 0u, 0u};
        float w0[8], w1[8], w2[8]; unpack8(hw[0], w0); unpack8(hw[1], w1); unpack8(hw[2], w2);
        const float sc = c8 < 1024 ? 1.0f : 0.0625f;
        for (int g = 0; g < 32; g += 8) { u32x4 x[8];
#pragma unroll
            for (int u = 0; u < 8; ++u) x[u] = *(const u32x4*)(src + (size_t)(g + u) * NPJ);
#pragma unroll
            for (int u = 0; u < 8; ++u) { float w3[8], a[8]; unpack8(x[u], w3);
#pragma unroll
                for (int q = 0; q < 8; ++q) a[q] = (q < 4 ? b0[q] : b1[q - 4]) + wv[0][q >> 2][q & 3] * w0[q] + wv[1][q >> 2][q & 3] * w1[q] + wv[2][q >> 2][q & 3] * w2[q] + wv[3][q >> 2][q & 3] * w3[q];
#pragma unroll
                for (int q = 0; q < 8; ++q) { w0[q] = w1[q]; w1[q] = w2[q]; w2[q] = w3[q]; }
                const size_t t = (size_t)t0 + g + u;
                if (which == 0) { u32x4 o; o.x = pk2(a[0], a[1]); o.y = pk2(a[2], a[3]); o.z = pk2(a[4], a[5]); o.w = pk2(a[6], a[7]); *(u32x4*)(U + t * 2048 + c8) = o; }
                else {
#pragma unroll
                    for (int q = 0; q < 8; ++q) a[q] = siluf_(a[q]) * sc;
                    u32x4 o; o.x = pk2(a[0], a[1]); o.y = pk2(a[2], a[3]); o.z = pk2(a[4], a[5]); o.w = pk2(a[6], a[7]);
                    if (c8 < 1024) *(u32x4*)(QC + t * 1024 + c8) = o; else *(u32x4*)(KC + t * 1024 + (c8 - 1024)) = o; } } }
    }
    bf16* LORA = (bf16*)(KWS() + WS_LORA); const float* mu = KIN(I_MU) + (size_t)l * 6336;
    for (size_t i = gt; i < (size_t)M * 32; i += NGT) { const int t = (int)(i >> 5), c8 = (int)(i & 31) * 8, ts = t & (SEQ - 1), seg = c8 >> 7, i0 = c8 & 127;
        u32x4 o = (u32x4){0u, 0u, 0u, 0u};
        if (i0 < 96) { const int pc = (seg == 0 ? PC_BWD : PC_BAD) + i0; const float* m8 = mu + 6144 + seg * 96 + i0;
            const u32x4 w = *(const u32x4*)(PROJ + (size_t)t * NPJ + pc); const u32x4 w2 = *(const u32x4*)(PROJ + (size_t)(ts > 0 ? t - 1 : t) * NPJ + pc);
            const f32x4 ma = *(const f32x4*)m8, mb = *(const f32x4*)(m8 + 4);
            float p[8], pv[8]; unpack8(w, p); unpack8(w2, pv);
            if (ts == 0) {
#pragma unroll
                for (int q = 0; q < 8; ++q) pv[q] = 0.f; }
            float r[8];
#pragma unroll
            for (int q = 0; q < 8; ++q) { const float s = p[q] + (pv[q] - p[q]) * (q < 4 ? ma[q] : mb[q - 4]); r[q] = seg == 0 ? tanhf(s) : s; }
            o.x = pk2(r[0], r[1]); o.y = pk2(r[2], r[3]); o.z = pk2(r[4], r[5]); o.w = pk2(r[6], r[7]); }
        *(u32x4*)(LORA + (size_t)t * 256 + c8) = o; }
    if (F.bid < 8) {
        const float* IFB = (const float*)(KWS() + WS_IFB); float* G = (float*)(KWS() + WS_SCAL); float* MX = G + (size_t)M * 4; float* MT = MX + (size_t)M * 4;
        const int b = F.bid >> 2, hd = F.bid & 3, lane = F.lane; const float bi = KIN(I_MBI)[l * 4 + hd], bfv = KIN(I_MBF)[l * 4 + hd];
        const size_t tok0 = (size_t)b * SEQ + (size_t)F.tid * 8; LAS float* sc = (LAS float*)F.lds;
        float lf[8], li[8];
#pragma unroll
        for (int j = 0; j < 8; ++j) { lf[j] = IFB[(tok0 + j) * 8 + 4 + hd]; li[j] = IFB[(tok0 + j) * 8 + hd]; }
        asm volatile("" ::: "memory");
#pragma unroll
        for (int j = 0; j < 8; ++j) { lf[j] = logsigf_(lf[j] + bfv); li[j] += bi; }
#pragma unroll
        for (int j = 1; j < 8; ++j) lf[j] += lf[j - 1];
        float incl = lf[7];
#pragma unroll
        for (int o = 1; o < 64; o <<= 1) { const float t = __shfl_up(incl, o); if (lane >= o) incl += t; }
        if (lane == 63) sc[F.wave] = incl;
        __syncthreads();
        float woff = 0.f;
        for (int w2 = 0; w2 < F.wave; ++w2) woff += sc[w2];
        const float excl = woff + incl - lf[7];
        float mx[8]; float run = -INFINITY;
#pragma unroll
        for (int j = 0; j < 8; ++j) { lf[j] += excl; li[j] -= lf[j]; run = fmaxf(run, li[j]); mx[j] = run; }
        float im = run;
#pragma unroll
        for (int o = 1; o < 64; o <<= 1) { const float t = __shfl_up(im, o); if (lane >= o) im = fmaxf(im, t); }
        if (lane == 63) sc[16 + F.wave] = im;
        float pm = __shfl_up(im, 1); if (lane == 0) pm = -INFINITY;
        __syncthreads();
        for (int w2 = 0; w2 < F.wave; ++w2) pm = fmaxf(pm, sc[16 + w2]);
#pragma unroll
        for (int j = 0; j < 8; ++j) { const float m = fmaxf(pm, mx[j]); G[(tok0 + j) * 4 + hd] = li[j]; MX[(tok0 + j) * 4 + hd] = m; MT[(tok0 + j) * 4 + hd] = lf[j] + m; }
        __syncthreads();
    }
}

__device__ __forceinline__ f32x4 ld_bf4(const bf16* p) { const u32x2 w = *(const u32x2*)p; return (f32x4){__uint_as_float(w.x << 16), __uint_as_float(w.x & 0xffff0000u), __uint_as_float(w.y << 16), __uint_as_float(w.y & 0xffff0000u)}; }
__device__ __forceinline__ f32x4 bf4_unpack(const u32x2 w) { return (f32x4){__uint_as_float(w.x << 16), __uint_as_float(w.x & 0xffff0000u), __uint_as_float(w.y << 16), __uint_as_float(w.y & 0xffff0000u)}; }
struct VecIn { u32x2 r, k, v, r1, k1, v1; f32x4 a; };
__device__ __forceinline__ void phase_rwkv_vec(const Frame& F0, int l) {
    const Frame F = reframe(F0);
    const bf16* __restrict__ PROJ = (const bf16*)(KWS() + WS_PROJ); const float* __restrict__ AA = (const float*)(KWS() + WS_AA);
    float* __restrict__ RV = (float*)(KWS() + WS_RV); float* __restrict__ VV = (float*)(KWS() + WS_VV); float* __restrict__ BON = (float*)(KWS() + WS_BON);
    const float* mu = KIN(I_MU) + (size_t)l * 6336; const float* kkw = KIN(I_KK) + (size_t)l * 2048; const float* kaw = KIN(I_KA) + (size_t)l * 2048; const float* rkw = KIN(I_RK) + (size_t)l * 2048;
    const int gw = F.bid * NWAVES + F.wave, NGW = F.nblk * NWAVES, lane = F.lane;
    const int hq = gw & 7, ch = hq * 256 + lane * 4, h = hq * 4 + (lane >> 4);
    const f32x4 mr = *(const f32x4*)(mu + ch), mk = *(const f32x4*)(mu + 2048 + ch), mv = *(const f32x4*)(mu + 4096 + ch), ckk = *(const f32x4*)(kkw + ch), cka = *(const f32x4*)(kaw + ch), crk = *(const f32x4*)(rkw + ch);
    auto vload = [&](const int it, VecIn& x) { const int t = it >> 3, ts = t & (SEQ - 1);
        const bf16* pr = PROJ + (size_t)t * NPJ + ch; const bf16* pp = ts > 0 ? pr - NPJ : pr;
        x.r = *(const u32x2*)(pr + PC_BR); x.k = *(const u32x2*)(pr + PC_BK); x.v = *(const u32x2*)(pr + PC_BV);
        x.r1 = *(const u32x2*)(pp + PC_BR); x.k1 = *(const u32x2*)(pp + PC_BK); x.v1 = *(const u32x2*)(pp + PC_BV);
        x.a = *(const f32x4*)(AA + (size_t)t * 2048 + ch); };
    auto vcomp = [&](const int it, const VecIn& x) { const int t = it >> 3, ts = t & (SEQ - 1), b = t >> 12;
        f32x4 r = bf4_unpack(x.r), k = bf4_unpack(x.k), v = bf4_unpack(x.v);
        const f32x4 z = (f32x4){0.f, 0.f, 0.f, 0.f}; const f32x4 r1 = ts > 0 ? bf4_unpack(x.r1) : z, k1 = ts > 0 ? bf4_unpack(x.k1) : z, v1 = ts > 0 ? bf4_unpack(x.v1) : z;
        r += (r1 - r) * mr; k += (k1 - k) * mk; v += (v1 - v) * mv;
        const f32x4 a = x.a;
        const f32x4 kku = k * ckk;
        const float n2 = row16_sum((kku.x * kku.x + kku.y * kku.y) + (kku.z * kku.z + kku.w * kku.w));
        const float inv = __builtin_amdgcn_rcpf(fmaxf(sqrtf(n2), 1e-12f)); const f32x4 kk = kku * inv;
        const f32x4 kmod = k * ((a - 1.0f) * cka + 1.0f);
        const f32x4 rkk = r * kmod * crk;
        const float bon = row16_sum((rkk.x + rkk.y) + (rkk.z + rkk.w));
        float* rv = RV + (((size_t)(b * 32 + h) * SEQ + ts) * 5) * 64 + (lane & 15) * 4;
        *(f32x4*)rv = kk; *(f32x4*)(rv + 128) = -(kk * a); *(f32x4*)(rv + 192) = kmod; *(f32x4*)(rv + 256) = r;
        *(f32x4*)(VV + (size_t)t * 2048 + ch) = v; if ((lane & 15) == 0) BON[(size_t)t * 32 + h] = bon; };
    int it = gw;
    for (; it + 3 * NGW < M * 8; it += 4 * NGW) { VecIn x0, x1, x2, x3; vload(it, x0); vload(it + NGW, x1); vload(it + 2 * NGW, x2); vload(it + 3 * NGW, x3);
        vcomp(it, x0); vcomp(it + NGW, x1); vcomp(it + 2 * NGW, x2); vcomp(it + 3 * NGW, x3); }
    for (; it < M * 8; it += NGW) { VecIn x0; vload(it, x0); vcomp(it, x0); }
}

#define SC_PIN(a) asm volatile("" : "+v"(a[0]), "+v"(a[1]), "+v"(a[2]), "+v"(a[3]), "+v"(a[4]), "+v"(a[5]), "+v"(a[6]), "+v"(a[7]), "+v"(a[8]), "+v"(a[9]), "+v"(a[10]), "+v"(a[11]), "+v"(a[12]), "+v"(a[13]), "+v"(a[14]), "+v"(a[15]) :: "memory")
__device__ __forceinline__ void phase_lru_scan1(const Frame& F0) {
    const Frame F = reframe(F0);
    const float* LA = (const float*)(KWS() + WS_LA); const float* LB = (const float*)(KWS() + WS_LB); float* CA = (float*)(KWS() + WS_CARRY); float* CH = CA + 2 * 32 * 2048;
    const size_t gt = (size_t)F.bid * NTHREADS + F.tid, NGT = (size_t)F.nblk * NTHREADS;
    for (size_t i = gt; i < (size_t)2 * 32 * 2048; i += NGT) { const int ch = (int)(i & 2047), chunk = (int)(i >> 11) & 31, b = (int)(i >> 16);
        const size_t base = ((size_t)b * SEQ + chunk * 128) * 2048 + ch; float A = 1.f, H = 0.f;
        for (int s0 = 0; s0 < 128; s0 += 16) { float la[16], lb[16];
#pragma unroll
            for (int u = 0; u < 16; ++u) { la[u] = LA[base + (size_t)(s0 + u) * 2048]; lb[u] = LB[base + (size_t)(s0 + u) * 2048]; }
            SC_PIN(la); SC_PIN(lb);
#pragma unroll
            for (int u = 0; u < 16; ++u) { H = la[u] * H + lb[u]; A *= la[u]; } }
        CA[i] = A; CH[i] = H; }
}
__device__ __forceinline__ void scan2_item(const Frame& F, const int vb) {
    const float* __restrict__ LA = (const float*)(KWS() + WS_LA); const float* __restrict__ LB = (const float*)(KWS() + WS_LB); const float* __restrict__ CA = (const float*)(KWS() + WS_CARRY); const float* __restrict__ CH = CA + 2 * 32 * 2048;
    const bf16* __restrict__ PROJ = (const bf16*)(KWS() + WS_PROJ); bf16* __restrict__ Y = (bf16*)(KWS() + WS_Y);
    { const size_t i = (size_t)vb * NTHREADS + F.tid; const int ch = (int)(i & 2047), chunk = (int)(i >> 11) & 31, b = (int)(i >> 16);
        float H = 0.f;
        for (int j0 = 0; j0 < chunk; j0 += 16) { float ca[16], chh[16];
#pragma unroll
            for (int u = 0; u < 16; ++u) { const int j = j0 + u < chunk ? j0 + u : chunk - 1; const size_t ci = ((size_t)b * 32 + j) * 2048 + ch; ca[u] = CA[ci]; chh[u] = CH[ci]; }
            SC_PIN(ca); SC_PIN(chh);
#pragma unroll
            for (int u = 0; u < 16; ++u) if (j0 + u < chunk) H = ca[u] * H + chh[u]; }
        const size_t row0 = (size_t)b * SEQ + chunk * 128;
        for (int s0 = 0; s0 < 128; s0 += 16) { float la[16], lb[16]; unsigned gg[16];
#pragma unroll
            for (int u = 0; u < 16; ++u) { const size_t row = row0 + s0 + u; la[u] = LA[row * 2048 + ch]; lb[u] = LB[row * 2048 + ch]; gg[u] = PROJ[row * NPJ + PC_AG + ch]; }
            SC_PIN(la); SC_PIN(lb); SC_PIN(gg);
#pragma unroll
            for (int u = 0; u < 16; ++u) { const size_t row = row0 + s0 + u; H = la[u] * H + lb[u]; Y[row * KCAT + YC_A + ch] = (bf16)f2bf(H * siluf_(bf2f((bf16)gg[u]))); } } }
}

constexpr int RW_CH = 32;
constexpr int RW_RVB = RW_CH * 1280, RW_VVB = RW_CH * 256;
struct RwVec { f32x4 kk, wv, nk, kv, rv; f32x2 vi; };
template <int S> __device__ __forceinline__ void rw_issue(RwVec& d, unsigned a, unsigned av) {
    asm volatile("ds_read_b128 %0, %6 offset:%8\n\tds_read_b128 %1, %6 offset:%9\n\tds_read_b128 %2, %6 offset:%10\n\tds_read_b128 %3, %6 offset:%11\n\tds_read_b128 %4, %6 offset:%12\n\tds_read_b64 %5, %7 offset:%13"
                 : "=&v"(d.kk), "=&v"(d.wv), "=&v"(d.nk), "=&v"(d.kv), "=&v"(d.rv), "=&v"(d.vi) : "v"(a), "v"(av), "n"(S * 1280), "n"(S * 1280 + 256), "n"(S * 1280 + 512), "n"(S * 1280 + 768), "n"(S * 1280 + 1024), "n"(S * 256) : "memory"); }
#define RW_OPS(d) "+v"(d.kk), "+v"(d.wv), "+v"(d.nk), "+v"(d.kv), "+v"(d.rv), "+v"(d.vi)
__device__ __forceinline__ void rw_wait6(RwVec& d) { asm volatile("s_waitcnt lgkmcnt(6)" : RW_OPS(d) :: "memory"); }
__device__ __forceinline__ void rw_wait0(RwVec& d) { asm volatile("s_waitcnt lgkmcnt(0)" : RW_OPS(d) :: "memory"); }
__device__ __forceinline__ void phase_rwkv_rec(const Frame& F0, const int first, const int stride) {
    const Frame F = reframe(F0);
    const char* RV = (const char*)(KWS() + WS_RV); const char* VV = (const char*)(KWS() + WS_VV); float* YR = (float*)(KWS() + WS_YR);
    LAS unsigned char* lds = F.lds;
    for (int item = first; item < 128; item += stride) {
        const int bh = item >> 1, hf = item & 1, b = bh >> 5, h = bh & 31, w = F.wave, lane = F.lane, cg = lane & 15, rl = lane >> 4;
        const int row = hf * 32 + (w & 3) * 8 + rl * 2;
        const char* rvg = RV + (size_t)bh * SEQ * 1280; const char* vvg = VV + ((size_t)b * SEQ * 2048 + h * 64) * 4;
        f32x2 Sa0 = (f32x2){0.f, 0.f}, Sa1 = Sa0, Sb0 = Sa0, Sb1 = Sa0;
#define RW_DMA(ck) do { const int _buf = (ck) & 1; _Pragma("unroll") for (int _p = 0; _p < 6; ++_p) { const int pc = w * 6 + _p; \
            if (pc < 40) __builtin_amdgcn_global_load_lds((const unsigned*)(rvg + (size_t)(ck) * RW_RVB + pc * 1024 + lane * 16), (LAS unsigned*)(lds + _buf * RW_RVB + pc * 1024), 16, 0, 0); \
            else { const int pv = pc - 40; __builtin_amdgcn_global_load_lds((const unsigned*)(vvg + ((size_t)((ck) * RW_CH + pv * 4 + (lane >> 4)) * 2048) * 4 + (lane & 15) * 16), (LAS unsigned*)(lds + 2 * RW_RVB + _buf * RW_VVB + pv * 1024), 16, 0, 0); } } } while (0)
        RW_DMA(0);
        VM_WAIT(); __syncthreads();
        for (int ck = 0; ck < SEQ / RW_CH; ++ck) {
            if (ck + 1 < SEQ / RW_CH) RW_DMA(ck + 1);
            if (w < 4) {
                const unsigned ra = (unsigned)(size_t)(lds + (ck & 1) * RW_RVB + cg * 16), va = (unsigned)(size_t)(lds + 2 * RW_RVB + (ck & 1) * RW_VVB + row * 4);
                float* yo = YR + ((size_t)b * SEQ + (size_t)ck * RW_CH + (cg & 3)) * 2048 + h * 64 + row;
                RwVec A_, B_;
                rw_issue<0>(A_, ra, va);
#define P2(v, hi) ((f32x2){(hi) ? v.z : v.x, (hi) ? v.w : v.y})
#define RW_STEP(CUR, NXT, s_) do { if ((s_) + 1 < RW_CH) { rw_issue<((s_) + 1) % RW_CH>(NXT, ra, va); rw_wait6(CUR); } else rw_wait0(CUR); \
                    const f32x2 via = (f32x2){CUR.vi.x, CUR.vi.x}, vib = (f32x2){CUR.vi.y, CUR.vi.y}; \
                    const f32x2 pa = Sa0 * P2(CUR.kk, 0) + Sa1 * P2(CUR.kk, 1), pb = Sb0 * P2(CUR.kk, 0) + Sb1 * P2(CUR.kk, 1); \
                    float sa = pa.x + pa.y, sb = pb.x + pb.y; \
                    sa += dpp_mov<0xB1>(sa); sb += dpp_mov<0xB1>(sb); sa += dpp_mov<0x4E>(sa); sb += dpp_mov<0x4E>(sb); sa += dpp_mov<0x141>(sa); sb += dpp_mov<0x141>(sb); sa += dpp_mov<0x140>(sa); sb += dpp_mov<0x140>(sb); \
                    const f32x2 sa2 = (f32x2){sa, sa}, sb2 = (f32x2){sb, sb}; \
                    Sa0 = sa2 * P2(CUR.nk, 0) + (via * P2(CUR.kv, 0) + Sa0 * P2(CUR.wv, 0)); Sa1 = sa2 * P2(CUR.nk, 1) + (via * P2(CUR.kv, 1) + Sa1 * P2(CUR.wv, 1)); \
                    Sb0 = sb2 * P2(CUR.nk, 0) + (vib * P2(CUR.kv, 0) + Sb0 * P2(CUR.wv, 0)); Sb1 = sb2 * P2(CUR.nk, 1) + (vib * P2(CUR.kv, 1) + Sb1 * P2(CUR.wv, 1)); \
                    const f32x2 qa = Sa0 * P2(CUR.rv, 0) + Sa1 * P2(CUR.rv, 1), qb = Sb0 * P2(CUR.rv, 0) + Sb1 * P2(CUR.rv, 1); \
                    ya[(s_) & 3] = qa.x + qa.y; yb[(s_) & 3] = qb.x + qb.y; } while (0)
#define RW_G4(g4) do { \
                    float ya[4], yb[4]; \
                    RW_STEP(A_, B_, g4 * 4 + 0); RW_STEP(B_, A_, g4 * 4 + 1); RW_STEP(A_, B_, g4 * 4 + 2); RW_STEP(B_, A_, g4 * 4 + 3); \
                      \
                    const bool o1 = cg & 1, o2 = cg & 2; \
                    const float uA = (o1 ? ya[1] : ya[0]) + dpp_mov<0xB1>(o1 ? ya[0] : ya[1]), uB = (o1 ? ya[3] : ya[2]) + dpp_mov<0xB1>(o1 ? ya[2] : ya[3]); \
                    const float wA = (o1 ? yb[1] : yb[0]) + dpp_mov<0xB1>(o1 ? yb[0] : yb[1]), wB = (o1 ? yb[3] : yb[2]) + dpp_mov<0xB1>(o1 ? yb[2] : yb[3]); \
                    float ysa = (o2 ? uB : uA) + dpp_mov<0x4E>(o2 ? uA : uB), ysb = (o2 ? wB : wA) + dpp_mov<0x4E>(o2 ? wA : wB); \
                    ysa += dpp_mov<0x114>(ysa); ysb += dpp_mov<0x114>(ysb); \
                    ysa += dpp_mov<0x118>(ysa); ysb += dpp_mov<0x118>(ysb); \
                    if (cg >= 12) *(f32x2*)(yo + (size_t)(g4) * 4 * 2048) = (f32x2){ysa, ysb}; } while (0)
                RW_G4(0); RW_G4(1); RW_G4(2); RW_G4(3); RW_G4(4); RW_G4(5); RW_G4(6); RW_G4(7);
                static_assert(RW_CH == 32, "eight groups of four steps");
#undef RW_G4
#undef RW_STEP
#undef P2
            }
            VM_WAIT(); __syncthreads();
        }
#undef RW_DMA
    }
}

__device__ __forceinline__ void phase_rwkv_post(const Frame& F0, int l) {
    const Frame F = reframe(F0);
    const float* __restrict__ YR = (const float*)(KWS() + WS_YR); const float* __restrict__ VV = (const float*)(KWS() + WS_VV); const float* __restrict__ BON = (const float*)(KWS() + WS_BON);
    const bf16* __restrict__ PROJ = (const bf16*)(KWS() + WS_PROJ); bf16* __restrict__ Y = (bf16*)(KWS() + WS_Y);
    const float* gw_ = KIN(I_GNW) + (size_t)l * 2048; const float* gb_ = KIN(I_GNB) + (size_t)l * 2048;
    const int gw = F.bid * NWAVES + F.wave, NGW = F.nblk * NWAVES, lane = F.lane;
    const int hq = gw & 7, ch = hq * 256 + lane * 4, h = hq * 4 + (lane >> 4);
    const f32x4 w4 = *(const f32x4*)(gw_ + ch), b4 = *(const f32x4*)(gb_ + ch);
    struct PostIn { f32x4 y, v; float bon; u32x2 g; };
    auto pload = [&](const int it, PostIn& x) { const int t = it >> 3; x.y = *(const f32x4*)(YR + (size_t)t * 2048 + ch); x.v = *(const f32x4*)(VV + (size_t)t * 2048 + ch); x.bon = BON[(size_t)t * 32 + h]; x.g = *(const u32x2*)(PROJ + (size_t)t * NPJ + PC_BG + ch); };
    auto pcomp = [&](const int it, const PostIn& x) { const int t = it >> 3; const f32x4 y = x.y, v = x.v, g = bf4_unpack(x.g); const float bon = x.bon;
        const float mean = row16_sum((y.x + y.y) + (y.z + y.w)) * (1.0f / 64.0f); const f32x4 d = y - mean;
        const float var = row16_sum((d.x * d.x + d.y * d.y) + (d.z * d.z + d.w * d.w)) * (1.0f / 64.0f); const float rs = rsqrtf(var + 64e-5f);
        const f32x4 o = (d * rs * w4 + b4 + v * bon);
        u32x2 pk; pk.x = pk2(o.x * siluf_(g.x), o.y * siluf_(g.y)); pk.y = pk2(o.z * siluf_(g.z), o.w * siluf_(g.w));
        *(u32x2*)(Y + (size_t)t * KCAT + YC_B + ch) = pk; };
    int it = gw;
    for (; it + 3 * NGW < M * 8; it += 4 * NGW) { PostIn x0, x1, x2, x3; pload(it, x0); pload(it + NGW, x1); pload(it + 2 * NGW, x2); pload(it + 3 * NGW, x3);
        pcomp(it, x0); pcomp(it + NGW, x1); pcomp(it + 2 * NGW, x2); pcomp(it + 3 * NGW, x3); }
    for (; it < M * 8; it += NGW) { PostIn x0; pload(it, x0); pcomp(it, x0); }
}
__device__ __forceinline__ void phase_mlstm_post(const Frame& F0, int l) {
    const Frame F = reframe(F0);
    const float* __restrict__ HC = (const float*)(KWS() + WS_HC); const bf16* __restrict__ PROJ = (const bf16*)(KWS() + WS_PROJ); bf16* __restrict__ Y = (bf16*)(KWS() + WS_Y);
    const float* gw_ = KIN(I_MGNW) + (size_t)l * 2048;
    const int gw = F.bid * NWAVES + F.wave, NGW = F.nblk * NWAVES, lane = F.lane;
#pragma unroll 2
    for (int it = gw; it < M * 4; it += NGW) { const int t = it >> 2, hd = it & 3, ch = hd * 512 + lane * 8;
        const f32x4 v0 = *(const f32x4*)(HC + (size_t)t * 2048 + ch), v1 = *(const f32x4*)(HC + (size_t)t * 2048 + ch + 4);
        float x[8] = {v0.x, v0.y, v0.z, v0.w, v1.x, v1.y, v1.z, v1.w}; float s = 0.f;
#pragma unroll
        for (int q = 0; q < 8; ++q) s += x[q];
        const float mean = wave_sum(s) * (1.0f / 512.0f); float s2 = 0.f;
#pragma unroll
        for (int q = 0; q < 8; ++q) { x[q] -= mean; s2 += x[q] * x[q]; }
        const float rstd = rsqrtf(wave_sum(s2) * (1.0f / 512.0f) + 1e-6f);
        const u32x4 gg = *(const u32x4*)(PROJ + (size_t)t * NPJ + PC_CG + ch); float gf[8]; unpack8(gg, gf); float o[8];
#pragma unroll
        for (int q = 0; q < 8; ++q) o[q] = x[q] * rstd * gw_[ch + q] * siluf_(gf[q]);
        u32x4 w; w.x = pk2(o[0], o[1]); w.y = pk2(o[2], o[3]); w.z = pk2(o[4], o[5]); w.w = pk2(o[6], o[7]);
        *(u32x4*)(Y + (size_t)t * KCAT + YC_C + ch) = w; }
}

__device__ __forceinline__ s16x4 tr16(const LAS unsigned char* p) { return __builtin_bit_cast(s16x4, __builtin_amdgcn_ds_read_tr16_b64_v4i16((LAS s16x4*)p)); }
constexpr int ML_SROW = 80;
constexpr int ML_K = 0, ML_V = 3 * 16384, ML_S = ML_V + 3 * 32768, ML_G = ML_S + 64 * ML_SROW, ML_DEN = ML_G + 1024, ML_END = ML_DEN + 512;
static_assert(ML_END <= RING_BYTES, "mLSTM LDS");
__device__ __forceinline__ void xattn_item(const Frame& F, int l, const int item);
__device__ __forceinline__ int ml_vswz(int row) { return ((row & 3) << 1) | (((row >> 3) & 1) << 3); }
__device__ __forceinline__ void phase_mlstm(const Frame& F0, int l, unsigned* queue, const int lim_lo = 0, const int lim_hi = 1 << 30) {
    const Frame F = reframe(F0);
    const bf16* PROJ = (const bf16*)(KWS() + WS_PROJ); const bf16* QC = (const bf16*)(KWS() + WS_QC); const bf16* KC = (const bf16*)(KWS() + WS_KC);
    const float* G = (const float*)(KWS() + WS_SCAL); const float* MX = G + (size_t)M * 4; const float* MT = MX + (size_t)M * 4; float* HC = (float*)(KWS() + WS_HC);
    LAS unsigned char* lds = F.lds; LAS float* denl = (LAS float*)(lds + ML_DEN);
    const int tid = F.tid, lane = F.lane, w = F.wave, l15 = lane & 15, lg = lane >> 4, rt = w >> 1, ctp = w & 1;
    volatile LAS unsigned* qslot = (volatile LAS unsigned*)(F.lds + MISC_OFF);
    const bool affine = (lim_lo == 0) && (lim_hi == (1 << 30)); bool ml_left = affine, cv_left = affine && CONV1_IN_QUEUE && (l == 0), cat_left = affine && CONV1_IN_QUEUE, flip = false;
    for (;;) {
        __syncthreads();
        if (tid == 0) { unsigned it = 0xffffffffu;
            if (cv_left && (flip || !ml_left)) { const unsigned t = __hip_atomic_fetch_add(queue + 16, 1u, __ATOMIC_RELAXED, __HIP_MEMORY_SCOPE_AGENT); if (t < (unsigned)CONV_NVB) it = 1024u + t; else cv_left = false; }
            if (it == 0xffffffffu && ml_left) { const unsigned x = xb_xcc_id() & 7u;
                for (unsigned j = 0; j < 8u; ++j) { const unsigned sidx = (x + j) & 7u; const unsigned t = __hip_atomic_fetch_add(queue + 8 + sidx, 1u, __ATOMIC_RELAXED, __HIP_MEMORY_SCOPE_AGENT); if (t < 64u) { it = (t << 3) | sidx; break; } }
                if (it == 0xffffffffu) ml_left = false; }
            if (it == 0xffffffffu && cv_left) { const unsigned t = __hip_atomic_fetch_add(queue + 16, 1u, __ATOMIC_RELAXED, __HIP_MEMORY_SCOPE_AGENT); if (t < (unsigned)CONV_NVB) it = 1024u + t; else cv_left = false; }
            flip = !flip;
            if (it == 0xffffffffu && cat_left) { const unsigned t = __hip_atomic_fetch_add(queue + 192 - 64 * l + 16 * l, 1u, __ATOMIC_RELAXED, __HIP_MEMORY_SCOPE_AGENT); if (t < (unsigned)CAT_NVB) it = 2048u + t; else cat_left = false; }
            if (it == 0xffffffffu) { const unsigned t = __hip_atomic_fetch_add(queue, 1u, __ATOMIC_RELAXED, __HIP_MEMORY_SCOPE_AGENT); it = affine ? (t < 512u ? 512u + t : 0xfffffffeu) : t; }
            qslot[0] = it; }
        __syncthreads();
        if (affine && qslot[0] == 0xfffffffeu) break;
        if (affine && qslot[0] >= 2048u) { phase_convert_layer(F, l, 4, (int)qslot[0] - 2048, CAT_NVB); continue; }
        const int item = (int)qslot[0] + lim_lo; if (item >= lim_hi || item >= 1024 + ((CONV1_IN_QUEUE && l == 0) ? CONV_NVB : 0)) break;
        if (item >= 1024) { phase_convert_layer(F, 1, 2, item - 1024, CONV_NVB); continue; }
        if (item >= 768) { scan2_item(F, item - 768); continue; }
        if (item >= 512) { xattn_item(F, l, item - 512); continue; }
        const int qt = 63 - (item >> 3), b = (item >> 2) & 1, hd = item & 3, t0 = qt * 64; const size_t rowb = (size_t)b * SEQ;
        const int tq = opaque_v(lane);
        const int q15 = tq & 15, qg = tq >> 4;
        bf16x8 qf[8];
#pragma unroll
        for (int ks = 0; ks < 8; ++ks) qf[ks] = *(const bf16x8*)(QC + (rowb + t0 + 16 * rt + q15) * 1024 + hd * 256 + 32 * ks + 8 * qg);
        float mxr[4];
#pragma unroll
        for (int j = 0; j < 4; ++j) mxr[j] = MX[(rowb + t0 + 16 * rt + qg * 4 + j) * 4 + hd];
        f32x4 num[4][4];
#pragma unroll
        for (int r4 = 0; r4 < 4; ++r4)
#pragma unroll
            for (int c4 = 0; c4 < 4; ++c4) num[r4][c4] = (f32x4){0.f, 0.f, 0.f, 0.f};
        float dacc[4] = {0.f, 0.f, 0.f, 0.f};
        asm volatile("s_waitcnt vmcnt(0)" ::: "memory");
        asm volatile("" : "+v"(qf[0]), "+v"(qf[1]), "+v"(qf[2]), "+v"(qf[3]), "+v"(qf[4]), "+v"(qf[5]), "+v"(qf[6]), "+v"(qf[7]));
        asm volatile("" : "+v"(mxr[0]), "+v"(mxr[1]), "+v"(mxr[2]), "+v"(mxr[3]));
#define ML_DMA_KV(kt_, bf_) do { const int s0_ = (kt_) * 32; const char* kb_ = (const char*)KC + ((rowb + s0_) * 1024 + hd * 256) * 2; const char* vb_ = (const char*)PROJ + ((rowb + s0_) * NPJ + PC_CV + hd * 512) * 2; \
            _Pragma("unroll") for (int i = 0; i < 2; ++i) { const int pc = w * 2 + i, row = 2 * pc + (lane >> 5), p = lane & 31; \
                __builtin_amdgcn_global_load_lds((const unsigned*)(kb_ + (size_t)row * 2048 + ((p ^ (row & 15)) * 16)), (LAS unsigned*)(lds + ML_K + (bf_) * 16384 + pc * 1024), 16, 0, 0); } \
            _Pragma("unroll") for (int i = 0; i < 4; ++i) { const int row = w * 4 + i; \
                __builtin_amdgcn_global_load_lds((const unsigned*)(vb_ + (size_t)row * (NPJ * 2) + ((lane ^ ml_vswz(row)) * 16)), (LAS unsigned*)(lds + ML_V + (bf_) * 32768 + row * 1024), 16, 0, 0); } \
            if (w == 0) __builtin_amdgcn_global_load_lds((const unsigned*)(G + (rowb + s0_ + (lane & 31)) * 4 + hd), (LAS unsigned*)(lds + ML_G + (bf_) * 256), 4, 0, 0); } while (0)
        const int nkt = 2 * qt + 2;
        ML_DMA_KV(0, 0); ML_DMA_KV(1, 1);
        int buf = 0;
        for (int kt = 0; kt < nkt; ++kt) {
            const int s0 = kt * 32;
            if (kt + 1 < nkt) { if (w == 0) asm volatile("s_waitcnt vmcnt(7) lgkmcnt(0)" ::: "memory"); else asm volatile("s_waitcnt vmcnt(6) lgkmcnt(0)" ::: "memory"); }
            else asm volatile("s_waitcnt vmcnt(0) lgkmcnt(0)" ::: "memory");
            __builtin_amdgcn_s_barrier(); asm volatile("" ::: "memory");
            { const int bf2 = buf >= 1 ? buf - 1 : 2; if (kt + 2 < nkt) ML_DMA_KV(kt + 2, bf2); }
            const LAS unsigned char* kb = lds + ML_K + buf * 16384; const LAS unsigned char* vbuf = lds + ML_V + buf * 32768; const LAS float* gl = (const LAS float*)(lds + ML_G + buf * 256);
            f32x4 sacc = (f32x4){0.f, 0.f, 0.f, 0.f};
            { bf16x8 kf[8];
#pragma unroll
              for (int ks = 0; ks < 8; ++ks) { const int r = 16 * ctp + l15; kf[ks] = *(const LAS bf16x8*)(kb + r * 512 + (((4 * ks + lg) ^ (r & 15)) * 16)); }
              asm volatile("" : "+v"(kf[0]), "+v"(kf[1]), "+v"(kf[2]), "+v"(kf[3]), "+v"(kf[4]), "+v"(kf[5]), "+v"(kf[6]), "+v"(kf[7]));
              f32x4 sacc1 = (f32x4){0.f, 0.f, 0.f, 0.f};
#pragma unroll
              for (int ks = 0; ks < 8; ks += 2) { sacc = __builtin_amdgcn_mfma_f32_16x16x32_bf16(qf[ks], kf[ks], sacc, 0, 0, 0); sacc1 = __builtin_amdgcn_mfma_f32_16x16x32_bf16(qf[ks + 1], kf[ks + 1], sacc1, 0, 0, 0); }
              sacc += sacc1; }
            { const int sl = 16 * ctp + l15; const float gs = gl[sl];
#pragma unroll
                for (int j = 0; j < 4; ++j) { const int tl = 16 * rt + lg * 4 + j;
                    const float wgt = (s0 + sl <= t0 + tl) ? __expf(gs - mxr[j]) : 0.f; const float val = sacc[j] * wgt;
                    *(LAS unsigned short*)(lds + ML_S + tl * ML_SROW + sl * 2) = (unsigned short)f2bf(val);
                    dacc[j] += row16_sum(val); } }
            asm volatile("s_waitcnt lgkmcnt(0)" ::: "memory"); __builtin_amdgcn_s_barrier(); asm volatile("" ::: "memory");
            { bf16x8 afr[4];
#pragma unroll
                for (int r4 = 0; r4 < 4; ++r4) afr[r4] = *(const LAS bf16x8*)(lds + ML_S + (16 * r4 + l15) * ML_SROW + (8 * lg) * 2);
                unsigned va[4];
#pragma unroll
                for (int c4 = 0; c4 < 4; ++c4) { const int r = 8 * lg + (l15 >> 2), ch = 8 * w + 2 * c4 + ((l15 & 3) >> 1); va[c4] = (unsigned)(size_t)(vbuf + r * 1024 + ((ch ^ ml_vswz(r)) * 16) + (l15 & 1) * 8); }
                s16x4 lo[4], hi[4];
                asm volatile("ds_read_b64_tr_b16 %0, %8\n\tds_read_b64_tr_b16 %1, %8 offset:4096\n\tds_read_b64_tr_b16 %2, %9\n\tds_read_b64_tr_b16 %3, %9 offset:4096\n\t"
                             "ds_read_b64_tr_b16 %4, %10\n\tds_read_b64_tr_b16 %5, %10 offset:4096\n\tds_read_b64_tr_b16 %6, %11\n\tds_read_b64_tr_b16 %7, %11 offset:4096\n\ts_waitcnt lgkmcnt(0)"
                             : "=&v"(lo[0]), "=&v"(hi[0]), "=&v"(lo[1]), "=&v"(hi[1]), "=&v"(lo[2]), "=&v"(hi[2]), "=&v"(lo[3]), "=&v"(hi[3]) : "v"(va[0]), "v"(va[1]), "v"(va[2]), "v"(va[3]) : "memory");
#pragma unroll
                for (int c4 = 0; c4 < 4; ++c4) { const bf16x8 bfr = __builtin_shufflevector(lo[c4], hi[c4], 0, 1, 2, 3, 4, 5, 6, 7);
#pragma unroll
                    for (int r4 = 0; r4 < 4; ++r4) num[r4][c4] = __builtin_amdgcn_mfma_f32_16x16x32_bf16(afr[r4], bfr, num[r4][c4], 0, 0, 0); } }
            buf = buf == 2 ? 0 : buf + 1;
        }
#undef ML_DMA_KV
        if (l15 == 0) {
#pragma unroll
            for (int j = 0; j < 4; ++j) denl[(16 * rt + lg * 4 + j) * 2 + ctp] = dacc[j]; }
        __syncthreads();
        { unsigned short co[4][4][4]; float mtv[4][4];
#pragma unroll
          for (int r4 = 0; r4 < 4; ++r4)
#pragma unroll
            for (int j = 0; j < 4; ++j) { const size_t row = rowb + t0 + 16 * r4 + lg * 4 + j; mtv[r4][j] = MT[row * 4 + hd];
#pragma unroll
                for (int c4 = 0; c4 < 4; ++c4) co[r4][j][c4] = PROJ[row * NPJ + PC_CO + hd * 512 + 64 * w + 16 * c4 + l15]; }
#pragma unroll
          for (int r4 = 0; r4 < 4; ++r4)
#pragma unroll
            for (int j = 0; j < 4; ++j) { const int tl = 16 * r4 + lg * 4 + j; const size_t row = rowb + t0 + tl;
                const float den = denl[2 * tl] + denl[2 * tl + 1], mt = mtv[r4][j]; const float inv = __builtin_amdgcn_rcpf(fmaxf(fabsf(den), __expf(-mt)));
#pragma unroll
                for (int c4 = 0; c4 < 4; ++c4) { const int dv = 64 * w + 16 * c4 + l15; const float o = sigm(bf2f(co[r4][j][c4]));
                    HC[row * 2048 + hd * 512 + dv] = num[r4][c4][j] * inv * o; } } }
        asm volatile("s_waitcnt vmcnt(0)" ::: "memory"); __syncthreads();
        { const float* gw_ = KIN(I_MGNW) + (size_t)l * 2048; bf16* Y = (bf16*)(KWS() + WS_Y); const int ch = hd * 512 + lane * 8;
          f32x4 hv0[8], hv1[8]; u32x4 hg[8]; const f32x4 gwa = *(const f32x4*)(gw_ + ch), gwb = *(const f32x4*)(gw_ + ch + 4);
#pragma unroll
          for (int rr = 0; rr < 8; ++rr) { const size_t t = rowb + t0 + w * 8 + rr; hv0[rr] = *(const f32x4*)(HC + t * 2048 + ch); hv1[rr] = *(const f32x4*)(HC + t * 2048 + ch + 4); hg[rr] = *(const u32x4*)(PROJ + t * NPJ + PC_CG + ch); }
          asm volatile("" ::: "memory");
#pragma unroll
          for (int rr = 0; rr < 8; ++rr) { const size_t t = rowb + t0 + w * 8 + rr;
            const f32x4 v0 = hv0[rr], v1 = hv1[rr];
            float x[8] = {v0.x, v0.y, v0.z, v0.w, v1.x, v1.y, v1.z, v1.w}; float sm_ = 0.f;
#pragma unroll
            for (int q = 0; q < 8; ++q) sm_ += x[q];
            const float mean = wave_sum(sm_) * (1.0f / 512.0f); float s2 = 0.f;
#pragma unroll
            for (int q = 0; q < 8; ++q) { x[q] -= mean; s2 += x[q] * x[q]; }
            const float rstd = rsqrtf(wave_sum(s2) * (1.0f / 512.0f) + 1e-6f);
            float gf[8]; unpack8(hg[rr], gf); float o[8];
#pragma unroll
            for (int q = 0; q < 8; ++q) o[q] = x[q] * rstd * (q < 4 ? gwa[q] : gwb[q - 4]) * siluf_(gf[q]);
            u32x4 wv; wv.x = pk2(o[0], o[1]); wv.y = pk2(o[2], o[3]); wv.z = pk2(o[4], o[5]); wv.w = pk2(o[6], o[7]);
            *(u32x4*)(Y + t * KCAT + YC_C + ch) = wv; } }
    }
    __syncthreads();
}

constexpr int XA_ROW = 272, XA_K = 0, XA_V = 256 * XA_ROW, XA_END = 2 * 256 * XA_ROW, XA_PROW = 528;
static_assert(XA_END <= RING_BYTES && 8 * 16 * XA_PROW <= XA_V, "x-attn LDS");
__device__ __forceinline__ void xattn_item(const Frame& F, int l, const int item) {
    const bf16* PROJ = (const bf16*)(KWS() + WS_PROJ); const bf16* KV = (const bf16*)(KWS() + WS_KV) + (size_t)l * MM * 1024; bf16* Y = (bf16*)(KWS() + WS_Y);
    LAS unsigned char* lds = F.lds; const int lane = opaque_v(F.lane), w = F.wave, tid = w * 64 + lane, l15 = lane & 15, lg = lane >> 4;
    {
        const int b = item >> 7, hd = (item >> 5) & 3, qb = item & 31; const size_t row0 = (size_t)b * SEQ + qb * 128 + 16 * w;
        __syncthreads();
        { u32x4 kq[8], vq[8];
#pragma unroll
          for (int i = 0; i < 8; ++i) { const int p = tid + 512 * i, r = p >> 4, c16 = p & 15; const bf16* src = KV + (size_t)(b * MEML + r) * 1024 + hd * 128 + c16 * 8; kq[i] = *(const u32x4*)src; vq[i] = *(const u32x4*)(src + 512); }
          asm volatile("" : "+v"(kq[0]), "+v"(kq[1]), "+v"(kq[2]), "+v"(kq[3]), "+v"(kq[4]), "+v"(kq[5]), "+v"(kq[6]), "+v"(kq[7]), "+v"(vq[0]), "+v"(vq[1]), "+v"(vq[2]), "+v"(vq[3]), "+v"(vq[4]), "+v"(vq[5]), "+v"(vq[6]), "+v"(vq[7]) :: "memory");
#pragma unroll
          for (int i = 0; i < 8; ++i) { const int p = tid + 512 * i, r = p >> 4, c16 = p & 15; *(LAS u32x4*)(lds + XA_K + r * XA_ROW + c16 * 16) = kq[i]; *(LAS u32x4*)(lds + XA_V + r * XA_ROW + c16 * 16) = vq[i]; } }
        bf16x8 qf[4];
#pragma unroll
        for (int ks = 0; ks < 4; ++ks) qf[ks] = *(const bf16x8*)(PROJ + (row0 + l15) * NPJ + PC_XQ + hd * 128 + 32 * ks + 8 * lg);
        unsigned short xg[4][8];
#pragma unroll
        for (int j = 0; j < 4; ++j)
#pragma unroll
            for (int cc = 0; cc < 8; ++cc) xg[j][cc] = PROJ[(row0 + lg * 4 + j) * NPJ + PC_XG + hd * 128 + 16 * cc + l15];
        __syncthreads();
        f32x4 sacc[16];
#pragma unroll
        for (int ct = 0; ct < 16; ++ct) { sacc[ct] = (f32x4){0.f, 0.f, 0.f, 0.f};
#pragma unroll
            for (int ks = 0; ks < 4; ++ks) { const bf16x8 bfr = *(const LAS bf16x8*)(lds + XA_K + (16 * ct + l15) * XA_ROW + (32 * ks + 8 * lg) * 2);
                sacc[ct] = __builtin_amdgcn_mfma_f32_16x16x32_bf16(qf[ks], bfr, sacc[ct], 0, 0, 0); } }
        float mx[4], sm[4];
#pragma unroll
        for (int j = 0; j < 4; ++j) { float m = sacc[0][j];
#pragma unroll
            for (int ct = 1; ct < 16; ++ct) m = fmaxf(m, sacc[ct][j]);
            mx[j] = row16_max(m); sm[j] = 0.f; }
        __syncthreads();
        LAS unsigned char* pw = lds + XA_K + w * 16 * XA_PROW;
#pragma unroll
        for (int ct = 0; ct < 16; ++ct)
#pragma unroll
            for (int j = 0; j < 4; ++j) { const float p = __expf((sacc[ct][j] - mx[j]) * 0.08838834764831845f); sm[j] += p;
                *(LAS unsigned short*)(pw + (lg * 4 + j) * XA_PROW + (16 * ct + l15) * 2) = (unsigned short)f2bf(p); }
#pragma unroll
        for (int j = 0; j < 4; ++j) sm[j] = row16_sum(sm[j]);
        LDS_WAIT(); asm volatile("" ::: "memory");
        f32x4 oacc[8];
#pragma unroll
        for (int cc = 0; cc < 8; ++cc) oacc[cc] = (f32x4){0.f, 0.f, 0.f, 0.f};
#pragma unroll
        for (int ks = 0; ks < 8; ++ks) { const bf16x8 afr = *(const LAS bf16x8*)(pw + l15 * XA_PROW + (32 * ks + 8 * lg) * 2);
#pragma unroll
            for (int cc = 0; cc < 8; ++cc) { const LAS unsigned char* vp = lds + XA_V + (32 * ks + 8 * lg + (l15 >> 2)) * XA_ROW + (16 * cc + 4 * (l15 & 3)) * 2;
                const s16x4 lo = tr16(vp), hi = tr16(vp + 4 * XA_ROW); const bf16x8 bfr = __builtin_shufflevector(lo, hi, 0, 1, 2, 3, 4, 5, 6, 7);
                oacc[cc] = __builtin_amdgcn_mfma_f32_16x16x32_bf16(afr, bfr, oacc[cc], 0, 0, 0); } }
#pragma unroll
        for (int j = 0; j < 4; ++j) { const size_t row = row0 + lg * 4 + j; const float inv = __builtin_amdgcn_rcpf(sm[j]);
#pragma unroll
            for (int cc = 0; cc < 8; ++cc) { const int d = 16 * cc + l15; const float gate = siluf_(bf2f(xg[j][cc]));
                Y[row * KCAT + YC_X + hd * 128 + d] = (bf16)f2bf(oacc[cc][j] * inv * gate); } }
    }
    __syncthreads();
}

constexpr int NPL = 9, NPHASE = 2 + DEPTH * NPL;
struct Args { Ctx c; int ph_lo, ph_hi; };
template <unsigned PH_MASK> __global__ void __launch_bounds__(NTHREADS, 2) mega(Args args) {
    extern __shared__ __attribute__((aligned(16))) unsigned char lds_raw[];
    Frame F; F.lds = (LAS unsigned char*)lds_raw; F.wave = __builtin_amdgcn_readfirstlane((int)threadIdx.x >> 6); F.lane = lane_id(); F.tid = F.wave * 64 + F.lane; F.bid = blockIdx.x; F.nblk = gridDim.x;
    volatile LAS unsigned* MISC = (volatile LAS unsigned*)(F.lds + MISC_OFF);
    if (F.tid < 16) MISC[F.tid] = 0u;
    __syncthreads();
    const int lo = args.ph_lo, hi = args.ph_hi;
    XcdBarrier bar; bar.bar = (unsigned*)(KWS() + WS_CTL) + CW_BAR; bar.st = MISC + 8;
    if (PH_MASK == 0x7FFu) { if (hi - lo > 1) xcd_barrier_setup(bar, F.wave); }
#ifndef PROBE_DUP
#define PROBE_DUP 0u
#endif
#define DUP(j) (((PROBE_DUP >> (j)) & 1u) ? 2 : 1)
#define IN(k) (lo <= (k) && (k) < hi)
#define EN(j) ((PH_MASK >> (j)) & 1u)
#define SEAM(k) do { if (PH_MASK == 0x7FFu) { if (IN(k) && IN((k) + 1)) xcd_barrier(bar, F.wave); } } while (0)
    if (IN(0) && EN(0)) for (int rep = 0; rep < DUP(0); ++rep) { phase_convert_layer(F, 0, 1, F.bid, F.nblk); phase_convert_layer(F, 1, CONV1_IN_QUEUE ? 1 : 7, F.bid, F.nblk);
        { unsigned* ctr = (unsigned*)(KWS() + WS_CTL) + CW_QUEUE + 128 + 16 * rep; volatile LAS unsigned* qs = MISC;
          for (;;) { __syncthreads(); if (F.tid == 0) qs[0] = __hip_atomic_fetch_add(ctr, 1u, __ATOMIC_RELAXED, __HIP_MEMORY_SCOPE_AGENT); __syncthreads();
              const int vb = (int)qs[0]; if (vb >= CONV_NVB + 256) break;
              if (vb < CONV_NVB) phase_convert_layer(F, 0, 2, vb, CONV_NVB);
              else { Frame Fv = F; Fv.bid = vb - CONV_NVB; Fv.nblk = 256; phase_norm(Fv, KIN(I_X), KIN(I_NORM_G), false); } } } }
    SEAM(0);
    for (int l0 = 0; l0 < DEPTH; ++l0) {
        const int l = opaque_s(l0);
        const int pb = 2 + l * NPL;
        if (IN(pb + 0) && EN(2)) for (int rep = 0; rep < DUP(2); ++rep) {
            if (l == 0) {
                for (int l2 = 0; l2 < DEPTH; ++l2) { unsigned char* ws = KWS(); unsigned char* wl2 = ws + WS_W + (size_t)l2 * SZ_WLAYER;
                    pg8::Gemm g{(const char*)(ws + WS_MEMN) + (size_t)l2 * MM * 4096 * 2, (const char*)(wl2 + WO_WKV)};
                    EpiProj<1024, false> E{(bf16*)(ws + WS_KV) + (size_t)l2 * MM * 1024, nullptr};
                    const int cc = F.bid - (F.nblk - 16) - 8 * l2;
                    pg8::gemm_phase<pg8::Geo<8192, 8192, 4096, MM / 256, 4>, EpiProj<1024, false>>(F.lds, g, 8, (cc >= 0 && cc < 8) ? cc : 1000, F.wave, E); }
            }
            unsigned char* ws = KWS(); unsigned char* wl = ws + WS_W + (size_t)l * SZ_WLAYER;
            { pg8::Gemm g{(const char*)(ws + WS_H), (const char*)(wl + WO_WIN)};
              EpiProj<NPJ, true> E{(bf16*)(ws + WS_PROJ), (float*)(ws + WS_IFB)};
              pg8::gemm_phase<pg8::Geo<8192, 8192, 4096, M / 256, PN_I8>, EpiProj<NPJ, true>>(F.lds, g, F.nblk, F.bid, F.wave, E); }
            { pg8::Gemm g{(const char*)(ws + WS_H8), (const char*)(wl + WO_WIN) + (size_t)PC_I8 * 8192};
              EpiGate8 E{(bf16*)(ws + WS_PROJ) + PC_I8, (const float*)(ws + WS_HS), (const unsigned*)(ws + WS_CTL) + CW_CMAX + l * N8};
              pg8::gemm_phase<pg8::Geo<4096, 4096, 2048, M / 256, N8 / 256, 0, 0, true>, EpiGate8>(F.lds, g, F.nblk, F.bid, F.wave, E); }
            if (CONV1_IN_QUEUE && F.nblk == 256 && F.bid >= 192 && !(l == 0 && F.bid >= 240)) {
                unsigned* cat = (unsigned*)(KWS() + WS_CTL) + CW_QUEUE + 192 + 16 * l; volatile LAS unsigned* qs = MISC;
                for (int k = 0; k < 2; ++k) { __syncthreads(); if (F.tid == 0) qs[0] = __hip_atomic_fetch_add(cat, 1u, __ATOMIC_RELAXED, __HIP_MEMORY_SCOPE_AGENT); __syncthreads();
                    const int vb = (int)qs[0]; if (vb >= CAT_NVB) break; phase_convert_layer(F, l, 4, vb, CAT_NVB); } }
        }
        SEAM(pb + 0);
        if (IN(pb + 1) && EN(3)) for (int rep = 0; rep < DUP(3); ++rep) { phase_prep(F, l); }
        SEAM(pb + 1);
        if (IN(pb + 2) && EN(4)) for (int rep = 0; rep < DUP(4); ++rep) {
            { unsigned char* ws = KWS(); unsigned char* wl = ws + WS_W + (size_t)l * SZ_WLAYER;
              pg8::Gemm g{(const char*)(ws + WS_U), (const char*)(wl + WO_WG)};
              EpiLru E{(const bf16*)(ws + WS_U), (float*)(ws + WS_LA), (float*)(ws + WS_LB), KIN(I_LRU_BA) + (size_t)l * 2048, KIN(I_LRU_BX) + (size_t)l * 2048, KIN(I_LRU_LAM) + (size_t)l * 2048};
              pg8::gemm_phase<pg8::Geo<4096, 512, 256, M / 256, 16, 1, 512>, EpiLru>(F.lds, g, F.nblk, F.bid, F.wave, E); }
            { unsigned char* ws = KWS(); unsigned char* wl = ws + WS_W + (size_t)l * SZ_WLAYER;
              pg8::Gemm g{(const char*)(ws + WS_LORA), (const char*)(wl + WO_WL)};
              EpiLora E{(float*)(ws + WS_RV), (float*)(ws + WS_AA), KIN(I_W0) + (size_t)l * 2048, KIN(I_A0) + (size_t)l * 2048};
              pg8::gemm_phase<pg8::Geo<512, 512, 256, M / 256, 16>, EpiLora>(F.lds, g, F.nblk, F.bid, F.wave, E); }
        }
        SEAM(pb + 2);
        if (IN(pb + 3) && EN(5)) for (int rep = 0; rep < DUP(5); ++rep) { phase_rwkv_vec(F, l); phase_lru_scan1(F); }
        SEAM(pb + 3);
        if (IN(pb + 4) && EN(6)) {
            for (int rep = 0; rep < DUP(6); ++rep) phase_rwkv_rec(F, F.bid, F.nblk);
#ifdef PROBE_Q
            phase_mlstm(F, l, (unsigned*)(KWS() + WS_CTL) + CW_QUEUE + 64 * l + 32, PROBE_Q_LO, PROBE_Q_HI);
#endif
            phase_mlstm(F, l, (unsigned*)(KWS() + WS_CTL) + CW_QUEUE + 64 * l);
        }
        SEAM(pb + 4);
        if (IN(pb + 5) && EN(7)) for (int rep = 0; rep < DUP(7); ++rep) { phase_rwkv_post(F, l); }
        SEAM(pb + 5);
        if (IN(pb + 6) && EN(8)) for (int rep = 0; rep < DUP(8); ++rep) {
            unsigned char* ws = KWS(); unsigned char* wl = ws + WS_W + (size_t)l * SZ_WLAYER;
            pg8::Gemm g{(const char*)(ws + WS_Y), (const char*)(wl + WO_WCAT)};
            EpiMerge E{(const bf16*)(ws + WS_PROJ) + PC_GATE, (bf16*)(ws + WS_MERGED)};
            pg8::gemm_phase<pg8::Geo<KCAT * 2, KCAT * 2, KCAT, M / 256, 16>, EpiMerge>(F.lds, g, F.nblk, F.bid, F.wave, E);
        }
        SEAM(pb + 6);
        if (IN(pb + 7) && EN(9)) for (int rep = 0; rep < ((l == 0) ? DUP(9) : 1); ++rep) {
            unsigned char* ws = KWS(); unsigned char* wl = ws + WS_W + (size_t)l * SZ_WLAYER;
            pg8::Gemm g{(const char*)(ws + WS_MERGED), (const char*)(wl + WO_WOUT)};
            EpiOut E{(l == 0) ? KIN(I_X) : (const float*)(ws + WS_X1), (float*)(ws + WS_X1)};
            pg8::gemm_phase<pg8::Geo<8192, 8192, 4096, M / 256, 16>, EpiOut>(F.lds, g, F.nblk, F.bid, F.wave, E);
        }
        SEAM(pb + 7);
        if (IN(pb + 8) && EN(10)) { const float* X1 = (const float*)(KWS() + WS_X1); if (l + 1 < DEPTH) phase_norm(F, X1, KIN(I_NORM_G) + (size_t)(l + 1) * 4096, false); else phase_norm(F, X1, KIN(I_FNG), true); }
        SEAM(pb + 8);
    }
#undef IN
#undef SEAM
}

typedef void (*kern_t)(Args);
static kern_t phase_kernel(int p) {
    const int j = p < 2 ? p : 2 + (p - 2) % NPL;
    switch (j) { case 0: return mega<1u << 0>; case 1: return mega<1u << 1>; case 2: return mega<1u << 2>; case 3: return mega<1u << 3>; case 4: return mega<1u << 4>; case 5: return mega<1u << 5>;
                 case 6: return mega<1u << 6>; case 7: return mega<1u << 7>; case 8: return mega<1u << 8>; case 9: return mega<1u << 9>; default: return mega<1u << 10>; }
}
extern "C" void kernel_launch(void* const* d_in, const int* in_sizes, int n_in, void* d_out, int out_size, void* d_ws, size_t ws_size, hipStream_t stream) {
    static int grid = 0;
    if (grid == 0) {
        if (n_in != 34 || ws_size < WS_END) { fprintf(stderr, "kernel_launch: unexpected problem (n_in %d, ws %zu, need %zu)\n", n_in, ws_size, (size_t)WS_END); grid = -1; return; }
        int dev = 0, cus = 0;
        if (hipGetDevice(&dev) != hipSuccess || hipDeviceGetAttribute(&cus, hipDeviceAttributeMultiprocessorCount, dev) != hipSuccess) { grid = -1; return; }
#if MK_PER_PHASE
        for (int p = 0; p < 2 + NPL; ++p) if (hipFuncSetAttribute((const void*)phase_kernel(p), hipFuncAttributeMaxDynamicSharedMemorySize, LDS_BYTES) != hipSuccess) { fprintf(stderr, "kernel_launch: hipFuncSetAttribute failed\n"); grid = -1; return; }
#else
        if (hipFuncSetAttribute((const void*)mega<0x7FFu>, hipFuncAttributeMaxDynamicSharedMemorySize, LDS_BYTES) != hipSuccess) { fprintf(stderr, "kernel_launch: hipFuncSetAttribute failed\n"); grid = -1; return; }
#endif
        int occ = 0;
#if MK_PER_PHASE
        occ = 1;
#else
        if (hipOccupancyMaxActiveBlocksPerMultiprocessor(&occ, mega<0x7FFu>, NTHREADS, LDS_BYTES) != hipSuccess || occ < 1) { fprintf(stderr, "kernel_launch: occupancy query reports %d workgroups per CU\n", occ); grid = -1; return; }
#endif
        (void)hipGetLastError();
        grid = cus;
    }
    if (grid < 0) return;
    (void)hipMemsetAsync((char*)d_ws + WS_CTL, 0, CTL_ZERO_BYTES, stream);
    Args a{};
    for (int i = 0; i < 34; ++i) a.c.in[i] = (const float*)d_in[i];
    a.c.out = (float*)d_out; a.c.ws = (unsigned char*)d_ws;
#if MK_PER_PHASE
    for (int p = 0; p < NPHASE; ++p) { a.ph_lo = p; a.ph_hi = p + 1; hipLaunchKernelGGL(phase_kernel(p), dim3(grid), dim3(NTHREADS), LDS_BYTES, stream, a); }
#else
    a.ph_lo = 0; a.ph_hi = NPHASE; hipLaunchKernelGGL(mega<0x7FFu>, dim3(grid), dim3(NTHREADS), LDS_BYTES, stream, a);
#endif
    (void)in_sizes; (void)out_size;
}
```

```cpp
#include <hip/hip_runtime.h>
#include <cstdio>
#include <cstdint>

#ifndef MK_PER_PHASE
#define MK_PER_PHASE 0
#endif

#define LAS __attribute__((address_space(3)))
#define GAS __attribute__((address_space(1)))
typedef unsigned short bf16;
typedef short bf16x8 __attribute__((ext_vector_type(8)));
typedef short s16x4 __attribute__((ext_vector_type(4)));
typedef float f32x4 __attribute__((ext_vector_type(4)));
typedef float f32x2 __attribute__((ext_vector_type(2)));
typedef unsigned u32x4 __attribute__((ext_vector_type(4)));
typedef unsigned u32x2 __attribute__((ext_vector_type(2)));
typedef int i32x4 __attribute__((ext_vector_type(4)));

constexpr int D = 4096, NBATCH = 2, SEQ = 4096, M = NBATCH * SEQ, DEPTH = 2, MEML = 256, MM = NBATCH * MEML;
constexpr int CIN = 38088;
constexpr int NPJ = 38400;
constexpr int PC_AX = 0, PC_AG = 2048, PC_BR = 4096, PC_BK = 6144, PC_BV = 8192, PC_BWD = 10240, PC_BAD = 10368, PC_BG = 10496,
              PC_CQK = 12544, PC_CV = 14592, PC_CG = 16640, PC_XQ = 18688, PC_XG = 19200, PC_IF = 19712, PC_CO = 19968, PC_GATE = 22016;
constexpr int PN_IF = PC_IF / 256;
constexpr int KCAT = 6656;
constexpr int YC_A = 0, YC_B = 2048, YC_C = 4096, YC_X = 6144;

constexpr size_t MiB = 1u << 20;
constexpr size_t WS_CTL = 0, CTL_ZERO_BYTES = 1 * MiB;
constexpr size_t SZ_WIN = 300 * MiB, SZ_WCAT = 52 * MiB, SZ_WOUT = 32 * MiB, SZ_WKV = 8 * MiB, SZ_WG = 2 * MiB, SZ_WL = 2 * MiB;
constexpr size_t SZ_WLAYER = SZ_WIN + SZ_WCAT + SZ_WOUT + SZ_WKV + SZ_WG + SZ_WL;
constexpr size_t WS_W = 1 * MiB;
constexpr size_t WO_WIN = 0, WO_WCAT = SZ_WIN, WO_WOUT = WO_WCAT + SZ_WCAT, WO_WKV = WO_WOUT + SZ_WOUT, WO_WG = WO_WKV + SZ_WKV, WO_WL = WO_WG + SZ_WG;
constexpr size_t WS_MEMN = WS_W + 2 * SZ_WLAYER;
constexpr size_t WS_KV = WS_MEMN + 8 * MiB;
constexpr size_t WS_H = WS_KV + 2 * MiB;
constexpr size_t WS_PROJ = WS_H + 64 * MiB;
constexpr size_t WS_IFB = WS_PROJ + 600 * MiB;
constexpr size_t WS_U = WS_IFB + 1 * MiB;
constexpr size_t WS_LA = WS_U + 32 * MiB;
constexpr size_t WS_LB = WS_LA + 64 * MiB;
constexpr size_t WS_CARRY = WS_LB + 64 * MiB;
constexpr size_t WS_LORA = WS_CARRY + 1 * MiB;
constexpr size_t WS_WDEC = WS_LORA + 4 * MiB;
constexpr size_t WS_AA = WS_WDEC + 64 * MiB;
constexpr size_t WS_RV = WS_AA + 64 * MiB;
constexpr size_t WS_VV = WS_RV + 320 * MiB;
constexpr size_t WS_BON = WS_VV + 64 * MiB;
constexpr size_t WS_YR = WS_BON + 1 * MiB;
constexpr size_t WS_QC = WS_YR + 64 * MiB;
constexpr size_t WS_KC = WS_QC + 16 * MiB;
constexpr size_t WS_SCAL = WS_KC + 16 * MiB;
constexpr size_t WS_HC = WS_SCAL + 1 * MiB;
constexpr size_t WS_Y = WS_HC + 64 * MiB;
constexpr size_t WS_MERGED = WS_Y + 104 * MiB;
constexpr size_t WS_X1 = WS_MERGED + 64 * MiB;
constexpr size_t WS_H8 = WS_X1 + 128 * MiB;
constexpr size_t WS_HS = WS_H8 + 32 * MiB;
constexpr size_t WS_END = WS_HS + 1 * MiB;
constexpr int CW_BAR = 4096, CW_QUEUE = 8192;
constexpr int CW_CMAX = 131072;
constexpr int NGATE = 16384, PC_I8 = PC_CO, N8 = 2048 + NGATE, PN_I8 = PC_I8 / 256;
#ifndef CONV1_IN_QUEUE
#define CONV1_IN_QUEUE 1
#endif
constexpr int CAT_NVB = 128;
constexpr int CONV_NVB = 512;

constexpr int RING_BYTES = 155648;
constexpr int MISC_OFF = RING_BYTES;
constexpr int LDS_BYTES = 159744;
constexpr int NWAVES = 8, NTHREADS = 512;

__device__ __forceinline__ float bf2f(unsigned short b) { return __uint_as_float(((unsigned)b) << 16); }
__device__ __forceinline__ unsigned f2bf(float f) { unsigned u = __float_as_uint(f); return (u + 0x7fffu + ((u >> 16) & 1u)) >> 16; }
__device__ __forceinline__ unsigned pk2(float lo, float hi) { return f2bf(lo) | (f2bf(hi) << 16); }
__device__ __forceinline__ unsigned cvt_pk_bf16(float lo, float hi) { unsigned r; asm volatile("v_cvt_pk_bf16_f32 %0, %1, %2" : "=v"(r) : "v"(lo), "v"(hi)); return r; }
__device__ __forceinline__ float sigm(float x) { return __builtin_amdgcn_rcpf(1.0f + __expf(-x)); }
__device__ __forceinline__ float siluf_(float x) { return x * __builtin_amdgcn_rcpf(1.0f + __expf(-x)); }
__device__ __forceinline__ float softplusf_(float x) { return fmaxf(x, 0.f) + __logf(1.0f + __expf(-fabsf(x))); }
__device__ __forceinline__ float expm1s_(float x) { const float p = x * (1.0f + x * (0.5f + x * (0.16666667f + x * (0.041666668f + x * 0.0083333338f)))); return fabsf(x) < 0.25f ? p : __expf(x) - 1.0f; }

template <int CTRL> __device__ __forceinline__ float dpp_mov(float v) { return __int_as_float(__builtin_amdgcn_update_dpp(0, __float_as_int(v), CTRL, 0xf, 0xf, true)); }
__device__ __forceinline__ float row16_sum(float v) {
    v += dpp_mov<0xB1>(v); v += dpp_mov<0x4E>(v); v += dpp_mov<0x141>(v); v += dpp_mov<0x140>(v); return v;
}
__device__ __forceinline__ float wave_sum(float v) { v = row16_sum(v); v += __shfl_xor(v, 16); v += __shfl_xor(v, 32); return v; }
__device__ __forceinline__ float row16_max(float v) {
    v = fmaxf(v, dpp_mov<0xB1>(v)); v = fmaxf(v, dpp_mov<0x4E>(v)); v = fmaxf(v, dpp_mov<0x141>(v)); v = fmaxf(v, dpp_mov<0x140>(v)); return v;
}
__device__ __forceinline__ void unpack8(const u32x4 w, float* f) {
    f[0] = __uint_as_float(w.x << 16); f[1] = __uint_as_float(w.x & 0xffff0000u); f[2] = __uint_as_float(w.y << 16); f[3] = __uint_as_float(w.y & 0xffff0000u);
    f[4] = __uint_as_float(w.z << 16); f[5] = __uint_as_float(w.z & 0xffff0000u); f[6] = __uint_as_float(w.w << 16); f[7] = __uint_as_float(w.w & 0xffff0000u);
}
__device__ __forceinline__ int opaque_v(int v) { asm volatile("" : "+v"(v)); return v; }
template <class T> __device__ __forceinline__ const T* opaque_p(const T* p) { asm volatile("" : "+s"(p)); return p; }
__device__ __forceinline__ int opaque_s(int v) { asm volatile("" : "+s"(v)); return v; }
__device__ __forceinline__ int lane_id() { unsigned z; asm volatile("v_mov_b32 %0, 0" : "=v"(z)); return (int)__builtin_amdgcn_mbcnt_hi(~0u, __builtin_amdgcn_mbcnt_lo(~0u, z)); }
#define LDS_WAIT() asm volatile("s_waitcnt lgkmcnt(0)" ::: "memory")
#define VM_WAIT() asm volatile("s_waitcnt vmcnt(0)" ::: "memory")

#define XB_TMO      128
#define XB_XCNT(j)  (256  + 64 * (j))
#define XB_XSUB(j)  (1280 + 64 * (j))
#define XB_XGEN(j)  (2304 + 64 * (j))
#define XB_TOP      3328
#define XB_TOPGEN   3392
#define XCD_BAR_WORDS 3456
#define XB_SPIN_CAP (1u << 18)
__device__ __forceinline__ unsigned xb_ld(unsigned* p)              { return __hip_atomic_load(p, __ATOMIC_RELAXED, __HIP_MEMORY_SCOPE_AGENT); }
__device__ __forceinline__ unsigned xb_add(unsigned* p, unsigned v) { return __hip_atomic_fetch_add(p, v, __ATOMIC_RELAXED, __HIP_MEMORY_SCOPE_AGENT); }
__device__ __forceinline__ unsigned xb_xcc_id() { return (unsigned)__builtin_amdgcn_s_getreg((3 << 11) | 20) & 0xFu; }
#define XB_SPIN(cond, bar) do { unsigned _sp = 0; while (cond) { __builtin_amdgcn_s_sleep(1); \
    if ((++_sp & 255u) == 0u) { if (xb_ld(&(bar)[XB_TMO])) break; if (_sp > XB_SPIN_CAP) { atomicAdd(&(bar)[XB_TMO], 1u); break; } } } } while (0)
struct XcdBarrier { unsigned* bar; volatile LAS unsigned* st; };
__device__ __forceinline__ void xcd_barrier_setup(const XcdBarrier& b, const int wave_) {
    if (opaque_s(wave_) == 0 && lane_id() == 0) {
        unsigned* bar = b.bar; const unsigned x = xb_xcc_id();
        (void)xb_add(&bar[XB_XCNT(x)], 1u);
        const unsigned G = gridDim.x * gridDim.y * gridDim.z;
        unsigned sum, cnt, mine, sp = 0u;
        for (;;) {
            sum = 0u; cnt = 0u; mine = 0u;
            for (unsigned j = 0; j < 16; ++j) { const unsigned c = xb_ld(&bar[XB_XCNT(j)]); sum += c; cnt += (c > 0u) ? 1u : 0u; mine = (j == x) ? c : mine; }
            if (sum == G) break;
            __builtin_amdgcn_s_sleep(1);
            if ((++sp & 255u) == 0u) { if (xb_ld(&bar[XB_TMO])) break; if (sp > XB_SPIN_CAP) { atomicAdd(&bar[XB_TMO], 1u); break; } }
        }
        b.st[0] = mine > 0u ? mine : 1u; b.st[1] = cnt > 0u ? cnt : 1u; b.st[2] = x;
    }
    __syncthreads();
}
__device__ __forceinline__ void xcd_barrier(const XcdBarrier& b, const int wave_) {
    asm volatile("s_waitcnt vmcnt(0)" ::: "memory");
    __syncthreads();
    if (opaque_s(wave_) == 0 && lane_id() == 0) {
        unsigned* bar = b.bar;
        __builtin_amdgcn_s_waitcnt(0);
        const unsigned nloc = b.st[0], nx = b.st[1], x = b.st[2];
        const unsigned old = xb_add(&bar[XB_XSUB(x)], 1u);
        const unsigned gen = old / nloc;
        if (old + 1u == (gen + 1u) * nloc) {
            __builtin_amdgcn_fence(__ATOMIC_RELEASE, "agent");
            asm volatile("s_waitcnt vmcnt(0)" ::: "memory");
            const unsigned og = xb_add(&bar[XB_TOP], 1u);
            const unsigned tg = og / nx;
            if (og + 1u == (tg + 1u) * nx) xb_add(&bar[XB_TOPGEN], 1u);
            else XB_SPIN(xb_ld(&bar[XB_TOPGEN]) == tg, bar);
            __builtin_amdgcn_fence(__ATOMIC_ACQUIRE, "agent");
            xb_add(&bar[XB_XGEN(x)], 1u);
            asm volatile("s_waitcnt vmcnt(0)" ::: "memory");
        } else {
            XB_SPIN(xb_ld(&bar[XB_XGEN(x)]) == gen, bar);
            __builtin_amdgcn_fence(__ATOMIC_ACQUIRE, "agent");
            asm volatile("s_waitcnt vmcnt(0)" ::: "memory");
        }
    }
    __syncthreads();
}

namespace pg8 {
constexpr int BM = 256, BK = 64, HALF = 128, HTB = HALF * BK * 2, STAGE_BYTES = 8 * HTB, NXCD = 8, WGM = 8;
__host__ __device__ __forceinline__ int lds_byte(int r, int c) { const int st = (r >> 4) * 2 + (c >> 5), rr = r & 15, cc = c & 31, ob = rr * 64 + cc * 2; return st * 1024 + (ob ^ (((ob >> 9) & 1) << 5)); }
__host__ __device__ __forceinline__ void stage_rc(int b, int& R, int& C) { const int st = b / 1024, sb = b % 1024, swz = sb ^ (((sb >> 9) & 1) << 5); R = (st >> 1) * 16 + swz / 64; C = (st & 1) * 32 + (swz % 64) / 2; }
__host__ __device__ __forceinline__ int perm32(int rho) { const int n = rho >> 4, i = rho & 15; return 8 * (i >> 2) + 4 * n + (i & 3); }
struct Unit { int pm, pn; };
struct Gemm { const char* A; const char* Bt; };
template <int LDA_, int LDB_, int K_, int NM_, int NN_, int ASHIFT_ = 0, int ASTEP_ = 0, bool I8_ = false> struct Geo { static constexpr int LDA = LDA_, LDB = LDB_, K = K_, NM = NM_, NN = NN_, ASHIFT = ASHIFT_, ASTEP = ASTEP_; static constexpr bool I8 = I8_; };
template <bool I8> __device__ __forceinline__ f32x4 mma16(const bf16x8 a, const bf16x8 b, const f32x4 c) {
    if constexpr (I8) return __builtin_bit_cast(f32x4, __builtin_amdgcn_mfma_i32_16x16x64_i8(__builtin_bit_cast(i32x4, a), __builtin_bit_cast(i32x4, b), __builtin_bit_cast(i32x4, c), 0, 0, 0));
    else return __builtin_amdgcn_mfma_f32_16x16x32_bf16(a, b, c, 0, 0, 0); }
struct StaticOrder {
    int nM, nN, nwg, G, c;
    __device__ void init(int nM_, int nN_, int G_, int c_) { nM = nM_; nN = nN_; nwg = nM * nN; G = G_; c = c_; }
    __device__ bool next(int i, Unit& u) const {
        const long L = (long)i * G + c; if (L >= nwg) return false;
        int wgid = (int)L; { const int q = nwg / NXCD, r = nwg % NXCD, xcd = wgid % NXCD, off = wgid / NXCD; wgid = (xcd < r ? xcd * (q + 1) : r * (q + 1) + (xcd - r) * q) + off; }
        const int nig = WGM * nN, gid = wgid / nig, fm = gid * WGM, gsz = (nM - fm) < WGM ? (nM - fm) : WGM;
        u.pm = fm + ((wgid % nig) % gsz); u.pn = (wgid % nig) / gsz; return true;
    }
};
template <class GEO, class Epi>
__device__ __forceinline__ void gemm_phase(LAS unsigned char* lds, const Gemm g, const int G_, const int c_, const int wave_, const Epi& E) {
    StaticOrder S; S.init(GEO::NM, GEO::NN, opaque_s(G_), opaque_s(c_));
    const int wid = opaque_s(wave_), lane = lane_id(), tid = wid * 64 + lane, wr = wid >> 2, wc = wid & 3, fr = lane & 15, fq = lane >> 4;
    constexpr int nt = GEO::K / BK;
    unsigned voffA[2], voffB[2];
#pragma unroll
    for (int i = 0; i < 2; ++i) { int R, C; stage_rc(tid * 16 + i * 8192, R, C); const int Rb = Epi::PERM ? ((R & ~31) + perm32(R & 31)) : R;
        voffA[i] = (unsigned)(R * GEO::LDA + C * 2); voffB[i] = (unsigned)(Rb * GEO::LDB + C * 2); }
    constexpr size_t kstep = (size_t)(BK * 2);
    constexpr size_t hstepA = (size_t)HALF * GEO::LDA, hstepB = (size_t)HALF * GEO::LDB;
    const unsigned ldsw = (unsigned)wid * 1024u;
    const int aoff = lds_byte(wr * 64 + fr, fq * 8), boff = lds_byte(wc * 32 + fr, fq * 8);
#define PG8_SA(b, h) (((b) * 2 + (h)) * HTB)
#define PG8_SB(b, h) ((4 + (b) * 2 + (h)) * HTB)
#define PG8_STAGE(bufoff, gbase, voff) do { _Pragma("unroll") for (int _i = 0; _i < 2; ++_i) \
        __builtin_amdgcn_global_load_lds((const unsigned*)((const char*)(gbase) + (voff)[_i]), (LAS unsigned*)(lds + (bufoff) + ldsw + _i * 8192), 16, 0, 0); } while (0)
#define PG8_LDA(dst, b, h) do { _Pragma("unroll") for (int m = 0; m < 4; ++m) _Pragma("unroll") for (int k = 0; k < 2; ++k) dst[m][k] = *(const LAS bf16x8*)(lds + PG8_SA(b, h) + aoff + m * 2048 + k * 1024); } while (0)
#define PG8_LDB(dst, b, h) do { _Pragma("unroll") for (int n = 0; n < 2; ++n) _Pragma("unroll") for (int k = 0; k < 2; ++k) dst[n][k] = *(const LAS bf16x8*)(lds + PG8_SB(b, h) + boff + n * 2048 + k * 1024); } while (0)
#define PG8_MMA(ai, bj, At, Bt) do { __builtin_amdgcn_s_setprio(1); _Pragma("unroll") for (int m = 0; m < 4; ++m) _Pragma("unroll") for (int n = 0; n < 2; ++n) _Pragma("unroll") for (int k = 0; k < 2; ++k) \
        acc[ai][bj][m][n] = mma16<GEO::I8>(Bt[n][k], At[m][k], acc[ai][bj][m][n]); __builtin_amdgcn_s_setprio(0); } while (0)
#define PG8_WAIT_V(n) asm volatile("s_waitcnt vmcnt(" #n ")" ::: "memory")
#define PG8_WAIT_L(n) asm volatile("s_waitcnt lgkmcnt(" #n ")" ::: "memory")
#define PG8_BAR __builtin_amdgcn_s_barrier()
#define PG8_SCHED __builtin_amdgcn_sched_barrier(0)
    Unit cur, nxt; int ui = 0;
    if (!S.next(0, cur)) return;
    f32x4 acc[2][2][4][2];
#pragma unroll
    for (int a = 0; a < 2; ++a)
#pragma unroll
        for (int b = 0; b < 2; ++b)
#pragma unroll
            for (int m = 0; m < 4; ++m)
#pragma unroll
                for (int n = 0; n < 2; ++n) acc[a][b][m][n] = (f32x4){0.f, 0.f, 0.f, 0.f};
    bf16x8 At[4][2], B0[2][2], B1[2][2];
    const char* cA = g.A + (size_t)cur.pm * (BM * GEO::LDA) + (size_t)((cur.pn >> GEO::ASHIFT) * GEO::ASTEP);
    const char* cB = g.Bt + (size_t)cur.pn * (BM * GEO::LDB);
    PG8_STAGE(PG8_SB(0, 0), cB, voffB); PG8_STAGE(PG8_SB(0, 1), cB + hstepB, voffB); PG8_STAGE(PG8_SA(0, 0), cA, voffA); PG8_STAGE(PG8_SA(0, 1), cA + hstepA, voffA);
    if (wr == 1) PG8_BAR;
    PG8_WAIT_V(2); PG8_BAR;
    PG8_STAGE(PG8_SB(1, 0), cB + kstep, voffB); PG8_STAGE(PG8_SA(1, 0), cA + kstep, voffA); PG8_STAGE(PG8_SB(1, 1), cB + hstepB + kstep, voffB);
    PG8_WAIT_V(6); PG8_BAR;
    for (;;) {
        const bool has_next = S.next(ui + 1, nxt);
        const char* nA = has_next ? g.A + (size_t)nxt.pm * (BM * GEO::LDA) + (size_t)((nxt.pn >> GEO::ASHIFT) * GEO::ASTEP) : cA;
        const char* nB = has_next ? g.Bt + (size_t)nxt.pn * (BM * GEO::LDB) : cB;
#pragma unroll 1
        for (int t = 0; t < nt; t += 2) {
            const bool last = (t == nt - 2);
            const char* a1 = cA + (size_t)(t + 1) * kstep;
            const char* a2 = last ? nA : cA + (size_t)(t + 2) * kstep; const char* b2 = last ? nB : cB + (size_t)(t + 2) * kstep;
            const char* a3 = a2 + kstep; const char* b3 = b2 + kstep;
            if constexpr (Epi::HOOK) { if (t != 0 && (t & 31) == 0) E.hook(acc, cur, (t >> 5) - 1, wr, wc, fr, fq); }
            PG8_LDB(B0, 0, 0); PG8_LDB(B1, 0, 1); PG8_SCHED; PG8_LDA(At, 0, 0); PG8_STAGE(PG8_SA(1, 1), a1 + hstepA, voffA);
            PG8_WAIT_V(8); PG8_WAIT_L(0); PG8_BAR; PG8_MMA(0, 0, At, B0); PG8_MMA(0, 1, At, B1); PG8_BAR; PG8_SCHED;
            PG8_LDA(At, 0, 1); PG8_STAGE(PG8_SB(0, 0), b2, voffB); PG8_STAGE(PG8_SB(0, 1), b2 + hstepB, voffB); PG8_STAGE(PG8_SA(0, 0), a2, voffA);
            PG8_WAIT_V(8); PG8_WAIT_L(0); PG8_BAR; PG8_MMA(1, 0, At, B0); PG8_MMA(1, 1, At, B1); PG8_BAR; PG8_SCHED;
            PG8_LDB(B0, 1, 0); PG8_LDB(B1, 1, 1); PG8_SCHED; PG8_LDA(At, 1, 0); PG8_STAGE(PG8_SA(0, 1), a2 + hstepA, voffA);
            PG8_WAIT_V(8); PG8_WAIT_L(0); PG8_BAR; PG8_MMA(0, 0, At, B0); PG8_MMA(0, 1, At, B1); PG8_BAR; PG8_SCHED;
            PG8_LDA(At, 1, 1); PG8_STAGE(PG8_SB(1, 0), b3, voffB); PG8_STAGE(PG8_SB(1, 1), b3 + hstepB, voffB); PG8_STAGE(PG8_SA(1, 0), a3, voffA);
            PG8_WAIT_V(8); PG8_WAIT_L(0); PG8_BAR; PG8_MMA(1, 0, At, B0); PG8_MMA(1, 1, At, B1); PG8_BAR; PG8_SCHED;
        }
        if (wr == 0) PG8_BAR;
        E(acc, cur, wr, wc, fr, fq);
        if (!has_next) break;
#pragma unroll
        for (int a = 0; a < 2; ++a)
#pragma unroll
            for (int b = 0; b < 2; ++b)
#pragma unroll
                for (int m = 0; m < 4; ++m)
#pragma unroll
                    for (int n = 0; n < 2; ++n) acc[a][b][m][n] = (f32x4){0.f, 0.f, 0.f, 0.f};
        cur = nxt; cA = nA; cB = nB; ++ui;
        if (wr == 1) PG8_BAR;
    }
    PG8_WAIT_V(0);
    PG8_BAR;
#undef PG8_SA
#undef PG8_SB
#undef PG8_STAGE
#undef PG8_LDA
#undef PG8_LDB
#undef PG8_MMA
#undef PG8_WAIT_V
#undef PG8_WAIT_L
#undef PG8_BAR
#undef PG8_SCHED
}
}

struct Ctx { const float* in[34]; float* out; unsigned char* ws; };
enum { I_X = 0, I_MEM, I_NORM_G, I_MEMNORM_G, I_WIN, I_LRU_CW, I_LRU_CB, I_LRU_WA, I_LRU_BA, I_LRU_WX, I_LRU_BX, I_LRU_LAM, I_MU, I_W0, I_WUP, I_A0, I_AUP,
       I_KK, I_KA, I_RK, I_GNW, I_GNB, I_MCW, I_MCB, I_MBI, I_MBF, I_MGNW, I_WKV, I_WBA, I_WBB, I_WBC, I_WBX, I_WOUT, I_FNG };


typedef const __attribute__((address_space(4))) char* kargp_t;
template <int OFF> __device__ __forceinline__ unsigned long long karg_u64() {
    kargp_t kp = (kargp_t)__builtin_amdgcn_kernarg_segment_ptr(); unsigned long long v;
    asm volatile("s_load_dwordx2 %0, %1, %2\n\ts_waitcnt lgkmcnt(0)" : "=s"(v) : "s"(kp), "i"(OFF)); return v; }
#define KIN(i) ((const float*)(const GAS float*)karg_u64<(i) * 8>())
#define KOUT() ((float*)(GAS float*)karg_u64<34 * 8>())
#define KWS() ((unsigned char*)(GAS unsigned char*)karg_u64<35 * 8>())

template <int ldc, bool HAS_IF> struct EpiProj {
    static constexpr bool PERM = true, HOOK = false;
    bf16* O; float* ifb;
    __device__ __forceinline__ void operator()(const f32x4 (&acc)[2][2][4][2], const pg8::Unit& u, int wr, int wc, int fr, int fq) const {
        const int row0 = u.pm * 256 + wr * 64 + fr, col0 = u.pn * 256 + wc * 32 + 8 * fq;
#pragma unroll
        for (int ai = 0; ai < 2; ++ai)
#pragma unroll
            for (int m = 0; m < 4; ++m) { const int row = row0 + ai * 128 + m * 16; bf16* rowp = O + (size_t)row * ldc + col0;
#pragma unroll
                for (int bj = 0; bj < 2; ++bj) { const f32x4 v0 = acc[ai][bj][m][0], v1 = acc[ai][bj][m][1];
                    u32x4 w; w.x = cvt_pk_bf16(v0[0], v0[1]); w.y = cvt_pk_bf16(v0[2], v0[3]); w.z = cvt_pk_bf16(v1[0], v1[1]); w.w = cvt_pk_bf16(v1[2], v1[3]);
                    *(u32x4*)(rowp + bj * 128) = w; }
                if (HAS_IF && u.pn == PN_IF && wc == 0 && fq == 0) { *(f32x4*)(ifb + (size_t)row * 8) = acc[ai][0][m][0]; *(f32x4*)(ifb + (size_t)row * 8 + 4) = acc[ai][0][m][1]; }
            }
    }
};
__device__ __forceinline__ void gl2n_issue(u32x4& a0, u32x4& a1, const void* pa, unsigned voff) {
    asm volatile("s_nop 4\n\tglobal_load_dwordx4 %0, %2, %3\n\tglobal_load_dwordx4 %1, %2, %3 offset:16" : "=&v"(a0), "=&v"(a1) : "v"(voff), "s"(pa) : "memory"); }
#define GL_WAIT4(g) asm volatile("s_waitcnt vmcnt(0)" : "+v"(g[0]), "+v"(g[1]), "+v"(g[2]), "+v"(g[3]) :: "memory")
struct EpiGate8 {
    static constexpr bool PERM = true, HOOK = false;
    bf16* O; const float* hs; const unsigned* cmax;
    __device__ __forceinline__ void operator()(const f32x4 (&acc)[2][2][4][2], const pg8::Unit& u, int wr, int wc, int fr, int fq) const {
        const int row0 = u.pm * 256 + wr * 64 + fr, col0 = u.pn * 256 + wc * 32 + 8 * fq;
        u32x4 cs[4]; const unsigned coff = (unsigned)((wc * 32 + 8 * fq) * 4);
        gl2n_issue(cs[0], cs[1], cmax + u.pn * 256, coff); gl2n_issue(cs[2], cs[3], cmax + u.pn * 256 + 128, coff);
        float rsv[8]; { const float* hb = hs + u.pm * 256 + wr * 64; const unsigned roff = (unsigned)(fr * 4);
            asm volatile("s_nop 4\n\tglobal_load_dword %0, %8, %9\n\tglobal_load_dword %1, %8, %9 offset:64\n\tglobal_load_dword %2, %8, %9 offset:128\n\tglobal_load_dword %3, %8, %9 offset:192\n\t"
                         "global_load_dword %4, %8, %9 offset:512\n\tglobal_load_dword %5, %8, %9 offset:576\n\tglobal_load_dword %6, %8, %9 offset:640\n\tglobal_load_dword %7, %8, %9 offset:704\n\ts_waitcnt vmcnt(0)"
                         : "=&v"(rsv[0]), "=&v"(rsv[1]), "=&v"(rsv[2]), "=&v"(rsv[3]), "=&v"(rsv[4]), "=&v"(rsv[5]), "=&v"(rsv[6]), "=&v"(rsv[7]) : "v"(roff), "s"(hb) : "memory"); }
        GL_WAIT4(cs);
        float wsc[2][8];
#pragma unroll
        for (int bj = 0; bj < 2; ++bj)
#pragma unroll
            for (int j = 0; j < 8; ++j) wsc[bj][j] = __uint_as_float(cs[2 * bj + (j >> 2)][j & 3]) * (1.0f / 127.0f);
#pragma unroll
        for (int ai = 0; ai < 2; ++ai)
#pragma unroll
            for (int m = 0; m < 4; ++m) { const int row = row0 + ai * 128 + m * 16; const float rs = rsv[ai * 4 + m]; bf16* rowp = O + (size_t)row * NPJ + col0;
#pragma unroll
                for (int bj = 0; bj < 2; ++bj) { const i32x4 v0 = __builtin_bit_cast(i32x4, acc[ai][bj][m][0]), v1 = __builtin_bit_cast(i32x4, acc[ai][bj][m][1]);
                    u32x4 w; w.x = cvt_pk_bf16((float)v0[0] * (rs * wsc[bj][0]), (float)v0[1] * (rs * wsc[bj][1])); w.y = cvt_pk_bf16((float)v0[2] * (rs * wsc[bj][2]), (float)v0[3] * (rs * wsc[bj][3]));
                    w.z = cvt_pk_bf16((float)v1[0] * (rs * wsc[bj][4]), (float)v1[1] * (rs * wsc[bj][5])); w.w = cvt_pk_bf16((float)v1[2] * (rs * wsc[bj][6]), (float)v1[3] * (rs * wsc[bj][7]));
                    *(u32x4*)(rowp + bj * 128) = w; } }
    }
};
struct EpiLru {
    static constexpr bool PERM = true, HOOK = false;
    const bf16* U; float* LA; float* LB; const float* ba; const float* bx; const float* lam;
    __device__ __forceinline__ void operator()(const f32x4 (&acc)[2][2][4][2], const pg8::Unit& u, int wr, int wc, int fr, int fq) const {
        const int row0 = u.pm * 256 + wr * 64 + fr, ch0 = u.pn * 128 + wc * 32 + 8 * fq;
        float cba[8], cbx[8], csp[8];
#pragma unroll
        for (int j = 0; j < 8; ++j) { cba[j] = ba[ch0 + j]; cbx[j] = bx[ch0 + j]; csp[j] = -8.0f * softplusf_(-lam[ch0 + j]); }
        u32x4 uws[8];
#pragma unroll
        for (int i = 0; i < 8; ++i) uws[i] = *(const u32x4*)(U + (size_t)(row0 + (i >> 2) * 128 + (i & 3) * 16) * 2048 + ch0);
        asm volatile("" ::: "memory");
#pragma unroll
        for (int ai = 0; ai < 2; ++ai)
#pragma unroll
            for (int m = 0; m < 4; ++m) { const int row = row0 + ai * 128 + m * 16;
                float uf[8]; unpack8(uws[ai * 4 + m], uf);
                float a8[8], b8[8];
#pragma unroll
                for (int n = 0; n < 2; ++n)
#pragma unroll
                    for (int j = 0; j < 4; ++j) { const int q = 4 * n + j;
                        const float r = sigm(acc[ai][0][m][n][j] + cba[q]), ig = sigm(acc[ai][1][m][n][j] + cbx[q]);
                        const float la = csp[q] * r; a8[q] = __expf(la); b8[q] = sqrtf(-expm1s_(2.0f * la)) * (ig * uf[q]); }
                float* pa = LA + (size_t)row * 2048 + ch0; float* pb = LB + (size_t)row * 2048 + ch0;
                *(f32x4*)pa = (f32x4){a8[0], a8[1], a8[2], a8[3]}; *(f32x4*)(pa + 4) = (f32x4){a8[4], a8[5], a8[6], a8[7]};
                *(f32x4*)pb = (f32x4){b8[0], b8[1], b8[2], b8[3]}; *(f32x4*)(pb + 4) = (f32x4){b8[4], b8[5], b8[6], b8[7]};
            }
    }
};
struct EpiLora {
    static constexpr bool PERM = true, HOOK = false;
    float* WDEC; float* AA; const float* w0; const float* a0;
    __device__ __forceinline__ void operator()(const f32x4 (&acc)[2][2][4][2], const pg8::Unit& u, int wr, int wc, int fr, int fq) const {
        const int row0 = u.pm * 256 + wr * 64 + fr, ch0 = u.pn * 128 + wc * 32 + 8 * fq;
        float cw0[8], ca0[8];
#pragma unroll
        for (int j = 0; j < 8; ++j) { cw0[j] = w0[ch0 + j]; ca0[j] = a0[ch0 + j]; }
#pragma unroll
        for (int ai = 0; ai < 2; ++ai)
#pragma unroll
            for (int m = 0; m < 4; ++m) { const int row = row0 + ai * 128 + m * 16; float d8[8], a8[8];
#pragma unroll
                for (int n = 0; n < 2; ++n)
#pragma unroll
                    for (int j = 0; j < 4; ++j) { const int q = 4 * n + j;
                        const float wl = -softplusf_(-(cw0[q] + acc[ai][0][m][n][j])) - 0.5f; d8[q] = __expf(-__expf(wl)); a8[q] = sigm(ca0[q] + acc[ai][1][m][n][j]); }
                float* pd = WDEC + ((((size_t)((row >> 12) * 32 + (ch0 >> 6)) * SEQ + (row & (SEQ - 1))) * 5 + 1) * 64 + (ch0 & 63)); float* pa = AA + (size_t)row * 2048 + ch0;
                *(f32x4*)pd = (f32x4){d8[0], d8[1], d8[2], d8[3]}; *(f32x4*)(pd + 4) = (f32x4){d8[4], d8[5], d8[6], d8[7]};
                *(f32x4*)pa = (f32x4){a8[0], a8[1], a8[2], a8[3]}; *(f32x4*)(pa + 4) = (f32x4){a8[4], a8[5], a8[6], a8[7]};
            }
    }
};
__device__ __forceinline__ void gl2_issue(u32x4& a0, u32x4& a1, const void* pa, unsigned voff) {
    asm volatile("s_nop 4\n\tglobal_load_dwordx4 %0, %2, %3\n\tglobal_load_dwordx4 %1, %2, %3 offset:256" : "=&v"(a0), "=&v"(a1) : "v"(voff), "s"(pa) : "memory"); }
__device__ __forceinline__ void gl4f_issue(u32x4& a0, u32x4& a1, u32x4& a2, u32x4& a3, const void* pa, unsigned voff) {
    asm volatile("s_nop 4\n\tglobal_load_dwordx4 %0, %4, %5\n\tglobal_load_dwordx4 %1, %4, %5 offset:64\n\tglobal_load_dwordx4 %2, %4, %5 offset:512\n\tglobal_load_dwordx4 %3, %4, %5 offset:576"
                 : "=&v"(a0), "=&v"(a1), "=&v"(a2), "=&v"(a3) : "v"(voff), "s"(pa) : "memory"); }
#define GL_WAIT8(g) asm volatile("s_waitcnt vmcnt(0)" : "+v"(g[0]), "+v"(g[1]), "+v"(g[2]), "+v"(g[3]), "+v"(g[4]), "+v"(g[5]), "+v"(g[6]), "+v"(g[7]) :: "memory")
#define GL_WAIT16(g) asm volatile("s_waitcnt vmcnt(0)" : "+v"(g[0]), "+v"(g[1]), "+v"(g[2]), "+v"(g[3]), "+v"(g[4]), "+v"(g[5]), "+v"(g[6]), "+v"(g[7]), \
                                  "+v"(g[8]), "+v"(g[9]), "+v"(g[10]), "+v"(g[11]), "+v"(g[12]), "+v"(g[13]), "+v"(g[14]), "+v"(g[15]) :: "memory")
struct EpiMerge {
    static constexpr bool PERM = true, HOOK = true;
    const bf16* GL; bf16* O; static constexpr int ldg = NPJ;
    __device__ __forceinline__ void hook(f32x4 (&acc)[2][2][4][2], const pg8::Unit& u, int br, int wr, int wc, int fr, int fq) const {
        const unsigned voff = (unsigned)(fr * (ldg * 2) + (wc * 32 + 8 * fq) * 2);
        const char* base = (const char*)GL + ((size_t)(u.pm * 256 + wr * 64) * ldg + br * 4096 + u.pn * 256) * 2;
#pragma unroll
        for (int ai = 0; ai < 2; ++ai) { u32x4 g[16];
#pragma unroll
            for (int m = 0; m < 4; ++m) { const char* pm_ = base + (size_t)(ai * 128 + m * 16) * (ldg * 2); gl2_issue(g[4 * m], g[4 * m + 1], pm_, voff); gl2_issue(g[4 * m + 2], g[4 * m + 3], pm_ + 8192, voff); }
            GL_WAIT16(g);
#pragma unroll
            for (int m = 0; m < 4; ++m)
#pragma unroll
                for (int bj = 0; bj < 2; ++bj) { float f0[8], f1[8]; unpack8(g[4 * m + bj], f0); unpack8(g[4 * m + 2 + bj], f1);
#pragma unroll
                    for (int n = 0; n < 2; ++n)
#pragma unroll
                        for (int j = 0; j < 4; ++j) { const int q = 4 * n + j; acc[ai][bj][m][n][j] *= (1.0f + __expf(-f1[q])) * __builtin_amdgcn_rcpf(1.0f + __expf(-f0[q])); } } }
    }
    __device__ __forceinline__ void operator()(const f32x4 (&acc)[2][2][4][2], const pg8::Unit& u, int wr, int wc, int fr, int fq) const {
        const int row0 = u.pm * 256 + wr * 64 + fr, col0 = u.pn * 256 + wc * 32 + 8 * fq;
        const unsigned voff = (unsigned)(fr * (ldg * 2) + (wc * 32 + 8 * fq) * 2);
        const char* base = (const char*)GL + ((size_t)(u.pm * 256 + wr * 64) * ldg + 3 * 4096 + u.pn * 256) * 2;
#pragma unroll
        for (int ai = 0; ai < 2; ++ai) { u32x4 g[8];
#pragma unroll
            for (int m = 0; m < 4; ++m) gl2_issue(g[2 * m], g[2 * m + 1], base + (size_t)(ai * 128 + m * 16) * (ldg * 2), voff);
            GL_WAIT8(g);
#pragma unroll
            for (int m = 0; m < 4; ++m) { const int row = row0 + ai * 128 + m * 16;
#pragma unroll
                for (int bj = 0; bj < 2; ++bj) { float f[8]; unpack8(g[2 * m + bj], f);
                    const f32x4 v0 = acc[ai][bj][m][0], v1 = acc[ai][bj][m][1];
                    u32x4 w; w.x = cvt_pk_bf16(v0[0] * sigm(f[0]), v0[1] * sigm(f[1])); w.y = cvt_pk_bf16(v0[2] * sigm(f[2]), v0[3] * sigm(f[3]));
                    w.z = cvt_pk_bf16(v1[0] * sigm(f[4]), v1[1] * sigm(f[5])); w.w = cvt_pk_bf16(v1[2] * sigm(f[6]), v1[3] * sigm(f[7]));
                    *(u32x4*)(O + (size_t)row * 4096 + col0 + bj * 128) = w; } } }
    }
};
struct EpiOut {
    static constexpr bool PERM = false, HOOK = false;
    const float* XI; float* XO;
    __device__ __forceinline__ void operator()(const f32x4 (&acc)[2][2][4][2], const pg8::Unit& u, int wr, int wc, int fr, int fq) const {
        const int row0 = u.pm * 256 + wr * 64 + fr, col0 = u.pn * 256 + wc * 32 + 4 * fq;
        const unsigned voff = (unsigned)(fr * 16384 + (wc * 32 + 4 * fq) * 4);
        const char* base = (const char*)XI + ((size_t)(u.pm * 256 + wr * 64) * 4096 + u.pn * 256) * 4;
#pragma unroll
        for (int ai = 0; ai < 2; ++ai) { u32x4 g[16];
#pragma unroll
            for (int m = 0; m < 4; ++m) gl4f_issue(g[4 * m], g[4 * m + 1], g[4 * m + 2], g[4 * m + 3], base + (size_t)(ai * 128 + m * 16) * 16384, voff);
            GL_WAIT16(g);
#pragma unroll
            for (int m = 0; m < 4; ++m) { const size_t off = (size_t)(row0 + ai * 128 + m * 16) * 4096 + col0;
#pragma unroll
                for (int bj = 0; bj < 2; ++bj)
#pragma unroll
                    for (int n = 0; n < 2; ++n) { const f32x4 xi = __builtin_bit_cast(f32x4, g[4 * m + 2 * bj + n]); *(f32x4*)(XO + off + bj * 128 + n * 16) = xi + acc[ai][bj][m][n]; } } }
    }
};

struct Frame { LAS unsigned char* lds; int tid, lane, wave, bid, nblk; };
__device__ __forceinline__ Frame reframe(const Frame& G) { Frame F; F.lds = G.lds; F.wave = opaque_s(G.wave); F.lane = lane_id(); F.tid = F.wave * 64 + F.lane; F.bid = opaque_s(G.bid); F.nblk = opaque_s(G.nblk); return F; }

#define TR_PIN16(a, o) asm volatile("" : "+v"(a[o]), "+v"(a[o + 1]), "+v"(a[o + 2]), "+v"(a[o + 3]), "+v"(a[o + 4]), "+v"(a[o + 5]), "+v"(a[o + 6]), "+v"(a[o + 7]), "+v"(a[o + 8]), "+v"(a[o + 9]), "+v"(a[o + 10]), "+v"(a[o + 11]), "+v"(a[o + 12]), "+v"(a[o + 13]), "+v"(a[o + 14]), "+v"(a[o + 15]) :: "memory")
__device__ __forceinline__ void tr_load(float (&tv)[32], const float* W, size_t ldw, int k0, int n0, int lane) {
#pragma unroll
    for (int i = 0; i < 32; ++i) tv[i] = W[(size_t)(k0 + 2 * i + (lane >> 5)) * ldw + n0 + (lane & 31)];
}
__device__ __forceinline__ void tr_item(const float (&tv)[32], bf16* WT, size_t ldt, LAS float* scr, int k0, int n0, int lane) {
#pragma unroll
    for (int i = 0; i < 32; ++i) scr[(2 * i + (lane >> 5)) * 33 + (lane & 31)] = tv[i];
    LDS_WAIT(); asm volatile("" ::: "memory");
    const int c = lane & 7;
#pragma unroll
    for (int j = 0; j < 4; ++j) { const int n = (lane >> 3) + 8 * j; const LAS float* s = scr + (8 * c) * 33 + n;
        u32x4 o; o.x = pk2(s[0 * 33], s[1 * 33]); o.y = pk2(s[2 * 33], s[3 * 33]); o.z = pk2(s[4 * 33], s[5 * 33]); o.w = pk2(s[6 * 33], s[7 * 33]);
        *(u32x4*)(WT + (size_t)(n0 + n) * ldt + k0 + 8 * c) = o; }
    LDS_WAIT(); asm volatile("" ::: "memory");
}
__device__ __forceinline__ void tr_job(const Frame& F, const float* W, size_t ldw, int K, int ncols, bf16* WT, size_t ldt) {
    LAS float* scr = (LAS float*)(F.lds + F.wave * 16384);
    const int gw = F.bid * NWAVES + F.wave, NGW = F.nblk * NWAVES, nb = ncols / 32, items = (K / 64) * nb;
    for (int it = gw; it < items; it += 2 * NGW) { float tv[32], tn[32]; const int nx = it + NGW, nc = nx < items ? nx : it;
        tr_load(tv, W, ldw, 64 * (it / nb), 32 * (it % nb), F.lane); tr_load(tn, W, ldw, 64 * (nc / nb), 32 * (nc % nb), F.lane);
        TR_PIN16(tv, 0); TR_PIN16(tv, 16);
        tr_item(tv, WT, ldt, scr, 64 * (it / nb), 32 * (it % nb), F.lane);
        if (nx < items) tr_item(tn, WT, ldt, scr, 64 * (nx / nb), 32 * (nx % nb), F.lane); }
}
__device__ __forceinline__ void tr8_item(const float (&tv)[32], signed char* WT, const float inv, LAS float* scr, int k0, int n0, int lane) {
#pragma unroll
    for (int i = 0; i < 32; ++i) scr[(2 * i + (lane >> 5)) * 33 + (lane & 31)] = tv[i];
    LDS_WAIT(); asm volatile("" ::: "memory");
    const int n = lane >> 1, hh = lane & 1;
#pragma unroll
    for (int c = 0; c < 2; ++c) { const LAS float* sp = scr + (32 * hh + 16 * c) * 33 + n; unsigned wq[4];
#pragma unroll
        for (int q = 0; q < 4; ++q) { const int a0 = (int)rintf(sp[(4 * q) * 33] * inv), a1 = (int)rintf(sp[(4 * q + 1) * 33] * inv), a2 = (int)rintf(sp[(4 * q + 2) * 33] * inv), a3 = (int)rintf(sp[(4 * q + 3) * 33] * inv);
            wq[q] = (unsigned)(a0 & 255) | ((unsigned)(a1 & 255) << 8) | ((unsigned)(a2 & 255) << 16) | ((unsigned)(a3 & 255) << 24); }
        *(u32x4*)(WT + (size_t)(n0 + n) * 4096 + k0 + 32 * hh + 16 * c) = (u32x4){wq[0], wq[1], wq[2], wq[3]}; }
    LDS_WAIT(); asm volatile("" ::: "memory");
}
__device__ __forceinline__ void gate8_strips(const Frame& F, const float* win, signed char* WT, unsigned* cmaxl, const int first, const int stride) {
    LAS float* scr = (LAS float*)(F.lds + F.wave * 16384); LAS float* cm = (LAS float*)(F.lds + 8 * 16384);
    const int lane = F.lane, w = F.wave, c8 = lane & 7, rsub = lane >> 3;
    for (int strip = first; strip < N8 / 32; strip += stride) { const int n0 = strip * 32; const float* W = win + (n0 < 2048 ? 16576 + n0 : 21704 + (n0 - 2048));
        { const float* wp = W + (size_t)(512 * w + rsub) * CIN + 4 * c8; f32x4 m = (f32x4){0.f, 0.f, 0.f, 0.f};
          for (int i0 = 0; i0 < 64; i0 += 16) { f32x4 tv[16];
#pragma unroll
              for (int i = 0; i < 16; ++i) tv[i] = *(const f32x4*)(wp + (size_t)(8 * (i0 + i)) * CIN);
              asm volatile("" : "+v"(tv[0]), "+v"(tv[1]), "+v"(tv[2]), "+v"(tv[3]), "+v"(tv[4]), "+v"(tv[5]), "+v"(tv[6]), "+v"(tv[7]), "+v"(tv[8]), "+v"(tv[9]), "+v"(tv[10]), "+v"(tv[11]), "+v"(tv[12]), "+v"(tv[13]), "+v"(tv[14]), "+v"(tv[15]) :: "memory");
#pragma unroll
              for (int i = 0; i < 16; ++i) { m.x = fmaxf(m.x, fabsf(tv[i].x)); m.y = fmaxf(m.y, fabsf(tv[i].y)); m.z = fmaxf(m.z, fabsf(tv[i].z)); m.w = fmaxf(m.w, fabsf(tv[i].w)); } }
#pragma unroll
          for (int q = 0; q < 4; ++q) { float v = m[q]; v = fmaxf(v, __shfl_xor(v, 8)); v = fmaxf(v, __shfl_xor(v, 16)); v = fmaxf(v, __shfl_xor(v, 32)); m[q] = v; }
          __syncthreads();
          if (lane < 8) { cm[w * 32 + 4 * c8] = m.x; cm[w * 32 + 4 * c8 + 1] = m.y; cm[w * 32 + 4 * c8 + 2] = m.z; cm[w * 32 + 4 * c8 + 3] = m.w; } }
        __syncthreads();
        float am = 0.f;
#pragma unroll
        for (int w2 = 0; w2 < 8; ++w2) am = fmaxf(am, cm[w2 * 32 + (lane >> 1)]);
        if (w == 0 && (lane & 1) == 0) cmaxl[n0 + (lane >> 1)] = __float_as_uint(am);
        const float inv = am > 0.f ? 127.0f / am : 0.f;
        for (int kb = 0; kb < 8; kb += 2) { const int k0 = 512 * w + 64 * kb; float tv[32], tn[32];
            tr_load(tv, W, CIN, k0, 0, lane); tr_load(tn, W, CIN, k0 + 64, 0, lane);
            TR_PIN16(tv, 0); TR_PIN16(tv, 16);
            tr8_item(tv, WT, inv, scr, k0, n0, lane); tr8_item(tn, WT, inv, scr, k0 + 64, n0, lane); }
    }
}
__device__ __forceinline__ void rms_row_bf16(const float* x, const float* g, bf16* o, int lane, signed char* q8 = nullptr, float* qs = nullptr) {
    const f32x4* xr = (const f32x4*)x + lane; const f32x4* gr = (const f32x4*)g + lane; f32x4 v[16], gv[16]; float ss = 0.f;
#pragma unroll
    for (int j = 0; j < 16; ++j) v[j] = xr[64 * j];
#pragma unroll
    for (int j = 0; j < 16; ++j) gv[j] = gr[64 * j];
    asm volatile("" ::: "memory");
#pragma unroll
    for (int j = 0; j < 16; ++j) ss += (v[j].x * v[j].x + v[j].y * v[j].y) + (v[j].z * v[j].z + v[j].w * v[j].w);
    const float r = rsqrtf(wave_sum(ss) * (1.0f / 4096.0f) + 1e-6f);
    u32x2* o8 = (u32x2*)o + lane; float am = 0.f;
#pragma unroll
    for (int j = 0; j < 16; ++j) { const f32x4 gg = gv[j]; v[j] = (f32x4){v[j].x * r * gg.x, v[j].y * r * gg.y, v[j].z * r * gg.z, v[j].w * r * gg.w};
        u32x2 w; w.x = pk2(v[j].x, v[j].y); w.y = pk2(v[j].z, v[j].w); o8[64 * j] = w;
        am = fmaxf(fmaxf(am, fmaxf(fabsf(v[j].x), fabsf(v[j].y))), fmaxf(fabsf(v[j].z), fabsf(v[j].w))); }
    if (q8 != nullptr) {
        am = row16_max(am); am = fmaxf(am, __shfl_xor(am, 16)); am = fmaxf(am, __shfl_xor(am, 32));
        const float inv = am > 0.f ? 127.0f / am : 0.f; unsigned* q4 = (unsigned*)q8 + lane;
#pragma unroll
        for (int j = 0; j < 16; ++j) { const int a0 = (int)rintf(v[j].x * inv), a1 = (int)rintf(v[j].y * inv), a2 = (int)rintf(v[j].z * inv), a3 = (int)rintf(v[j].w * inv);
            q4[64 * j] = (unsigned)(a0 & 255) | ((unsigned)(a1 & 255) << 8) | ((unsigned)(a2 & 255) << 16) | ((unsigned)(a3 & 255) << 24); }
        if (lane == 0) *qs = am * (1.0f / 127.0f); }
}
__device__ __forceinline__ void rms_row_f32(const float* x, const float* g, float* o, int lane) {
    const f32x4* xr = (const f32x4*)x + lane; const f32x4* gr = (const f32x4*)g + lane; f32x4 v[16], gv[16]; float ss = 0.f;
#pragma unroll
    for (int j = 0; j < 16; ++j) v[j] = xr[64 * j];
#pragma unroll
    for (int j = 0; j < 16; ++j) gv[j] = gr[64 * j];
    asm volatile("" ::: "memory");
#pragma unroll
    for (int j = 0; j < 16; ++j) ss += (v[j].x * v[j].x + v[j].y * v[j].y) + (v[j].z * v[j].z + v[j].w * v[j].w);
    const float r = rsqrtf(wave_sum(ss) * (1.0f / 4096.0f) + 1e-6f);
    f32x4* o4 = (f32x4*)o + lane;
#pragma unroll
    for (int j = 0; j < 16; ++j) { const f32x4 gg = gv[j]; o4[64 * j] = (f32x4){v[j].x * r * gg.x, v[j].y * r * gg.y, v[j].z * r * gg.z, v[j].w * r * gg.w}; }
}

__device__ __forceinline__ void phase_convert_layer(const Frame& F0, int l, const int parts, const int vb, const int nvb) {
    Frame F = reframe(F0); F.bid = vb; F.nblk = nvb;
    unsigned char* wl = KWS() + WS_W + (size_t)l * SZ_WLAYER;
    bf16* WIN = (bf16*)(wl + WO_WIN); bf16* WCAT = (bf16*)(wl + WO_WCAT); bf16* WOUT = (bf16*)(wl + WO_WOUT); bf16* WKV = (bf16*)(wl + WO_WKV); bf16* WG = (bf16*)(wl + WO_WG); bf16* WL = (bf16*)(wl + WO_WL);
    const float* win = KIN(I_WIN) + (size_t)l * 4096 * CIN;
    if (parts & 2) {
    tr_job(F, win + 0, CIN, 4096, 4096, WIN + (size_t)0 * 4096, 4096);
    tr_job(F, win + 4096, CIN, 4096, 6144, WIN + (size_t)PC_BR * 4096, 4096);
    tr_job(F, win + 10240, CIN, 4096, 96, WIN + (size_t)PC_BWD * 4096, 4096);
    tr_job(F, win + 10336, CIN, 4096, 96, WIN + (size_t)PC_BAD * 4096, 4096);
    tr_job(F, win + 10432, CIN, 4096, 2048, WIN + (size_t)PC_BG * 4096, 4096);
    tr_job(F, win + 12480, CIN, 4096, 4096, WIN + (size_t)PC_CQK * 4096, 4096);
    tr_job(F, win + 18624, CIN, 4096, 2048, WIN + (size_t)PC_CG * 4096, 4096);
    tr_job(F, win + 20680, CIN, 4096, 1024, WIN + (size_t)PC_XQ * 4096, 4096);
    gate8_strips(F, win, (signed char*)(WIN + (size_t)PC_I8 * 4096), (unsigned*)(KWS() + WS_CTL) + CW_CMAX + l * N8, F.bid, F.nblk);
    }
    if (parts & 4) {
    tr_job(F, KIN(I_WBA) + (size_t)l * 2048 * 4096, 4096, 2048, 4096, WCAT + YC_A, KCAT);
    tr_job(F, KIN(I_WBB) + (size_t)l * 2048 * 4096, 4096, 2048, 4096, WCAT + YC_B, KCAT);
    tr_job(F, KIN(I_WBC) + (size_t)l * 2048 * 4096, 4096, 2048, 4096, WCAT + YC_C, KCAT);
    tr_job(F, KIN(I_WBX) + (size_t)l * 512 * 4096, 4096, 512, 4096, WCAT + YC_X, KCAT);
    tr_job(F, KIN(I_WOUT) + (size_t)l * 4096 * 4096, 4096, 4096, 4096, WOUT, 4096);
    }
    if (parts & 1) tr_job(F, KIN(I_WKV) + (size_t)l * 4096 * 1024, 1024, 4096, 1024, WKV, 4096);
    if (parts & 2) {
    const size_t gt = (size_t)F.bid * NTHREADS + F.tid, NGT = (size_t)F.nblk * NTHREADS;
    for (size_t i = gt; i < (size_t)8 * 4096; i += NGT) { const int j = (int)(i >> 12), k = (int)(i & 4095); WIN[(size_t)(PC_IF + j) * 4096 + k] = (bf16)f2bf(win[(size_t)k * CIN + 20672 + j]); }
    for (size_t i = gt; i < (size_t)(32 + 32 + 248) * 4096; i += NGT) { const int r = (int)(i >> 12), k = (int)(i & 4095);
        const int row = r < 32 ? PC_BWD + 96 + r : (r < 64 ? PC_BAD + 96 + (r - 32) : PC_IF + 8 + (r - 64)); WIN[(size_t)row * 4096 + k] = 0; }
    const float* wa = KIN(I_LRU_WA) + (size_t)l * 8 * 256 * 256; const float* wx = KIN(I_LRU_WX) + (size_t)l * 8 * 256 * 256;
    for (size_t c = gt; c < (size_t)4096 * 32; c += NGT) { const int n = (int)(c >> 5), k0 = (int)(c & 31) * 8, pn = n >> 8, dd = n & 255, nb = pn >> 1, d = (pn & 1) * 128 + (dd & 127);
        const float* sp = (dd < 128 ? wa : wx) + ((size_t)nb * 256 + k0) * 256 + d; float v[8];
#pragma unroll
        for (int q = 0; q < 8; ++q) v[q] = sp[(size_t)q * 256];
        asm volatile("" : "+v"(v[0]), "+v"(v[1]), "+v"(v[2]), "+v"(v[3]), "+v"(v[4]), "+v"(v[5]), "+v"(v[6]), "+v"(v[7]) :: "memory");
        u32x4 o; o.x = pk2(v[0], v[1]); o.y = pk2(v[2], v[3]); o.z = pk2(v[4], v[5]); o.w = pk2(v[6], v[7]); *(u32x4*)(WG + (size_t)n * 256 + k0) = o; }
    const float* wup = KIN(I_WUP) + (size_t)l * 96 * 2048; const float* aup = KIN(I_AUP) + (size_t)l * 96 * 2048;
    for (size_t c = gt; c < (size_t)4096 * 32; c += NGT) { const int n = (int)(c >> 5), k0 = (int)(c & 31) * 8, pn = n >> 8, dd = n & 255, ch = pn * 128 + (dd & 127);
        const float* sp = nullptr; if (dd < 128) { if (k0 < 96) sp = wup + (size_t)k0 * 2048 + ch; } else { if (k0 >= 128 && k0 < 224) sp = aup + (size_t)(k0 - 128) * 2048 + ch; }
        u32x4 o = (u32x4){0u, 0u, 0u, 0u};
        if (sp != nullptr) { float v[8];
#pragma unroll
            for (int q = 0; q < 8; ++q) v[q] = sp[(size_t)q * 2048];
            asm volatile("" : "+v"(v[0]), "+v"(v[1]), "+v"(v[2]), "+v"(v[3]), "+v"(v[4]), "+v"(v[5]), "+v"(v[6]), "+v"(v[7]) :: "memory");
            o.x = pk2(v[0], v[1]); o.y = pk2(v[2], v[3]); o.z = pk2(v[4], v[5]); o.w = pk2(v[6], v[7]); }
        *(u32x4*)(WL + (size_t)n * 256 + k0) = o; }
    }
    if (parts & 1) {
    const int gw = F.bid * NWAVES + F.wave, NGW = F.nblk * NWAVES;
    bf16* MEMN = (bf16*)(KWS() + WS_MEMN) + (size_t)l * MM * 4096;
    for (int r = gw; r < MM; r += NGW) rms_row_bf16(KIN(I_MEM) + (size_t)r * 4096, KIN(I_MEMNORM_G) + (size_t)l * 4096, MEMN + (size_t)r * 4096, F.lane);
    }
}
__device__ __forceinline__ void phase_norm(const Frame& F0, const float* X, const float* g, bool final_out) {
    const Frame F = reframe(F0);
    const int gw = F.bid * NWAVES + F.wave, NGW = F.nblk * NWAVES;
    bf16* H = (bf16*)(KWS() + WS_H);
    for (int r = gw; r < M; r += NGW) { if (final_out) rms_row_f32(X + (size_t)r * 4096, g, KOUT() + (size_t)r * 4096, F.lane); else rms_row_bf16(X + (size_t)r * 4096, g, H + (size_t)r * 4096, F.lane, (signed char*)(KWS() + WS_H8) + (size_t)r * 4096, (float*)(KWS() + WS_HS) + r); }
}

__device__ __forceinline__ float logsigf_(float x) { return fminf(x, 0.f) - log1pf(__expf(-fabsf(x))); }
__device__ __forceinline__ void phase_prep(const Frame& F0, int l) {
    const Frame F = reframe(F0);
    const bf16* __restrict__ PROJ = (const bf16*)(KWS() + WS_PROJ);
    const size_t gt = (size_t)F.bid * NTHREADS + F.tid, NGT = (size_t)F.nblk * NTHREADS;
    bf16* __restrict__ U = (bf16*)(KWS() + WS_U); bf16* __restrict__ QC = (bf16*)(KWS() + WS_QC); bf16* __restrict__ KC = (bf16*)(KWS() + WS_KC);
    for (size_t id = gt; id < (size_t)2 * 256 * (M / 32); id += NGT) {
        const int which = (int)(id / ((size_t)256 * (M / 32))), rem = (int)(id % ((size_t)256 * (M / 32))), c8 = (rem & 255) * 8, t0 = (rem >> 8) * 32, ts0 = t0 & (SEQ - 1);
        const float* cw = (which == 0 ? KIN(I_LRU_CW) : KIN(I_MCW)) + (size_t)l * 4 * 2048 + c8; const float* cb = (which == 0 ? KIN(I_LRU_CB) : KIN(I_MCB)) + (size_t)l * 2048 + c8;
        const bf16* src = PROJ + (size_t)t0 * NPJ + (which == 0 ? PC_AX : PC_CQK) + c8;
        f32x4 wv[4][2];
#pragma unroll
        for (int j = 0; j < 4; ++j) { wv[j][0] = *(const f32x4*)(cw + j * 2048); wv[j][1] = *(const f32x4*)(cw + j * 2048 + 4); }
        const f32x4 b0 = *(const f32x4*)cb, b1 = *(const f32x4*)(cb + 4);
        u32x4 hw[3];
#pragma unroll
        for (int j = 0; j < 3; ++j) hw[j] = ts0 > 0 ? *(const u32x4*)(src - (size_t)(3 - j) * NPJ) : (u32x4){0u, 0u, 0u, 0u};
        float w0[8], w1[8], w2[8]; unpack8(hw[0], w0); unpack8(hw[1], w1); unpack8(hw[2], w2);
        const float sc = c8 < 1024 ? 1.0f : 0.0625f;
        for (int g = 0; g < 32; g += 8) { u32x4 x[8];
#pragma unroll
            for (int u = 0; u < 8; ++u) x[u] = *(const u32x4*)(src + (size_t)(g + u) * NPJ);
#pragma unroll
            for (int u = 0; u < 8; ++u) { float w3[8], a[8]; unpack8(x[u], w3);
#pragma unroll
                for (int q = 0; q < 8; ++q) a[q] = (q < 4 ? b0[q] : b1[q - 4]) + wv[0][q >> 2][q & 3] * w0[q] + wv[1][q >> 2][q & 3] * w1[q] + wv[2][q >> 2][q & 3] * w2[q] + wv[3][q >> 2][q & 3] * w3[q];
#pragma unroll
                for (int q = 0; q < 8; ++q) { w0[q] = w1[q]; w1[q] = w2[q]; w2[q] = w3[q]; }
                const size_t t = (size_t)t0 + g + u;
                if (which == 0) { u32x4 o; o.x = pk2(a[0], a[1]); o.y = pk2(a[2], a[3]); o.z = pk2(a[4], a[5]); o.w = pk2(a[6], a[7]); *(u32x4*)(U + t * 2048 + c8) = o; }
                else {
#pragma unroll
                    for (int q = 0; q < 8; ++q) a[q] = siluf_(a[q]) * sc;
                    u32x4 o; o.x = pk2(a[0], a[1]); o.y = pk2(a[2], a[3]); o.z = pk2(a[4], a[5]); o.w = pk2(a[6], a[7]);
                    if (c8 < 1024) *(u32x4*)(QC + t * 1024 + c8) = o; else *(u32x4*)(KC + t * 1024 + (c8 - 1024)) = o; } } }
    }
    bf16* LORA = (bf16*)(KWS() + WS_LORA); const float* mu = KIN(I_MU) + (size_t)l * 6336;
    for (size_t i = gt; i < (size_t)M * 32; i += NGT) { const int t = (int)(i >> 5), c8 = (int)(i & 31) * 8, ts = t & (SEQ - 1), seg = c8 >> 7, i0 = c8 & 127;
        u32x4 o = (u32x4){0u, 0u, 0u, 0u};
        if (i0 < 96) { const int pc = (seg == 0 ? PC_BWD : PC_BAD) + i0; const float* m8 = mu + 6144 + seg * 96 + i0;
            const u32x4 w = *(const u32x4*)(PROJ + (size_t)t * NPJ + pc); const u32x4 w2 = *(const u32x4*)(PROJ + (size_t)(ts > 0 ? t - 1 : t) * NPJ + pc);
            const f32x4 ma = *(const f32x4*)m8, mb = *(const f32x4*)(m8 + 4);
            float p[8], pv[8]; unpack8(w, p); unpack8(w2, pv);
            if (ts == 0) {
#pragma unroll
                for (int q = 0; q < 8; ++q) pv[q] = 0.f; }
            float r[8];
#pragma unroll
            for (int q = 0; q < 8; ++q) { const float s = p[q] + (pv[q] - p[q]) * (q < 4 ? ma[q] : mb[q - 4]); r[q] = seg == 0 ? tanhf(s) : s; }
            o.x = pk2(r[0], r[1]); o.y = pk2(r[2], r[3]); o.z = pk2(r[4], r[5]); o.w = pk2(r[6], r[7]); }
        *(u32x4*)(LORA + (size_t)t * 256 + c8) = o; }
    if (F.bid < 8) {
        const float* IFB = (const float*)(KWS() + WS_IFB); float* G = (float*)(KWS() + WS_SCAL); float* MX = G + (size_t)M * 4; float* MT = MX + (size_t)M * 4;
        const int b = F.bid >> 2, hd = F.bid & 3, lane = F.lane; const float bi = KIN(I_MBI)[l * 4 + hd], bfv = KIN(I_MBF)[l * 4 + hd];
        const size_t tok0 = (size_t)b * SEQ + (size_t)F.tid * 8; LAS float* sc = (LAS float*)F.lds;
        float lf[8], li[8];
#pragma unroll
        for (int j = 0; j < 8; ++j) { lf[j] = IFB[(tok0 + j) * 8 + 4 + hd]; li[j] = IFB[(tok0 + j) * 8 + hd]; }
        asm volatile("" ::: "memory");
#pragma unroll
        for (int j = 0; j < 8; ++j) { lf[j] = logsigf_(lf[j] + bfv); li[j] += bi; }
#pragma unroll
        for (int j = 1; j < 8; ++j) lf[j] += lf[j - 1];
        float incl = lf[7];
#pragma unroll
        for (int o = 1; o < 64; o <<= 1) { const float t = __shfl_up(incl, o); if (lane >= o) incl += t; }
        if (lane == 63) sc[F.wave] = incl;
        __syncthreads();
        float woff = 0.f;
        for (int w2 = 0; w2 < F.wave; ++w2) woff += sc[w2];
        const float excl = woff + incl - lf[7];
        float mx[8]; float run = -INFINITY;
#pragma unroll
        for (int j = 0; j < 8; ++j) { lf[j] += excl; li[j] -= lf[j]; run = fmaxf(run, li[j]); mx[j] = run; }
        float im = run;
#pragma unroll
        for (int o = 1; o < 64; o <<= 1) { const float t = __shfl_up(im, o); if (lane >= o) im = fmaxf(im, t); }
        if (lane == 63) sc[16 + F.wave] = im;
        float pm = __shfl_up(im, 1); if (lane == 0) pm = -INFINITY;
        __syncthreads();
        for (int w2 = 0; w2 < F.wave; ++w2) pm = fmaxf(pm, sc[16 + w2]);
#pragma unroll
        for (int j = 0; j < 8; ++j) { const float m = fmaxf(pm, mx[j]); G[(tok0 + j) * 4 + hd] = li[j]; MX[(tok0 + j) * 4 + hd] = m; MT[(tok0 + j) * 4 + hd] = lf[j] + m; }
        __syncthreads();
    }
}

__device__ __forceinline__ f32x4 ld_bf4(const bf16* p) { const u32x2 w = *(const u32x2*)p; return (f32x4){__uint_as_float(w.x << 16), __uint_as_float(w.x & 0xffff0000u), __uint_as_float(w.y << 16), __uint_as_float(w.y & 0xffff0000u)}; }
__device__ __forceinline__ f32x4 bf4_unpack(const u32x2 w) { return (f32x4){__uint_as_float(w.x << 16), __uint_as_float(w.x & 0xffff0000u), __uint_as_float(w.y << 16), __uint_as_float(w.y & 0xffff0000u)}; }
struct VecIn { u32x2 r, k, v, r1, k1, v1; f32x4 a; };
__device__ __forceinline__ void phase_rwkv_vec(const Frame& F0, int l) {
    const Frame F = reframe(F0);
    const bf16* __restrict__ PROJ = (const bf16*)(KWS() + WS_PROJ); const float* __restrict__ AA = (const float*)(KWS() + WS_AA);
    float* __restrict__ RV = (float*)(KWS() + WS_RV); float* __restrict__ VV = (float*)(KWS() + WS_VV); float* __restrict__ BON = (float*)(KWS() + WS_BON);
    const float* mu = KIN(I_MU) + (size_t)l * 6336; const float* kkw = KIN(I_KK) + (size_t)l * 2048; const float* kaw = KIN(I_KA) + (size_t)l * 2048; const float* rkw = KIN(I_RK) + (size_t)l * 2048;
    const int gw = F.bid * NWAVES + F.wave, NGW = F.nblk * NWAVES, lane = F.lane;
    const int hq = gw & 7, ch = hq * 256 + lane * 4, h = hq * 4 + (lane >> 4);
    const f32x4 mr = *(const f32x4*)(mu + ch), mk = *(const f32x4*)(mu + 2048 + ch), mv = *(const f32x4*)(mu + 4096 + ch), ckk = *(const f32x4*)(kkw + ch), cka = *(const f32x4*)(kaw + ch), crk = *(const f32x4*)(rkw + ch);
    auto vload = [&](const int it, VecIn& x) { const int t = it >> 3, ts = t & (SEQ - 1);
        const bf16* pr = PROJ + (size_t)t * NPJ + ch; const bf16* pp = ts > 0 ? pr - NPJ : pr;
        x.r = *(const u32x2*)(pr + PC_BR); x.k = *(const u32x2*)(pr + PC_BK); x.v = *(const u32x2*)(pr + PC_BV);
        x.r1 = *(const u32x2*)(pp + PC_BR); x.k1 = *(const u32x2*)(pp + PC_BK); x.v1 = *(const u32x2*)(pp + PC_BV);
        x.a = *(const f32x4*)(AA + (size_t)t * 2048 + ch); };
    auto vcomp = [&](const int it, const VecIn& x) { const int t = it >> 3, ts = t & (SEQ - 1), b = t >> 12;
        f32x4 r = bf4_unpack(x.r), k = bf4_unpack(x.k), v = bf4_unpack(x.v);
        const f32x4 z = (f32x4){0.f, 0.f, 0.f, 0.f}; const f32x4 r1 = ts > 0 ? bf4_unpack(x.r1) : z, k1 = ts > 0 ? bf4_unpack(x.k1) : z, v1 = ts > 0 ? bf4_unpack(x.v1) : z;
        r += (r1 - r) * mr; k += (k1 - k) * mk; v += (v1 - v) * mv;
        const f32x4 a = x.a;
        const f32x4 kku = k * ckk;
        const float n2 = row16_sum((kku.x * kku.x + kku.y * kku.y) + (kku.z * kku.z + kku.w * kku.w));
        const float inv = __builtin_amdgcn_rcpf(fmaxf(sqrtf(n2), 1e-12f)); const f32x4 kk = kku * inv;
        const f32x4 kmod = k * ((a - 1.0f) * cka + 1.0f);
        const f32x4 rkk = r * kmod * crk;
        const float bon = row16_sum((rkk.x + rkk.y) + (rkk.z + rkk.w));
        float* rv = RV + (((size_t)(b * 32 + h) * SEQ + ts) * 5) * 64 + (lane & 15) * 4;
        *(f32x4*)rv = kk; *(f32x4*)(rv + 128) = -(kk * a); *(f32x4*)(rv + 192) = kmod; *(f32x4*)(rv + 256) = r;
        *(f32x4*)(VV + (size_t)t * 2048 + ch) = v; if ((lane & 15) == 0) BON[(size_t)t * 32 + h] = bon; };
    int it = gw;
    for (; it + 3 * NGW < M * 8; it += 4 * NGW) { VecIn x0, x1, x2, x3; vload(it, x0); vload(it + NGW, x1); vload(it + 2 * NGW, x2); vload(it + 3 * NGW, x3);
        vcomp(it, x0); vcomp(it + NGW, x1); vcomp(it + 2 * NGW, x2); vcomp(it + 3 * NGW, x3); }
    for (; it < M * 8; it += NGW) { VecIn x0; vload(it, x0); vcomp(it, x0); }
}

#define SC_PIN(a) asm volatile("" : "+v"(a[0]), "+v"(a[1]), "+v"(a[2]), "+v"(a[3]), "+v"(a[4]), "+v"(a[5]), "+v"(a[6]), "+v"(a[7]), "+v"(a[8]), "+v"(a[9]), "+v"(a[10]), "+v"(a[11]), "+v"(a[12]), "+v"(a[13]), "+v"(a[14]), "+v"(a[15]) :: "memory")
__device__ __forceinline__ void phase_lru_scan1(const Frame& F0) {
    const Frame F = reframe(F0);
    const float* LA = (const float*)(KWS() + WS_LA); const float* LB = (const float*)(KWS() + WS_LB); float* CA = (float*)(KWS() + WS_CARRY); float* CH = CA + 2 * 32 * 2048;
    const size_t gt = (size_t)F.bid * NTHREADS + F.tid, NGT = (size_t)F.nblk * NTHREADS;
    for (size_t i = gt; i < (size_t)2 * 32 * 2048; i += NGT) { const int ch = (int)(i & 2047), chunk = (int)(i >> 11) & 31, b = (int)(i >> 16);
        const size_t base = ((size_t)b * SEQ + chunk * 128) * 2048 + ch; float A = 1.f, H = 0.f;
        for (int s0 = 0; s0 < 128; s0 += 16) { float la[16], lb[16];
#pragma unroll
            for (int u = 0; u < 16; ++u) { la[u] = LA[base + (size_t)(s0 + u) * 2048]; lb[u] = LB[base + (size_t)(s0 + u) * 2048]; }
            SC_PIN(la); SC_PIN(lb);
#pragma unroll
            for (int u = 0; u < 16; ++u) { H = la[u] * H + lb[u]; A *= la[u]; } }
        CA[i] = A; CH[i] = H; }
}
__device__ __forceinline__ void scan2_item(const Frame& F, const int vb) {
    const float* __restrict__ LA = (const float*)(KWS() + WS_LA); const float* __restrict__ LB = (const float*)(KWS() + WS_LB); const float* __restrict__ CA = (const float*)(KWS() + WS_CARRY); const float* __restrict__ CH = CA + 2 * 32 * 2048;
    const bf16* __restrict__ PROJ = (const bf16*)(KWS() + WS_PROJ); bf16* __restrict__ Y = (bf16*)(KWS() + WS_Y);
    { const size_t i = (size_t)vb * NTHREADS + F.tid; const int ch = (int)(i & 2047), chunk = (int)(i >> 11) & 31, b = (int)(i >> 16);
        float H = 0.f;
        for (int j0 = 0; j0 < chunk; j0 += 16) { float ca[16], chh[16];
#pragma unroll
            for (int u = 0; u < 16; ++u) { const int j = j0 + u < chunk ? j0 + u : chunk - 1; const size_t ci = ((size_t)b * 32 + j) * 2048 + ch; ca[u] = CA[ci]; chh[u] = CH[ci]; }
            SC_PIN(ca); SC_PIN(chh);
#pragma unroll
            for (int u = 0; u < 16; ++u) if (j0 + u < chunk) H = ca[u] * H + chh[u]; }
        const size_t row0 = (size_t)b * SEQ + chunk * 128;
        for (int s0 = 0; s0 < 128; s0 += 16) { float la[16], lb[16]; unsigned gg[16];
#pragma unroll
            for (int u = 0; u < 16; ++u) { const size_t row = row0 + s0 + u; la[u] = LA[row * 2048 + ch]; lb[u] = LB[row * 2048 + ch]; gg[u] = PROJ[row * NPJ + PC_AG + ch]; }
            SC_PIN(la); SC_PIN(lb); SC_PIN(gg);
#pragma unroll
            for (int u = 0; u < 16; ++u) { const size_t row = row0 + s0 + u; H = la[u] * H + lb[u]; Y[row * KCAT + YC_A + ch] = (bf16)f2bf(H * siluf_(bf2f((bf16)gg[u]))); } } }
}

constexpr int RW_CH = 32;
constexpr int RW_RVB = RW_CH * 1280, RW_VVB = RW_CH * 256;
struct RwVec { f32x4 kk, wv, nk, kv, rv; f32x2 vi; };
template <int S> __device__ __forceinline__ void rw_issue(RwVec& d, unsigned a, unsigned av) {
    asm volatile("ds_read_b128 %0, %6 offset:%8\n\tds_read_b128 %1, %6 offset:%9\n\tds_read_b128 %2, %6 offset:%10\n\tds_read_b128 %3, %6 offset:%11\n\tds_read_b128 %4, %6 offset:%12\n\tds_read_b64 %5, %7 offset:%13"
                 : "=&v"(d.kk), "=&v"(d.wv), "=&v"(d.nk), "=&v"(d.kv), "=&v"(d.rv), "=&v"(d.vi) : "v"(a), "v"(av), "n"(S * 1280), "n"(S * 1280 + 256), "n"(S * 1280 + 512), "n"(S * 1280 + 768), "n"(S * 1280 + 1024), "n"(S * 256) : "memory"); }
#define RW_OPS(d) "+v"(d.kk), "+v"(d.wv), "+v"(d.nk), "+v"(d.kv), "+v"(d.rv), "+v"(d.vi)
__device__ __forceinline__ void rw_wait6(RwVec& d) { asm volatile("s_waitcnt lgkmcnt(6)" : RW_OPS(d) :: "memory"); }
__device__ __forceinline__ void rw_wait0(RwVec& d) { asm volatile("s_waitcnt lgkmcnt(0)" : RW_OPS(d) :: "memory"); }
__device__ __forceinline__ void phase_rwkv_rec(const Frame& F0, const int first, const int stride) {
    const Frame F = reframe(F0);
    const char* RV = (const char*)(KWS() + WS_RV); const char* VV = (const char*)(KWS() + WS_VV); float* YR = (float*)(KWS() + WS_YR);
    LAS unsigned char* lds = F.lds;
    for (int item = first; item < 128; item += stride) {
        const int bh = item >> 1, hf = item & 1, b = bh >> 5, h = bh & 31, w = F.wave, lane = F.lane, cg = lane & 15, rl = lane >> 4;
        const int row = hf * 32 + (w & 3) * 8 + rl * 2;
        const char* rvg = RV + (size_t)bh * SEQ * 1280; const char* vvg = VV + ((size_t)b * SEQ * 2048 + h * 64) * 4;
        f32x2 Sa0 = (f32x2){0.f, 0.f}, Sa1 = Sa0, Sb0 = Sa0, Sb1 = Sa0;
#define RW_DMA(ck) do { const int _buf = (ck) & 1; _Pragma("unroll") for (int _p = 0; _p < 6; ++_p) { const int pc = w * 6 + _p; \
            if (pc < 40) __builtin_amdgcn_global_load_lds((const unsigned*)(rvg + (size_t)(ck) * RW_RVB + pc * 1024 + lane * 16), (LAS unsigned*)(lds + _buf * RW_RVB + pc * 1024), 16, 0, 0); \
            else { const int pv = pc - 40; __builtin_amdgcn_global_load_lds((const unsigned*)(vvg + ((size_t)((ck) * RW_CH + pv * 4 + (lane >> 4)) * 2048) * 4 + (lane & 15) * 16), (LAS unsigned*)(lds + 2 * RW_RVB + _buf * RW_VVB + pv * 1024), 16, 0, 0); } } } while (0)
        RW_DMA(0);
        VM_WAIT(); __syncthreads();
        for (int ck = 0; ck < SEQ / RW_CH; ++ck) {
            if (ck + 1 < SEQ / RW_CH) RW_DMA(ck + 1);
            if (w < 4) {
                const unsigned ra = (unsigned)(size_t)(lds + (ck & 1) * RW_RVB + cg * 16), va = (unsigned)(size_t)(lds + 2 * RW_RVB + (ck & 1) * RW_VVB + row * 4);
                float* yo = YR + ((size_t)b * SEQ + (size_t)ck * RW_CH + (cg & 3)) * 2048 + h * 64 + row;
                RwVec A_, B_;
                rw_issue<0>(A_, ra, va);
#define P2(v, hi) ((f32x2){(hi) ? v.z : v.x, (hi) ? v.w : v.y})
#define RW_STEP(CUR, NXT, s_) do { if ((s_) + 1 < RW_CH) { rw_issue<((s_) + 1) % RW_CH>(NXT, ra, va); rw_wait6(CUR); } else rw_wait0(CUR); \
                    const f32x2 via = (f32x2){CUR.vi.x, CUR.vi.x}, vib = (f32x2){CUR.vi.y, CUR.vi.y}; \
                    const f32x2 pa = Sa0 * P2(CUR.kk, 0) + Sa1 * P2(CUR.kk, 1), pb = Sb0 * P2(CUR.kk, 0) + Sb1 * P2(CUR.kk, 1); \
                    float sa = pa.x + pa.y, sb = pb.x + pb.y; \
                    sa += dpp_mov<0xB1>(sa); sb += dpp_mov<0xB1>(sb); sa += dpp_mov<0x4E>(sa); sb += dpp_mov<0x4E>(sb); sa += dpp_mov<0x141>(sa); sb += dpp_mov<0x141>(sb); sa += dpp_mov<0x140>(sa); sb += dpp_mov<0x140>(sb); \
                    const f32x2 sa2 = (f32x2){sa, sa}, sb2 = (f32x2){sb, sb}; \
                    Sa0 = sa2 * P2(CUR.nk, 0) + (via * P2(CUR.kv, 0) + Sa0 * P2(CUR.wv, 0)); Sa1 = sa2 * P2(CUR.nk, 1) + (via * P2(CUR.kv, 1) + Sa1 * P2(CUR.wv, 1)); \
                    Sb0 = sb2 * P2(CUR.nk, 0) + (vib * P2(CUR.kv, 0) + Sb0 * P2(CUR.wv, 0)); Sb1 = sb2 * P2(CUR.nk, 1) + (vib * P2(CUR.kv, 1) + Sb1 * P2(CUR.wv, 1)); \
                    const f32x2 qa = Sa0 * P2(CUR.rv, 0) + Sa1 * P2(CUR.rv, 1), qb = Sb0 * P2(CUR.rv, 0) + Sb1 * P2(CUR.rv, 1); \
                    ya[(s_) & 3] = qa.x + qa.y; yb[(s_) & 3] = qb.x + qb.y; } while (0)
#define RW_G4(g4) do { \
                    float ya[4], yb[4]; \
                    RW_STEP(A_, B_, g4 * 4 + 0); RW_STEP(B_, A_, g4 * 4 + 1); RW_STEP(A_, B_, g4 * 4 + 2); RW_STEP(B_, A_, g4 * 4 + 3); \
                      \
                    const bool o1 = cg & 1, o2 = cg & 2; \
                    const float uA = (o1 ? ya[1] : ya[0]) + dpp_mov<0xB1>(o1 ? ya[0] : ya[1]), uB = (o1 ? ya[3] : ya[2]) + dpp_mov<0xB1>(o1 ? ya[2] : ya[3]); \
                    const float wA = (o1 ? yb[1] : yb[0]) + dpp_mov<0xB1>(o1 ? yb[0] : yb[1]), wB = (o1 ? yb[3] : yb[2]) + dpp_mov<0xB1>(o1 ? yb[2] : yb[3]); \
                    float ysa = (o2 ? uB : uA) + dpp_mov<0x4E>(o2 ? uA : uB), ysb = (o2 ? wB : wA) + dpp_mov<0x4E>(o2 ? wA : wB); \
                    ysa += dpp_mov<0x114>(ysa); ysb += dpp_mov<0x114>(ysb); \
                    ysa += dpp_mov<0x118>(ysa); ysb += dpp_mov<0x118>(ysb); \
                    if (cg >= 12) *(f32x2*)(yo + (size_t)(g4) * 4 * 2048) = (f32x2){ysa, ysb}; } while (0)
                RW_G4(0); RW_G4(1); RW_G4(2); RW_G4(3); RW_G4(4); RW_G4(5); RW_G4(6); RW_G4(7);
                static_assert(RW_CH == 32, "eight groups of four steps");
#undef RW_G4
#undef RW_STEP
#undef P2
            }
            VM_WAIT(); __syncthreads();
        }
#undef RW_DMA
    }
}

__device__ __forceinline__ void phase_rwkv_post(const Frame& F0, int l) {
    const Frame F = reframe(F0);
    const float* __restrict__ YR = (const float*)(KWS() + WS_YR); const float* __restrict__ VV = (const float*)(KWS() + WS_VV); const float* __restrict__ BON = (const float*)(KWS() + WS_BON);
    const bf16* __restrict__ PROJ = (const bf16*)(KWS() + WS_PROJ); bf16* __restrict__ Y = (bf16*)(KWS() + WS_Y);
    const float* gw_ = KIN(I_GNW) + (size_t)l * 2048; const float* gb_ = KIN(I_GNB) + (size_t)l * 2048;
    const int gw = F.bid * NWAVES + F.wave, NGW = F.nblk * NWAVES, lane = F.lane;
    const int hq = gw & 7, ch = hq * 256 + lane * 4, h = hq * 4 + (lane >> 4);
    const f32x4 w4 = *(const f32x4*)(gw_ + ch), b4 = *(const f32x4*)(gb_ + ch);
    struct PostIn { f32x4 y, v; float bon; u32x2 g; };
    auto pload = [&](const int it, PostIn& x) { const int t = it >> 3; x.y = *(const f32x4*)(YR + (size_t)t * 2048 + ch); x.v = *(const f32x4*)(VV + (size_t)t * 2048 + ch); x.bon = BON[(size_t)t * 32 + h]; x.g = *(const u32x2*)(PROJ + (size_t)t * NPJ + PC_BG + ch); };
    auto pcomp = [&](const int it, const PostIn& x) { const int t = it >> 3; const f32x4 y = x.y, v = x.v, g = bf4_unpack(x.g); const float bon = x.bon;
        const float mean = row16_sum((y.x + y.y) + (y.z + y.w)) * (1.0f / 64.0f); const f32x4 d = y - mean;
        const float var = row16_sum((d.x * d.x + d.y * d.y) + (d.z * d.z + d.w * d.w)) * (1.0f / 64.0f); const float rs = rsqrtf(var + 64e-5f);
        const f32x4 o = (d * rs * w4 + b4 + v * bon);
        u32x2 pk; pk.x = pk2(o.x * siluf_(g.x), o.y * siluf_(g.y)); pk.y = pk2(o.z * siluf_(g.z), o.w * siluf_(g.w));
        *(u32x2*)(Y + (size_t)t * KCAT + YC_B + ch) = pk; };
    int it = gw;
    for (; it + 3 * NGW < M * 8; it += 4 * NGW) { PostIn x0, x1, x2, x3; pload(it, x0); pload(it + NGW, x1); pload(it + 2 * NGW, x2); pload(it + 3 * NGW, x3);
        pcomp(it, x0); pcomp(it + NGW, x1); pcomp(it + 2 * NGW, x2); pcomp(it + 3 * NGW, x3); }
    for (; it < M * 8; it += NGW) { PostIn x0; pload(it, x0); pcomp(it, x0); }
}
__device__ __forceinline__ void phase_mlstm_post(const Frame& F0, int l) {
    const Frame F = reframe(F0);
    const float* __restrict__ HC = (const float*)(KWS() + WS_HC); const bf16* __restrict__ PROJ = (const bf16*)(KWS() + WS_PROJ); bf16* __restrict__ Y = (bf16*)(KWS() + WS_Y);
    const float* gw_ = KIN(I_MGNW) + (size_t)l * 2048;
    const int gw = F.bid * NWAVES + F.wave, NGW = F.nblk * NWAVES, lane = F.lane;
#pragma unroll 2
    for (int it = gw; it < M * 4; it += NGW) { const int t = it >> 2, hd = it & 3, ch = hd * 512 + lane * 8;
        const f32x4 v0 = *(const f32x4*)(HC + (size_t)t * 2048 + ch), v1 = *(const f32x4*)(HC + (size_t)t * 2048 + ch + 4);
        float x[8] = {v0.x, v0.y, v0.z, v0.w, v1.x, v1.y, v1.z, v1.w}; float s = 0.f;
#pragma unroll
        for (int q = 0; q < 8; ++q) s += x[q];
        const float mean = wave_sum(s) * (1.0f / 512.0f); float s2 = 0.f;
#pragma unroll
        for (int q = 0; q < 8; ++q) { x[q] -= mean; s2 += x[q] * x[q]; }
        const float rstd = rsqrtf(wave_sum(s2) * (1.0f / 512.0f) + 1e-6f);
        const u32x4 gg = *(const u32x4*)(PROJ + (size_t)t * NPJ + PC_CG + ch); float gf[8]; unpack8(gg, gf); float o[8];
#pragma unroll
        for (int q = 0; q < 8; ++q) o[q] = x[q] * rstd * gw_[ch + q] * siluf_(gf[q]);
        u32x4 w; w.x = pk2(o[0], o[1]); w.y = pk2(o[2], o[3]); w.z = pk2(o[4], o[5]); w.w = pk2(o[6], o[7]);
        *(u32x4*)(Y + (size_t)t * KCAT + YC_C + ch) = w; }
}

__device__ __forceinline__ s16x4 tr16(const LAS unsigned char* p) { return __builtin_bit_cast(s16x4, __builtin_amdgcn_ds_read_tr16_b64_v4i16((LAS s16x4*)p)); }
constexpr int ML_SROW = 80;
constexpr int ML_K = 0, ML_V = 3 * 16384, ML_S = ML_V + 3 * 32768, ML_G = ML_S + 64 * ML_SROW, ML_DEN = ML_G + 1024, ML_END = ML_DEN + 512;
static_assert(ML_END <= RING_BYTES, "mLSTM LDS");
__device__ __forceinline__ void xattn_item(const Frame& F, int l, const int item);
__device__ __forceinline__ int ml_vswz(int row) { return ((row & 3) << 1) | (((row >> 3) & 1) << 3); }
__device__ __forceinline__ void phase_mlstm(const Frame& F0, int l, unsigned* queue, const int lim_lo = 0, const int lim_hi = 1 << 30) {
    const Frame F = reframe(F0);
    const bf16* PROJ = (const bf16*)(KWS() + WS_PROJ); const bf16* QC = (const bf16*)(KWS() + WS_QC); const bf16* KC = (const bf16*)(KWS() + WS_KC);
    const float* G = (const float*)(KWS() + WS_SCAL); const float* MX = G + (size_t)M * 4; const float* MT = MX + (size_t)M * 4; float* HC = (float*)(KWS() + WS_HC);
    LAS unsigned char* lds = F.lds; LAS float* denl = (LAS float*)(lds + ML_DEN);
    const int tid = F.tid, lane = F.lane, w = F.wave, l15 = lane & 15, lg = lane >> 4, rt = w >> 1, ctp = w & 1;
    volatile LAS unsigned* qslot = (volatile LAS unsigned*)(F.lds + MISC_OFF);
    const bool affine = (lim_lo == 0) && (lim_hi == (1 << 30)); bool ml_left = affine, cv_left = affine && CONV1_IN_QUEUE && (l == 0), cat_left = affine && CONV1_IN_QUEUE, flip = false;
    for (;;) {
        __syncthreads();
        if (tid == 0) { unsigned it = 0xffffffffu;
            if (cv_left && (flip || !ml_left)) { const unsigned t = __hip_atomic_fetch_add(queue + 16, 1u, __ATOMIC_RELAXED, __HIP_MEMORY_SCOPE_AGENT); if (t < (unsigned)CONV_NVB) it = 1024u + t; else cv_left = false; }
            if (it == 0xffffffffu && ml_left) { const unsigned x = xb_xcc_id() & 7u;
                for (unsigned j = 0; j < 8u; ++j) { const unsigned sidx = (x + j) & 7u; const unsigned t = __hip_atomic_fetch_add(queue + 8 + sidx, 1u, __ATOMIC_RELAXED, __HIP_MEMORY_SCOPE_AGENT); if (t < 64u) { it = (t << 3) | sidx; break; } }
                if (it == 0xffffffffu) ml_left = false; }
            if (it == 0xffffffffu && cv_left) { const unsigned t = __hip_atomic_fetch_add(queue + 16, 1u, __ATOMIC_RELAXED, __HIP_MEMORY_SCOPE_AGENT); if (t < (unsigned)CONV_NVB) it = 1024u + t; else cv_left = false; }
            flip = !flip;
            if (it == 0xffffffffu && cat_left) { const unsigned t = __hip_atomic_fetch_add(queue + 192 - 64 * l + 16 * l, 1u, __ATOMIC_RELAXED, __HIP_MEMORY_SCOPE_AGENT); if (t < (unsigned)CAT_NVB) it = 2048u + t; else cat_left = false; }
            if (it == 0xffffffffu) { const unsigned t = __hip_atomic_fetch_add(queue, 1u, __ATOMIC_RELAXED, __HIP_MEMORY_SCOPE_AGENT); it = affine ? (t < 512u ? 512u + t : 0xfffffffeu) : t; }
            qslot[0] = it; }
        __syncthreads();
        if (affine && qslot[0] == 0xfffffffeu) break;
        if (affine && qslot[0] >= 2048u) { phase_convert_layer(F, l, 4, (int)qslot[0] - 2048, CAT_NVB); continue; }
        const int item = (int)qslot[0] + lim_lo; if (item >= lim_hi || item >= 1024 + ((CONV1_IN_QUEUE && l == 0) ? CONV_NVB : 0)) break;
        if (item >= 1024) { phase_convert_layer(F, 1, 2, item - 1024, CONV_NVB); continue; }
        if (item >= 768) { scan2_item(F, item - 768); continue; }
        if (item >= 512) { xattn_item(F, l, item - 512); continue; }
        const int qt = 63 - (item >> 3), b = (item >> 2) & 1, hd = item & 3, t0 = qt * 64; const size_t rowb = (size_t)b * SEQ;
        const int tq = opaque_v(lane);
        const int q15 = tq & 15, qg = tq >> 4;
        bf16x8 qf[8];
#pragma unroll
        for (int ks = 0; ks < 8; ++ks) qf[ks] = *(const bf16x8*)(QC + (rowb + t0 + 16 * rt + q15) * 1024 + hd * 256 + 32 * ks + 8 * qg);
        float mxr[4];
#pragma unroll
        for (int j = 0; j < 4; ++j) mxr[j] = MX[(rowb + t0 + 16 * rt + qg * 4 + j) * 4 + hd];
        f32x4 num[4][4];
#pragma unroll
        for (int r4 = 0; r4 < 4; ++r4)
#pragma unroll
            for (int c4 = 0; c4 < 4; ++c4) num[r4][c4] = (f32x4){0.f, 0.f, 0.f, 0.f};
        float dacc[4] = {0.f, 0.f, 0.f, 0.f};
        asm volatile("s_waitcnt vmcnt(0)" ::: "memory");
        asm volatile("" : "+v"(qf[0]), "+v"(qf[1]), "+v"(qf[2]), "+v"(qf[3]), "+v"(qf[4]), "+v"(qf[5]), "+v"(qf[6]), "+v"(qf[7]));
        asm volatile("" : "+v"(mxr[0]), "+v"(mxr[1]), "+v"(mxr[2]), "+v"(mxr[3]));
#define ML_DMA_KV(kt_, bf_) do { const int s0_ = (kt_) * 32; const char* kb_ = (const char*)KC + ((rowb + s0_) * 1024 + hd * 256) * 2; const char* vb_ = (const char*)PROJ + ((rowb + s0_) * NPJ + PC_CV + hd * 512) * 2; \
            _Pragma("unroll") for (int i = 0; i < 2; ++i) { const int pc = w * 2 + i, row = 2 * pc + (lane >> 5), p = lane & 31; \
                __builtin_amdgcn_global_load_lds((const unsigned*)(kb_ + (size_t)row * 2048 + ((p ^ (row & 15)) * 16)), (LAS unsigned*)(lds + ML_K + (bf_) * 16384 + pc * 1024), 16, 0, 0); } \
            _Pragma("unroll") for (int i = 0; i < 4; ++i) { const int row = w * 4 + i; \
                __builtin_amdgcn_global_load_lds((const unsigned*)(vb_ + (size_t)row * (NPJ * 2) + ((lane ^ ml_vswz(row)) * 16)), (LAS unsigned*)(lds + ML_V + (bf_) * 32768 + row * 1024), 16, 0, 0); } \
            if (w == 0) __builtin_amdgcn_global_load_lds((const unsigned*)(G + (rowb + s0_ + (lane & 31)) * 4 + hd), (LAS unsigned*)(lds + ML_G + (bf_) * 256), 4, 0, 0); } while (0)
        const int nkt = 2 * qt + 2;
        ML_DMA_KV(0, 0); ML_DMA_KV(1, 1);
        int buf = 0;
        for (int kt = 0; kt < nkt; ++kt) {
            const int s0 = kt * 32;
            if (kt + 1 < nkt) { if (w == 0) asm volatile("s_waitcnt vmcnt(7) lgkmcnt(0)" ::: "memory"); else asm volatile("s_waitcnt vmcnt(6) lgkmcnt(0)" ::: "memory"); }
            else asm volatile("s_waitcnt vmcnt(0) lgkmcnt(0)" ::: "memory");
            __builtin_amdgcn_s_barrier(); asm volatile("" ::: "memory");
            { const int bf2 = buf >= 1 ? buf - 1 : 2; if (kt + 2 < nkt) ML_DMA_KV(kt + 2, bf2); }
            const LAS unsigned char* kb = lds + ML_K + buf * 16384; const LAS unsigned char* vbuf = lds + ML_V + buf * 32768; const LAS float* gl = (const LAS float*)(lds + ML_G + buf * 256);
            f32x4 sacc = (f32x4){0.f, 0.f, 0.f, 0.f};
            { bf16x8 kf[8];
#pragma unroll
              for (int ks = 0; ks < 8; ++ks) { const int r = 16 * ctp + l15; kf[ks] = *(const LAS bf16x8*)(kb + r * 512 + (((4 * ks + lg) ^ (r & 15)) * 16)); }
              asm volatile("" : "+v"(kf[0]), "+v"(kf[1]), "+v"(kf[2]), "+v"(kf[3]), "+v"(kf[4]), "+v"(kf[5]), "+v"(kf[6]), "+v"(kf[7]));
              f32x4 sacc1 = (f32x4){0.f, 0.f, 0.f, 0.f};
#pragma unroll
              for (int ks = 0; ks < 8; ks += 2) { sacc = __builtin_amdgcn_mfma_f32_16x16x32_bf16(qf[ks], kf[ks], sacc, 0, 0, 0); sacc1 = __builtin_amdgcn_mfma_f32_16x16x32_bf16(qf[ks + 1], kf[ks + 1], sacc1, 0, 0, 0); }
              sacc += sacc1; }
            { const int sl = 16 * ctp + l15; const float gs = gl[sl];
#pragma unroll
                for (int j = 0; j < 4; ++j) { const int tl = 16 * rt + lg * 4 + j;
                    const float wgt = (s0 + sl <= t0 + tl) ? __expf(gs - mxr[j]) : 0.f; const float val = sacc[j] * wgt;
                    *(LAS unsigned short*)(lds + ML_S + tl * ML_SROW + sl * 2) = (unsigned short)f2bf(val);
                    dacc[j] += row16_sum(val); } }
            asm volatile("s_waitcnt lgkmcnt(0)" ::: "memory"); __builtin_amdgcn_s_barrier(); asm volatile("" ::: "memory");
            { bf16x8 afr[4];
#pragma unroll
                for (int r4 = 0; r4 < 4; ++r4) afr[r4] = *(const LAS bf16x8*)(lds + ML_S + (16 * r4 + l15) * ML_SROW + (8 * lg) * 2);
                unsigned va[4];
#pragma unroll
                for (int c4 = 0; c4 < 4; ++c4) { const int r = 8 * lg + (l15 >> 2), ch = 8 * w + 2 * c4 + ((l15 & 3) >> 1); va[c4] = (unsigned)(size_t)(vbuf + r * 1024 + ((ch ^ ml_vswz(r)) * 16) + (l15 & 1) * 8); }
                s16x4 lo[4], hi[4];
                asm volatile("ds_read_b64_tr_b16 %0, %8\n\tds_read_b64_tr_b16 %1, %8 offset:4096\n\tds_read_b64_tr_b16 %2, %9\n\tds_read_b64_tr_b16 %3, %9 offset:4096\n\t"
                             "ds_read_b64_tr_b16 %4, %10\n\tds_read_b64_tr_b16 %5, %10 offset:4096\n\tds_read_b64_tr_b16 %6, %11\n\tds_read_b64_tr_b16 %7, %11 offset:4096\n\ts_waitcnt lgkmcnt(0)"
                             : "=&v"(lo[0]), "=&v"(hi[0]), "=&v"(lo[1]), "=&v"(hi[1]), "=&v"(lo[2]), "=&v"(hi[2]), "=&v"(lo[3]), "=&v"(hi[3]) : "v"(va[0]), "v"(va[1]), "v"(va[2]), "v"(va[3]) : "memory");
#pragma unroll
                for (int c4 = 0; c4 < 4; ++c4) { const bf16x8 bfr = __builtin_shufflevector(lo[c4], hi[c4], 0, 1, 2, 3, 4, 5, 6, 7);
#pragma unroll
                    for (int r4 = 0; r4 < 4; ++r4) num[r4][c4] = __builtin_amdgcn_mfma_f32_16x16x32_bf16(afr[r4], bfr, num[r4][c4], 0, 0, 0); } }
            buf = buf == 2 ? 0 : buf + 1;
        }
#undef ML_DMA_KV
        if (l15 == 0) {
#pragma unroll
            for (int j = 0; j < 4; ++j) denl[(16 * rt + lg * 4 + j) * 2 + ctp] = dacc[j]; }
        __syncthreads();
        { unsigned short co[4][4][4]; float mtv[4][4];
#pragma unroll
          for (int r4 = 0; r4 < 4; ++r4)
#pragma unroll
            for (int j = 0; j < 4; ++j) { const size_t row = rowb + t0 + 16 * r4 + lg * 4 + j; mtv[r4][j] = MT[row * 4 + hd];
#pragma unroll
                for (int c4 = 0; c4 < 4; ++c4) co[r4][j][c4] = PROJ[row * NPJ + PC_CO + hd * 512 + 64 * w + 16 * c4 + l15]; }
#pragma unroll
          for (int r4 = 0; r4 < 4; ++r4)
#pragma unroll
            for (int j = 0; j < 4; ++j) { const int tl = 16 * r4 + lg * 4 + j; const size_t row = rowb + t0 + tl;
                const float den = denl[2 * tl] + denl[2 * tl + 1], mt = mtv[r4][j]; const float inv = __builtin_amdgcn_rcpf(fmaxf(fabsf(den), __expf(-mt)));
#pragma unroll
                for (int c4 = 0; c4 < 4; ++c4) { const int dv = 64 * w + 16 * c4 + l15; const float o = sigm(bf2f(co[r4][j][c4]));
                    HC[row * 2048 + hd * 512 + dv] = num[r4][c4][j] * inv * o; } } }
        asm volatile("s_waitcnt vmcnt(0)" ::: "memory"); __syncthreads();
        { const float* gw_ = KIN(I_MGNW) + (size_t)l * 2048; bf16* Y = (bf16*)(KWS() + WS_Y); const int ch = hd * 512 + lane * 8;
          f32x4 hv0[8], hv1[8]; u32x4 hg[8]; const f32x4 gwa = *(const f32x4*)(gw_ + ch), gwb = *(const f32x4*)(gw_ + ch + 4);
#pragma unroll
          for (int rr = 0; rr < 8; ++rr) { const size_t t = rowb + t0 + w * 8 + rr; hv0[rr] = *(const f32x4*)(HC + t * 2048 + ch); hv1[rr] = *(const f32x4*)(HC + t * 2048 + ch + 4); hg[rr] = *(const u32x4*)(PROJ + t * NPJ + PC_CG + ch); }
          asm volatile("" ::: "memory");
#pragma unroll
          for (int rr = 0; rr < 8; ++rr) { const size_t t = rowb + t0 + w * 8 + rr;
            const f32x4 v0 = hv0[rr], v1 = hv1[rr];
            float x[8] = {v0.x, v0.y, v0.z, v0.w, v1.x, v1.y, v1.z, v1.w}; float sm_ = 0.f;
#pragma unroll
            for (int q = 0; q < 8; ++q) sm_ += x[q];
            const float mean = wave_sum(sm_) * (1.0f / 512.0f); float s2 = 0.f;
#pragma unroll
            for (int q = 0; q < 8; ++q) { x[q] -= mean; s2 += x[q] * x[q]; }
            const float rstd = rsqrtf(wave_sum(s2) * (1.0f / 512.0f) + 1e-6f);
            float gf[8]; unpack8(hg[rr], gf); float o[8];
#pragma unroll
            for (int q = 0; q < 8; ++q) o[q] = x[q] * rstd * (q < 4 ? gwa[q] : gwb[q - 4]) * siluf_(gf[q]);
            u32x4 wv; wv.x = pk2(o[0], o[1]); wv.y = pk2(o[2], o[3]); wv.z = pk2(o[4], o[5]); wv.w = pk2(o[6], o[7]);
            *(u32x4*)(Y + t * KCAT + YC_C + ch) = wv; } }
    }
    __syncthreads();
}

constexpr int XA_ROW = 272, XA_K = 0, XA_V = 256 * XA_ROW, XA_END = 2 * 256 * XA_ROW, XA_PROW = 528;
static_assert(XA_END <= RING_BYTES && 8 * 16 * XA_PROW <= XA_V, "x-attn LDS");
__device__ __forceinline__ void xattn_item(const Frame& F, int l, const int item) {
    const bf16* PROJ = (const bf16*)(KWS() + WS_PROJ); const bf16* KV = (const bf16*)(KWS() + WS_KV) + (size_t)l * MM * 1024; bf16* Y = (bf16*)(KWS() + WS_Y);
    LAS unsigned char* lds = F.lds; const int lane = opaque_v(F.lane), w = F.wave, tid = w * 64 + lane, l15 = lane & 15, lg = lane >> 4;
    {
        const int b = item >> 7, hd = (item >> 5) & 3, qb = item & 31; const size_t row0 = (size_t)b * SEQ + qb * 128 + 16 * w;
        __syncthreads();
        { u32x4 kq[8], vq[8];
#pragma unroll
          for (int i = 0; i < 8; ++i) { const int p = tid + 512 * i, r = p >> 4, c16 = p & 15; const bf16* src = KV + (size_t)(b * MEML + r) * 1024 + hd * 128 + c16 * 8; kq[i] = *(const u32x4*)src; vq[i] = *(const u32x4*)(src + 512); }
          asm volatile("" : "+v"(kq[0]), "+v"(kq[1]), "+v"(kq[2]), "+v"(kq[3]), "+v"(kq[4]), "+v"(kq[5]), "+v"(kq[6]), "+v"(kq[7]), "+v"(vq[0]), "+v"(vq[1]), "+v"(vq[2]), "+v"(vq[3]), "+v"(vq[4]), "+v"(vq[5]), "+v"(vq[6]), "+v"(vq[7]) :: "memory");
#pragma unroll
          for (int i = 0; i < 8; ++i) { const int p = tid + 512 * i, r = p >> 4, c16 = p & 15; *(LAS u32x4*)(lds + XA_K + r * XA_ROW + c16 * 16) = kq[i]; *(LAS u32x4*)(lds + XA_V + r * XA_ROW + c16 * 16) = vq[i]; } }
        bf16x8 qf[4];
#pragma unroll
        for (int ks = 0; ks < 4; ++ks) qf[ks] = *(const bf16x8*)(PROJ + (row0 + l15) * NPJ + PC_XQ + hd * 128 + 32 * ks + 8 * lg);
        unsigned short xg[4][8];
#pragma unroll
        for (int j = 0; j < 4; ++j)
#pragma unroll
            for (int cc = 0; cc < 8; ++cc) xg[j][cc] = PROJ[(row0 + lg * 4 + j) * NPJ + PC_XG + hd * 128 + 16 * cc + l15];
        __syncthreads();
        f32x4 sacc[16];
#pragma unroll
        for (int ct = 0; ct < 16; ++ct) { sacc[ct] = (f32x4){0.f, 0.f, 0.f, 0.f};
#pragma unroll
            for (int ks = 0; ks < 4; ++ks) { const bf16x8 bfr = *(const LAS bf16x8*)(lds + XA_K + (16 * ct + l15) * XA_ROW + (32 * ks + 8 * lg) * 2);
                sacc[ct] = __builtin_amdgcn_mfma_f32_16x16x32_bf16(qf[ks], bfr, sacc[ct], 0, 0, 0); } }
        float mx[4], sm[4];
#pragma unroll
        for (int j = 0; j < 4; ++j) { float m = sacc[0][j];
#pragma unroll
            for (int ct = 1; ct < 16; ++ct) m = fmaxf(m, sacc[ct][j]);
            mx[j] = row16_max(m); sm[j] = 0.f; }
        __syncthreads();
        LAS unsigned char* pw = lds + XA_K + w * 16 * XA_PROW;
#pragma unroll
        for (int ct = 0; ct < 16; ++ct)
#pragma unroll
            for (int j = 0; j < 4; ++j) { const float p = __expf((sacc[ct][j] - mx[j]) * 0.08838834764831845f); sm[j] += p;
                *(LAS unsigned short*)(pw + (lg * 4 + j) * XA_PROW + (16 * ct + l15) * 2) = (unsigned short)f2bf(p); }
#pragma unroll
        for (int j = 0; j < 4; ++j) sm[j] = row16_sum(sm[j]);
        LDS_WAIT(); asm volatile("" ::: "memory");
        f32x4 oacc[8];
#pragma unroll
        for (int cc = 0; cc < 8; ++cc) oacc[cc] = (f32x4){0.f, 0.f, 0.f, 0.f};
#pragma unroll
        for (int ks = 0; ks < 8; ++ks) { const bf16x8 afr = *(const LAS bf16x8*)(pw + l15 * XA_PROW + (32 * ks + 8 * lg) * 2);
#pragma unroll
            for (int cc = 0; cc < 8; ++cc) { const LAS unsigned char* vp = lds + XA_V + (32 * ks + 8 * lg + (l15 >> 2)) * XA_ROW + (16 * cc + 4 * (l15 & 3)) * 2;
                const s16x4 lo = tr16(vp), hi = tr16(vp + 4 * XA_ROW); const bf16x8 bfr = __builtin_shufflevector(lo, hi, 0, 1, 2, 3, 4, 5, 6, 7);
                oacc[cc] = __builtin_amdgcn_mfma_f32_16x16x32_bf16(afr, bfr, oacc[cc], 0, 0, 0); } }
#pragma unroll
        for (int j = 0; j < 4; ++j) { const size_t row = row0 + lg * 4 + j; const float inv = __builtin_amdgcn_rcpf(sm[j]);
#pragma unroll
            for (int cc = 0; cc < 8; ++cc) { const int d = 16 * cc + l15; const float gate = siluf_(bf2f(xg[j][cc]));
                Y[row * KCAT + YC_X + hd * 128 + d] = (bf16)f2bf(oacc[cc][j] * inv * gate); } }
    }
    __syncthreads();
}

constexpr int NPL = 9, NPHASE = 2 + DEPTH * NPL;
struct Args { Ctx c; int ph_lo, ph_hi; };
template <unsigned PH_MASK> __global__ void __launch_bounds__(NTHREADS, 2) mega(Args args) {
    extern __shared__ __attribute__((aligned(16))) unsigned char lds_raw[];
    Frame F; F.lds = (LAS unsigned char*)lds_raw; F.wave = __builtin_amdgcn_readfirstlane((int)threadIdx.x >> 6); F.lane = lane_id(); F.tid = F.wave * 64 + F.lane; F.bid = blockIdx.x; F.nblk = gridDim.x;
    volatile LAS unsigned* MISC = (volatile LAS unsigned*)(F.lds + MISC_OFF);
    if (F.tid < 16) MISC[F.tid] = 0u;
    __syncthreads();
    const int lo = args.ph_lo, hi = args.ph_hi;
    XcdBarrier bar; bar.bar = (unsigned*)(KWS() + WS_CTL) + CW_BAR; bar.st = MISC + 8;
    if (PH_MASK == 0x7FFu) { if (hi - lo > 1) xcd_barrier_setup(bar, F.wave); }
#ifndef PROBE_DUP
#define PROBE_DUP 0u
#endif
#define DUP(j) (((PROBE_DUP >> (j)) & 1u) ? 2 : 1)
#define IN(k) (lo <= (k) && (k) < hi)
#define EN(j) ((PH_MASK >> (j)) & 1u)
#define SEAM(k) do { if (PH_MASK == 0x7FFu) { if (IN(k) && IN((k) + 1)) xcd_barrier(bar, F.wave); } } while (0)
    if (IN(0) && EN(0)) for (int rep = 0; rep < DUP(0); ++rep) { phase_convert_layer(F, 0, 1, F.bid, F.nblk); phase_convert_layer(F, 1, CONV1_IN_QUEUE ? 1 : 7, F.bid, F.nblk);
        { unsigned* ctr = (unsigned*)(KWS() + WS_CTL) + CW_QUEUE + 128 + 16 * rep; volatile LAS unsigned* qs = MISC;
          for (;;) { __syncthreads(); if (F.tid == 0) qs[0] = __hip_atomic_fetch_add(ctr, 1u, __ATOMIC_RELAXED, __HIP_MEMORY_SCOPE_AGENT); __syncthreads();
              const int vb = (int)qs[0]; if (vb >= CONV_NVB + 256) break;
              if (vb < CONV_NVB) phase_convert_layer(F, 0, 2, vb, CONV_NVB);
              else { Frame Fv = F; Fv.bid = vb - CONV_NVB; Fv.nblk = 256; phase_norm(Fv, KIN(I_X), KIN(I_NORM_G), false); } } } }
    SEAM(0);
    for (int l0 = 0; l0 < DEPTH; ++l0) {
        const int l = opaque_s(l0);
        const int pb = 2 + l * NPL;
        if (IN(pb + 0) && EN(2)) for (int rep = 0; rep < DUP(2); ++rep) {
            if (l == 0) {
                for (int l2 = 0; l2 < DEPTH; ++l2) { unsigned char* ws = KWS(); unsigned char* wl2 = ws + WS_W + (size_t)l2 * SZ_WLAYER;
                    pg8::Gemm g{(const char*)(ws + WS_MEMN) + (size_t)l2 * MM * 4096 * 2, (const char*)(wl2 + WO_WKV)};
                    EpiProj<1024, false> E{(bf16*)(ws + WS_KV) + (size_t)l2 * MM * 1024, nullptr};
                    const int cc = F.bid - (F.nblk - 16) - 8 * l2;
                    pg8::gemm_phase<pg8::Geo<8192, 8192, 4096, MM / 256, 4>, EpiProj<1024, false>>(F.lds, g, 8, (cc >= 0 && cc < 8) ? cc : 1000, F.wave, E); }
            }
            unsigned char* ws = KWS(); unsigned char* wl = ws + WS_W + (size_t)l * SZ_WLAYER;
            { pg8::Gemm g{(const char*)(ws + WS_H), (const char*)(wl + WO_WIN)};
              EpiProj<NPJ, true> E{(bf16*)(ws + WS_PROJ), (float*)(ws + WS_IFB)};
              pg8::gemm_phase<pg8::Geo<8192, 8192, 4096, M / 256, PN_I8>, EpiProj<NPJ, true>>(F.lds, g, F.nblk, F.bid, F.wave, E); }
            { pg8::Gemm g{(const char*)(ws + WS_H8), (const char*)(wl + WO_WIN) + (size_t)PC_I8 * 8192};
              EpiGate8 E{(bf16*)(ws + WS_PROJ) + PC_I8, (const float*)(ws + WS_HS), (const unsigned*)(ws + WS_CTL) + CW_CMAX + l * N8};
              pg8::gemm_phase<pg8::Geo<4096, 4096, 2048, M / 256, N8 / 256, 0, 0, true>, EpiGate8>(F.lds, g, F.nblk, F.bid, F.wave, E); }
            if (CONV1_IN_QUEUE && F.nblk == 256 && F.bid >= 192 && !(l == 0 && F.bid >= 240)) {
                unsigned* cat = (unsigned*)(KWS() + WS_CTL) + CW_QUEUE + 192 + 16 * l; volatile LAS unsigned* qs = MISC;
                for (int k = 0; k < 1; ++k) { __syncthreads(); if (F.tid == 0) qs[0] = __hip_atomic_fetch_add(cat, 1u, __ATOMIC_RELAXED, __HIP_MEMORY_SCOPE_AGENT); __syncthreads();
                    const int vb = (int)qs[0]; if (vb >= CAT_NVB) break; phase_convert_layer(F, l, 4, vb, CAT_NVB); } }
        }
        SEAM(pb + 0);
        if (IN(pb + 1) && EN(3)) for (int rep = 0; rep < DUP(3); ++rep) { phase_prep(F, l); }
        SEAM(pb + 1);
        if (IN(pb + 2) && EN(4)) for (int rep = 0; rep < DUP(4); ++rep) {
            { unsigned char* ws = KWS(); unsigned char* wl = ws + WS_W + (size_t)l * SZ_WLAYER;
              pg8::Gemm g{(const char*)(ws + WS_U), (const char*)(wl + WO_WG)};
              EpiLru E{(const bf16*)(ws + WS_U), (float*)(ws + WS_LA), (float*)(ws + WS_LB), KIN(I_LRU_BA) + (size_t)l * 2048, KIN(I_LRU_BX) + (size_t)l * 2048, KIN(I_LRU_LAM) + (size_t)l * 2048};
              pg8::gemm_phase<pg8::Geo<4096, 512, 256, M / 256, 16, 1, 512>, EpiLru>(F.lds, g, F.nblk, F.bid, F.wave, E); }
            { unsigned char* ws = KWS(); unsigned char* wl = ws + WS_W + (size_t)l * SZ_WLAYER;
              pg8::Gemm g{(const char*)(ws + WS_LORA), (const char*)(wl + WO_WL)};
              EpiLora E{(float*)(ws + WS_RV), (float*)(ws + WS_AA), KIN(I_W0) + (size_t)l * 2048, KIN(I_A0) + (size_t)l * 2048};
              pg8::gemm_phase<pg8::Geo<512, 512, 256, M / 256, 16>, EpiLora>(F.lds, g, F.nblk, F.bid, F.wave, E); }
        }
        SEAM(pb + 2);
        if (IN(pb + 3) && EN(5)) for (int rep = 0; rep < DUP(5); ++rep) { phase_rwkv_vec(F, l); phase_lru_scan1(F); }
        SEAM(pb + 3);
        if (IN(pb + 4) && EN(6)) {
            for (int rep = 0; rep < DUP(6); ++rep) phase_rwkv_rec(F, F.bid, F.nblk);
#ifdef PROBE_Q
            phase_mlstm(F, l, (unsigned*)(KWS() + WS_CTL) + CW_QUEUE + 64 * l + 32, PROBE_Q_LO, PROBE_Q_HI);
#endif
            phase_mlstm(F, l, (unsigned*)(KWS() + WS_CTL) + CW_QUEUE + 64 * l);
        }
        SEAM(pb + 4);
        if (IN(pb + 5) && EN(7)) for (int rep = 0; rep < DUP(7); ++rep) { phase_rwkv_post(F, l); }
        SEAM(pb + 5);
        if (IN(pb + 6) && EN(8)) for (int rep = 0; rep < DUP(8); ++rep) {
            unsigned char* ws = KWS(); unsigned char* wl = ws + WS_W + (size_t)l * SZ_WLAYER;
            pg8::Gemm g{(const char*)(ws + WS_Y), (const char*)(wl + WO_WCAT)};
            EpiMerge E{(const bf16*)(ws + WS_PROJ) + PC_GATE, (bf16*)(ws + WS_MERGED)};
            pg8::gemm_phase<pg8::Geo<KCAT * 2, KCAT * 2, KCAT, M / 256, 16>, EpiMerge>(F.lds, g, F.nblk, F.bid, F.wave, E);
        }
        SEAM(pb + 6);
        if (IN(pb + 7) && EN(9)) for (int rep = 0; rep < ((l == 0) ? DUP(9) : 1); ++rep) {
            unsigned char* ws = KWS(); unsigned char* wl = ws + WS_W + (size_t)l * SZ_WLAYER;
            pg8::Gemm g{(const char*)(ws + WS_MERGED), (const char*)(wl + WO_WOUT)};
            EpiOut E{(l == 0) ? KIN(I_X) : (const float*)(ws + WS_X1), (float*)(ws + WS_X1)};
            pg8::gemm_phase<pg8::Geo<8192, 8192, 4096, M / 256, 16>, EpiOut>(F.lds, g, F.nblk, F.bid, F.wave, E);
        }
        SEAM(pb + 7);
        if (IN(pb + 8) && EN(10)) { const float* X1 = (const float*)(KWS() + WS_X1); if (l + 1 < DEPTH) phase_norm(F, X1, KIN(I_NORM_G) + (size_t)(l + 1) * 4096, false); else phase_norm(F, X1, KIN(I_FNG), true); }
        SEAM(pb + 8);
    }
#undef IN
#undef SEAM
}

typedef void (*kern_t)(Args);
static kern_t phase_kernel(int p) {
    const int j = p < 2 ? p : 2 + (p - 2) % NPL;
    switch (j) { case 0: return mega<1u << 0>; case 1: return mega<1u << 1>; case 2: return mega<1u << 2>; case 3: return mega<1u << 3>; case 4: return mega<1u << 4>; case 5: return mega<1u << 5>;
                 case 6: return mega<1u << 6>; case 7: return mega<1u << 7>; case 8: return mega<1u << 8>; case 9: return mega<1u << 9>; default: return mega<1u << 10>; }
}
extern "C" void kernel_launch(void* const* d_in, const int* in_sizes, int n_in, void* d_out, int out_size, void* d_ws, size_t ws_size, hipStream_t stream) {
    static int grid = 0;
    if (grid == 0) {
        if (n_in != 34 || ws_size < WS_END) { fprintf(stderr, "kernel_launch: unexpected problem (n_in %d, ws %zu, need %zu)\n", n_in, ws_size, (size_t)WS_END); grid = -1; return; }
        int dev = 0, cus = 0;
        if (hipGetDevice(&dev) != hipSuccess || hipDeviceGetAttribute(&cus, hipDeviceAttributeMultiprocessorCount, dev) != hipSuccess) { grid = -1; return; }
#if MK_PER_PHASE
        for (int p = 0; p < 2 + NPL; ++p) if (hipFuncSetAttribute((const void*)phase_kernel(p), hipFuncAttributeMaxDynamicSharedMemorySize, LDS_BYTES) != hipSuccess) { fprintf(stderr, "kernel_launch: hipFuncSetAttribute failed\n"); grid = -1; return; }
#else
        if (hipFuncSetAttribute((const void*)mega<0x7FFu>, hipFuncAttributeMaxDynamicSharedMemorySize, LDS_BYTES) != hipSuccess) { fprintf(stderr, "kernel_launch: hipFuncSetAttribute failed\n"); grid = -1; return; }
#endif
        int occ = 0;
#if MK_PER_PHASE
        occ = 1;
#else
        if (hipOccupancyMaxActiveBlocksPerMultiprocessor(&occ, mega<0x7FFu>, NTHREADS, LDS_BYTES) != hipSuccess || occ < 1) { fprintf(stderr, "kernel_launch: occupancy query reports %d workgroups per CU\n", occ); grid = -1; return; }
#endif
        (void)hipGetLastError();
        grid = cus;
    }
    if (grid < 0) return;
    (void)hipMemsetAsync((char*)d_ws + WS_CTL, 0, CTL_ZERO_BYTES, stream);
    Args a{};
    for (int i = 0; i < 34; ++i) a.c.in[i] = (const float*)d_in[i];
    a.c.out = (float*)d_out; a.c.ws = (unsigned char*)d_ws;
#if MK_PER_PHASE
    for (int p = 0; p < NPHASE; ++p) { a.ph_lo = p; a.ph_hi = p + 1; hipLaunchKernelGGL(phase_kernel(p), dim3(grid), dim3(NTHREADS), LDS_BYTES, stream, a); }
#else
    a.ph_lo = 0; a.ph_hi = NPHASE; hipLaunchKernelGGL(mega<0x7FFu>, dim3(grid), dim3(NTHREADS), LDS_BYTES, stream, a);
#endif
    (void)in_sizes; (void)out_size;
}
```
